# Optimizing an MI355X kernel written in HIP

```python
import jax, jax.numpy as jnp
from jax import lax
import numpy as np

D_MODEL = 1024
BATCH = 2
SEQ = 8192
DEPTH = 2

CHUNK = 64
D_MIX = D_MODEL
HEAD_DIM = 64
ATT_WIDTH = 3 * D_MIX // 8
ATT_HEADS = ATT_WIDTH // HEAD_DIM
ATT_PAST_CHUNKS = 8
ATT_BAND = (ATT_PAST_CHUNKS + 1) * CHUNK
REL_CLIP = 128
ML_WIDTH = 3 * D_MIX // 8
ML_HEADS = ML_WIDTH // HEAD_DIM
CONV_WIDTH = 4
GLA_WIDTH = D_MIX - ATT_WIDTH - ML_WIDTH
GLA_HEADS = 4
GLA_DV = GLA_WIDTH // GLA_HEADS
GLA_DK = GLA_DV // 2
GLA_KW = GLA_HEADS * GLA_DK
GLA_RANK = 16
GLA_TAU = 16.0
IN_SPLITS = (ATT_WIDTH, ATT_WIDTH, ATT_WIDTH, ATT_WIDTH,
             ML_WIDTH, ML_WIDTH, ML_WIDTH, ML_WIDTH, ML_HEADS, ML_HEADS, ML_WIDTH,
             GLA_KW, GLA_KW, GLA_WIDTH, GLA_RANK, GLA_WIDTH)
D_IN = sum(IN_SPLITS)
EPS = 1e-6
NEG = -1e30

kernel_name = "hymba_chunk_attn_mlstm_gla_trunk"


def rmsnorm(x, g):
    xf = x.astype(jnp.float32)
    y = xf * lax.rsqrt(jnp.mean(xf * xf, axis=-1, keepdims=True) + EPS)
    return (y * g.astype(jnp.float32)).astype(x.dtype)


def head_rmsnorm(x, g, n_heads):
    b, s, w = x.shape
    y = rmsnorm(x.reshape(b, s, n_heads, w // n_heads), g.reshape(n_heads, w // n_heads))
    return y.reshape(b, s, w)


def causal_conv(x, w):
    k_w = w.shape[0]
    s = x.shape[1]
    xp = jnp.pad(x, ((0, 0), (k_w - 1, 0), (0, 0)))
    return sum(xp[:, j:j + s] * w[j] for j in range(k_w))


def band_chunk_attention(q, k, v, rel_bias):
    bsz, s, h, d = q.shape
    nc = s // CHUNK
    pad = ATT_PAST_CHUNKS * CHUNK
    qc = q.reshape(bsz, nc, CHUNK, h, d)
    kp = jnp.pad(k, ((0, 0), (pad, 0), (0, 0), (0, 0))).reshape(bsz, nc + ATT_PAST_CHUNKS, CHUNK, h, d)
    vp = jnp.pad(v, ((0, 0), (pad, 0), (0, 0), (0, 0))).reshape(bsz, nc + ATT_PAST_CHUNKS, CHUNK, h, d)
    kb = jnp.concatenate([kp[:, m:m + nc] for m in range(ATT_PAST_CHUNKS + 1)], axis=2)
    vb = jnp.concatenate([vp[:, m:m + nc] for m in range(ATT_PAST_CHUNKS + 1)], axis=2)
    scores = jnp.einsum('bnqhd,bnkhd->bnhqk', qc, kb).astype(jnp.float32) * (d ** -0.5)
    rel = jnp.arange(CHUNK)[:, None] + pad - jnp.arange(ATT_BAND)[None, :]
    bias = rel_bias[:, jnp.clip(rel, -REL_CLIP, REL_CLIP) + REL_CLIP].astype(jnp.float32)
    kpos = (jnp.arange(nc)[:, None] - ATT_PAST_CHUNKS) * CHUNK + jnp.arange(ATT_BAND)[None, :]
    valid = kpos >= 0
    scores = jnp.where(valid[None, :, None, None, :], scores + bias[None, None], NEG)
    p = jax.nn.softmax(scores, axis=-1).astype(v.dtype)
    o = jnp.einsum('bnhqk,bnkhd->bnqhd', p, vb)
    return o.reshape(bsz, s, h * d)


def mlstm_chunkwise(q, k, v, i_pre, f_pre):
    bsz, s, h, d = q.shape
    nc = s // CHUNK
    L = CHUNK
    dt = q.dtype
    qc = q.astype(jnp.float32).reshape(bsz, nc, L, h, d)
    kc = (k.astype(jnp.float32) * (d ** -0.5)).reshape(bsz, nc, L, h, d)
    vc = v.astype(jnp.float32).reshape(bsz, nc, L, h, d)
    ig = i_pre.astype(jnp.float32).reshape(bsz, nc, L, h).transpose(0, 1, 3, 2)
    lf = jax.nn.log_sigmoid(f_pre.astype(jnp.float32)).reshape(bsz, nc, L, h).transpose(0, 1, 3, 2)
    bcum = jnp.cumsum(lf, axis=-1)
    g = bcum[..., -1]
    a = g[..., None] - bcum + ig
    m_loc = jnp.max(a, axis=-1)
    w = jnp.exp(a - m_loc[..., None])
    c_loc = jnp.einsum('bnhj,bnjhv,bnjhk->bnhvk', w, vc, kc)
    n_loc = jnp.einsum('bnhj,bnjhk->bnhk', w, kc)

    def step(carry, xs):
        c_st, n_st, m_st = carry
        g_c, m_l, c_l, n_l = xs
        m_new = jnp.maximum(g_c + m_st, m_l)
        s_old = jnp.exp(g_c + m_st - m_new)
        s_new = jnp.exp(m_l - m_new)
        c_new = s_old[..., None, None] * c_st + s_new[..., None, None] * c_l
        n_new = s_old[..., None] * n_st + s_new[..., None] * n_l
        return (c_new, n_new, m_new), (c_st, n_st, m_st)

    init = (jnp.zeros((bsz, h, d, d), jnp.float32), jnp.zeros((bsz, h, d), jnp.float32),
            jnp.zeros((bsz, h), jnp.float32))
    xs = (jnp.moveaxis(g, 1, 0), jnp.moveaxis(m_loc, 1, 0), jnp.moveaxis(c_loc, 1, 0), jnp.moveaxis(n_loc, 1, 0))
    _, (c_prev, n_prev, m_prev) = lax.scan(step, init, xs)
    c_prev = jnp.moveaxis(c_prev, 0, 1)
    n_prev = jnp.moveaxis(n_prev, 0, 1)
    m_prev = jnp.moveaxis(m_prev, 0, 1)

    causal = jnp.tril(jnp.ones((L, L), dtype=bool))
    log_d = jnp.where(causal, bcum[..., :, None] - bcum[..., None, :] + ig[..., None, :], NEG)
    inter_log = bcum + m_prev[..., None]
    m_row = jnp.maximum(inter_log, jnp.max(log_d, axis=-1))
    d_mat = jnp.exp(log_d - m_row[..., None])
    inter_w = jnp.exp(inter_log - m_row)
    sc = jnp.einsum('bnthd,bnjhd->bnhtj', qc, kc) * d_mat
    num = jnp.einsum('bnhtj,bnjhv->bnthv', sc, vc) + \
        inter_w.transpose(0, 1, 3, 2)[..., None] * jnp.einsum('bnhvk,bnthk->bnthv', c_prev, qc)
    den = jnp.sum(sc, axis=-1) + inter_w * jnp.einsum('bnhk,bnthk->bnht', n_prev, qc)
    den = jnp.maximum(jnp.abs(den), jnp.exp(-m_row))
    out = num / den.transpose(0, 1, 3, 2)[..., None]
    return out.reshape(bsz, s, h * d).astype(dt)


def gla_chunkwise(q, k, v, log_alpha):
    bsz, s, h, dk = q.shape
    dv = v.shape[-1]
    nc = s // CHUNK
    L = CHUNK
    dt = q.dtype

    def to_chunks(t):
        return jnp.moveaxis(t.astype(jnp.float32).reshape(bsz, nc, L, h, t.shape[-1]), 1, 0)

    xs = (to_chunks(q * (dk ** -0.5)), to_chunks(k), to_chunks(v), to_chunks(log_alpha))
    causal = jnp.tril(jnp.ones((L, L), dtype=bool))

    def step(state, chunk):
        qx, kx, vx, la = chunk
        bcum = jnp.cumsum(la, axis=1)
        diff = bcum[:, :, None] - bcum[:, None, :]
        decay = jnp.where(causal[None, :, :, None, None], jnp.exp(jnp.minimum(diff, 0.0)), 0.0)
        att = jnp.einsum('bthd,bjhd,btjhd->bhtj', qx, kx, decay)
        o_intra = jnp.einsum('bhtj,bjhv->bthv', att, vx)
        o_inter = jnp.einsum('bthd,bhdv->bthv', qx * jnp.exp(bcum), state)
        btot = bcum[:, -1]
        k_dec = kx * jnp.exp(btot[:, None] - bcum)
        state_new = jnp.exp(btot)[..., None] * state + jnp.einsum('bjhd,bjhv->bhdv', k_dec, vx)
        return state_new, o_intra + o_inter

    _, o = lax.scan(step, jnp.zeros((bsz, h, dk, dv), jnp.float32), xs)
    return jnp.moveaxis(o, 0, 1).reshape(bsz, s, h * dv).astype(dt)


def hybrid_layer(x, norm_g, w_in, b_gates, conv_w, w_alpha, b_alpha, rel_bias, ml_norm_g, gla_norm_g, w_out):
    bsz, s, _ = x.shape
    hn = rmsnorm(x, norm_g)
    z = jnp.einsum('bsd,de->bse', hn, w_in)
    split_idx = [int(i) for i in np.cumsum(IN_SPLITS)[:-1]]
    (aq, ak, av, ag, mq, mk, mv, mo, mi, mf, mg, gq, gk, gv, ga, gg) = jnp.split(z, split_idx, axis=-1)

    att = band_chunk_attention(aq.reshape(bsz, s, ATT_HEADS, HEAD_DIM), ak.reshape(bsz, s, ATT_HEADS, HEAD_DIM),
                               av.reshape(bsz, s, ATT_HEADS, HEAD_DIM), rel_bias)
    y_a = att * jax.nn.silu(ag)

    qk = jax.nn.silu(causal_conv(jnp.concatenate([mq, mk], axis=-1), conv_w))
    mq_c, mk_c = qk[..., :ML_WIDTH], qk[..., ML_WIDTH:]
    h_ml = mlstm_chunkwise(mq_c.reshape(bsz, s, ML_HEADS, HEAD_DIM), mk_c.reshape(bsz, s, ML_HEADS, HEAD_DIM),
                           mv.reshape(bsz, s, ML_HEADS, HEAD_DIM),
                           mi + b_gates[:ML_HEADS], mf + b_gates[ML_HEADS:])
    y_b = jax.nn.sigmoid(mo) * head_rmsnorm(h_ml, ml_norm_g, ML_HEADS) * jax.nn.silu(mg)

    log_alpha = jax.nn.log_sigmoid((jnp.einsum('bsr,rk->bsk', ga, w_alpha) + b_alpha).astype(jnp.float32)) / GLA_TAU
    h_gla = gla_chunkwise(gq.reshape(bsz, s, GLA_HEADS, GLA_DK), gk.reshape(bsz, s, GLA_HEADS, GLA_DK),
                          gv.reshape(bsz, s, GLA_HEADS, GLA_DV), log_alpha.reshape(bsz, s, GLA_HEADS, GLA_DK))
    y_c = head_rmsnorm(h_gla, gla_norm_g, GLA_HEADS) * jax.nn.silu(gg)

    y = jnp.concatenate([y_a, y_b, y_c], axis=-1)
    return x + jnp.einsum('bse,ed->bsd', y, w_out)


def setup_inputs(seed: int = 0) -> dict:
    key = jax.random.key(seed)
    ks = jax.random.split(key, 12)
    f32 = jnp.float32
    x = jax.random.normal(ks[0], (BATCH, SEQ, D_MODEL), f32)
    norm_g = 1.0 + 0.1 * jax.random.normal(ks[1], (DEPTH, D_MODEL), f32)
    w_in = jax.random.normal(ks[2], (DEPTH, D_MODEL, D_IN), f32) * D_MODEL ** -0.5
    f_bias = jnp.broadcast_to(jnp.linspace(3.0, 6.0, ML_HEADS, dtype=f32), (DEPTH, ML_HEADS))
    i_bias = 0.1 * jax.random.normal(ks[3], (DEPTH, ML_HEADS), f32)
    b_gates = jnp.concatenate([i_bias, f_bias + 0.1 * jax.random.normal(ks[4], (DEPTH, ML_HEADS), f32)], axis=-1)
    conv_w = jax.random.normal(ks[5], (DEPTH, CONV_WIDTH, 2 * ML_WIDTH), f32) * CONV_WIDTH ** -0.5
    w_alpha = jax.random.normal(ks[6], (DEPTH, GLA_RANK, GLA_KW), f32) * GLA_RANK ** -0.5
    b_alpha = 0.1 * jax.random.normal(ks[7], (DEPTH, GLA_KW), f32)
    rel_bias = 0.1 * jax.random.normal(ks[8], (DEPTH, ATT_HEADS, 2 * REL_CLIP + 1), f32)
    ml_norm_g = 1.0 + 0.1 * jax.random.normal(ks[9], (DEPTH, ML_WIDTH), f32)
    gla_norm_g = 1.0 + 0.1 * jax.random.normal(ks[10], (DEPTH, GLA_WIDTH), f32)
    k_out, k_fin = jax.random.split(ks[11])
    w_out = jax.random.normal(k_out, (DEPTH, D_MIX, D_MODEL), f32) * D_MIX ** -0.5
    final_g = 1.0 + 0.1 * jax.random.normal(k_fin, (D_MODEL,), f32)
    return {"x": x, "norm_g": norm_g, "w_in": w_in, "b_gates": b_gates, "conv_w": conv_w,
            "w_alpha": w_alpha, "b_alpha": b_alpha, "rel_bias": rel_bias, "ml_norm_g": ml_norm_g,
            "gla_norm_g": gla_norm_g, "w_out": w_out, "final_g": final_g}


def reference(x, norm_g, w_in, b_gates, conv_w, w_alpha, b_alpha, rel_bias, ml_norm_g, gla_norm_g, w_out, final_g):
    for l in range(DEPTH):
        x = hybrid_layer(x, norm_g[l], w_in[l], b_gates[l], conv_w[l], w_alpha[l], b_alpha[l], rel_bias[l],
                         ml_norm_g[l], gla_norm_g[l], w_out[l])
    return rmsnorm(x, final_g)
```

```cpp
#include <hip/hip_runtime.h>
#include <cstdio>
#include <cstdint>
#include <cmath>

#ifndef MK_N_LAUNCHES
#define MK_N_LAUNCHES 1
#endif

namespace pg8 {
#define PG8_LAS __attribute__((address_space(3)))
typedef unsigned short bf16_t;
typedef short bf16x8 __attribute__((ext_vector_type(8)));
typedef float f32x4 __attribute__((ext_vector_type(4)));
typedef unsigned u32x4 __attribute__((ext_vector_type(4)));
constexpr int BM = 256, BK = 64, HALF = 128, HTB = HALF * BK * 2  , STAGE_BYTES = 8 * HTB, NXCD = 8, WGM = 8;

__host__ __device__ __forceinline__ int lds_byte(int r, int c) { const int st = (r >> 4) * 2 + (c >> 5), rr = r & 15, cc = c & 31, ob = rr * 64 + cc * 2; return st * 1024 + (ob ^ (((ob >> 9) & 1) << 5)); }
__host__ __device__ __forceinline__ void stage_rc(int b, int& R, int& C) { const int st = b / 1024, sb = b % 1024, swz = sb ^ (((sb >> 9) & 1) << 5); R = (st >> 1) * 16 + swz / 64; C = (st & 1) * 32 + (swz % 64) / 2; }
__host__ __device__ __forceinline__ int perm32(int rho) { const int n = rho >> 4, i = rho & 15; return 8 * (i >> 2) + 4 * n + (i & 3); }

struct Unit { int pm, pn; };
struct Gemm { const bf16_t* A; const bf16_t* Bt; int M, N, K; };

struct StaticOrder {
    int nM, nN, nwg, G, c;
    __host__ __device__ void init(int M, int N, int G_, int c_) { nM = M / BM; nN = N / BM; nwg = nM * nN; G = G_; c = c_; }
    __host__ __device__ bool next(int i, Unit& u) const {
        const long L = (long)i * G + c; if (L >= nwg) return false;
        int wgid = (int)L; { const int q = nwg / NXCD, r = nwg % NXCD, xcd = wgid % NXCD, off = wgid / NXCD; wgid = (xcd < r ? xcd * (q + 1) : r * (q + 1) + (xcd - r) * q) + off; }
        const int nig = WGM * nN, gid = wgid / nig, fm = gid * WGM, gsz = (nM - fm) < WGM ? (nM - fm) : WGM;
        u.pm = fm + ((wgid % nig) % gsz); u.pn = (wgid % nig) / gsz; return true;
    }
    __device__ __forceinline__ void a_ready(const Unit&) const {}
    __device__ __forceinline__ void done(const Unit&) const {}
};

__device__ __forceinline__ unsigned cvt_pk_bf16(float lo, float hi) { unsigned r; asm volatile("v_cvt_pk_bf16_f32 %0, %1, %2" : "=v"(r) : "v"(lo), "v"(hi)); return r; }

typedef unsigned u32x2 __attribute__((ext_vector_type(2)));
struct EpiZ {
    bf16_t* Z; int ldz; const float* ssq; float* G32; int gcol0;
    __device__ __forceinline__ void operator()(const f32x4 (&acc)[2][2][4][2], const Unit& u, int wr, int wc, int fr, int fq) const {
        const int row0 = u.pm * BM + wr * 64 + fr, col0 = u.pn * BM + wc * 32 + 8 * fq;
#pragma unroll
        for (int ai = 0; ai < 2; ++ai)
#pragma unroll
            for (int m = 0; m < 4; ++m) {
                const int row = row0 + ai * HALF + m * 16;
                const float rs = 1.0f / sqrtf(ssq[row] * (1.0f / 1024.0f) + 1e-6f);
#pragma unroll
                for (int bj = 0; bj < 2; ++bj) {
                    const int col = col0 + bj * HALF;
                    const f32x4 v0 = acc[ai][bj][m][0] * rs, v1 = acc[ai][bj][m][1] * rs;
                    if (col < ldz) {
                        u32x4 w; w.x = cvt_pk_bf16(v0[0], v0[1]); w.y = cvt_pk_bf16(v0[2], v0[3]); w.z = cvt_pk_bf16(v1[0], v1[1]); w.w = cvt_pk_bf16(v1[2], v1[3]);
                        *(u32x4*)(Z + (size_t)row * ldz + col) = w;
                    } else if (col < gcol0 + 32) {
                        float* gp = G32 + (size_t)row * 32 + (col - gcol0);
                        *(f32x4*)gp = v0; *(f32x4*)(gp + 4) = v1;
                    }
                }
            }
    }
};
struct EpiRes {
    const float* base; float* out; bf16_t* xb; float* ssq;
    __device__ __forceinline__ void operator()(const f32x4 (&acc)[2][2][4][2], const Unit& u, int wr, int wc, int fr, int fq) const {
        const int col0 = u.pn * BM + wc * 32 + 8 * fq;
#pragma unroll
        for (int ai = 0; ai < 2; ++ai)
#pragma unroll
            for (int m = 0; m < 4; ++m) {
                const int row = u.pm * BM + ai * HALF + wr * 64 + m * 16 + fr;
                float s = 0.f;
#pragma unroll
                for (int bj = 0; bj < 2; ++bj) {
                    const size_t off = (size_t)row * 1024 + col0 + bj * HALF;
                    const f32x4 o0 = *(const f32x4*)(base + off) + acc[ai][bj][m][0], o1 = *(const f32x4*)(base + off + 4) + acc[ai][bj][m][1];
                    *(f32x4*)(out + off) = o0; *(f32x4*)(out + off + 4) = o1;
                    s += (o0[0] * o0[0] + o0[1] * o0[1]) + (o0[2] * o0[2] + o0[3] * o0[3]) + (o1[0] * o1[0] + o1[1] * o1[1]) + (o1[2] * o1[2] + o1[3] * o1[3]);
                    if (xb) { u32x4 w; w.x = cvt_pk_bf16(o0[0], o0[1]); w.y = cvt_pk_bf16(o0[2], o0[3]); w.z = cvt_pk_bf16(o1[0], o1[1]); w.w = cvt_pk_bf16(o1[2], o1[3]); *(u32x4*)(xb + off) = w; }
                }
                s += __shfl_xor(s, 16); s += __shfl_xor(s, 32);
                if (fq == 0) atomicAdd(ssq + row, s);
            }
    }
};
struct EpiBoth {
    static constexpr bool PERM = true, AFTER_DRAIN = false;
    int mode; EpiZ z; EpiRes r;
    __device__ __forceinline__ void operator()(const f32x4 (&acc)[2][2][4][2], const Unit& u, int wr, int wc, int fr, int fq) const {
        if (mode == 0) z(acc, u, wr, wc, fr, fq); else r(acc, u, wr, wc, fr, fq);
    }
};

template <class Epi, class Sched, bool ALIGN_EPI = false, bool SP2 = false>
__device__ __forceinline__ void gemm_phase(PG8_LAS unsigned char* lds, const Gemm g, const Sched& S, const Epi& E) {
    const int tid = threadIdx.x, wid = __builtin_amdgcn_readfirstlane(tid >> 6), lane = tid & 63, wr = wid >> 2, wc = wid & 3, fr = lane & 15, fq = lane >> 4;
    const int K = g.K, nt = K / BK;
    unsigned voffA[2], voffB[2];
#pragma unroll
    for (int i = 0; i < 2; ++i) { int R, C; stage_rc(tid * 16 + i * 8192, R, C); const int Rb = Epi::PERM ? ((R & ~31) + perm32(R & 31)) : R;
        voffA[i] = (unsigned)(R * K + C) * 2u; voffB[i] = (unsigned)(Rb * K + C) * 2u; }
    const size_t kstep = (size_t)(BK * 2);
    const size_t hstep = (size_t)HALF * K * 2;
    const size_t tstep = 2 * hstep;
    const unsigned ldsw = (unsigned)wid * 1024u;
    const int aoff = lds_byte(wr * 64 + fr, fq * 8), boff = lds_byte(wc * 32 + fr, fq * 8);
#define PG8_SA(b, h) (((b) * 2 + (h)) * HTB)
#define PG8_SB(b, h) ((4 + (b) * 2 + (h)) * HTB)
#define PG8_STAGE(bufoff, gbase, voff) do { _Pragma("unroll") for (int _i = 0; _i < 2; ++_i) \
        __builtin_amdgcn_global_load_lds((const unsigned*)((const char*)(gbase) + (voff)[_i]), (PG8_LAS unsigned*)(lds + (bufoff) + ldsw + _i * 8192), 16, 0, 0); } while (0)
#define PG8_LDA(dst, b, h) do { _Pragma("unroll") for (int m = 0; m < 4; ++m) _Pragma("unroll") for (int k = 0; k < 2; ++k) dst[m][k] = *(const PG8_LAS bf16x8*)(lds + PG8_SA(b, h) + aoff + m * 2048 + k * 1024); } while (0)
#define PG8_LDB(dst, b, h) do { _Pragma("unroll") for (int n = 0; n < 2; ++n) _Pragma("unroll") for (int k = 0; k < 2; ++k) dst[n][k] = *(const PG8_LAS bf16x8*)(lds + PG8_SB(b, h) + boff + n * 2048 + k * 1024); } while (0)
#define PG8_MMA(ai, bj, At, Bt) do { __builtin_amdgcn_s_setprio(1); _Pragma("unroll") for (int m = 0; m < 4; ++m) _Pragma("unroll") for (int n = 0; n < 2; ++n) _Pragma("unroll") for (int k = 0; k < 2; ++k) \
        acc[ai][bj][m][n] = __builtin_amdgcn_mfma_f32_16x16x32_bf16(Bt[n][k], At[m][k], acc[ai][bj][m][n], 0, 0, 0); __builtin_amdgcn_s_setprio(0); } while (0)
#define PG8_WAIT_V(n) asm volatile("s_waitcnt vmcnt(" #n ")" ::: "memory")
#define PG8_WAIT_L(n) asm volatile("s_waitcnt lgkmcnt(" #n ")" ::: "memory")
#define PG8_BAR __builtin_amdgcn_s_barrier()
#define PG8_SCHED __builtin_amdgcn_sched_barrier(0)
    Unit cur, nxt; int ui = 0;
    if (!S.next(0, cur)) return;
    f32x4 acc[2][2][4][2];
#pragma unroll
    for (int a = 0; a < 2; ++a)
#pragma unroll
        for (int b = 0; b < 2; ++b)
#pragma unroll
            for (int m = 0; m < 4; ++m)
#pragma unroll
                for (int n = 0; n < 2; ++n) acc[a][b][m][n] = (f32x4){0.f, 0.f, 0.f, 0.f};
    bf16x8 At[4][2], B0[2][2], B1[2][2];
    const char* cA = (const char*)g.A + (size_t)cur.pm * tstep; const char* cB = (const char*)g.Bt + (size_t)cur.pn * tstep;
    S.a_ready(cur);
    if constexpr (SP2) {
        PG8_STAGE(PG8_SB(0, 0), cB, voffB); PG8_STAGE(PG8_SB(0, 1), cB + hstep, voffB); PG8_STAGE(PG8_SA(0, 0), cA, voffA); PG8_STAGE(PG8_SA(0, 1), cA + hstep, voffA);
        if (wr == 1) PG8_BAR;
        PG8_WAIT_V(2); PG8_BAR;
        PG8_STAGE(PG8_SB(1, 0), cB + kstep, voffB); PG8_STAGE(PG8_SA(1, 0), cA + kstep, voffA); PG8_STAGE(PG8_SB(1, 1), cB + hstep + kstep, voffB);
        PG8_WAIT_V(6); PG8_BAR;
    } else {
        PG8_STAGE(PG8_SB(0, 0), cB, voffB); PG8_STAGE(PG8_SA(0, 0), cA, voffA); PG8_STAGE(PG8_SB(0, 1), cB + hstep, voffB); PG8_STAGE(PG8_SA(0, 1), cA + hstep, voffA);
        if (wr == 1) PG8_BAR;
        PG8_WAIT_V(4); PG8_BAR;
        PG8_STAGE(PG8_SB(1, 0), cB + kstep, voffB); PG8_STAGE(PG8_SA(1, 0), cA + kstep, voffA); PG8_STAGE(PG8_SB(1, 1), cB + hstep + kstep, voffB);
        PG8_WAIT_V(6); PG8_BAR;
    }
    for (;;) {
        const bool has_next = S.next(ui + 1, nxt);
        const char* nA = has_next ? (const char*)g.A + (size_t)nxt.pm * tstep : cA; const char* nB = has_next ? (const char*)g.Bt + (size_t)nxt.pn * tstep : cB;
        for (int t = 0; t < nt; t += 2) {
            const bool last = (t == nt - 2);
            const char* a1 = cA + (size_t)(t + 1) * kstep;
            const char* a2 = last ? nA : cA + (size_t)(t + 2) * kstep; const char* b2 = last ? nB : cB + (size_t)(t + 2) * kstep;
            const char* a3 = a2 + kstep; const char* b3 = b2 + kstep;
            if (last && has_next) S.a_ready(nxt);
            if constexpr (SP2) {
            PG8_LDB(B0, 0, 0); PG8_LDB(B1, 0, 1); PG8_SCHED; PG8_LDA(At, 0, 0); PG8_STAGE(PG8_SA(1, 1), a1 + hstep, voffA);
            PG8_WAIT_V(8); PG8_WAIT_L(0); PG8_BAR; PG8_MMA(0, 0, At, B0); PG8_MMA(0, 1, At, B1); PG8_BAR; PG8_SCHED;
            PG8_LDA(At, 0, 1); PG8_STAGE(PG8_SB(0, 0), b2, voffB); PG8_STAGE(PG8_SB(0, 1), b2 + hstep, voffB); PG8_STAGE(PG8_SA(0, 0), a2, voffA);
            PG8_WAIT_V(8); PG8_WAIT_L(0); PG8_BAR; PG8_MMA(1, 0, At, B0); PG8_MMA(1, 1, At, B1); PG8_BAR; PG8_SCHED;
            PG8_LDB(B0, 1, 0); PG8_LDB(B1, 1, 1); PG8_SCHED; PG8_LDA(At, 1, 0); PG8_STAGE(PG8_SA(0, 1), a2 + hstep, voffA);
            PG8_WAIT_V(8); PG8_WAIT_L(0); PG8_BAR; PG8_MMA(0, 0, At, B0); PG8_MMA(0, 1, At, B1); PG8_BAR; PG8_SCHED;
            PG8_LDA(At, 1, 1); PG8_STAGE(PG8_SB(1, 0), b3, voffB); PG8_STAGE(PG8_SB(1, 1), b3 + hstep, voffB); PG8_STAGE(PG8_SA(1, 0), a3, voffA);
            PG8_WAIT_V(8); PG8_WAIT_L(0); PG8_BAR; PG8_MMA(1, 0, At, B0); PG8_MMA(1, 1, At, B1); PG8_BAR; PG8_SCHED;
            } else {
            PG8_LDB(B0, 0, 0); PG8_SCHED; PG8_LDA(At, 0, 0); PG8_STAGE(PG8_SA(1, 1), a1 + hstep, voffA);
            PG8_WAIT_L(8); PG8_BAR; PG8_WAIT_L(0); PG8_MMA(0, 0, At, B0); PG8_BAR; PG8_SCHED;
            PG8_LDB(B1, 0, 1); PG8_STAGE(PG8_SB(0, 0), b2, voffB);
            PG8_BAR; PG8_WAIT_L(0); PG8_MMA(0, 1, At, B1); PG8_BAR;
            PG8_LDA(At, 0, 1); PG8_STAGE(PG8_SA(0, 0), a2, voffA);
            PG8_BAR; PG8_WAIT_L(0); PG8_MMA(1, 0, At, B0); PG8_BAR; PG8_SCHED;
            PG8_STAGE(PG8_SB(0, 1), b2 + hstep, voffB);
            PG8_WAIT_V(6); PG8_BAR; PG8_MMA(1, 1, At, B1); PG8_BAR;
            PG8_LDB(B0, 1, 0); PG8_SCHED; PG8_LDA(At, 1, 0); PG8_STAGE(PG8_SA(0, 1), a2 + hstep, voffA);
            PG8_WAIT_L(8); PG8_BAR; PG8_WAIT_L(0); PG8_MMA(0, 0, At, B0); PG8_BAR; PG8_SCHED;
            PG8_LDB(B1, 1, 1); PG8_STAGE(PG8_SB(1, 0), b3, voffB);
            PG8_BAR; PG8_WAIT_L(0); PG8_MMA(0, 1, At, B1); PG8_BAR;
            PG8_LDA(At, 1, 1); PG8_STAGE(PG8_SA(1, 0), a3, voffA);
            PG8_BAR; PG8_WAIT_L(0); PG8_MMA(1, 0, At, B0); PG8_BAR; PG8_SCHED;
            PG8_STAGE(PG8_SB(1, 1), b3 + hstep, voffB);
            PG8_WAIT_V(6); PG8_BAR; PG8_MMA(1, 1, At, B1); PG8_BAR;
            }
        }
        if constexpr (ALIGN_EPI) { if (wr == 0) PG8_BAR; }
        if constexpr (!Epi::AFTER_DRAIN) { E(acc, cur, wr, wc, fr, fq); S.done(cur); }
        if (!has_next) break;
#pragma unroll
        for (int a = 0; a < 2; ++a)
#pragma unroll
            for (int b = 0; b < 2; ++b)
#pragma unroll
                for (int m = 0; m < 4; ++m)
#pragma unroll
                    for (int n = 0; n < 2; ++n) acc[a][b][m][n] = (f32x4){0.f, 0.f, 0.f, 0.f};
        cur = nxt; cA = nA; cB = nB; ++ui;
        if constexpr (ALIGN_EPI) { if (wr == 1) PG8_BAR; }
    }
    PG8_WAIT_V(0);
    if constexpr (!ALIGN_EPI) { if (wr == 0) PG8_BAR; }
    PG8_BAR;
    if constexpr (Epi::AFTER_DRAIN) { E.fused(acc, cur, wr, wc, fr, fq, lds, wid, lane); S.done(cur); }
#undef PG8_SA
#undef PG8_SB
#undef PG8_STAGE
#undef PG8_LDA
#undef PG8_LDB
#undef PG8_MMA
#undef PG8_WAIT_V
#undef PG8_WAIT_L
#undef PG8_BAR
#undef PG8_SCHED
}
}

constexpr int NWAVES = 8, NTHR = 512;
constexpr int N_LAUNCHES = MK_N_LAUNCHES;
constexpr int NPHASE = 12;
constexpr int BATCH = 2, SEQ = 8192, DM = 1024, T = BATCH * SEQ, DEPTH = 2, CH = 64, NCHT = T / CH  , NCHS = SEQ / CH  ;
constexpr int DIN = 4252, NP = 4352, LDZ = 4224;
constexpr int ZC_AQ = 0, ZC_AK = 384, ZC_AV = 768, ZC_AG = 1152, ZC_MQ = 1536, ZC_MK = 1920, ZC_MV = 2304, ZC_MO = 2688, ZC_MG = 3072, ZC_GQ = 3456, ZC_GK = 3584, ZC_GV = 3712, ZC_GG = 3968, ZC_SM = 4224;
constexpr float EPS = 1e-6f;
__host__ __device__ __forceinline__ int src_col(int n) {
    if (n < 3072) return n;
    if (n < 3968) return n + 12;
    if (n < 4224) return n + 28;
    if (n < 4236) return n - 1152;
    if (n < 4252) return n - 256;
    return -1;
}

constexpr size_t MiB = 1u << 20;
constexpr size_t WS_CTL = 0, CTL_ZERO_BYTES = 1 * MiB;
constexpr size_t WS_SSQ = 512 * 1024;
constexpr size_t WS_WIN = 1 * MiB;
constexpr size_t WS_WOUT = WS_WIN + (size_t)2 * NP * DM * 2;
constexpr size_t WS_XB = WS_WOUT + (size_t)2 * DM * DM * 2;
constexpr size_t WS_Y = WS_XB + (size_t)T * DM * 2;
constexpr size_t WS_Z = WS_Y + (size_t)T * DM * 2;
constexpr size_t WS_G32 = WS_Z + (size_t)T * LDZ * 2;
constexpr size_t WS_CST = WS_G32 + (size_t)T * 32 * 4;
constexpr size_t WS_NST = WS_CST + (size_t)NCHT * 6 * 4096 * 4;
constexpr size_t WS_SST = WS_NST + (size_t)NCHT * 6 * 64 * 4;
constexpr size_t WS_ADEC = WS_SST + (size_t)NCHT * 4 * 2048 * 4;
constexpr size_t WS_GS = WS_ADEC + (size_t)NCHT * 4 * 32 * 4;
constexpr size_t WS_MS = WS_GS + 8192;
constexpr size_t WS_MP = WS_MS + 8192;
constexpr size_t WS_END = WS_MP + 8192;
static_assert(WS_END <= 268435456, "d_ws map exceeds 256 MiB");
constexpr int CW_BAR = 4096;

constexpr int RING_OFF = 0, RING_BYTES = 131072;
constexpr int LDSCTL_OFF = RING_BYTES, MISC_OFF = LDSCTL_OFF + 320;
constexpr int LDS_BYTES = 147456;
#define GAS __attribute__((address_space(1)))
#define LAS __attribute__((address_space(3)))
typedef unsigned short bf16;
typedef unsigned v4u __attribute__((ext_vector_type(4)));
typedef float f32x4 __attribute__((ext_vector_type(4)));
typedef short bf16x8 __attribute__((ext_vector_type(8)));
typedef GAS unsigned gu32;
typedef GAS unsigned long long gu64;
#define RLX_AGENT __ATOMIC_RELAXED, __HIP_MEMORY_SCOPE_AGENT
#define LDS_WAIT() asm volatile("s_waitcnt lgkmcnt(0)" ::: "memory")
#define VM_WAIT() asm volatile("s_waitcnt vmcnt(0)" ::: "memory")
__device__ __forceinline__ unsigned long long rt() { return __builtin_amdgcn_s_memrealtime(); }
__device__ __forceinline__ unsigned f2bf(float f) { unsigned u = __builtin_bit_cast(unsigned, f); return (u + 0x7fffu + ((u >> 16) & 1u)) >> 16; }
__device__ __forceinline__ unsigned pk2(float lo, float hi) { return f2bf(lo) | (f2bf(hi) << 16); }

#define XB_TMO      128
#define XB_XCNT(j)  (256  + 64 * (j))
#define XB_XSUB(j)  (1280 + 64 * (j))
#define XB_XGEN(j)  (2304 + 64 * (j))
#define XB_TOP      3328
#define XB_TOPGEN   3392
#define XCD_BAR_WORDS 3456
#define XB_SPIN_CAP (1u << 18)

__device__ __forceinline__ unsigned xb_ld(unsigned* p)              { return __hip_atomic_load(p, __ATOMIC_RELAXED, __HIP_MEMORY_SCOPE_AGENT); }
__device__ __forceinline__ unsigned xb_add(unsigned* p, unsigned v) { return __hip_atomic_fetch_add(p, v, __ATOMIC_RELAXED, __HIP_MEMORY_SCOPE_AGENT); }
__device__ __forceinline__ unsigned xb_xcc_id() { return (unsigned)__builtin_amdgcn_s_getreg((3 << 11) | 20) & 0xFu; }
#define XB_SPIN(cond, bar) do { unsigned _sp = 0; while (cond) { __builtin_amdgcn_s_sleep(1); \
    if ((++_sp & 255u) == 0u) { if (xb_ld(&(bar)[XB_TMO])) break; if (_sp > XB_SPIN_CAP) { atomicAdd(&(bar)[XB_TMO], 1u); break; } } } } while (0)

struct XcdBarrier {
    unsigned* bar; unsigned x;
    volatile LAS unsigned* st;
};

__device__ __forceinline__ XcdBarrier xcd_barrier_post(unsigned* bar, volatile LAS unsigned* st) {
    XcdBarrier b; b.bar = bar; b.x = xb_xcc_id(); b.st = st;
    if (threadIdx.x == 0) (void)xb_add(&bar[XB_XCNT(b.x)], 1u);
    return b;
}
__device__ __forceinline__ void xcd_barrier_complete(unsigned* bar, unsigned x, unsigned& nloc, unsigned& nx) {
    const unsigned G = gridDim.x * gridDim.y * gridDim.z;
    unsigned sum, cnt, mine, sp = 0u;
    for (;;) {
        sum = 0u; cnt = 0u; mine = 0u;
#pragma unroll
        for (unsigned j = 0; j < 16; ++j) { const unsigned c = xb_ld(&bar[XB_XCNT(j)]); sum += c; cnt += (c > 0u) ? 1u : 0u; mine = (j == x) ? c : mine; }
        if (sum == G) break;
        __builtin_amdgcn_s_sleep(1);
        if ((++sp & 255u) == 0u) { if (xb_ld(&bar[XB_TMO])) break; if (sp > XB_SPIN_CAP) { atomicAdd(&bar[XB_TMO], 1u); break; } }
    }
    nloc = mine > 0u ? mine : 1u; nx = cnt > 0u ? cnt : 1u;
}

__device__ __forceinline__ void xcd_barrier(const XcdBarrier& b) {
    asm volatile("s_waitcnt vmcnt(0)" ::: "memory");
    __syncthreads();
    if (threadIdx.x == 0) {
        unsigned* bar = b.bar;
        __builtin_amdgcn_s_waitcnt(0);
        unsigned nloc = b.st[0], nx = b.st[1];
        if (nloc == 0u) { xcd_barrier_complete(bar, b.x, nloc, nx); b.st[0] = nloc; b.st[1] = nx; }
        const unsigned old = xb_add(&bar[XB_XSUB(b.x)], 1u);
        const unsigned gen = old / nloc;
        if (old + 1u == (gen + 1u) * nloc) {
            __builtin_amdgcn_fence(__ATOMIC_RELEASE, "agent");
            asm volatile("s_waitcnt vmcnt(0)" ::: "memory");
            const unsigned og = xb_add(&bar[XB_TOP], 1u);
            const unsigned tg = og / nx;
            if (og + 1u == (tg + 1u) * nx) xb_add(&bar[XB_TOPGEN], 1u);
            else XB_SPIN(xb_ld(&bar[XB_TOPGEN]) == tg, bar);
            __builtin_amdgcn_fence(__ATOMIC_ACQUIRE, "agent");
            xb_add(&bar[XB_XGEN(b.x)], 1u);
            asm volatile("s_waitcnt vmcnt(0)" ::: "memory");
        } else {
            XB_SPIN(xb_ld(&bar[XB_XGEN(b.x)]) == gen, bar);
            __builtin_amdgcn_fence(__ATOMIC_ACQUIRE, "agent");
            asm volatile("s_waitcnt vmcnt(0)" ::: "memory");
        }
    }
    __syncthreads();
}


struct Args { const float* in[12]; float* out; unsigned char* ws; int ph_lo, ph_hi, li, pad; };
struct Frame {
    LAS unsigned char* lds;
    volatile LAS unsigned* MISC;
    const Args* A;
    int wave, vcu, G;
};
__device__ __forceinline__ int opaque_tid() { int t = threadIdx.x; asm volatile("" : "+v"(t)); return t; }
#define F_tid (opaque_tid())
#define F_lane (opaque_tid() & 63)
#define F_x          (F.A->in[0])
#define F_norm_g     (F.A->in[1])
#define F_w_in       (F.A->in[2])
#define F_b_gates    (F.A->in[3])
#define F_conv_w     (F.A->in[4])
#define F_w_alpha    (F.A->in[5])
#define F_b_alpha    (F.A->in[6])
#define F_rel_bias   (F.A->in[7])
#define F_ml_norm_g  (F.A->in[8])
#define F_gla_norm_g (F.A->in[9])
#define F_w_out      (F.A->in[10])
#define F_final_g    (F.A->in[11])
#define F_out        (F.A->out)
#define F_ws         (F.A->ws)
#define F_ctl        ((gu32*)(F_ws + WS_CTL))
#define F_Win_t      ((bf16*)(F_ws + WS_WIN))
#define F_Wout_t     ((bf16*)(F_ws + WS_WOUT))
#define F_XB         ((bf16*)(F_ws + WS_XB))
#define F_Y          ((bf16*)(F_ws + WS_Y))
#define F_Z          ((bf16*)(F_ws + WS_Z))
#define F_G32        ((float*)(F_ws + WS_G32))
#define F_SSQ        ((float*)(F_ws + WS_SSQ))
#define F_CST        ((float*)(F_ws + WS_CST))
#define F_NST        ((float*)(F_ws + WS_NST))
#define F_SST        ((float*)(F_ws + WS_SST))
#define F_ADEC       ((float*)(F_ws + WS_ADEC))
#define F_GS         ((float*)(F_ws + WS_GS))
#define F_MS         ((float*)(F_ws + WS_MS))
#define F_MP         ((float*)(F_ws + WS_MP))
__device__ __forceinline__ float bf2f(unsigned short u) { return __uint_as_float((unsigned)u << 16); }
__device__ __forceinline__ float wave_sum(float v) {
#pragma unroll
    for (int o = 1; o < 64; o <<= 1) v += __shfl_xor(v, o);
    return v;
}
__device__ __forceinline__ float siluf(float x) { return x / (1.0f + expf(-x)); }
__device__ __forceinline__ float sigmf(float x) { return 1.0f / (1.0f + expf(-x)); }
__device__ __forceinline__ float logsigf(float x) { return fminf(x, 0.f) - log1pf(expf(-fabsf(x))); }
__device__ __forceinline__ void ld8(const bf16* p, float* o) {
    const v4u w = *(const v4u*)p;
    o[0] = __uint_as_float(w.x << 16); o[1] = __uint_as_float(w.x & 0xffff0000u); o[2] = __uint_as_float(w.y << 16); o[3] = __uint_as_float(w.y & 0xffff0000u);
    o[4] = __uint_as_float(w.z << 16); o[5] = __uint_as_float(w.z & 0xffff0000u); o[6] = __uint_as_float(w.w << 16); o[7] = __uint_as_float(w.w & 0xffff0000u);
}

template <bool PERMUTE>
__device__ __forceinline__ void p0_transpose_item(const float* W, int Nsrc, int Ndst, const float* gk, bf16* WT, LAS float* scr, int item, int lane) {
    const int nblk = Ndst / 32, kb = item / nblk, nb = item % nblk, k0 = 64 * kb, n0 = 32 * nb;
    const int nd = n0 + (lane & 31), ns = PERMUTE ? src_col(nd) : nd;
#pragma unroll 8
    for (int i = 0; i < 32; ++i) { const int kk = 2 * i + (lane >> 5);
        float v = 0.f; if (ns >= 0) { v = W[(size_t)(k0 + kk) * Nsrc + ns]; if (gk) v *= gk[k0 + kk]; }
        scr[kk * 33 + (lane & 31)] = v; }
    LDS_WAIT(); asm volatile("" ::: "memory");
    const int c = lane & 7;
#pragma unroll
    for (int j = 0; j < 4; ++j) { const int n = (lane >> 3) + 8 * j; const LAS float* s = scr + (8 * c) * 33 + n;
        v4u o; o.x = pk2(s[0 * 33], s[1 * 33]); o.y = pk2(s[2 * 33], s[3 * 33]); o.z = pk2(s[4 * 33], s[5 * 33]); o.w = pk2(s[6 * 33], s[7 * 33]);
        *(GAS v4u*)(WT + (size_t)(n0 + n) * 1024 + k0 + 8 * c) = o; }
    LDS_WAIT(); asm volatile("" ::: "memory");
}
__device__ __forceinline__ void p0_prologue(Frame& F) {
    LAS float* scr = (LAS float*)(F.lds + RING_OFF + F.wave * 16384);
    const int gw = F.vcu * NWAVES + F.wave, NGW = F.G * NWAVES;
    constexpr int I_IN = 16 * (NP / 32), I_OUT = 16 * (DM / 32);
    constexpr int NITEMS = 2 * I_IN + 2 * I_OUT;
    for (int it = gw; it < NITEMS; it += NGW) {
        int r = it;
        if (r < 2 * I_IN) { const int l = r / I_IN; r -= l * I_IN;
            p0_transpose_item<true>(F_w_in + (size_t)l * DM * DIN, DIN, NP, F_norm_g + l * DM, F_Win_t + (size_t)l * NP * DM, scr, r, F_lane); continue; }
        r -= 2 * I_IN;
        { const int l = r / I_OUT; r -= l * I_OUT;
            p0_transpose_item<false>(F_w_out + (size_t)l * DM * DM, DM, DM, nullptr, F_Wout_t + (size_t)l * DM * DM, scr, r, F_lane); }
    }
    for (int m = gw; m < T; m += NGW) {
        const GAS f32x4* xr = (const GAS f32x4*)(F_x + (size_t)m * DM) + F_lane;
        GAS unsigned long long* o8 = (GAS unsigned long long*)(F_XB + (size_t)m * DM) + F_lane;
        float s = 0.f;
#pragma unroll
        for (int j = 0; j < 4; ++j) { const f32x4 v = xr[64 * j]; s += (v.x * v.x + v.y * v.y) + (v.z * v.z + v.w * v.w);
            o8[64 * j] = (unsigned long long)pk2(v.x, v.y) | ((unsigned long long)pk2(v.z, v.w) << 32); }
        s = wave_sum(s);
        if (F_lane == 0) F_SSQ[m] = s;
    }
}

constexpr int LP = 65;
__device__ __forceinline__ void stage_conv(Frame& F, int layer, int b, int n, int zcol, int wch, float scale, LAS float* dst) {
    const float* cw = F_conv_w + (size_t)layer * 4 * 768;
    const int r0 = b * SEQ + n * CH;
    for (int idx = F_tid; idx < 4096; idx += NTHR) {
        const int t = idx >> 6, c = idx & 63;
        float a = 0.f;
#pragma unroll
        for (int j = 0; j < 4; ++j) { const int tt = t + j - 3;
            if (n * CH + tt >= 0) a += bf2f(F_Z[(size_t)(r0 + tt) * LDZ + zcol + c]) * cw[j * 768 + wch + c]; }
        dst[t * LP + c] = siluf(a) * scale;
    }
}
__device__ __forceinline__ void stage_tile(Frame& F, int b, int n, int zcol, int W, float scale, LAS float* dst, int pitch) {
    const int r0 = b * SEQ + n * CH;
    for (int idx = F_tid; idx < 64 * W; idx += NTHR) { const int t = idx / W, c = idx % W; dst[t * pitch + c] = bf2f(F_Z[(size_t)(r0 + t) * LDZ + zcol + c]) * scale; }
}
__device__ __forceinline__ void stage_mgates(Frame& F, int layer, int b, int n, int h, LAS float* ig, LAS float* bc, LAS float* lf) {
    const int r0 = b * SEQ + n * CH;
    if (F_tid < 64) { const float* g = F_G32 + (size_t)(r0 + F_tid) * 32;
        ig[F_tid] = g[h] + F_b_gates[layer * 12 + h]; lf[F_tid] = logsigf(g[6 + h] + F_b_gates[layer * 12 + 6 + h]); }
    __syncthreads();
    if (F_tid < 64) { float s = 0.f; for (int j = 0; j <= F_tid; ++j) s += lf[j]; bc[F_tid] = s; }
}
__device__ __forceinline__ void stage_gla_decay(Frame& F, int layer, int b, int n, int hh, LAS float* bcum) {
    const int r0 = b * SEQ + n * CH;
    const float* wa = F_w_alpha + (size_t)layer * 16 * 128; const float* ba = F_b_alpha + layer * 128;
    for (int idx = F_tid; idx < 2048; idx += NTHR) { const int t = idx >> 5, d = idx & 31;
        const float* g = F_G32 + (size_t)(r0 + t) * 32 + 12; float a = ba[hh * 32 + d];
#pragma unroll
        for (int r = 0; r < 16; ++r) a += g[r] * wa[r * 128 + hh * 32 + d];
        bcum[t * 33 + d] = logsigf(a) * (1.0f / 16.0f); }
    __syncthreads();
    if (F_tid < 32) { float s = 0.f; for (int t = 0; t < 64; ++t) { s += bcum[t * 33 + F_tid]; bcum[t * 33 + F_tid] = s; } }
    __syncthreads();
}

__device__ __forceinline__ void p2_local(Frame& F, int layer) {
    LAS float* L = (LAS float*)(F.lds + RING_OFF);
    for (int u = F.vcu; u < NCHT * 10; u += F.G) {
        const int task = u % 10, cn = u / 10, b = cn / NCHS, n = cn % NCHS;
        __syncthreads();
        if (task < 6) {
            const int h = task;
            LAS float* kc = L; LAS float* vv = L + 64 * LP; LAS float* ig = L + 2 * 64 * LP; LAS float* bc = ig + 64; LAS float* lf = bc + 64; LAS float* wj = lf + 64;
            stage_conv(F, layer, b, n, ZC_MK + h * 64, 384 + h * 64, 0.125f, kc);
            stage_tile(F, b, n, ZC_MV + h * 64, 64, 1.f, vv, LP);
            stage_mgates(F, layer, b, n, h, ig, bc, lf);
            __syncthreads();
            const float g = bc[63];
            float mloc = -3.0e38f;
            for (int j = 0; j < 64; ++j) mloc = fmaxf(mloc, g - bc[j] + ig[j]);
            if (F_tid < 64) wj[F_tid] = expf(g - bc[F_tid] + ig[F_tid] - mloc);
            __syncthreads();
            { const int v = F_tid >> 3, k0 = (F_tid & 7) * 8; float a[8];
#pragma unroll
              for (int i = 0; i < 8; ++i) a[i] = 0.f;
              for (int j = 0; j < 64; ++j) { const float wv = wj[j] * vv[j * LP + v];
#pragma unroll
                  for (int i = 0; i < 8; ++i) a[i] += wv * kc[j * LP + k0 + i]; }
              float* dst = F_CST + ((size_t)cn * 6 + h) * 4096 + v * 64 + k0;
              *(f32x4*)dst = (f32x4){a[0], a[1], a[2], a[3]}; *(f32x4*)(dst + 4) = (f32x4){a[4], a[5], a[6], a[7]}; }
            if (F_tid < 64) { float s = 0.f; for (int j = 0; j < 64; ++j) s += wj[j] * kc[j * LP + F_tid]; F_NST[((size_t)cn * 6 + h) * 64 + F_tid] = s; }
            if (F_tid == 0) { F_GS[cn * 6 + h] = g; F_MS[cn * 6 + h] = mloc; }
        } else {
            const int hh = task - 6;
            LAS float* kk = L; LAS float* vv = L + 64 * 33; LAS float* bcum = vv + 64 * LP;
            stage_tile(F, b, n, ZC_GK + hh * 32, 32, 1.f, kk, 33);
            stage_tile(F, b, n, ZC_GV + hh * 64, 64, 1.f, vv, LP);
            stage_gla_decay(F, layer, b, n, hh, bcum);
            for (int idx = F_tid; idx < 2048; idx += NTHR) { const int j = idx >> 5, d = idx & 31; kk[j * 33 + d] *= expf(bcum[63 * 33 + d] - bcum[j * 33 + d]); }
            __syncthreads();
            { const int d = F_tid >> 4, v0 = (F_tid & 15) * 4; float a[4] = {0.f, 0.f, 0.f, 0.f};
              for (int j = 0; j < 64; ++j) { const float kd = kk[j * 33 + d];
#pragma unroll
                  for (int i = 0; i < 4; ++i) a[i] += kd * vv[j * LP + v0 + i]; }
              *(f32x4*)(F_SST + ((size_t)cn * 4 + hh) * 2048 + d * 64 + v0) = (f32x4){a[0], a[1], a[2], a[3]}; }
            if (F_tid < 32) F_ADEC[((size_t)cn * 4 + hh) * 32 + F_tid] = expf(bcum[63 * 33 + F_tid]);
        }
    }
    __syncthreads();
}

__device__ __forceinline__ void p3_scan(Frame& F) {
    LAS float* L = (LAS float*)(F.lds + RING_OFF);
    LAS float* so = L; LAS float* sn = L + 128;
    constexpr int NU_M = 12 * 8, NU_G = 8 * 4;
    for (int u = F.vcu; u < NU_M + NU_G; u += F.G) {
        __syncthreads();
        if (u < NU_M) {
            const int bh = u >> 3, sl = u & 7, b = bh / 6, h = bh % 6;
            if (F_tid == 0) { float m = 0.f;
                for (int n = 0; n < NCHS; ++n) { const int ci = (b * NCHS + n) * 6 + h; const float g = F_GS[ci], ml = F_MS[ci];
                    const float mn = fmaxf(g + m, ml); so[n] = expf(g + m - mn); sn[n] = expf(ml - mn); if (sl == 0) F_MP[ci] = m; m = mn; } }
            __syncthreads();
            { float st = 0.f; float* p = F_CST + ((size_t)(b * NCHS) * 6 + h) * 4096 + sl * 512 + F_tid;
#pragma unroll 8
              for (int n = 0; n < NCHS; ++n) { const float c = p[(size_t)n * 6 * 4096]; p[(size_t)n * 6 * 4096] = st; st = so[n] * st + sn[n] * c; } }
            if (sl == 0 && F_tid < 64) { float st = 0.f; float* p = F_NST + ((size_t)(b * NCHS) * 6 + h) * 64 + F_tid;
#pragma unroll 8
              for (int n = 0; n < NCHS; ++n) { const float c = p[(size_t)n * 6 * 64]; p[(size_t)n * 6 * 64] = st; st = so[n] * st + sn[n] * c; } }
        } else {
            const int v = u - NU_M, bh = v >> 2, sl = v & 3, b = bh / 4, hh = bh % 4;
            const int e = sl * 512 + F_tid, d = e >> 6;
            float st = 0.f; float* p = F_SST + ((size_t)(b * NCHS) * 4 + hh) * 2048 + e; const float* ad = F_ADEC + ((size_t)(b * NCHS) * 4 + hh) * 32 + d;
#pragma unroll 8
            for (int n = 0; n < NCHS; ++n) { const float c = p[(size_t)n * 4 * 2048]; const float a = ad[(size_t)n * 4 * 32]; p[(size_t)n * 4 * 2048] = st; st = a * st + c; }
        }
    }
    __syncthreads();
}

#define P4_STORE8(o, kg, yrow, GATE_EXPR) do { _Pragma("unroll") for (int c8 = 0; c8 < 8; ++c8) if ((kg) == c8) { float yv[8]; \
    _Pragma("unroll") for (int i = 0; i < 8; ++i) { const int v = c8 * 8 + i; yv[i] = (o)[v] * (GATE_EXPR); } \
    v4u w; w.x = pk2(yv[0], yv[1]); w.y = pk2(yv[2], yv[3]); w.z = pk2(yv[4], yv[5]); w.w = pk2(yv[6], yv[7]); *(GAS v4u*)((yrow) + c8 * 8) = w; } } while (0)

__device__ __forceinline__ void p4_attn(Frame& F, int layer, int b, int n, int h) {
    const int t = F_tid >> 3, kg = F_tid & 7;
    const int r0 = b * SEQ + n * CH, row = r0 + t;
    LAS float* qL = (LAS float*)(F.lds + RING_OFF);
    stage_tile(F, b, n, ZC_AQ + h * 64, 64, 1.f, qL, LP);
    __syncthreads();
    float o[64];
#pragma unroll
    for (int c = 0; c < 64; ++c) o[c] = 0.f;
    float m = -1e30f, l = 0.f;
    const float* rb = F_rel_bias + (size_t)(layer * 6 + h) * 257;
    for (int i = 0; i < 72; ++i) {
        const int jb = kg + 8 * i, kpos = n * CH - 512 + jb;
        if (kpos < 0) continue;
        const bf16* kr = F_Z + (size_t)(b * SEQ + kpos) * LDZ + ZC_AK + h * 64;
        float s = 0.f;
#pragma unroll
        for (int c = 0; c < 8; ++c) { float kf[8]; ld8(kr + c * 8, kf);
#pragma unroll
            for (int e = 0; e < 8; ++e) s += qL[t * LP + c * 8 + e] * kf[e]; }
        int rel = t + 512 - jb; rel = rel < -128 ? -128 : (rel > 128 ? 128 : rel);
        s = s * 0.125f + rb[rel + 128];
        const float mn = fmaxf(m, s), a = expf(m - mn), p = expf(s - mn);
        l = l * a + p; m = mn;
        const bf16* vr = F_Z + (size_t)(b * SEQ + kpos) * LDZ + ZC_AV + h * 64;
#pragma unroll
        for (int c = 0; c < 8; ++c) { float vf[8]; ld8(vr + c * 8, vf);
#pragma unroll
            for (int e = 0; e < 8; ++e) o[c * 8 + e] = o[c * 8 + e] * a + p * vf[e]; }
    }
#pragma unroll
    for (int off = 1; off < 8; off <<= 1) {
        const float m2 = __shfl_xor(m, off), l2 = __shfl_xor(l, off);
        const float mn = fmaxf(m, m2), a = expf(m - mn), bb = expf(m2 - mn);
        l = l * a + l2 * bb; m = mn;
#pragma unroll
        for (int c = 0; c < 64; ++c) { const float o2 = __shfl_xor(o[c], off); o[c] = o[c] * a + o2 * bb; }
    }
    const float inv = 1.0f / l;
    const bf16* gr = F_Z + (size_t)row * LDZ + ZC_AG + h * 64;
    bf16* yrow = F_Y + (size_t)row * DM + h * 64;
    P4_STORE8(o, kg, yrow, inv * siluf(bf2f(gr[v])));
}

__device__ __forceinline__ void p4_mlstm(Frame& F, int layer, int b, int n, int h) {
    LAS float* L = (LAS float*)(F.lds + RING_OFF);
    LAS float* qc = L; LAS float* kc = qc + 64 * LP; LAS float* vv = kc + 64 * LP; LAS float* Cp = vv + 64 * LP;
    LAS float* np = Cp + 64 * LP; LAS float* ig = np + 64; LAS float* bc = ig + 64; LAS float* lf = bc + 64;
    const int cn = b * NCHS + n, r0 = b * SEQ + n * CH;
    stage_conv(F, layer, b, n, ZC_MQ + h * 64, h * 64, 1.f, qc);
    stage_conv(F, layer, b, n, ZC_MK + h * 64, 384 + h * 64, 0.125f, kc);
    stage_tile(F, b, n, ZC_MV + h * 64, 64, 1.f, vv, LP);
    { const float* cs = F_CST + ((size_t)cn * 6 + h) * 4096; for (int idx = F_tid; idx < 4096; idx += NTHR) Cp[(idx >> 6) * LP + (idx & 63)] = cs[idx]; }
    if (F_tid < 64) np[F_tid] = F_NST[((size_t)cn * 6 + h) * 64 + F_tid];
    stage_mgates(F, layer, b, n, h, ig, bc, lf);
    __syncthreads();
    const float mprev = F_MP[cn * 6 + h];
    const int t = F_tid >> 3, jg = F_tid & 7, row = r0 + t;
    const float bt = bc[t], il = bt + mprev;
    float mx = il;
    for (int i = 0; i < 8; ++i) { const int j = jg + 8 * i; if (j <= t) mx = fmaxf(mx, bt - bc[j] + ig[j]); }
    mx = fmaxf(mx, __shfl_xor(mx, 1)); mx = fmaxf(mx, __shfl_xor(mx, 2)); mx = fmaxf(mx, __shfl_xor(mx, 4));
    float num[64]; float den = 0.f;
#pragma unroll
    for (int c = 0; c < 64; ++c) num[c] = 0.f;
    for (int i = 0; i < 8; ++i) { const int j = jg + 8 * i;
        if (j <= t) { float dot = 0.f;
#pragma unroll 8
            for (int k = 0; k < 64; ++k) dot += qc[t * LP + k] * kc[j * LP + k];
            const float sc = dot * expf(bt - bc[j] + ig[j] - mx); den += sc;
#pragma unroll
            for (int c = 0; c < 64; ++c) num[c] += sc * vv[j * LP + c]; } }
    const float iw = expf(il - mx);
#pragma unroll 2
    for (int kk = 0; kk < 8; ++kk) { const int k = jg * 8 + kk; const float qk = qc[t * LP + k] * iw; den += qk * np[k];
#pragma unroll
        for (int c = 0; c < 64; ++c) num[c] += qk * Cp[c * LP + k]; }
#pragma unroll
    for (int off = 1; off < 8; off <<= 1) { den += __shfl_xor(den, off);
#pragma unroll
        for (int c = 0; c < 64; ++c) num[c] += __shfl_xor(num[c], off); }
    den = fmaxf(fabsf(den), expf(-mx));
    const float rden = 1.0f / den; float ss = 0.f;
#pragma unroll
    for (int c = 0; c < 64; ++c) { num[c] *= rden; ss += num[c] * num[c]; }
    const float rn = 1.0f / sqrtf(ss * (1.0f / 64.0f) + EPS);
    const bf16* mo = F_Z + (size_t)row * LDZ + ZC_MO + h * 64; const bf16* mg = F_Z + (size_t)row * LDZ + ZC_MG + h * 64;
    const float* gn = F_ml_norm_g + layer * 384 + h * 64;
    bf16* yrow = F_Y + (size_t)row * DM + 384 + h * 64;
    P4_STORE8(num, jg, yrow, rn * gn[v] * sigmf(bf2f(mo[v])) * siluf(bf2f(mg[v])));
}

__device__ __forceinline__ void p4_gla(Frame& F, int layer, int b, int n, int hh) {
    LAS float* L = (LAS float*)(F.lds + RING_OFF);
    LAS float* qx = L; LAS float* kk = qx + 64 * 33; LAS float* vv = kk + 64 * 33; LAS float* bcum = vv + 64 * LP; LAS float* Sp = bcum + 64 * 33;
    const int cn = b * NCHS + n, r0 = b * SEQ + n * CH;
    stage_tile(F, b, n, ZC_GQ + hh * 32, 32, 0.17677669529663687f, qx, 33);
    stage_tile(F, b, n, ZC_GK + hh * 32, 32, 1.f, kk, 33);
    stage_tile(F, b, n, ZC_GV + hh * 64, 64, 1.f, vv, LP);
    { const float* ss = F_SST + ((size_t)cn * 4 + hh) * 2048; for (int idx = F_tid; idx < 2048; idx += NTHR) Sp[(idx >> 6) * LP + (idx & 63)] = ss[idx]; }
    stage_gla_decay(F, layer, b, n, hh, bcum);
    const int t = F_tid >> 3, jg = F_tid & 7, row = r0 + t;
    float num[64];
#pragma unroll
    for (int c = 0; c < 64; ++c) num[c] = 0.f;
    for (int i = 0; i < 8; ++i) { const int j = jg + 8 * i;
        if (j <= t) { float att = 0.f;
#pragma unroll 4
            for (int d = 0; d < 32; ++d) att += qx[t * 33 + d] * kk[j * 33 + d] * expf(bcum[t * 33 + d] - bcum[j * 33 + d]);
#pragma unroll
            for (int c = 0; c < 64; ++c) num[c] += att * vv[j * LP + c]; } }
#pragma unroll 2
    for (int dd = 0; dd < 4; ++dd) { const int d = jg * 4 + dd; const float w = qx[t * 33 + d] * expf(bcum[t * 33 + d]);
#pragma unroll
        for (int c = 0; c < 64; ++c) num[c] += w * Sp[d * LP + c]; }
    float ss = 0.f;
#pragma unroll
    for (int off = 1; off < 8; off <<= 1) {
#pragma unroll
        for (int c = 0; c < 64; ++c) num[c] += __shfl_xor(num[c], off); }
#pragma unroll
    for (int c = 0; c < 64; ++c) ss += num[c] * num[c];
    const float rn = 1.0f / sqrtf(ss * (1.0f / 64.0f) + EPS);
    const bf16* gg = F_Z + (size_t)row * LDZ + ZC_GG + hh * 64;
    const float* gn = F_gla_norm_g + layer * 256 + hh * 64;
    bf16* yrow = F_Y + (size_t)row * DM + 768 + hh * 64;
    P4_STORE8(num, jg, yrow, rn * gn[v] * siluf(bf2f(gg[v])));
}

__device__ __forceinline__ void p4_outputs(Frame& F, int layer) {
    for (int u = F.vcu; u < NCHT * 16; u += F.G) {
        const int task = u & 15, cn = u >> 4, b = cn / NCHS, n = cn % NCHS;
        __syncthreads();
        if (task < 6) p4_attn(F, layer, b, n, task);
        else if (task < 12) p4_mlstm(F, layer, b, n, task - 6);
        else p4_gla(F, layer, b, n, task - 12);
    }
    __syncthreads();
}

__device__ __forceinline__ void p11_final(Frame& F) {
    const int gw = F.vcu * NWAVES + F.wave, NGW = F.G * NWAVES;
    const float* ssq = F_SSQ + 2 * T;
    for (int m = gw; m < T; m += NGW) {
        const float rs = 1.0f / sqrtf(ssq[m] * (1.0f / 1024.0f) + EPS);
        GAS f32x4* xr = (GAS f32x4*)(F_out + (size_t)m * DM) + F_lane; const GAS f32x4* gr = (const GAS f32x4*)F_final_g + F_lane;
#pragma unroll
        for (int j = 0; j < 4; ++j) { const f32x4 v = xr[64 * j], g = gr[64 * j]; xr[64 * j] = v * rs * g; }
    }
}

__global__ void __launch_bounds__(NTHR, 2) hymba_fwd(Args args) {
    extern __shared__ __attribute__((aligned(16))) unsigned char lds[];
    Frame F;
    F.lds = (LAS unsigned char*)lds;
    F.MISC = (volatile LAS unsigned*)(F.lds + MISC_OFF);
    F.wave = __builtin_amdgcn_readfirstlane(F_tid >> 6);
    F.G = gridDim.x; { const int bx = blockIdx.x; F.vcu = (F.G % 8 == 0) ? (bx % 8) * (F.G / 8) + bx / 8 : bx; }
    F.A = &args;
    for (int u = F_tid; u < (LDS_BYTES - LDSCTL_OFF) / 4; u += NTHR) ((LAS unsigned*)(F.lds + LDSCTL_OFF))[u] = 0u;
    __syncthreads();
    XcdBarrier bar; bar.bar = (unsigned*)(F_ctl + CW_BAR); bar.x = 0; bar.st = nullptr;
    if (N_LAUNCHES == 1) bar = xcd_barrier_post((unsigned*)(F_ctl + CW_BAR), F.MISC + 8);
#define GRID_BAR() do { if (N_LAUNCHES == 1) xcd_barrier(bar); } while (0)
    const int lo = args.ph_lo, hi = args.ph_hi;
#define IN(k) (lo <= (k) && (k) < hi)
#define BOTH(k) (IN(k) && IN((k) + 1))
    if (IN(0)) { p0_prologue(F); if (BOTH(0)) GRID_BAR(); }
#pragma unroll 1
    for (int step = 0; step < 2 * DEPTH; ++step) {
        const int layer = step >> 1, which = step & 1, pb = 1 + 5 * layer, pid = which ? pb + 4 : pb;
        if (IN(pid)) {
            const int N = which ? DM : NP;
            pg8::Gemm g{which ? F_Y : F_XB, which ? F_Wout_t + (size_t)layer * DM * DM : F_Win_t + (size_t)layer * NP * DM, T, N, DM};
            pg8::StaticOrder S; S.init(T, N, F.G, (int)blockIdx.x);
            pg8::EpiBoth E{which, pg8::EpiZ{F_Z, LDZ, F_SSQ + layer * T, F_G32, ZC_SM},
                           pg8::EpiRes{layer == 0 ? F_x : (const float*)F_out, F_out, layer == 0 ? F_XB : (bf16*)nullptr, F_SSQ + (layer + 1) * T}};
            pg8::gemm_phase<pg8::EpiBoth, pg8::StaticOrder, true, true>(F.lds + RING_OFF, g, S, E);
            if (BOTH(pid)) GRID_BAR();
        }
        if (which == 0) {
            if (IN(pb + 1)) { p2_local(F, layer); if (BOTH(pb + 1)) GRID_BAR(); }
            if (IN(pb + 2)) { p3_scan(F); if (BOTH(pb + 2)) GRID_BAR(); }
            if (IN(pb + 3)) { p4_outputs(F, layer); if (BOTH(pb + 3)) GRID_BAR(); }
        }
    }
    if (IN(11)) p11_final(F);
#undef IN
#undef BOTH
}

extern "C" void kernel_launch(void* const* d_in, const int* in_sizes, int n_in, void* d_out, int out_size, void* d_ws, size_t ws_size, hipStream_t stream) {
    static int grid = 0;
    if (grid == 0) {
        if (n_in != 12 || in_sizes[0] != T * DM || out_size != T * DM || ws_size < WS_END) {
            fprintf(stderr, "kernel_launch: unexpected shapes (n_in %d, in0 %d, out %d, ws %zu, need %zu); nothing launched\n", n_in, n_in > 0 ? in_sizes[0] : -1, out_size, ws_size, (size_t)WS_END); grid = -1; return; }
        int dev = 0, cus = 0, per_cu = 0;
        if (hipGetDevice(&dev) != hipSuccess || hipDeviceGetAttribute(&cus, hipDeviceAttributeMultiprocessorCount, dev) != hipSuccess) { fprintf(stderr, "kernel_launch: device query failed\n"); grid = -1; return; }
        if (hipFuncSetAttribute((const void*)hymba_fwd, hipFuncAttributeMaxDynamicSharedMemorySize, LDS_BYTES) != hipSuccess) { fprintf(stderr, "kernel_launch: hipFuncSetAttribute failed\n"); grid = -1; return; }
        if (hipOccupancyMaxActiveBlocksPerMultiprocessor(&per_cu, (const void*)hymba_fwd, NTHR, LDS_BYTES) != hipSuccess || per_cu < 1) {
            fprintf(stderr, "kernel_launch: occupancy query reports %d workgroups per CU; nothing launched\n", per_cu); (void)hipGetLastError(); grid = -1; return; }
        grid = cus;
        fprintf(stderr, "kernel_launch: grid %d x %d threads, %d B LDS, occupancy query %d/CU\n", grid, NTHR, LDS_BYTES, per_cu);
    }
    if (grid < 0) return;
    if (hipMemsetAsync((char*)d_ws + WS_CTL, 0, CTL_ZERO_BYTES, stream) != hipSuccess) { fprintf(stderr, "kernel_launch: memset failed\n"); return; }
    Args a{};
    for (int i = 0; i < 12; ++i) a.in[i] = (const float*)d_in[i];
    a.out = (float*)d_out; a.ws = (unsigned char*)d_ws;
    if (N_LAUNCHES == 1) {
        a.ph_lo = 0; a.ph_hi = NPHASE; a.li = 0;
        void* kargs[] = {&a};
        hipError_t e = hipLaunchCooperativeKernel((const void*)hymba_fwd, dim3(grid), dim3(NTHR), kargs, LDS_BYTES, stream);
        if (e != hipSuccess) fprintf(stderr, "kernel_launch: cooperative launch failed: %s\n", hipGetErrorString(e));
    } else {
        for (int p = 0; p < NPHASE; ++p) { a.ph_lo = p; a.ph_hi = p + 1; a.li = p;
            hipLaunchKernelGGL(hymba_fwd, dim3(grid), dim3(NTHR), LDS_BYTES, stream, a);
            if (hipPeekAtLastError() != hipSuccess) { fprintf(stderr, "kernel_launch: launch %d failed\n", p); break; } }
    }
}
```

```cpp
#include <hip/hip_runtime.h>
#include <cstdio>
#include <cstdint>
#include <cmath>

#ifndef MK_N_LAUNCHES
#define MK_N_LAUNCHES 1
#endif

namespace pg8 {
#define PG8_LAS __attribute__((address_space(3)))
typedef unsigned short bf16_t;
typedef short bf16x8 __attribute__((ext_vector_type(8)));
typedef float f32x4 __attribute__((ext_vector_type(4)));
typedef unsigned u32x4 __attribute__((ext_vector_type(4)));
constexpr int BM = 256, BK = 64, HALF = 128, HTB = HALF * BK * 2  , STAGE_BYTES = 8 * HTB, NXCD = 8, WGM = 8;

__host__ __device__ __forceinline__ int lds_byte(int r, int c) { const int st = (r >> 4) * 2 + (c >> 5), rr = r & 15, cc = c & 31, ob = rr * 64 + cc * 2; return st * 1024 + (ob ^ (((ob >> 9) & 1) << 5)); }
__host__ __device__ __forceinline__ void stage_rc(int b, int& R, int& C) { const int st = b / 1024, sb = b % 1024, swz = sb ^ (((sb >> 9) & 1) << 5); R = (st >> 1) * 16 + swz / 64; C = (st & 1) * 32 + (swz % 64) / 2; }
__host__ __device__ __forceinline__ int perm32(int rho) { const int n = rho >> 4, i = rho & 15; return 8 * (i >> 2) + 4 * n + (i & 3); }

struct Unit { int pm, pn; };
struct Gemm { const bf16_t* A; const bf16_t* Bt; int M, N, K; };

struct StaticOrder {
    int nM, nN, nwg, G, c;
    __host__ __device__ void init(int M, int N, int G_, int c_) { nM = M / BM; nN = N / BM; nwg = nM * nN; G = G_; c = c_; }
    __host__ __device__ bool next(int i, Unit& u) const {
        const long L = (long)i * G + c; if (L >= nwg) return false;
        int wgid = (int)L; { const int q = nwg / NXCD, r = nwg % NXCD, xcd = wgid % NXCD, off = wgid / NXCD; wgid = (xcd < r ? xcd * (q + 1) : r * (q + 1) + (xcd - r) * q) + off; }
        const int nig = WGM * nN, gid = wgid / nig, fm = gid * WGM, gsz = (nM - fm) < WGM ? (nM - fm) : WGM;
        u.pm = fm + ((wgid % nig) % gsz); u.pn = (wgid % nig) / gsz; return true;
    }
    __device__ __forceinline__ void a_ready(const Unit&) const {}
    __device__ __forceinline__ void done(const Unit&) const {}
};

__device__ __forceinline__ unsigned cvt_pk_bf16(float lo, float hi) { unsigned r; asm volatile("v_cvt_pk_bf16_f32 %0, %1, %2" : "=v"(r) : "v"(lo), "v"(hi)); return r; }

typedef unsigned u32x2 __attribute__((ext_vector_type(2)));
struct EpiZ {
    bf16_t* Z; int ldz; const float* ssq; float* G32; int gcol0;
    __device__ __forceinline__ void operator()(const f32x4 (&acc)[2][2][4][2], const Unit& u, int wr, int wc, int fr, int fq) const {
        const int row0 = u.pm * BM + wr * 64 + fr, col0 = u.pn * BM + wc * 32 + 8 * fq;
#pragma unroll
        for (int ai = 0; ai < 2; ++ai)
#pragma unroll
            for (int m = 0; m < 4; ++m) {
                const int row = row0 + ai * HALF + m * 16;
                const float rs = 1.0f / sqrtf(ssq[row] * (1.0f / 1024.0f) + 1e-6f);
#pragma unroll
                for (int bj = 0; bj < 2; ++bj) {
                    const int col = col0 + bj * HALF;
                    const f32x4 v0 = acc[ai][bj][m][0] * rs, v1 = acc[ai][bj][m][1] * rs;
                    if (col < ldz) {
                        u32x4 w; w.x = cvt_pk_bf16(v0[0], v0[1]); w.y = cvt_pk_bf16(v0[2], v0[3]); w.z = cvt_pk_bf16(v1[0], v1[1]); w.w = cvt_pk_bf16(v1[2], v1[3]);
                        *(u32x4*)(Z + (size_t)row * ldz + col) = w;
                    } else if (col < gcol0 + 32) {
                        float* gp = G32 + (size_t)row * 32 + (col - gcol0);
                        *(f32x4*)gp = v0; *(f32x4*)(gp + 4) = v1;
                    }
                }
            }
    }
};
struct EpiRes {
    const float* base; float* out; bf16_t* xb; float* ssq;
    __device__ __forceinline__ void operator()(const f32x4 (&acc)[2][2][4][2], const Unit& u, int wr, int wc, int fr, int fq) const {
        const int col0 = u.pn * BM + wc * 32 + 8 * fq;
#pragma unroll
        for (int ai = 0; ai < 2; ++ai)
#pragma unroll
            for (int m = 0; m < 4; ++m) {
                const int row = u.pm * BM + ai * HALF + wr * 64 + m * 16 + fr;
                float s = 0.f;
#pragma unroll
                for (int bj = 0; bj < 2; ++bj) {
                    const size_t off = (size_t)row * 1024 + col0 + bj * HALF;
                    const f32x4 o0 = *(const f32x4*)(base + off) + acc[ai][bj][m][0], o1 = *(const f32x4*)(base + off + 4) + acc[ai][bj][m][1];
                    *(f32x4*)(out + off) = o0; *(f32x4*)(out + off + 4) = o1;
                    s += (o0[0] * o0[0] + o0[1] * o0[1]) + (o0[2] * o0[2] + o0[3] * o0[3]) + (o1[0] * o1[0] + o1[1] * o1[1]) + (o1[2] * o1[2] + o1[3] * o1[3]);
                    if (xb) { u32x4 w; w.x = cvt_pk_bf16(o0[0], o0[1]); w.y = cvt_pk_bf16(o0[2], o0[3]); w.z = cvt_pk_bf16(o1[0], o1[1]); w.w = cvt_pk_bf16(o1[2], o1[3]); *(u32x4*)(xb + off) = w; }
                }
                s += __shfl_xor(s, 16); s += __shfl_xor(s, 32);
                if (fq == 0) atomicAdd(ssq + row, s);
                asm volatile("" ::: "memory");
            }
    }
};
struct EpiBoth {
    static constexpr bool PERM = true, AFTER_DRAIN = false;
    int mode; EpiZ z; EpiRes r;
    __device__ __forceinline__ void operator()(const f32x4 (&acc)[2][2][4][2], const Unit& u, int wr, int wc, int fr, int fq) const {
        if (mode == 0) z(acc, u, wr, wc, fr, fq); else r(acc, u, wr, wc, fr, fq);
    }
};

template <class Epi, class Sched, bool ALIGN_EPI = false, bool SP2 = false>
__device__ __forceinline__ void gemm_phase(PG8_LAS unsigned char* lds, const Gemm g, const Sched& S, const Epi& E) {
    int tid_ = threadIdx.x; asm volatile("" : "+v"(tid_));
    const int tid = tid_, wid = __builtin_amdgcn_readfirstlane(tid >> 6), lane = tid & 63, wr = wid >> 2, wc = wid & 3, fr = lane & 15, fq = lane >> 4;
    const int K = g.K, nt = K / BK;
    unsigned voffA[2], voffB[2];
#pragma unroll
    for (int i = 0; i < 2; ++i) { int R, C; stage_rc(tid * 16 + i * 8192, R, C); const int Rb = Epi::PERM ? ((R & ~31) + perm32(R & 31)) : R;
        voffA[i] = (unsigned)(R * K + C) * 2u; voffB[i] = (unsigned)(Rb * K + C) * 2u; }
    const size_t kstep = (size_t)(BK * 2);
    const size_t hstep = (size_t)HALF * K * 2;
    const size_t tstep = 2 * hstep;
    const unsigned ldsw = (unsigned)wid * 1024u;
    const int aoff = lds_byte(wr * 64 + fr, fq * 8), boff = lds_byte(wc * 32 + fr, fq * 8);
#define PG8_SA(b, h) (((b) * 2 + (h)) * HTB)
#define PG8_SB(b, h) ((4 + (b) * 2 + (h)) * HTB)
#define PG8_STAGE(bufoff, gbase, voff) do { _Pragma("unroll") for (int _i = 0; _i < 2; ++_i) \
        __builtin_amdgcn_global_load_lds((const unsigned*)((const char*)(gbase) + (voff)[_i]), (PG8_LAS unsigned*)(lds + (bufoff) + ldsw + _i * 8192), 16, 0, 0); } while (0)
#define PG8_LDA(dst, b, h) do { _Pragma("unroll") for (int m = 0; m < 4; ++m) _Pragma("unroll") for (int k = 0; k < 2; ++k) dst[m][k] = *(const PG8_LAS bf16x8*)(lds + PG8_SA(b, h) + aoff + m * 2048 + k * 1024); } while (0)
#define PG8_LDB(dst, b, h) do { _Pragma("unroll") for (int n = 0; n < 2; ++n) _Pragma("unroll") for (int k = 0; k < 2; ++k) dst[n][k] = *(const PG8_LAS bf16x8*)(lds + PG8_SB(b, h) + boff + n * 2048 + k * 1024); } while (0)
#define PG8_MMA(ai, bj, At, Bt) do { __builtin_amdgcn_s_setprio(1); _Pragma("unroll") for (int m = 0; m < 4; ++m) _Pragma("unroll") for (int n = 0; n < 2; ++n) _Pragma("unroll") for (int k = 0; k < 2; ++k) \
        acc[ai][bj][m][n] = __builtin_amdgcn_mfma_f32_16x16x32_bf16(Bt[n][k], At[m][k], acc[ai][bj][m][n], 0, 0, 0); __builtin_amdgcn_s_setprio(0); } while (0)
#define PG8_WAIT_V(n) asm volatile("s_waitcnt vmcnt(" #n ")" ::: "memory")
#define PG8_WAIT_L(n) asm volatile("s_waitcnt lgkmcnt(" #n ")" ::: "memory")
#define PG8_BAR __builtin_amdgcn_s_barrier()
#define PG8_SCHED __builtin_amdgcn_sched_barrier(0)
    Unit cur, nxt; int ui = 0;
    if (!S.next(0, cur)) return;
    f32x4 acc[2][2][4][2];
#pragma unroll
    for (int a = 0; a < 2; ++a)
#pragma unroll
        for (int b = 0; b < 2; ++b)
#pragma unroll
            for (int m = 0; m < 4; ++m)
#pragma unroll
                for (int n = 0; n < 2; ++n) acc[a][b][m][n] = (f32x4){0.f, 0.f, 0.f, 0.f};
    bf16x8 At[4][2], B0[2][2], B1[2][2];
    const char* cA = (const char*)g.A + (size_t)cur.pm * tstep; const char* cB = (const char*)g.Bt + (size_t)cur.pn * tstep;
    S.a_ready(cur);
    if constexpr (SP2) {
        PG8_STAGE(PG8_SB(0, 0), cB, voffB); PG8_STAGE(PG8_SB(0, 1), cB + hstep, voffB); PG8_STAGE(PG8_SA(0, 0), cA, voffA); PG8_STAGE(PG8_SA(0, 1), cA + hstep, voffA);
        if (wr == 1) PG8_BAR;
        PG8_WAIT_V(2); PG8_BAR;
        PG8_STAGE(PG8_SB(1, 0), cB + kstep, voffB); PG8_STAGE(PG8_SA(1, 0), cA + kstep, voffA); PG8_STAGE(PG8_SB(1, 1), cB + hstep + kstep, voffB);
        PG8_WAIT_V(6); PG8_BAR;
    } else {
        PG8_STAGE(PG8_SB(0, 0), cB, voffB); PG8_STAGE(PG8_SA(0, 0), cA, voffA); PG8_STAGE(PG8_SB(0, 1), cB + hstep, voffB); PG8_STAGE(PG8_SA(0, 1), cA + hstep, voffA);
        if (wr == 1) PG8_BAR;
        PG8_WAIT_V(4); PG8_BAR;
        PG8_STAGE(PG8_SB(1, 0), cB + kstep, voffB); PG8_STAGE(PG8_SA(1, 0), cA + kstep, voffA); PG8_STAGE(PG8_SB(1, 1), cB + hstep + kstep, voffB);
        PG8_WAIT_V(6); PG8_BAR;
    }
    for (;;) {
        const bool has_next = S.next(ui + 1, nxt);
        const char* nA = has_next ? (const char*)g.A + (size_t)nxt.pm * tstep : cA; const char* nB = has_next ? (const char*)g.Bt + (size_t)nxt.pn * tstep : cB;
        for (int t = 0; t < nt; t += 2) {
            const bool last = (t == nt - 2);
            const char* a1 = cA + (size_t)(t + 1) * kstep;
            const char* a2 = last ? nA : cA + (size_t)(t + 2) * kstep; const char* b2 = last ? nB : cB + (size_t)(t + 2) * kstep;
            const char* a3 = a2 + kstep; const char* b3 = b2 + kstep;
            if (last && has_next) S.a_ready(nxt);
            if constexpr (SP2) {
            PG8_LDB(B0, 0, 0); PG8_LDB(B1, 0, 1); PG8_SCHED; PG8_LDA(At, 0, 0); PG8_STAGE(PG8_SA(1, 1), a1 + hstep, voffA);
            PG8_WAIT_V(8); PG8_WAIT_L(0); PG8_BAR; PG8_MMA(0, 0, At, B0); PG8_MMA(0, 1, At, B1); PG8_BAR; PG8_SCHED;
            PG8_LDA(At, 0, 1); PG8_STAGE(PG8_SB(0, 0), b2, voffB); PG8_STAGE(PG8_SB(0, 1), b2 + hstep, voffB); PG8_STAGE(PG8_SA(0, 0), a2, voffA);
            PG8_WAIT_V(8); PG8_WAIT_L(0); PG8_BAR; PG8_MMA(1, 0, At, B0); PG8_MMA(1, 1, At, B1); PG8_BAR; PG8_SCHED;
            PG8_LDB(B0, 1, 0); PG8_LDB(B1, 1, 1); PG8_SCHED; PG8_LDA(At, 1, 0); PG8_STAGE(PG8_SA(0, 1), a2 + hstep, voffA);
            PG8_WAIT_V(8); PG8_WAIT_L(0); PG8_BAR; PG8_MMA(0, 0, At, B0); PG8_MMA(0, 1, At, B1); PG8_BAR; PG8_SCHED;
            PG8_LDA(At, 1, 1); PG8_STAGE(PG8_SB(1, 0), b3, voffB); PG8_STAGE(PG8_SB(1, 1), b3 + hstep, voffB); PG8_STAGE(PG8_SA(1, 0), a3, voffA);
            PG8_WAIT_V(8); PG8_WAIT_L(0); PG8_BAR; PG8_MMA(1, 0, At, B0); PG8_MMA(1, 1, At, B1); PG8_BAR; PG8_SCHED;
            } else {
            PG8_LDB(B0, 0, 0); PG8_SCHED; PG8_LDA(At, 0, 0); PG8_STAGE(PG8_SA(1, 1), a1 + hstep, voffA);
            PG8_WAIT_L(8); PG8_BAR; PG8_WAIT_L(0); PG8_MMA(0, 0, At, B0); PG8_BAR; PG8_SCHED;
            PG8_LDB(B1, 0, 1); PG8_STAGE(PG8_SB(0, 0), b2, voffB);
            PG8_BAR; PG8_WAIT_L(0); PG8_MMA(0, 1, At, B1); PG8_BAR;
            PG8_LDA(At, 0, 1); PG8_STAGE(PG8_SA(0, 0), a2, voffA);
            PG8_BAR; PG8_WAIT_L(0); PG8_MMA(1, 0, At, B0); PG8_BAR; PG8_SCHED;
            PG8_STAGE(PG8_SB(0, 1), b2 + hstep, voffB);
            PG8_WAIT_V(6); PG8_BAR; PG8_MMA(1, 1, At, B1); PG8_BAR;
            PG8_LDB(B0, 1, 0); PG8_SCHED; PG8_LDA(At, 1, 0); PG8_STAGE(PG8_SA(0, 1), a2 + hstep, voffA);
            PG8_WAIT_L(8); PG8_BAR; PG8_WAIT_L(0); PG8_MMA(0, 0, At, B0); PG8_BAR; PG8_SCHED;
            PG8_LDB(B1, 1, 1); PG8_STAGE(PG8_SB(1, 0), b3, voffB);
            PG8_BAR; PG8_WAIT_L(0); PG8_MMA(0, 1, At, B1); PG8_BAR;
            PG8_LDA(At, 1, 1); PG8_STAGE(PG8_SA(1, 0), a3, voffA);
            PG8_BAR; PG8_WAIT_L(0); PG8_MMA(1, 0, At, B0); PG8_BAR; PG8_SCHED;
            PG8_STAGE(PG8_SB(1, 1), b3 + hstep, voffB);
            PG8_WAIT_V(6); PG8_BAR; PG8_MMA(1, 1, At, B1); PG8_BAR;
            }
        }
        if constexpr (ALIGN_EPI) { if (wr == 0) PG8_BAR; }
        if constexpr (!Epi::AFTER_DRAIN) { E(acc, cur, wr, wc, fr, fq); S.done(cur); }
        if (!has_next) break;
#pragma unroll
        for (int a = 0; a < 2; ++a)
#pragma unroll
            for (int b = 0; b < 2; ++b)
#pragma unroll
                for (int m = 0; m < 4; ++m)
#pragma unroll
                    for (int n = 0; n < 2; ++n) acc[a][b][m][n] = (f32x4){0.f, 0.f, 0.f, 0.f};
        cur = nxt; cA = nA; cB = nB; ++ui;
        if constexpr (ALIGN_EPI) { if (wr == 1) PG8_BAR; }
    }
    PG8_WAIT_V(0);
    if constexpr (!ALIGN_EPI) { if (wr == 0) PG8_BAR; }
    PG8_BAR;
    if constexpr (Epi::AFTER_DRAIN) { E.fused(acc, cur, wr, wc, fr, fq, lds, wid, lane); S.done(cur); }
#undef PG8_SA
#undef PG8_SB
#undef PG8_STAGE
#undef PG8_LDA
#undef PG8_LDB
#undef PG8_MMA
#undef PG8_WAIT_V
#undef PG8_WAIT_L
#undef PG8_BAR
#undef PG8_SCHED
}
}

constexpr int NWAVES = 8, NTHR = 512;
constexpr int N_LAUNCHES = MK_N_LAUNCHES;
constexpr int NPHASE = 12;
constexpr int BATCH = 2, SEQ = 8192, DM = 1024, T = BATCH * SEQ, DEPTH = 2, CH = 64, NCHT = T / CH  , NCHS = SEQ / CH  ;
constexpr int DIN = 4252, NP = 4352, LDZ = 4224;
constexpr int ZC_AQ = 0, ZC_AK = 384, ZC_AV = 768, ZC_AG = 1152, ZC_MQ = 1536, ZC_MK = 1920, ZC_MV = 2304, ZC_MO = 2688, ZC_MG = 3072, ZC_GQ = 3456, ZC_GK = 3584, ZC_GV = 3712, ZC_GG = 3968, ZC_SM = 4224;
constexpr float EPS = 1e-6f;
__host__ __device__ __forceinline__ int src_col(int n) {
    if (n < 3072) return n;
    if (n < 3968) return n + 12;
    if (n < 4224) return n + 28;
    if (n < 4236) return n - 1152;
    if (n < 4252) return n - 256;
    return -1;
}

constexpr size_t MiB = 1u << 20;
constexpr size_t WS_CTL = 0, CTL_ZERO_BYTES = 1 * MiB;
constexpr size_t WS_SSQ = 512 * 1024;
constexpr size_t WS_WIN = 1 * MiB;
constexpr size_t WS_WOUT = WS_WIN + (size_t)2 * NP * DM * 2;
constexpr size_t WS_XB = WS_WOUT + (size_t)2 * DM * DM * 2;
constexpr size_t WS_Y = WS_XB + (size_t)T * DM * 2;
constexpr size_t WS_Z = WS_Y + (size_t)T * DM * 2;
constexpr size_t WS_G32 = WS_Z + (size_t)T * LDZ * 2;
constexpr size_t WS_CST = WS_G32 + (size_t)T * 32 * 4;
constexpr size_t WS_NST = WS_CST + (size_t)NCHT * 6 * 4096 * 4;
constexpr size_t WS_SST = WS_NST + (size_t)NCHT * 6 * 64 * 4;
constexpr size_t WS_ADEC = WS_SST + (size_t)NCHT * 4 * 2048 * 4;
constexpr size_t WS_GS = WS_ADEC + (size_t)NCHT * 4 * 32 * 4;
constexpr size_t WS_MS = WS_GS + 8192;
constexpr size_t WS_MP = WS_MS + 8192;
constexpr size_t WS_END = WS_MP + 8192;
static_assert(WS_END <= 268435456, "d_ws map exceeds 256 MiB");
constexpr int CW_BAR = 4096;

constexpr int RING_OFF = 0, RING_BYTES = 147456;
constexpr int WL_BYTES = 18432;
constexpr int LDSCTL_OFF = RING_BYTES, MISC_OFF = LDSCTL_OFF + 320;
constexpr int LDS_BYTES = 148480;
#define GAS __attribute__((address_space(1)))
#define LAS __attribute__((address_space(3)))
typedef unsigned short bf16;
typedef unsigned v4u __attribute__((ext_vector_type(4)));
typedef float f32x4 __attribute__((ext_vector_type(4)));
typedef short bf16x8 __attribute__((ext_vector_type(8)));
typedef GAS unsigned gu32;
typedef GAS unsigned long long gu64;
#define RLX_AGENT __ATOMIC_RELAXED, __HIP_MEMORY_SCOPE_AGENT
#define LDS_WAIT() asm volatile("s_waitcnt lgkmcnt(0)" ::: "memory")
#define VM_WAIT() asm volatile("s_waitcnt vmcnt(0)" ::: "memory")
__device__ __forceinline__ unsigned long long rt() { return __builtin_amdgcn_s_memrealtime(); }
__device__ __forceinline__ unsigned f2bf(float f) { unsigned u = __builtin_bit_cast(unsigned, f); return (u + 0x7fffu + ((u >> 16) & 1u)) >> 16; }
__device__ __forceinline__ unsigned pk2(float lo, float hi) { return f2bf(lo) | (f2bf(hi) << 16); }

#define XB_TMO      128
#define XB_XCNT(j)  (256  + 64 * (j))
#define XB_XSUB(j)  (1280 + 64 * (j))
#define XB_XGEN(j)  (2304 + 64 * (j))
#define XB_TOP      3328
#define XB_TOPGEN   3392
#define XCD_BAR_WORDS 3456
#define XB_SPIN_CAP (1u << 18)

__device__ __forceinline__ unsigned xb_ld(unsigned* p)              { return __hip_atomic_load(p, __ATOMIC_RELAXED, __HIP_MEMORY_SCOPE_AGENT); }
__device__ __forceinline__ unsigned xb_add(unsigned* p, unsigned v) { return __hip_atomic_fetch_add(p, v, __ATOMIC_RELAXED, __HIP_MEMORY_SCOPE_AGENT); }
__device__ __forceinline__ unsigned xb_xcc_id() { return (unsigned)__builtin_amdgcn_s_getreg((3 << 11) | 20) & 0xFu; }
#define XB_SPIN(cond, bar) do { unsigned _sp = 0; while (cond) { __builtin_amdgcn_s_sleep(1); \
    if ((++_sp & 255u) == 0u) { if (xb_ld(&(bar)[XB_TMO])) break; if (_sp > XB_SPIN_CAP) { atomicAdd(&(bar)[XB_TMO], 1u); break; } } } } while (0)

struct XcdBarrier {
    unsigned* bar; unsigned x;
    volatile LAS unsigned* st;
};

__device__ __forceinline__ XcdBarrier xcd_barrier_post(unsigned* bar, volatile LAS unsigned* st) {
    XcdBarrier b; b.bar = bar; b.x = xb_xcc_id(); b.st = st;
    if (threadIdx.x == 0) (void)xb_add(&bar[XB_XCNT(b.x)], 1u);
    return b;
}
__device__ __forceinline__ void xcd_barrier_complete(unsigned* bar, unsigned x, unsigned& nloc, unsigned& nx) {
    const unsigned G = gridDim.x * gridDim.y * gridDim.z;
    unsigned sum, cnt, mine, sp = 0u;
    for (;;) {
        sum = 0u; cnt = 0u; mine = 0u;
#pragma unroll
        for (unsigned j = 0; j < 16; ++j) { const unsigned c = xb_ld(&bar[XB_XCNT(j)]); sum += c; cnt += (c > 0u) ? 1u : 0u; mine = (j == x) ? c : mine; }
        if (sum == G) break;
        __builtin_amdgcn_s_sleep(1);
        if ((++sp & 255u) == 0u) { if (xb_ld(&bar[XB_TMO])) break; if (sp > XB_SPIN_CAP) { atomicAdd(&bar[XB_TMO], 1u); break; } }
    }
    nloc = mine > 0u ? mine : 1u; nx = cnt > 0u ? cnt : 1u;
}

__device__ __forceinline__ void xcd_barrier(const XcdBarrier& b) {
    asm volatile("s_waitcnt vmcnt(0)" ::: "memory");
    __syncthreads();
    if (threadIdx.x == 0) {
        unsigned* bar = b.bar;
        __builtin_amdgcn_s_waitcnt(0);
        unsigned nloc = b.st[0], nx = b.st[1];
        if (nloc == 0u) { xcd_barrier_complete(bar, b.x, nloc, nx); b.st[0] = nloc; b.st[1] = nx; }
        const unsigned old = xb_add(&bar[XB_XSUB(b.x)], 1u);
        const unsigned gen = old / nloc;
        if (old + 1u == (gen + 1u) * nloc) {
            __builtin_amdgcn_fence(__ATOMIC_RELEASE, "agent");
            asm volatile("s_waitcnt vmcnt(0)" ::: "memory");
            const unsigned og = xb_add(&bar[XB_TOP], 1u);
            const unsigned tg = og / nx;
            if (og + 1u == (tg + 1u) * nx) xb_add(&bar[XB_TOPGEN], 1u);
            else XB_SPIN(xb_ld(&bar[XB_TOPGEN]) == tg, bar);
            __builtin_amdgcn_fence(__ATOMIC_ACQUIRE, "agent");
            xb_add(&bar[XB_XGEN(b.x)], 1u);
            asm volatile("s_waitcnt vmcnt(0)" ::: "memory");
        } else {
            XB_SPIN(xb_ld(&bar[XB_XGEN(b.x)]) == gen, bar);
            __builtin_amdgcn_fence(__ATOMIC_ACQUIRE, "agent");
            asm volatile("s_waitcnt vmcnt(0)" ::: "memory");
        }
    }
    __syncthreads();
}


struct Args { const float* in[12]; float* out; unsigned char* ws; int ph_lo, ph_hi, li, pad; };
struct Frame {
    LAS unsigned char* lds;
    volatile LAS unsigned* MISC;
    const Args* A;
    int wave, vcu, G;
};
__device__ __forceinline__ int opaque_tid() { int t = threadIdx.x; asm volatile("" : "+v"(t)); return t; }
#define F_tid (opaque_tid())
#define F_lane (opaque_tid() & 63)
#define F_x          (F.A->in[0])
#define F_norm_g     (F.A->in[1])
#define F_w_in       (F.A->in[2])
#define F_b_gates    (F.A->in[3])
#define F_conv_w     (F.A->in[4])
#define F_w_alpha    (F.A->in[5])
#define F_b_alpha    (F.A->in[6])
#define F_rel_bias   (F.A->in[7])
#define F_ml_norm_g  (F.A->in[8])
#define F_gla_norm_g (F.A->in[9])
#define F_w_out      (F.A->in[10])
#define F_final_g    (F.A->in[11])
#define F_out        (F.A->out)
#define F_ws         (F.A->ws)
#define F_ctl        ((gu32*)(F_ws + WS_CTL))
#define F_Win_t      ((bf16*)(F_ws + WS_WIN))
#define F_Wout_t     ((bf16*)(F_ws + WS_WOUT))
#define F_XB         ((bf16*)(F_ws + WS_XB))
#define F_Y          ((bf16*)(F_ws + WS_Y))
#define F_Z          ((bf16*)(F_ws + WS_Z))
#define F_G32        ((float*)(F_ws + WS_G32))
#define F_SSQ        ((float*)(F_ws + WS_SSQ))
#define F_CST        ((float*)(F_ws + WS_CST))
#define F_NST        ((float*)(F_ws + WS_NST))
#define F_SST        ((float*)(F_ws + WS_SST))
#define F_ADEC       ((float*)(F_ws + WS_ADEC))
#define F_GS         ((float*)(F_ws + WS_GS))
#define F_MS         ((float*)(F_ws + WS_MS))
#define F_MP         ((float*)(F_ws + WS_MP))
__device__ __forceinline__ float bf2f(unsigned short u) { return __uint_as_float((unsigned)u << 16); }
__device__ __forceinline__ float wave_sum(float v) {
#pragma unroll
    for (int o = 1; o < 64; o <<= 1) v += __shfl_xor(v, o);
    return v;
}
__device__ __forceinline__ float siluf(float x) { return x / (1.0f + expf(-x)); }
__device__ __forceinline__ float sigmf(float x) { return 1.0f / (1.0f + expf(-x)); }
__device__ __forceinline__ float logsigf(float x) { return fminf(x, 0.f) - log1pf(expf(-fabsf(x))); }
__device__ __forceinline__ void ld8(const bf16* p, float* o) {
    const v4u w = *(const v4u*)p;
    o[0] = __uint_as_float(w.x << 16); o[1] = __uint_as_float(w.x & 0xffff0000u); o[2] = __uint_as_float(w.y << 16); o[3] = __uint_as_float(w.y & 0xffff0000u);
    o[4] = __uint_as_float(w.z << 16); o[5] = __uint_as_float(w.z & 0xffff0000u); o[6] = __uint_as_float(w.w << 16); o[7] = __uint_as_float(w.w & 0xffff0000u);
}

template <bool PERMUTE>
__device__ __forceinline__ void p0_transpose_item(const float* W, int Nsrc, int Ndst, const float* gk, bf16* WT, LAS float* scr, int item, int lane) {
    const int nblk = Ndst / 32, kb = item / nblk, nb = item % nblk, k0 = 64 * kb, n0 = 32 * nb;
    const int nd = n0 + (lane & 31), ns = PERMUTE ? src_col(nd) : nd;
#pragma unroll 8
    for (int i = 0; i < 32; ++i) { const int kk = 2 * i + (lane >> 5);
        float v = 0.f; if (ns >= 0) { v = W[(size_t)(k0 + kk) * Nsrc + ns]; if (gk) v *= gk[k0 + kk]; }
        scr[kk * 33 + (lane & 31)] = v; }
    LDS_WAIT(); asm volatile("" ::: "memory");
    const int c = lane & 7;
#pragma unroll
    for (int j = 0; j < 4; ++j) { const int n = (lane >> 3) + 8 * j; const LAS float* s = scr + (8 * c) * 33 + n;
        v4u o; o.x = pk2(s[0 * 33], s[1 * 33]); o.y = pk2(s[2 * 33], s[3 * 33]); o.z = pk2(s[4 * 33], s[5 * 33]); o.w = pk2(s[6 * 33], s[7 * 33]);
        *(GAS v4u*)(WT + (size_t)(n0 + n) * 1024 + k0 + 8 * c) = o; }
    LDS_WAIT(); asm volatile("" ::: "memory");
}
__device__ __forceinline__ void p0_prologue(Frame& F) {
    LAS float* scr = (LAS float*)(F.lds + RING_OFF + F.wave * 16384);
    const int gw = F.vcu * NWAVES + F.wave, NGW = F.G * NWAVES;
    constexpr int I_IN = 16 * (NP / 32), I_OUT = 16 * (DM / 32);
    constexpr int NITEMS = 2 * I_IN + 2 * I_OUT;
    for (int it = gw; it < NITEMS; it += NGW) {
        int r = it;
        if (r < 2 * I_IN) { const int l = r / I_IN; r -= l * I_IN;
            p0_transpose_item<true>(F_w_in + (size_t)l * DM * DIN, DIN, NP, F_norm_g + l * DM, F_Win_t + (size_t)l * NP * DM, scr, r, F_lane); continue; }
        r -= 2 * I_IN;
        { const int l = r / I_OUT; r -= l * I_OUT;
            p0_transpose_item<false>(F_w_out + (size_t)l * DM * DM, DM, DM, nullptr, F_Wout_t + (size_t)l * DM * DM, scr, r, F_lane); }
    }
    for (int m = gw; m < T; m += NGW) {
        const GAS f32x4* xr = (const GAS f32x4*)(F_x + (size_t)m * DM) + F_lane;
        GAS unsigned long long* o8 = (GAS unsigned long long*)(F_XB + (size_t)m * DM) + F_lane;
        float s = 0.f;
#pragma unroll
        for (int j = 0; j < 4; ++j) { const f32x4 v = xr[64 * j]; s += (v.x * v.x + v.y * v.y) + (v.z * v.z + v.w * v.w);
            o8[64 * j] = (unsigned long long)pk2(v.x, v.y) | ((unsigned long long)pk2(v.z, v.w) << 32); }
        s = wave_sum(s);
        if (F_lane == 0) F_SSQ[m] = s;
    }
}

constexpr int LP = 65;
__device__ __forceinline__ void stage_conv(Frame& F, int layer, int b, int n, int zcol, int wch, float scale, LAS float* dst) {
    const float* cw = F_conv_w + (size_t)layer * 4 * 768;
    const int r0 = b * SEQ + n * CH;
    for (int idx = F_tid; idx < 4096; idx += NTHR) {
        const int t = idx >> 6, c = idx & 63;
        float a = 0.f;
#pragma unroll
        for (int j = 0; j < 4; ++j) { const int tt = t + j - 3;
            if (n * CH + tt >= 0) a += bf2f(F_Z[(size_t)(r0 + tt) * LDZ + zcol + c]) * cw[j * 768 + wch + c]; }
        dst[t * LP + c] = siluf(a) * scale;
    }
}
__device__ __forceinline__ void stage_tile(Frame& F, int b, int n, int zcol, int W, float scale, LAS float* dst, int pitch) {
    const int r0 = b * SEQ + n * CH;
    for (int idx = F_tid; idx < 64 * W; idx += NTHR) { const int t = idx / W, c = idx % W; dst[t * pitch + c] = bf2f(F_Z[(size_t)(r0 + t) * LDZ + zcol + c]) * scale; }
}
__device__ __forceinline__ void stage_mgates(Frame& F, int layer, int b, int n, int h, LAS float* ig, LAS float* bc, LAS float* lf) {
    const int r0 = b * SEQ + n * CH;
    if (F_tid < 64) { const float* g = F_G32 + (size_t)(r0 + F_tid) * 32;
        ig[F_tid] = g[h] + F_b_gates[layer * 12 + h]; lf[F_tid] = logsigf(g[6 + h] + F_b_gates[layer * 12 + 6 + h]); }
    __syncthreads();
    if (F_tid < 64) { float s = 0.f; for (int j = 0; j <= F_tid; ++j) s += lf[j]; bc[F_tid] = s; }
}
__device__ __forceinline__ void stage_gla_decay(Frame& F, int layer, int b, int n, int hh, LAS float* bcum) {
    const int r0 = b * SEQ + n * CH;
    const float* wa = F_w_alpha + (size_t)layer * 16 * 128; const float* ba = F_b_alpha + layer * 128;
    for (int idx = F_tid; idx < 2048; idx += NTHR) { const int t = idx >> 5, d = idx & 31;
        const float* g = F_G32 + (size_t)(r0 + t) * 32 + 12; float a = ba[hh * 32 + d];
#pragma unroll
        for (int r = 0; r < 16; ++r) a += g[r] * wa[r * 128 + hh * 32 + d];
        bcum[t * 33 + d] = logsigf(a) * (1.0f / 16.0f); }
    __syncthreads();
    if (F_tid < 32) { float s = 0.f; for (int t = 0; t < 64; ++t) { s += bcum[t * 33 + F_tid]; bcum[t * 33 + F_tid] = s; } }
    __syncthreads();
}

__device__ __forceinline__ void p2_local(Frame& F, int layer) {
    LAS float* L = (LAS float*)(F.lds + RING_OFF);
    for (int u = F.vcu; u < NCHT * 10; u += F.G) {
        const int task = u % 10, cn = u / 10, b = cn / NCHS, n = cn % NCHS;
        __syncthreads();
        if (task < 6) {
            const int h = task;
            LAS float* kc = L; LAS float* vv = L + 64 * LP; LAS float* ig = L + 2 * 64 * LP; LAS float* bc = ig + 64; LAS float* lf = bc + 64; LAS float* wj = lf + 64;
            stage_conv(F, layer, b, n, ZC_MK + h * 64, 384 + h * 64, 0.125f, kc);
            stage_tile(F, b, n, ZC_MV + h * 64, 64, 1.f, vv, LP);
            stage_mgates(F, layer, b, n, h, ig, bc, lf);
            __syncthreads();
            const float g = bc[63];
            float mloc = -3.0e38f;
            for (int j = 0; j < 64; ++j) mloc = fmaxf(mloc, g - bc[j] + ig[j]);
            if (F_tid < 64) wj[F_tid] = expf(g - bc[F_tid] + ig[F_tid] - mloc);
            __syncthreads();
            { const int v = F_tid >> 3, k0 = (F_tid & 7) * 8; float a[8];
#pragma unroll
              for (int i = 0; i < 8; ++i) a[i] = 0.f;
              for (int j = 0; j < 64; ++j) { const float wv = wj[j] * vv[j * LP + v];
#pragma unroll
                  for (int i = 0; i < 8; ++i) a[i] += wv * kc[j * LP + k0 + i]; }
              float* dst = F_CST + ((size_t)cn * 6 + h) * 4096 + v * 64 + k0;
              *(f32x4*)dst = (f32x4){a[0], a[1], a[2], a[3]}; *(f32x4*)(dst + 4) = (f32x4){a[4], a[5], a[6], a[7]}; }
            if (F_tid < 64) { float s = 0.f; for (int j = 0; j < 64; ++j) s += wj[j] * kc[j * LP + F_tid]; F_NST[((size_t)cn * 6 + h) * 64 + F_tid] = s; }
            if (F_tid == 0) { F_GS[cn * 6 + h] = g; F_MS[cn * 6 + h] = mloc; }
        } else {
            const int hh = task - 6;
            LAS float* kk = L; LAS float* vv = L + 64 * 33; LAS float* bcum = vv + 64 * LP;
            stage_tile(F, b, n, ZC_GK + hh * 32, 32, 1.f, kk, 33);
            stage_tile(F, b, n, ZC_GV + hh * 64, 64, 1.f, vv, LP);
            stage_gla_decay(F, layer, b, n, hh, bcum);
            for (int idx = F_tid; idx < 2048; idx += NTHR) { const int j = idx >> 5, d = idx & 31; kk[j * 33 + d] *= expf(bcum[63 * 33 + d] - bcum[j * 33 + d]); }
            __syncthreads();
            { const int d = F_tid >> 4, v0 = (F_tid & 15) * 4; float a[4] = {0.f, 0.f, 0.f, 0.f};
              for (int j = 0; j < 64; ++j) { const float kd = kk[j * 33 + d];
#pragma unroll
                  for (int i = 0; i < 4; ++i) a[i] += kd * vv[j * LP + v0 + i]; }
              *(f32x4*)(F_SST + ((size_t)cn * 4 + hh) * 2048 + d * 64 + v0) = (f32x4){a[0], a[1], a[2], a[3]}; }
            if (F_tid < 32) F_ADEC[((size_t)cn * 4 + hh) * 32 + F_tid] = expf(bcum[63 * 33 + F_tid]);
        }
    }
    __syncthreads();
}

__device__ __forceinline__ void p3_scan(Frame& F) {
    LAS float* L = (LAS float*)(F.lds + RING_OFF);
    LAS float* so = L; LAS float* sn = L + 128;
    constexpr int NU_M = 12 * 8, NU_G = 8 * 4;
    for (int u = F.vcu; u < NU_M + NU_G; u += F.G) {
        __syncthreads();
        if (u < NU_M) {
            const int bh = u >> 3, sl = u & 7, b = bh / 6, h = bh % 6;
            if (F_tid == 0) { float m = 0.f;
                for (int n = 0; n < NCHS; ++n) { const int ci = (b * NCHS + n) * 6 + h; const float g = F_GS[ci], ml = F_MS[ci];
                    const float mn = fmaxf(g + m, ml); so[n] = expf(g + m - mn); sn[n] = expf(ml - mn); if (sl == 0) F_MP[ci] = m; m = mn; } }
            __syncthreads();
            { float st = 0.f; float* p = F_CST + ((size_t)(b * NCHS) * 6 + h) * 4096 + sl * 512 + F_tid;
#pragma unroll 8
              for (int n = 0; n < NCHS; ++n) { const float c = p[(size_t)n * 6 * 4096]; p[(size_t)n * 6 * 4096] = st; st = so[n] * st + sn[n] * c; } }
            if (sl == 0 && F_tid < 64) { float st = 0.f; float* p = F_NST + ((size_t)(b * NCHS) * 6 + h) * 64 + F_tid;
#pragma unroll 8
              for (int n = 0; n < NCHS; ++n) { const float c = p[(size_t)n * 6 * 64]; p[(size_t)n * 6 * 64] = st; st = so[n] * st + sn[n] * c; } }
        } else {
            const int v = u - NU_M, bh = v >> 2, sl = v & 3, b = bh / 4, hh = bh % 4;
            const int e = sl * 512 + F_tid, d = e >> 6;
            float st = 0.f; float* p = F_SST + ((size_t)(b * NCHS) * 4 + hh) * 2048 + e; const float* ad = F_ADEC + ((size_t)(b * NCHS) * 4 + hh) * 32 + d;
#pragma unroll 8
            for (int n = 0; n < NCHS; ++n) { const float c = p[(size_t)n * 4 * 2048]; const float a = ad[(size_t)n * 4 * 32]; p[(size_t)n * 4 * 2048] = st; st = a * st + c; }
        }
    }
    __syncthreads();
}

#define P4_STORE8(o, kg, yrow, GATE_EXPR) do { _Pragma("unroll") for (int c8 = 0; c8 < 8; ++c8) if ((kg) == c8) { float yv[8]; \
    _Pragma("unroll") for (int i = 0; i < 8; ++i) { const int v = c8 * 8 + i; yv[i] = (o)[v] * (GATE_EXPR); } \
    v4u w; w.x = pk2(yv[0], yv[1]); w.y = pk2(yv[2], yv[3]); w.z = pk2(yv[4], yv[5]); w.w = pk2(yv[6], yv[7]); *(GAS v4u*)((yrow) + c8 * 8) = w; } } while (0)

__device__ __forceinline__ void p4_attn(Frame& F, int layer, int b, int n, int h) {
    const int t = F_tid >> 3, kg = F_tid & 7;
    const int r0 = b * SEQ + n * CH, row = r0 + t;
    LAS float* qL = (LAS float*)(F.lds + RING_OFF);
    stage_tile(F, b, n, ZC_AQ + h * 64, 64, 1.f, qL, LP);
    __syncthreads();
    float o[64];
#pragma unroll
    for (int c = 0; c < 64; ++c) o[c] = 0.f;
    float m = -1e30f, l = 0.f;
    const float* rb = F_rel_bias + (size_t)(layer * 6 + h) * 257;
    for (int i = 0; i < 72; ++i) {
        const int jb = kg + 8 * i, kpos = n * CH - 512 + jb;
        if (kpos < 0) continue;
        const bf16* kr = F_Z + (size_t)(b * SEQ + kpos) * LDZ + ZC_AK + h * 64;
        float s = 0.f;
#pragma unroll
        for (int c = 0; c < 8; ++c) { float kf[8]; ld8(kr + c * 8, kf);
#pragma unroll
            for (int e = 0; e < 8; ++e) s += qL[t * LP + c * 8 + e] * kf[e]; }
        int rel = t + 512 - jb; rel = rel < -128 ? -128 : (rel > 128 ? 128 : rel);
        s = s * 0.125f + rb[rel + 128];
        const float mn = fmaxf(m, s), a = expf(m - mn), p = expf(s - mn);
        l = l * a + p; m = mn;
        const bf16* vr = F_Z + (size_t)(b * SEQ + kpos) * LDZ + ZC_AV + h * 64;
#pragma unroll
        for (int c = 0; c < 8; ++c) { float vf[8]; ld8(vr + c * 8, vf);
#pragma unroll
            for (int e = 0; e < 8; ++e) o[c * 8 + e] = o[c * 8 + e] * a + p * vf[e]; }
    }
#pragma unroll
    for (int off = 1; off < 8; off <<= 1) {
        const float m2 = __shfl_xor(m, off), l2 = __shfl_xor(l, off);
        const float mn = fmaxf(m, m2), a = expf(m - mn), bb = expf(m2 - mn);
        l = l * a + l2 * bb; m = mn;
#pragma unroll
        for (int c = 0; c < 64; ++c) { const float o2 = __shfl_xor(o[c], off); o[c] = o[c] * a + o2 * bb; }
    }
    const float inv = 1.0f / l;
    const bf16* gr = F_Z + (size_t)row * LDZ + ZC_AG + h * 64;
    bf16* yrow = F_Y + (size_t)row * DM + h * 64;
    P4_STORE8(o, kg, yrow, inv * siluf(bf2f(gr[v])));
}

__device__ __forceinline__ void p4_mlstm(Frame& F, int layer, int b, int n, int h) {
    LAS float* L = (LAS float*)(F.lds + RING_OFF);
    LAS float* qc = L; LAS float* kc = qc + 64 * LP; LAS float* vv = kc + 64 * LP; LAS float* Cp = vv + 64 * LP;
    LAS float* np = Cp + 64 * LP; LAS float* ig = np + 64; LAS float* bc = ig + 64; LAS float* lf = bc + 64;
    const int cn = b * NCHS + n, r0 = b * SEQ + n * CH;
    stage_conv(F, layer, b, n, ZC_MQ + h * 64, h * 64, 1.f, qc);
    stage_conv(F, layer, b, n, ZC_MK + h * 64, 384 + h * 64, 0.125f, kc);
    stage_tile(F, b, n, ZC_MV + h * 64, 64, 1.f, vv, LP);
    { const float* cs = F_CST + ((size_t)cn * 6 + h) * 4096; for (int idx = F_tid; idx < 4096; idx += NTHR) Cp[(idx >> 6) * LP + (idx & 63)] = cs[idx]; }
    if (F_tid < 64) np[F_tid] = F_NST[((size_t)cn * 6 + h) * 64 + F_tid];
    stage_mgates(F, layer, b, n, h, ig, bc, lf);
    __syncthreads();
    const float mprev = F_MP[cn * 6 + h];
    const int t = F_tid >> 3, jg = F_tid & 7, row = r0 + t;
    const float bt = bc[t], il = bt + mprev;
    float mx = il;
    for (int i = 0; i < 8; ++i) { const int j = jg + 8 * i; if (j <= t) mx = fmaxf(mx, bt - bc[j] + ig[j]); }
    mx = fmaxf(mx, __shfl_xor(mx, 1)); mx = fmaxf(mx, __shfl_xor(mx, 2)); mx = fmaxf(mx, __shfl_xor(mx, 4));
    float num[64]; float den = 0.f;
#pragma unroll
    for (int c = 0; c < 64; ++c) num[c] = 0.f;
    for (int i = 0; i < 8; ++i) { const int j = jg + 8 * i;
        if (j <= t) { float dot = 0.f;
#pragma unroll 8
            for (int k = 0; k < 64; ++k) dot += qc[t * LP + k] * kc[j * LP + k];
            const float sc = dot * expf(bt - bc[j] + ig[j] - mx); den += sc;
#pragma unroll
            for (int c = 0; c < 64; ++c) num[c] += sc * vv[j * LP + c]; } }
    const float iw = expf(il - mx);
#pragma unroll 2
    for (int kk = 0; kk < 8; ++kk) { const int k = jg * 8 + kk; const float qk = qc[t * LP + k] * iw; den += qk * np[k];
#pragma unroll
        for (int c = 0; c < 64; ++c) num[c] += qk * Cp[c * LP + k]; }
#pragma unroll
    for (int off = 1; off < 8; off <<= 1) { den += __shfl_xor(den, off);
#pragma unroll
        for (int c = 0; c < 64; ++c) num[c] += __shfl_xor(num[c], off); }
    den = fmaxf(fabsf(den), expf(-mx));
    const float rden = 1.0f / den; float ss = 0.f;
#pragma unroll
    for (int c = 0; c < 64; ++c) { num[c] *= rden; ss += num[c] * num[c]; }
    const float rn = 1.0f / sqrtf(ss * (1.0f / 64.0f) + EPS);
    const bf16* mo = F_Z + (size_t)row * LDZ + ZC_MO + h * 64; const bf16* mg = F_Z + (size_t)row * LDZ + ZC_MG + h * 64;
    const float* gn = F_ml_norm_g + layer * 384 + h * 64;
    bf16* yrow = F_Y + (size_t)row * DM + 384 + h * 64;
    P4_STORE8(num, jg, yrow, rn * gn[v] * sigmf(bf2f(mo[v])) * siluf(bf2f(mg[v])));
}

__device__ __forceinline__ void p4_gla(Frame& F, int layer, int b, int n, int hh) {
    LAS float* L = (LAS float*)(F.lds + RING_OFF);
    LAS float* qx = L; LAS float* kk = qx + 64 * 33; LAS float* vv = kk + 64 * 33; LAS float* bcum = vv + 64 * LP; LAS float* Sp = bcum + 64 * 33;
    const int cn = b * NCHS + n, r0 = b * SEQ + n * CH;
    stage_tile(F, b, n, ZC_GQ + hh * 32, 32, 0.17677669529663687f, qx, 33);
    stage_tile(F, b, n, ZC_GK + hh * 32, 32, 1.f, kk, 33);
    stage_tile(F, b, n, ZC_GV + hh * 64, 64, 1.f, vv, LP);
    { const float* ss = F_SST + ((size_t)cn * 4 + hh) * 2048; for (int idx = F_tid; idx < 2048; idx += NTHR) Sp[(idx >> 6) * LP + (idx & 63)] = ss[idx]; }
    stage_gla_decay(F, layer, b, n, hh, bcum);
    const int t = F_tid >> 3, jg = F_tid & 7, row = r0 + t;
    float num[64];
#pragma unroll
    for (int c = 0; c < 64; ++c) num[c] = 0.f;
    for (int i = 0; i < 8; ++i) { const int j = jg + 8 * i;
        if (j <= t) { float att = 0.f;
#pragma unroll 4
            for (int d = 0; d < 32; ++d) att += qx[t * 33 + d] * kk[j * 33 + d] * expf(bcum[t * 33 + d] - bcum[j * 33 + d]);
#pragma unroll
            for (int c = 0; c < 64; ++c) num[c] += att * vv[j * LP + c]; } }
#pragma unroll 2
    for (int dd = 0; dd < 4; ++dd) { const int d = jg * 4 + dd; const float w = qx[t * 33 + d] * expf(bcum[t * 33 + d]);
#pragma unroll
        for (int c = 0; c < 64; ++c) num[c] += w * Sp[d * LP + c]; }
    float ss = 0.f;
#pragma unroll
    for (int off = 1; off < 8; off <<= 1) {
#pragma unroll
        for (int c = 0; c < 64; ++c) num[c] += __shfl_xor(num[c], off); }
#pragma unroll
    for (int c = 0; c < 64; ++c) ss += num[c] * num[c];
    const float rn = 1.0f / sqrtf(ss * (1.0f / 64.0f) + EPS);
    const bf16* gg = F_Z + (size_t)row * LDZ + ZC_GG + hh * 64;
    const float* gn = F_gla_norm_g + layer * 256 + hh * 64;
    bf16* yrow = F_Y + (size_t)row * DM + 768 + hh * 64;
    P4_STORE8(num, jg, yrow, rn * gn[v] * siluf(bf2f(gg[v])));
}

typedef float f32x16 __attribute__((ext_vector_type(16)));
typedef short s16x4 __attribute__((ext_vector_type(4)));
typedef short v4i16_t __attribute__((ext_vector_type(4)));
typedef float f32x2_t __attribute__((ext_vector_type(2))); typedef __bf16 bf16x2_t __attribute__((ext_vector_type(2)));
__device__ __forceinline__ unsigned cvtpk(float lo, float hi) { f32x2_t v = {lo, hi}; bf16x2_t b = __builtin_convertvector(v, bf16x2_t); return __builtin_bit_cast(unsigned, b); }
__device__ __forceinline__ s16x4 lds_tr(LAS const unsigned char* p) { return __builtin_bit_cast(s16x4, __builtin_amdgcn_ds_read_tr16_b64_v4i16((LAS v4i16_t*)p)); }
__device__ __forceinline__ bf16x8 pack8(float a0, float a1, float a2, float a3, float a4, float a5, float a6, float a7) {
    v4u w; w.x = cvtpk(a0, a1); w.y = cvtpk(a2, a3); w.z = cvtpk(a4, a5); w.w = cvtpk(a6, a7); return __builtin_bit_cast(bf16x8, w); }
#define MFMA32(a, b, c) __builtin_amdgcn_mfma_f32_32x32x16_bf16((a), (b), (c), 0, 0, 0)
constexpr float LOG2E = 1.4426950408889634f;
__device__ __forceinline__ int tile_off(int row, int bytecol) { return row * 128 + ((((bytecol >> 4) ^ (((row >> 1) & 1) << 2)) << 4) | (bytecol & 15)); }
__device__ __forceinline__ void dma_tile(const bf16* g, LAS unsigned char* tile, int lane) {
    const int rr = lane >> 3, cpos = lane & 7;
#pragma unroll
    for (int it = 0; it < 8; ++it) { const int row = 8 * it + rr, ch = cpos ^ (((row >> 1) & 1) << 2);
        __builtin_amdgcn_global_load_lds((const unsigned*)(g + (size_t)row * LDZ + ch * 8), (LAS unsigned*)(tile + it * 1024), 16, 0, 0); }
}
__device__ __forceinline__ bf16x8 tr_frag(LAS const unsigned char* tile, int lane, int c0, int ks) {
    const int g = lane >> 4, i = lane & 15, hf = g >> 1;
    const int row = 16 * ks + 4 * hf + (i >> 2), bc = (c0 + 16 * (g & 1) + 4 * (i & 3)) * 2;
    const s16x4 lo = lds_tr(tile + tile_off(row, bc)), hi = lds_tr(tile + tile_off(row + 8, bc));
    return (bf16x8){lo[0], lo[1], lo[2], lo[3], hi[0], hi[1], hi[2], hi[3]};
}

__device__ __forceinline__ const char* uptr(const void* p) { const unsigned long long v = (unsigned long long)p;
    const unsigned lo = __builtin_amdgcn_readfirstlane((unsigned)v), hi = __builtin_amdgcn_readfirstlane((unsigned)(v >> 32)); return (const char*)(((unsigned long long)hi << 32) | lo); }
__device__ __forceinline__ bf16x8 ldfrag(const char* ub, unsigned voff) { return *(const bf16x8*)(ub + voff); }
__device__ __forceinline__ unsigned dma_voff(int lane) { const int rr = lane >> 3; return (unsigned)(rr * LDZ + (((lane & 7) ^ (((rr >> 1) & 1) << 2)) * 8)) * 2u; }
__device__ __forceinline__ void dma_tile_u(const char* ub, unsigned voff, LAS unsigned char* tile) {
#pragma unroll
    for (int it = 0; it < 8; ++it) __builtin_amdgcn_global_load_lds((const unsigned*)(ub + (size_t)it * 8 * LDZ * 2 + voff), (LAS unsigned*)(tile + it * 1024), 16, 0, 0);
}
__device__ __forceinline__ void tr_bases(int lane, unsigned& b0, unsigned& b1) {
    const int g = lane >> 4, i = lane & 15, hf = g >> 1, row = 4 * hf + (i >> 2), bc = (16 * (g & 1) + 4 * (i & 3)) * 2;
    b0 = (unsigned)tile_off(row, bc); b1 = (unsigned)tile_off(row, bc + 64);
}
__device__ __forceinline__ bf16x8 tr_frag_b(LAS const unsigned char* tile, unsigned base, int ks) {
    const s16x4 lo = lds_tr(tile + base + ks * 2048), hi = lds_tr(tile + base + ks * 2048 + 1024);
    return (bf16x8){lo[0], lo[1], lo[2], lo[3], hi[0], hi[1], hi[2], hi[3]};
}

__device__ __forceinline__ void attn_wave(Frame& F, int layer, int cn, int h, LAS unsigned char* wl) {
    const int lane = F_lane, r = lane & 31, hf = lane >> 5;
    const int b = cn / NCHS, n = cn % NCHS;
    const size_t row0 = (size_t)b * SEQ + (size_t)n * CH;
    const bf16* Z = F_Z;
    LAS float* rbl = (LAS float*)(wl + 16384);
    const float* rb = F_rel_bias + (size_t)(layer * 6 + h) * 257;
    for (int i = lane; i < 257; i += 64) rbl[i] = rb[i] * LOG2E;
    const float bfar = rb[256] * LOG2E;
    constexpr float C1 = 0.125f * LOG2E;
    const unsigned voffK = (unsigned)(r * LDZ + 8 * hf) * 2u, voffV = dma_voff(lane);
    unsigned trb0, trb1; tr_bases(lane, trb0, trb1);
    bf16x8 qf[2][4];
    { const char* qb_ = uptr(Z + row0 * LDZ + ZC_AQ + h * 64);
#pragma unroll
    for (int qb = 0; qb < 2; ++qb)
#pragma unroll
        for (int s = 0; s < 4; ++s) qf[qb][s] = ldfrag(qb_ + ((size_t)32 * qb * LDZ + 16 * s) * 2, voffK); }
    f32x16 o[2][2];
#pragma unroll
    for (int a = 0; a < 2; ++a)
#pragma unroll
        for (int c = 0; c < 2; ++c)
#pragma unroll
            for (int i = 0; i < 16; ++i) o[a][c][i] = 0.f;
    float m[2] = {-1e30f, -1e30f}, lsum[2] = {0.f, 0.f};
    const int i0 = (n >= 8) ? 0 : 8 - n;
    dma_tile_u(uptr(Z + (row0 - 512 + 64 * i0) * LDZ + ZC_AV + h * 64), voffV, wl + (i0 & 1) * 8192);
#pragma unroll 1
    for (int ti = i0; ti < 9; ++ti) {
        const size_t kr0 = row0 - 512 + 64 * ti;
        LAS const unsigned char* vt = wl + (ti & 1) * 8192;
        const char* kb_ = uptr(Z + kr0 * LDZ + ZC_AK + h * 64);
#pragma unroll
        for (int kb = 0; kb < 2; ++kb) {
            bf16x8 kf[4];
#pragma unroll
            for (int s = 0; s < 4; ++s) kf[s] = ldfrag(kb_ + ((size_t)32 * kb * LDZ + 16 * s) * 2, voffK);
            if (kb == 0 && ti < 8) dma_tile_u(uptr(Z + (kr0 + 64) * LDZ + ZC_AV + h * 64), voffV, wl + ((ti + 1) & 1) * 8192);
            f32x16 st[2];
#pragma unroll
            for (int qb = 0; qb < 2; ++qb) {
#pragma unroll
                for (int i = 0; i < 16; ++i) st[qb][i] = 0.f;
#pragma unroll
                for (int s = 0; s < 4; ++s) st[qb] = MFMA32(kf[s], qf[qb][s], st[qb]);
            }
            if (ti <= 5) {
#pragma unroll
                for (int qb = 0; qb < 2; ++qb)
#pragma unroll
                    for (int i = 0; i < 16; ++i) st[qb][i] = st[qb][i] * C1 + bfar;
            } else {
#pragma unroll
                for (int qb = 0; qb < 2; ++qb)
#pragma unroll
                    for (int i = 0; i < 16; ++i) {
                        const int kk = 32 * kb + (i & 3) + 8 * (i >> 2) + 4 * hf, t = 32 * qb + r;
                        int rel = t + 512 - 64 * ti - kk; rel = rel < -128 ? -128 : (rel > 128 ? 128 : rel);
                        st[qb][i] = st[qb][i] * C1 + rbl[rel + 128];
                    }
            }
            bf16x8 pf[2][2];
#pragma unroll
            for (int qb = 0; qb < 2; ++qb) {
                float mx = st[qb][0];
#pragma unroll
                for (int i = 1; i < 16; ++i) mx = fmaxf(mx, st[qb][i]);
                mx = fmaxf(mx, __shfl_xor(mx, 32));
                const float mn = fmaxf(m[qb], mx), alpha = __builtin_amdgcn_exp2f(m[qb] - mn);
                m[qb] = mn;
                float ps = 0.f;
#pragma unroll
                for (int i = 0; i < 16; ++i) { const float p = __builtin_amdgcn_exp2f(st[qb][i] - mn); st[qb][i] = p; ps += p; }
                lsum[qb] = lsum[qb] * alpha + ps;
#pragma unroll
                for (int i = 0; i < 16; ++i) { o[0][qb][i] *= alpha; o[1][qb][i] *= alpha; }
                pf[qb][0] = pack8(st[qb][0], st[qb][1], st[qb][2], st[qb][3], st[qb][4], st[qb][5], st[qb][6], st[qb][7]);
                pf[qb][1] = pack8(st[qb][8], st[qb][9], st[qb][10], st[qb][11], st[qb][12], st[qb][13], st[qb][14], st[qb][15]);
            }
            if (kb == 0) { if (ti < 8) asm volatile("s_waitcnt vmcnt(8)" ::: "memory"); else asm volatile("s_waitcnt vmcnt(0)" ::: "memory"); }
#pragma unroll
            for (int k2 = 0; k2 < 2; ++k2)
#pragma unroll
                for (int dvb = 0; dvb < 2; ++dvb) {
                    const bf16x8 vf = tr_frag_b(vt, dvb ? trb1 : trb0, 2 * kb + k2);
                    o[dvb][0] = MFMA32(vf, pf[0][k2], o[dvb][0]);
                    o[dvb][1] = MFMA32(vf, pf[1][k2], o[dvb][1]);
                }
        }
    }
#pragma unroll
    for (int qb = 0; qb < 2; ++qb) {
        const float l = lsum[qb] + __shfl_xor(lsum[qb], 32), inv = 1.0f / l;
        const size_t row = row0 + 32 * qb + r;
#pragma unroll
        for (int dvb = 0; dvb < 2; ++dvb)
#pragma unroll
            for (int i4 = 0; i4 < 4; ++i4) {
                const int dv = 32 * dvb + 8 * i4 + 4 * hf;
                const unsigned long long gw = *(const unsigned long long*)(Z + row * LDZ + ZC_AG + h * 64 + dv);
                const float g0 = __uint_as_float((unsigned)gw << 16), g1 = __uint_as_float((unsigned)gw & 0xffff0000u);
                const float g2 = __uint_as_float((unsigned)(gw >> 32) << 16), g3 = __uint_as_float((unsigned)(gw >> 32) & 0xffff0000u);
                const float y0 = o[dvb][qb][4 * i4] * inv * siluf(g0), y1 = o[dvb][qb][4 * i4 + 1] * inv * siluf(g1);
                const float y2 = o[dvb][qb][4 * i4 + 2] * inv * siluf(g2), y3 = o[dvb][qb][4 * i4 + 3] * inv * siluf(g3);
                *(unsigned long long*)(F_Y + row * DM + h * 64 + dv) = (unsigned long long)cvtpk(y0, y1) | ((unsigned long long)cvtpk(y2, y3) << 32);
            }
    }
}

__device__ __forceinline__ void p4_outputs(Frame& F, int layer) {
    {
        const int gw = F.vcu * NWAVES + F.wave, NGW = F.G * NWAVES;
        LAS unsigned char* wl = F.lds + RING_OFF + F.wave * WL_BYTES;
        for (int a = gw; a < NCHT * 6; a += NGW) attn_wave(F, layer, a / 6, a % 6, wl);
    }
    for (int u = F.vcu; u < NCHT * 10; u += F.G) {
        const int task = u % 10, cn = u / 10, b = cn / NCHS, n = cn % NCHS;
        __syncthreads();
        if (task < 6) p4_mlstm(F, layer, b, n, task);
        else p4_gla(F, layer, b, n, task - 6);
    }
    __syncthreads();
}

__device__ __forceinline__ void p11_final(Frame& F) {
    const int gw = F.vcu * NWAVES + F.wave, NGW = F.G * NWAVES;
    const float* ssq = F_SSQ + 2 * T;
    for (int m = gw; m < T; m += NGW) {
        const float rs = 1.0f / sqrtf(ssq[m] * (1.0f / 1024.0f) + EPS);
        GAS f32x4* xr = (GAS f32x4*)(F_out + (size_t)m * DM) + F_lane; const GAS f32x4* gr = (const GAS f32x4*)F_final_g + F_lane;
#pragma unroll
        for (int j = 0; j < 4; ++j) { const f32x4 v = xr[64 * j], g = gr[64 * j]; xr[64 * j] = v * rs * g; }
    }
}

__global__ void __launch_bounds__(NTHR, 2) hymba_fwd(Args args) {
    extern __shared__ __attribute__((aligned(16))) unsigned char lds[];
    Frame F;
    F.lds = (LAS unsigned char*)lds;
    F.MISC = (volatile LAS unsigned*)(F.lds + MISC_OFF);
    F.wave = __builtin_amdgcn_readfirstlane(F_tid >> 6);
    F.G = gridDim.x; { const int bx = blockIdx.x; F.vcu = (F.G % 8 == 0) ? (bx % 8) * (F.G / 8) + bx / 8 : bx; }
    F.A = &args;
    for (int u = F_tid; u < (LDS_BYTES - LDSCTL_OFF) / 4; u += NTHR) ((LAS unsigned*)(F.lds + LDSCTL_OFF))[u] = 0u;
    __syncthreads();
    XcdBarrier bar; bar.bar = (unsigned*)(F_ctl + CW_BAR); bar.x = 0; bar.st = nullptr;
    if (N_LAUNCHES == 1) bar = xcd_barrier_post((unsigned*)(F_ctl + CW_BAR), F.MISC + 8);
#define GRID_BAR() do { if (N_LAUNCHES == 1) xcd_barrier(bar); } while (0)
    const int lo = args.ph_lo, hi = args.ph_hi;
#define IN(k) (lo <= (k) && (k) < hi)
#define BOTH(k) (IN(k) && IN((k) + 1))
    if (IN(0)) { p0_prologue(F); if (BOTH(0)) GRID_BAR(); }
#pragma unroll 1
    for (int step = 0; step < 2 * DEPTH; ++step) {
        const int layer = step >> 1, which = step & 1, pb = 1 + 5 * layer, pid = which ? pb + 4 : pb;
        if (IN(pid)) {
            const int N = which ? DM : NP;
            pg8::Gemm g{which ? F_Y : F_XB, which ? F_Wout_t + (size_t)layer * DM * DM : F_Win_t + (size_t)layer * NP * DM, T, N, DM};
            pg8::StaticOrder S; S.init(T, N, F.G, (int)blockIdx.x);
            pg8::EpiBoth E{which, pg8::EpiZ{F_Z, LDZ, F_SSQ + layer * T, F_G32, ZC_SM},
                           pg8::EpiRes{layer == 0 ? F_x : (const float*)F_out, F_out, layer == 0 ? F_XB : (bf16*)nullptr, F_SSQ + (layer + 1) * T}};
            pg8::gemm_phase<pg8::EpiBoth, pg8::StaticOrder, true, true>(F.lds + RING_OFF, g, S, E);
            if (BOTH(pid)) GRID_BAR();
        }
        if (which == 0) {
            if (IN(pb + 1)) { p2_local(F, layer); if (BOTH(pb + 1)) GRID_BAR(); }
            if (IN(pb + 2)) { p3_scan(F); if (BOTH(pb + 2)) GRID_BAR(); }
            if (IN(pb + 3)) { p4_outputs(F, layer); if (BOTH(pb + 3)) GRID_BAR(); }
        }
    }
    if (IN(11)) p11_final(F);
#undef IN
#undef BOTH
}

extern "C" void kernel_launch(void* const* d_in, const int* in_sizes, int n_in, void* d_out, int out_size, void* d_ws, size_t ws_size, hipStream_t stream) {
    static int grid = 0;
    if (grid == 0) {
        if (n_in != 12 || in_sizes[0] != T * DM || out_size != T * DM || ws_size < WS_END) {
            fprintf(stderr, "kernel_launch: unexpected shapes (n_in %d, in0 %d, out %d, ws %zu, need %zu); nothing launched\n", n_in, n_in > 0 ? in_sizes[0] : -1, out_size, ws_size, (size_t)WS_END); grid = -1; return; }
        int dev = 0, cus = 0, per_cu = 0;
        if (hipGetDevice(&dev) != hipSuccess || hipDeviceGetAttribute(&cus, hipDeviceAttributeMultiprocessorCount, dev) != hipSuccess) { fprintf(stderr, "kernel_launch: device query failed\n"); grid = -1; return; }
        if (hipFuncSetAttribute((const void*)hymba_fwd, hipFuncAttributeMaxDynamicSharedMemorySize, LDS_BYTES) != hipSuccess) { fprintf(stderr, "kernel_launch: hipFuncSetAttribute failed\n"); grid = -1; return; }
        if (hipOccupancyMaxActiveBlocksPerMultiprocessor(&per_cu, (const void*)hymba_fwd, NTHR, LDS_BYTES) != hipSuccess || per_cu < 1) {
            fprintf(stderr, "kernel_launch: occupancy query reports %d workgroups per CU; nothing launched\n", per_cu); (void)hipGetLastError(); grid = -1; return; }
        grid = cus;
        fprintf(stderr, "kernel_launch: grid %d x %d threads, %d B LDS, occupancy query %d/CU\n", grid, NTHR, LDS_BYTES, per_cu);
    }
    if (grid < 0) return;
    if (hipMemsetAsync((char*)d_ws + WS_CTL, 0, CTL_ZERO_BYTES, stream) != hipSuccess) { fprintf(stderr, "kernel_launch: memset failed\n"); return; }
    Args a{};
    for (int i = 0; i < 12; ++i) a.in[i] = (const float*)d_in[i];
    a.out = (float*)d_out; a.ws = (unsigned char*)d_ws;
    if (N_LAUNCHES == 1) {
        a.ph_lo = 0; a.ph_hi = NPHASE; a.li = 0;
        void* kargs[] = {&a};
        hipError_t e = hipLaunchCooperativeKernel((const void*)hymba_fwd, dim3(grid), dim3(NTHR), kargs, LDS_BYTES, stream);
        if (e != hipSuccess) fprintf(stderr, "kernel_launch: cooperative launch failed: %s\n", hipGetErrorString(e));
    } else {
        for (int p = 0; p < NPHASE; ++p) { a.ph_lo = p; a.ph_hi = p + 1; a.li = p;
            hipLaunchKernelGGL(hymba_fwd, dim3(grid), dim3(NTHR), LDS_BYTES, stream, a);
            if (hipPeekAtLastError() != hipSuccess) { fprintf(stderr, "kernel_launch: launch %d failed\n", p); break; } }
    }
}
```

```cpp
#include <hip/hip_runtime.h>
#include <cstdio>
#include <cstdint>
#include <cmath>

#ifndef MK_N_LAUNCHES
#define MK_N_LAUNCHES 1
#endif

namespace pg8 {
#define PG8_LAS __attribute__((address_space(3)))
typedef unsigned short bf16_t;
typedef short bf16x8 __attribute__((ext_vector_type(8)));
typedef float f32x4 __attribute__((ext_vector_type(4)));
typedef unsigned u32x4 __attribute__((ext_vector_type(4)));
constexpr int BM = 256, BK = 64, HALF = 128, HTB = HALF * BK * 2  , STAGE_BYTES = 8 * HTB, NXCD = 8, WGM = 8;

__host__ __device__ __forceinline__ int lds_byte(int r, int c) { const int st = (r >> 4) * 2 + (c >> 5), rr = r & 15, cc = c & 31, ob = rr * 64 + cc * 2; return st * 1024 + (ob ^ (((ob >> 9) & 1) << 5)); }
__host__ __device__ __forceinline__ void stage_rc(int b, int& R, int& C) { const int st = b / 1024, sb = b % 1024, swz = sb ^ (((sb >> 9) & 1) << 5); R = (st >> 1) * 16 + swz / 64; C = (st & 1) * 32 + (swz % 64) / 2; }
__host__ __device__ __forceinline__ int perm32(int rho) { const int n = rho >> 4, i = rho & 15; return 8 * (i >> 2) + 4 * n + (i & 3); }

struct Unit { int pm, pn; };
struct Gemm { const bf16_t* A; const bf16_t* Bt; int M, N, K; };

struct StaticOrder {
    int nM, nN, nwg, G, c;
    __host__ __device__ void init(int M, int N, int G_, int c_) { nM = M / BM; nN = N / BM; nwg = nM * nN; G = G_; c = c_; }
    __host__ __device__ bool next(int i, Unit& u) const {
        const long L = (long)i * G + c; if (L >= nwg) return false;
        int wgid = (int)L; { const int q = nwg / NXCD, r = nwg % NXCD, xcd = wgid % NXCD, off = wgid / NXCD; wgid = (xcd < r ? xcd * (q + 1) : r * (q + 1) + (xcd - r) * q) + off; }
        const int nig = WGM * nN, gid = wgid / nig, fm = gid * WGM, gsz = (nM - fm) < WGM ? (nM - fm) : WGM;
        u.pm = fm + ((wgid % nig) % gsz); u.pn = (wgid % nig) / gsz; return true;
    }
    __device__ __forceinline__ void a_ready(const Unit&) const {}
    __device__ __forceinline__ void done(const Unit&) const {}
};

__device__ __forceinline__ unsigned cvt_pk_bf16(float lo, float hi) { unsigned r; asm volatile("v_cvt_pk_bf16_f32 %0, %1, %2" : "=v"(r) : "v"(lo), "v"(hi)); return r; }

typedef unsigned u32x2 __attribute__((ext_vector_type(2)));
struct EpiZ {
    bf16_t* Z; int ldz; const float* ssq; float* G32; int gcol0;
    __device__ __forceinline__ void operator()(const f32x4 (&acc)[2][2][4][2], const Unit& u, int wr, int wc, int fr, int fq) const {
        const int row0 = u.pm * BM + wr * 64 + fr, col0 = u.pn * BM + wc * 32 + 8 * fq;
#pragma unroll
        for (int ai = 0; ai < 2; ++ai)
#pragma unroll
            for (int m = 0; m < 4; ++m) {
                const int row = row0 + ai * HALF + m * 16;
                const float rs = 1.0f / sqrtf(ssq[row] * (1.0f / 1024.0f) + 1e-6f);
#pragma unroll
                for (int bj = 0; bj < 2; ++bj) {
                    const int col = col0 + bj * HALF;
                    const f32x4 v0 = acc[ai][bj][m][0] * rs, v1 = acc[ai][bj][m][1] * rs;
                    if (col < ldz) {
                        u32x4 w; w.x = cvt_pk_bf16(v0[0], v0[1]); w.y = cvt_pk_bf16(v0[2], v0[3]); w.z = cvt_pk_bf16(v1[0], v1[1]); w.w = cvt_pk_bf16(v1[2], v1[3]);
                        *(u32x4*)(Z + (size_t)row * ldz + col) = w;
                    } else if (col < gcol0 + 32) {
                        float* gp = G32 + (size_t)row * 32 + (col - gcol0);
                        *(f32x4*)gp = v0; *(f32x4*)(gp + 4) = v1;
                    }
                }
            }
    }
};
struct EpiRes {
    const float* base; float* out; bf16_t* xb; float* ssq;
    __device__ __forceinline__ void operator()(const f32x4 (&acc)[2][2][4][2], const Unit& u, int wr, int wc, int fr, int fq) const {
        const int col0 = u.pn * BM + wc * 32 + 8 * fq;
#pragma unroll
        for (int ai = 0; ai < 2; ++ai)
#pragma unroll
            for (int m = 0; m < 4; ++m) {
                const int row = u.pm * BM + ai * HALF + wr * 64 + m * 16 + fr;
                float s = 0.f;
#pragma unroll
                for (int bj = 0; bj < 2; ++bj) {
                    const size_t off = (size_t)row * 1024 + col0 + bj * HALF;
                    const f32x4 o0 = *(const f32x4*)(base + off) + acc[ai][bj][m][0], o1 = *(const f32x4*)(base + off + 4) + acc[ai][bj][m][1];
                    *(f32x4*)(out + off) = o0; *(f32x4*)(out + off + 4) = o1;
                    s += (o0[0] * o0[0] + o0[1] * o0[1]) + (o0[2] * o0[2] + o0[3] * o0[3]) + (o1[0] * o1[0] + o1[1] * o1[1]) + (o1[2] * o1[2] + o1[3] * o1[3]);
                    if (xb) { u32x4 w; w.x = cvt_pk_bf16(o0[0], o0[1]); w.y = cvt_pk_bf16(o0[2], o0[3]); w.z = cvt_pk_bf16(o1[0], o1[1]); w.w = cvt_pk_bf16(o1[2], o1[3]); *(u32x4*)(xb + off) = w; }
                }
                s += __shfl_xor(s, 16); s += __shfl_xor(s, 32);
                if (fq == 0) atomicAdd(ssq + row, s);
                asm volatile("" ::: "memory");
            }
    }
};
struct EpiBoth {
    static constexpr bool PERM = true, AFTER_DRAIN = false;
    int mode; EpiZ z; EpiRes r;
    __device__ __forceinline__ void operator()(const f32x4 (&acc)[2][2][4][2], const Unit& u, int wr, int wc, int fr, int fq) const {
        if (mode == 0) z(acc, u, wr, wc, fr, fq); else r(acc, u, wr, wc, fr, fq);
    }
};

template <class Epi, class Sched, bool ALIGN_EPI = false, bool SP2 = false>
__device__ __forceinline__ void gemm_phase(PG8_LAS unsigned char* lds, const Gemm g, const Sched& S, const Epi& E) {
    int tid_ = threadIdx.x; asm volatile("" : "+v"(tid_));
    const int tid = tid_, wid = __builtin_amdgcn_readfirstlane(tid >> 6), lane = tid & 63, wr = wid >> 2, wc = wid & 3, fr = lane & 15, fq = lane >> 4;
    const int K = g.K, nt = K / BK;
    unsigned voffA[2], voffB[2];
#pragma unroll
    for (int i = 0; i < 2; ++i) { int R, C; stage_rc(tid * 16 + i * 8192, R, C); const int Rb = Epi::PERM ? ((R & ~31) + perm32(R & 31)) : R;
        voffA[i] = (unsigned)(R * K + C) * 2u; voffB[i] = (unsigned)(Rb * K + C) * 2u; }
    const size_t kstep = (size_t)(BK * 2);
    const size_t hstep = (size_t)HALF * K * 2;
    const size_t tstep = 2 * hstep;
    const unsigned ldsw = (unsigned)wid * 1024u;
    const int aoff = lds_byte(wr * 64 + fr, fq * 8), boff = lds_byte(wc * 32 + fr, fq * 8);
#define PG8_SA(b, h) (((b) * 2 + (h)) * HTB)
#define PG8_SB(b, h) ((4 + (b) * 2 + (h)) * HTB)
#define PG8_STAGE(bufoff, gbase, voff) do { _Pragma("unroll") for (int _i = 0; _i < 2; ++_i) \
        __builtin_amdgcn_global_load_lds((const unsigned*)((const char*)(gbase) + (voff)[_i]), (PG8_LAS unsigned*)(lds + (bufoff) + ldsw + _i * 8192), 16, 0, 0); } while (0)
#define PG8_LDA(dst, b, h) do { _Pragma("unroll") for (int m = 0; m < 4; ++m) _Pragma("unroll") for (int k = 0; k < 2; ++k) dst[m][k] = *(const PG8_LAS bf16x8*)(lds + PG8_SA(b, h) + aoff + m * 2048 + k * 1024); } while (0)
#define PG8_LDB(dst, b, h) do { _Pragma("unroll") for (int n = 0; n < 2; ++n) _Pragma("unroll") for (int k = 0; k < 2; ++k) dst[n][k] = *(const PG8_LAS bf16x8*)(lds + PG8_SB(b, h) + boff + n * 2048 + k * 1024); } while (0)
#define PG8_MMA(ai, bj, At, Bt) do { __builtin_amdgcn_s_setprio(1); _Pragma("unroll") for (int m = 0; m < 4; ++m) _Pragma("unroll") for (int n = 0; n < 2; ++n) _Pragma("unroll") for (int k = 0; k < 2; ++k) \
        acc[ai][bj][m][n] = __builtin_amdgcn_mfma_f32_16x16x32_bf16(Bt[n][k], At[m][k], acc[ai][bj][m][n], 0, 0, 0); __builtin_amdgcn_s_setprio(0); } while (0)
#define PG8_WAIT_V(n) asm volatile("s_waitcnt vmcnt(" #n ")" ::: "memory")
#define PG8_WAIT_L(n) asm volatile("s_waitcnt lgkmcnt(" #n ")" ::: "memory")
#define PG8_BAR __builtin_amdgcn_s_barrier()
#define PG8_SCHED __builtin_amdgcn_sched_barrier(0)
    Unit cur, nxt; int ui = 0;
    if (!S.next(0, cur)) return;
    f32x4 acc[2][2][4][2];
#pragma unroll
    for (int a = 0; a < 2; ++a)
#pragma unroll
        for (int b = 0; b < 2; ++b)
#pragma unroll
            for (int m = 0; m < 4; ++m)
#pragma unroll
                for (int n = 0; n < 2; ++n) acc[a][b][m][n] = (f32x4){0.f, 0.f, 0.f, 0.f};
    bf16x8 At[4][2], B0[2][2], B1[2][2];
    const char* cA = (const char*)g.A + (size_t)cur.pm * tstep; const char* cB = (const char*)g.Bt + (size_t)cur.pn * tstep;
    S.a_ready(cur);
    if constexpr (SP2) {
        PG8_STAGE(PG8_SB(0, 0), cB, voffB); PG8_STAGE(PG8_SB(0, 1), cB + hstep, voffB); PG8_STAGE(PG8_SA(0, 0), cA, voffA); PG8_STAGE(PG8_SA(0, 1), cA + hstep, voffA);
        if (wr == 1) PG8_BAR;
        PG8_WAIT_V(2); PG8_BAR;
        PG8_STAGE(PG8_SB(1, 0), cB + kstep, voffB); PG8_STAGE(PG8_SA(1, 0), cA + kstep, voffA); PG8_STAGE(PG8_SB(1, 1), cB + hstep + kstep, voffB);
        PG8_WAIT_V(6); PG8_BAR;
    } else {
        PG8_STAGE(PG8_SB(0, 0), cB, voffB); PG8_STAGE(PG8_SA(0, 0), cA, voffA); PG8_STAGE(PG8_SB(0, 1), cB + hstep, voffB); PG8_STAGE(PG8_SA(0, 1), cA + hstep, voffA);
        if (wr == 1) PG8_BAR;
        PG8_WAIT_V(4); PG8_BAR;
        PG8_STAGE(PG8_SB(1, 0), cB + kstep, voffB); PG8_STAGE(PG8_SA(1, 0), cA + kstep, voffA); PG8_STAGE(PG8_SB(1, 1), cB + hstep + kstep, voffB);
        PG8_WAIT_V(6); PG8_BAR;
    }
    for (;;) {
        const bool has_next = S.next(ui + 1, nxt);
        const char* nA = has_next ? (const char*)g.A + (size_t)nxt.pm * tstep : cA; const char* nB = has_next ? (const char*)g.Bt + (size_t)nxt.pn * tstep : cB;
        for (int t = 0; t < nt; t += 2) {
            const bool last = (t == nt - 2);
            const char* a1 = cA + (size_t)(t + 1) * kstep;
            const char* a2 = last ? nA : cA + (size_t)(t + 2) * kstep; const char* b2 = last ? nB : cB + (size_t)(t + 2) * kstep;
            const char* a3 = a2 + kstep; const char* b3 = b2 + kstep;
            if (last && has_next) S.a_ready(nxt);
            if constexpr (SP2) {
            PG8_LDB(B0, 0, 0); PG8_LDB(B1, 0, 1); PG8_SCHED; PG8_LDA(At, 0, 0); PG8_STAGE(PG8_SA(1, 1), a1 + hstep, voffA);
            PG8_WAIT_V(8); PG8_WAIT_L(0); PG8_BAR; PG8_MMA(0, 0, At, B0); PG8_MMA(0, 1, At, B1); PG8_BAR; PG8_SCHED;
            PG8_LDA(At, 0, 1); PG8_STAGE(PG8_SB(0, 0), b2, voffB); PG8_STAGE(PG8_SB(0, 1), b2 + hstep, voffB); PG8_STAGE(PG8_SA(0, 0), a2, voffA);
            PG8_WAIT_V(8); PG8_WAIT_L(0); PG8_BAR; PG8_MMA(1, 0, At, B0); PG8_MMA(1, 1, At, B1); PG8_BAR; PG8_SCHED;
            PG8_LDB(B0, 1, 0); PG8_LDB(B1, 1, 1); PG8_SCHED; PG8_LDA(At, 1, 0); PG8_STAGE(PG8_SA(0, 1), a2 + hstep, voffA);
            PG8_WAIT_V(8); PG8_WAIT_L(0); PG8_BAR; PG8_MMA(0, 0, At, B0); PG8_MMA(0, 1, At, B1); PG8_BAR; PG8_SCHED;
            PG8_LDA(At, 1, 1); PG8_STAGE(PG8_SB(1, 0), b3, voffB); PG8_STAGE(PG8_SB(1, 1), b3 + hstep, voffB); PG8_STAGE(PG8_SA(1, 0), a3, voffA);
            PG8_WAIT_V(8); PG8_WAIT_L(0); PG8_BAR; PG8_MMA(1, 0, At, B0); PG8_MMA(1, 1, At, B1); PG8_BAR; PG8_SCHED;
            } else {
            PG8_LDB(B0, 0, 0); PG8_SCHED; PG8_LDA(At, 0, 0); PG8_STAGE(PG8_SA(1, 1), a1 + hstep, voffA);
            PG8_WAIT_L(8); PG8_BAR; PG8_WAIT_L(0); PG8_MMA(0, 0, At, B0); PG8_BAR; PG8_SCHED;
            PG8_LDB(B1, 0, 1); PG8_STAGE(PG8_SB(0, 0), b2, voffB);
            PG8_BAR; PG8_WAIT_L(0); PG8_MMA(0, 1, At, B1); PG8_BAR;
            PG8_LDA(At, 0, 1); PG8_STAGE(PG8_SA(0, 0), a2, voffA);
            PG8_BAR; PG8_WAIT_L(0); PG8_MMA(1, 0, At, B0); PG8_BAR; PG8_SCHED;
            PG8_STAGE(PG8_SB(0, 1), b2 + hstep, voffB);
            PG8_WAIT_V(6); PG8_BAR; PG8_MMA(1, 1, At, B1); PG8_BAR;
            PG8_LDB(B0, 1, 0); PG8_SCHED; PG8_LDA(At, 1, 0); PG8_STAGE(PG8_SA(0, 1), a2 + hstep, voffA);
            PG8_WAIT_L(8); PG8_BAR; PG8_WAIT_L(0); PG8_MMA(0, 0, At, B0); PG8_BAR; PG8_SCHED;
            PG8_LDB(B1, 1, 1); PG8_STAGE(PG8_SB(1, 0), b3, voffB);
            PG8_BAR; PG8_WAIT_L(0); PG8_MMA(0, 1, At, B1); PG8_BAR;
            PG8_LDA(At, 1, 1); PG8_STAGE(PG8_SA(1, 0), a3, voffA);
            PG8_BAR; PG8_WAIT_L(0); PG8_MMA(1, 0, At, B0); PG8_BAR; PG8_SCHED;
            PG8_STAGE(PG8_SB(1, 1), b3 + hstep, voffB);
            PG8_WAIT_V(6); PG8_BAR; PG8_MMA(1, 1, At, B1); PG8_BAR;
            }
        }
        if constexpr (ALIGN_EPI) { if (wr == 0) PG8_BAR; }
        if constexpr (!Epi::AFTER_DRAIN) { E(acc, cur, wr, wc, fr, fq); S.done(cur); }
        if (!has_next) break;
#pragma unroll
        for (int a = 0; a < 2; ++a)
#pragma unroll
            for (int b = 0; b < 2; ++b)
#pragma unroll
                for (int m = 0; m < 4; ++m)
#pragma unroll
                    for (int n = 0; n < 2; ++n) acc[a][b][m][n] = (f32x4){0.f, 0.f, 0.f, 0.f};
        cur = nxt; cA = nA; cB = nB; ++ui;
        if constexpr (ALIGN_EPI) { if (wr == 1) PG8_BAR; }
    }
    PG8_WAIT_V(0);
    if constexpr (!ALIGN_EPI) { if (wr == 0) PG8_BAR; }
    PG8_BAR;
    if constexpr (Epi::AFTER_DRAIN) { E.fused(acc, cur, wr, wc, fr, fq, lds, wid, lane); S.done(cur); }
#undef PG8_SA
#undef PG8_SB
#undef PG8_STAGE
#undef PG8_LDA
#undef PG8_LDB
#undef PG8_MMA
#undef PG8_WAIT_V
#undef PG8_WAIT_L
#undef PG8_BAR
#undef PG8_SCHED
}
}

constexpr int NWAVES = 8, NTHR = 512;
constexpr int N_LAUNCHES = MK_N_LAUNCHES;
constexpr int NPHASE = 12;
constexpr int BATCH = 2, SEQ = 8192, DM = 1024, T = BATCH * SEQ, DEPTH = 2, CH = 64, NCHT = T / CH  , NCHS = SEQ / CH  ;
constexpr int DIN = 4252, NP = 4352, LDZ = 4224;
constexpr int ZC_AQ = 0, ZC_AK = 384, ZC_AV = 768, ZC_AG = 1152, ZC_MQ = 1536, ZC_MK = 1920, ZC_MV = 2304, ZC_MO = 2688, ZC_MG = 3072, ZC_GQ = 3456, ZC_GK = 3584, ZC_GV = 3712, ZC_GG = 3968, ZC_SM = 4224;
constexpr float EPS = 1e-6f;
__host__ __device__ __forceinline__ int src_col(int n) {
    if (n < 3072) return n;
    if (n < 3968) return n + 12;
    if (n < 4224) return n + 28;
    if (n < 4236) return n - 1152;
    if (n < 4252) return n - 256;
    return -1;
}

constexpr size_t MiB = 1u << 20;
constexpr size_t WS_CTL = 0, CTL_ZERO_BYTES = 1 * MiB;
constexpr size_t WS_SSQ = 512 * 1024;
constexpr size_t WS_WIN = 1 * MiB;
constexpr size_t WS_WOUT = WS_WIN + (size_t)2 * NP * DM * 2;
constexpr size_t WS_XB = WS_WOUT + (size_t)2 * DM * DM * 2;
constexpr size_t WS_Y = WS_XB + (size_t)T * DM * 2;
constexpr size_t WS_Z = WS_Y + (size_t)T * DM * 2;
constexpr size_t WS_G32 = WS_Z + (size_t)T * LDZ * 2;
constexpr size_t WS_CST = WS_G32 + (size_t)T * 32 * 4;
constexpr size_t WS_NST = WS_CST + (size_t)NCHT * 6 * 4096 * 4;
constexpr size_t WS_SST = WS_NST + (size_t)NCHT * 6 * 64 * 4;
constexpr size_t WS_ADEC = WS_SST + (size_t)NCHT * 4 * 2048 * 4;
constexpr size_t WS_GS = WS_ADEC + (size_t)NCHT * 4 * 32 * 4;
constexpr size_t WS_MS = WS_GS + 8192;
constexpr size_t WS_MP = WS_MS + 8192;
constexpr size_t WS_END = WS_MP + 8192;
static_assert(WS_END <= 268435456, "d_ws map exceeds 256 MiB");
constexpr int CW_BAR = 4096;

constexpr int RING_OFF = 0, RING_BYTES = 147456;
constexpr int WL_BYTES = 18432;
constexpr int LDSCTL_OFF = RING_BYTES, MISC_OFF = LDSCTL_OFF + 320;
constexpr int LDS_BYTES = 148480;
#define GAS __attribute__((address_space(1)))
#define LAS __attribute__((address_space(3)))
typedef unsigned short bf16;
typedef unsigned v4u __attribute__((ext_vector_type(4)));
typedef float f32x4 __attribute__((ext_vector_type(4)));
typedef short bf16x8 __attribute__((ext_vector_type(8)));
typedef GAS unsigned gu32;
typedef GAS unsigned long long gu64;
#define RLX_AGENT __ATOMIC_RELAXED, __HIP_MEMORY_SCOPE_AGENT
#define LDS_WAIT() asm volatile("s_waitcnt lgkmcnt(0)" ::: "memory")
#define VM_WAIT() asm volatile("s_waitcnt vmcnt(0)" ::: "memory")
__device__ __forceinline__ unsigned long long rt() { return __builtin_amdgcn_s_memrealtime(); }
__device__ __forceinline__ unsigned f2bf(float f) { unsigned u = __builtin_bit_cast(unsigned, f); return (u + 0x7fffu + ((u >> 16) & 1u)) >> 16; }
__device__ __forceinline__ unsigned pk2(float lo, float hi) { return f2bf(lo) | (f2bf(hi) << 16); }

#define XB_TMO      128
#define XB_XCNT(j)  (256  + 64 * (j))
#define XB_XSUB(j)  (1280 + 64 * (j))
#define XB_XGEN(j)  (2304 + 64 * (j))
#define XB_TOP      3328
#define XB_TOPGEN   3392
#define XCD_BAR_WORDS 3456
#define XB_SPIN_CAP (1u << 18)

__device__ __forceinline__ unsigned xb_ld(unsigned* p)              { return __hip_atomic_load(p, __ATOMIC_RELAXED, __HIP_MEMORY_SCOPE_AGENT); }
__device__ __forceinline__ unsigned xb_add(unsigned* p, unsigned v) { return __hip_atomic_fetch_add(p, v, __ATOMIC_RELAXED, __HIP_MEMORY_SCOPE_AGENT); }
__device__ __forceinline__ unsigned xb_xcc_id() { return (unsigned)__builtin_amdgcn_s_getreg((3 << 11) | 20) & 0xFu; }
#define XB_SPIN(cond, bar) do { unsigned _sp = 0; while (cond) { __builtin_amdgcn_s_sleep(1); \
    if ((++_sp & 255u) == 0u) { if (xb_ld(&(bar)[XB_TMO])) break; if (_sp > XB_SPIN_CAP) { atomicAdd(&(bar)[XB_TMO], 1u); break; } } } } while (0)

struct XcdBarrier {
    unsigned* bar; unsigned x;
    volatile LAS unsigned* st;
};

__device__ __forceinline__ XcdBarrier xcd_barrier_post(unsigned* bar, volatile LAS unsigned* st) {
    XcdBarrier b; b.bar = bar; b.x = xb_xcc_id(); b.st = st;
    if (threadIdx.x == 0) (void)xb_add(&bar[XB_XCNT(b.x)], 1u);
    return b;
}
__device__ __forceinline__ void xcd_barrier_complete(unsigned* bar, unsigned x, unsigned& nloc, unsigned& nx) {
    const unsigned G = gridDim.x * gridDim.y * gridDim.z;
    unsigned sum, cnt, mine, sp = 0u;
    for (;;) {
        sum = 0u; cnt = 0u; mine = 0u;
#pragma unroll
        for (unsigned j = 0; j < 16; ++j) { const unsigned c = xb_ld(&bar[XB_XCNT(j)]); sum += c; cnt += (c > 0u) ? 1u : 0u; mine = (j == x) ? c : mine; }
        if (sum == G) break;
        __builtin_amdgcn_s_sleep(1);
        if ((++sp & 255u) == 0u) { if (xb_ld(&bar[XB_TMO])) break; if (sp > XB_SPIN_CAP) { atomicAdd(&bar[XB_TMO], 1u); break; } }
    }
    nloc = mine > 0u ? mine : 1u; nx = cnt > 0u ? cnt : 1u;
}

__device__ __forceinline__ void xcd_barrier(const XcdBarrier& b) {
    asm volatile("s_waitcnt vmcnt(0)" ::: "memory");
    __syncthreads();
    if (threadIdx.x == 0) {
        unsigned* bar = b.bar;
        __builtin_amdgcn_s_waitcnt(0);
        unsigned nloc = b.st[0], nx = b.st[1];
        if (nloc == 0u) { xcd_barrier_complete(bar, b.x, nloc, nx); b.st[0] = nloc; b.st[1] = nx; }
        const unsigned old = xb_add(&bar[XB_XSUB(b.x)], 1u);
        const unsigned gen = old / nloc;
        if (old + 1u == (gen + 1u) * nloc) {
            __builtin_amdgcn_fence(__ATOMIC_RELEASE, "agent");
            asm volatile("s_waitcnt vmcnt(0)" ::: "memory");
            const unsigned og = xb_add(&bar[XB_TOP], 1u);
            const unsigned tg = og / nx;
            if (og + 1u == (tg + 1u) * nx) xb_add(&bar[XB_TOPGEN], 1u);
            else XB_SPIN(xb_ld(&bar[XB_TOPGEN]) == tg, bar);
            __builtin_amdgcn_fence(__ATOMIC_ACQUIRE, "agent");
            xb_add(&bar[XB_XGEN(b.x)], 1u);
            asm volatile("s_waitcnt vmcnt(0)" ::: "memory");
        } else {
            XB_SPIN(xb_ld(&bar[XB_XGEN(b.x)]) == gen, bar);
            __builtin_amdgcn_fence(__ATOMIC_ACQUIRE, "agent");
            asm volatile("s_waitcnt vmcnt(0)" ::: "memory");
        }
    }
    __syncthreads();
}


struct Args { const float* in[12]; float* out; unsigned char* ws; int ph_lo, ph_hi, li, pad; };
struct Frame {
    LAS unsigned char* lds;
    volatile LAS unsigned* MISC;
    const Args* A;
    int wave, vcu, G;
};
__device__ __forceinline__ int opaque_tid() { int t = threadIdx.x; asm volatile("" : "+v"(t)); return t; }
#define F_tid (opaque_tid())
#define F_lane (opaque_tid() & 63)
#define F_x          (F.A->in[0])
#define F_norm_g     (F.A->in[1])
#define F_w_in       (F.A->in[2])
#define F_b_gates    (F.A->in[3])
#define F_conv_w     (F.A->in[4])
#define F_w_alpha    (F.A->in[5])
#define F_b_alpha    (F.A->in[6])
#define F_rel_bias   (F.A->in[7])
#define F_ml_norm_g  (F.A->in[8])
#define F_gla_norm_g (F.A->in[9])
#define F_w_out      (F.A->in[10])
#define F_final_g    (F.A->in[11])
#define F_out        (F.A->out)
#define F_ws         (F.A->ws)
#define F_ctl        ((gu32*)(F_ws + WS_CTL))
#define F_Win_t      ((bf16*)(F_ws + WS_WIN))
#define F_Wout_t     ((bf16*)(F_ws + WS_WOUT))
#define F_XB         ((bf16*)(F_ws + WS_XB))
#define F_Y          ((bf16*)(F_ws + WS_Y))
#define F_Z          ((bf16*)(F_ws + WS_Z))
#define F_G32        ((float*)(F_ws + WS_G32))
#define F_SSQ        ((float*)(F_ws + WS_SSQ))
#define F_CST        ((float*)(F_ws + WS_CST))
#define F_NST        ((float*)(F_ws + WS_NST))
#define F_SST        ((float*)(F_ws + WS_SST))
#define F_ADEC       ((float*)(F_ws + WS_ADEC))
#define F_GS         ((float*)(F_ws + WS_GS))
#define F_MS         ((float*)(F_ws + WS_MS))
#define F_MP         ((float*)(F_ws + WS_MP))
#define F_BC         ((float*)(F_ws + WS_XB))
__device__ __forceinline__ float bf2f(unsigned short u) { return __uint_as_float((unsigned)u << 16); }
__device__ __forceinline__ float wave_sum(float v) {
#pragma unroll
    for (int o = 1; o < 64; o <<= 1) v += __shfl_xor(v, o);
    return v;
}
__device__ __forceinline__ float siluf(float x) { return x / (1.0f + expf(-x)); }
__device__ __forceinline__ float sigmf(float x) { return 1.0f / (1.0f + expf(-x)); }
__device__ __forceinline__ float logsigf(float x) { return fminf(x, 0.f) - log1pf(expf(-fabsf(x))); }
__device__ __forceinline__ void ld8(const bf16* p, float* o) {
    const v4u w = *(const v4u*)p;
    o[0] = __uint_as_float(w.x << 16); o[1] = __uint_as_float(w.x & 0xffff0000u); o[2] = __uint_as_float(w.y << 16); o[3] = __uint_as_float(w.y & 0xffff0000u);
    o[4] = __uint_as_float(w.z << 16); o[5] = __uint_as_float(w.z & 0xffff0000u); o[6] = __uint_as_float(w.w << 16); o[7] = __uint_as_float(w.w & 0xffff0000u);
}

template <bool PERMUTE>
__device__ __forceinline__ void p0_transpose_item(const float* W, int Nsrc, int Ndst, const float* gk, bf16* WT, LAS float* scr, int item, int lane) {
    const int nblk = Ndst / 32, kb = item / nblk, nb = item % nblk, k0 = 64 * kb, n0 = 32 * nb;
    const int nd = n0 + (lane & 31), ns = PERMUTE ? src_col(nd) : nd;
#pragma unroll 8
    for (int i = 0; i < 32; ++i) { const int kk = 2 * i + (lane >> 5);
        float v = 0.f; if (ns >= 0) { v = W[(size_t)(k0 + kk) * Nsrc + ns]; if (gk) v *= gk[k0 + kk]; }
        scr[kk * 33 + (lane & 31)] = v; }
    LDS_WAIT(); asm volatile("" ::: "memory");
    const int c = lane & 7;
#pragma unroll
    for (int j = 0; j < 4; ++j) { const int n = (lane >> 3) + 8 * j; const LAS float* s = scr + (8 * c) * 33 + n;
        v4u o; o.x = pk2(s[0 * 33], s[1 * 33]); o.y = pk2(s[2 * 33], s[3 * 33]); o.z = pk2(s[4 * 33], s[5 * 33]); o.w = pk2(s[6 * 33], s[7 * 33]);
        *(GAS v4u*)(WT + (size_t)(n0 + n) * 1024 + k0 + 8 * c) = o; }
    LDS_WAIT(); asm volatile("" ::: "memory");
}
__device__ __forceinline__ void p0_prologue(Frame& F) {
    LAS float* scr = (LAS float*)(F.lds + RING_OFF + F.wave * 16384);
    const int gw = F.vcu * NWAVES + F.wave, NGW = F.G * NWAVES;
    constexpr int I_IN = 16 * (NP / 32), I_OUT = 16 * (DM / 32);
    constexpr int NITEMS = 2 * I_IN + 2 * I_OUT;
    for (int it = gw; it < NITEMS; it += NGW) {
        int r = it;
        if (r < 2 * I_IN) { const int l = r / I_IN; r -= l * I_IN;
            p0_transpose_item<true>(F_w_in + (size_t)l * DM * DIN, DIN, NP, F_norm_g + l * DM, F_Win_t + (size_t)l * NP * DM, scr, r, F_lane); continue; }
        r -= 2 * I_IN;
        { const int l = r / I_OUT; r -= l * I_OUT;
            p0_transpose_item<false>(F_w_out + (size_t)l * DM * DM, DM, DM, nullptr, F_Wout_t + (size_t)l * DM * DM, scr, r, F_lane); }
    }
    for (int m = gw; m < T; m += NGW) {
        const GAS f32x4* xr = (const GAS f32x4*)(F_x + (size_t)m * DM) + F_lane;
        GAS unsigned long long* o8 = (GAS unsigned long long*)(F_XB + (size_t)m * DM) + F_lane;
        float s = 0.f;
#pragma unroll
        for (int j = 0; j < 4; ++j) { const f32x4 v = xr[64 * j]; s += (v.x * v.x + v.y * v.y) + (v.z * v.z + v.w * v.w);
            o8[64 * j] = (unsigned long long)pk2(v.x, v.y) | ((unsigned long long)pk2(v.z, v.w) << 32); }
        s = wave_sum(s);
        if (F_lane == 0) F_SSQ[m] = s;
    }
}

constexpr int LP = 65;
__device__ __forceinline__ void stage_conv(Frame& F, int layer, int b, int n, int zcol, int wch, float scale, LAS float* dst) {
    const float* cw = F_conv_w + (size_t)layer * 4 * 768;
    const int r0 = b * SEQ + n * CH;
    for (int idx = F_tid; idx < 4096; idx += NTHR) {
        const int t = idx >> 6, c = idx & 63;
        float a = 0.f;
#pragma unroll
        for (int j = 0; j < 4; ++j) { const int tt = t + j - 3;
            if (n * CH + tt >= 0) a += bf2f(F_Z[(size_t)(r0 + tt) * LDZ + zcol + c]) * cw[j * 768 + wch + c]; }
        dst[t * LP + c] = siluf(a) * scale;
    }
}
__device__ __forceinline__ void stage_tile(Frame& F, int b, int n, int zcol, int W, float scale, LAS float* dst, int pitch) {
    const int r0 = b * SEQ + n * CH;
    for (int idx = F_tid; idx < 64 * W; idx += NTHR) { const int t = idx / W, c = idx % W; dst[t * pitch + c] = bf2f(F_Z[(size_t)(r0 + t) * LDZ + zcol + c]) * scale; }
}
__device__ __forceinline__ void stage_mgates(Frame& F, int layer, int b, int n, int h, LAS float* ig, LAS float* bc, LAS float* lf) {
    const int r0 = b * SEQ + n * CH;
    if (F_tid < 64) { const float* g = F_G32 + (size_t)(r0 + F_tid) * 32;
        ig[F_tid] = g[h] + F_b_gates[layer * 12 + h]; lf[F_tid] = logsigf(g[6 + h] + F_b_gates[layer * 12 + 6 + h]); }
    __syncthreads();
    if (F_tid < 64) { float s = 0.f; for (int j = 0; j <= F_tid; ++j) s += lf[j]; bc[F_tid] = s; }
}
__device__ __forceinline__ void stage_gla_decay(Frame& F, int layer, int b, int n, int hh, LAS float* bcum) {
    const int r0 = b * SEQ + n * CH;
    const float* wa = F_w_alpha + (size_t)layer * 16 * 128; const float* ba = F_b_alpha + layer * 128;
    for (int idx = F_tid; idx < 2048; idx += NTHR) { const int t = idx >> 5, d = idx & 31;
        const float* g = F_G32 + (size_t)(r0 + t) * 32 + 12; float a = ba[hh * 32 + d];
#pragma unroll
        for (int r = 0; r < 16; ++r) a += g[r] * wa[r * 128 + hh * 32 + d];
        bcum[t * 33 + d] = logsigf(a) * (1.0f / 16.0f); }
    __syncthreads();
    if (F_tid < 32) { float s = 0.f; for (int t = 0; t < 64; ++t) { s += bcum[t * 33 + F_tid]; bcum[t * 33 + F_tid] = s; } }
    __syncthreads();
}

__device__ __forceinline__ void p3_scan(Frame& F) {
    LAS float* L = (LAS float*)(F.lds + RING_OFF);
    LAS float* so = L; LAS float* sn = L + 128;
    constexpr int NU_M = 12 * 8, NU_G = 8 * 4;
    for (int u = F.vcu; u < NU_M + NU_G; u += F.G) {
        __syncthreads();
        if (u < NU_M) {
            const int bh = u >> 3, sl = u & 7, b = bh / 6, h = bh % 6;
            if (F_tid == 0) { float m = 0.f;
                for (int n = 0; n < NCHS; ++n) { const int ci = (b * NCHS + n) * 6 + h; const float g = F_GS[ci], ml = F_MS[ci];
                    const float mn = fmaxf(g + m, ml); so[n] = expf(g + m - mn); sn[n] = expf(ml - mn); if (sl == 0) F_MP[ci] = m; m = mn; } }
            __syncthreads();
            { float st = 0.f; float* p = F_CST + ((size_t)(b * NCHS) * 6 + h) * 4096 + sl * 512 + F_tid;
#pragma unroll 8
              for (int n = 0; n < NCHS; ++n) { const float c = p[(size_t)n * 6 * 4096]; p[(size_t)n * 6 * 4096] = st; st = so[n] * st + sn[n] * c; } }
            if (sl == 0 && F_tid < 64) { float st = 0.f; float* p = F_NST + ((size_t)(b * NCHS) * 6 + h) * 64 + F_tid;
#pragma unroll 8
              for (int n = 0; n < NCHS; ++n) { const float c = p[(size_t)n * 6 * 64]; p[(size_t)n * 6 * 64] = st; st = so[n] * st + sn[n] * c; } }
        } else {
            const int v = u - NU_M, bh = v >> 2, sl = v & 3, b = bh / 4, hh = bh % 4;
            const int e = sl * 512 + F_tid, d = e & 31;
            float st = 0.f; float* p = F_SST + ((size_t)(b * NCHS) * 4 + hh) * 2048 + e; const float* ad = F_ADEC + ((size_t)(b * NCHS) * 4 + hh) * 32 + d;
#pragma unroll 8
            for (int n = 0; n < NCHS; ++n) { const float c = p[(size_t)n * 4 * 2048]; const float a = ad[(size_t)n * 4 * 32]; p[(size_t)n * 4 * 2048] = st; st = a * st + c; }
        }
    }
    __syncthreads();
}

#define P4_STORE8(o, kg, yrow, GATE_EXPR) do { _Pragma("unroll") for (int c8 = 0; c8 < 8; ++c8) if ((kg) == c8) { float yv[8]; \
    _Pragma("unroll") for (int i = 0; i < 8; ++i) { const int v = c8 * 8 + i; yv[i] = (o)[v] * (GATE_EXPR); } \
    v4u w; w.x = pk2(yv[0], yv[1]); w.y = pk2(yv[2], yv[3]); w.z = pk2(yv[4], yv[5]); w.w = pk2(yv[6], yv[7]); *(GAS v4u*)((yrow) + c8 * 8) = w; } } while (0)

__device__ __forceinline__ void p4_attn(Frame& F, int layer, int b, int n, int h) {
    const int t = F_tid >> 3, kg = F_tid & 7;
    const int r0 = b * SEQ + n * CH, row = r0 + t;
    LAS float* qL = (LAS float*)(F.lds + RING_OFF);
    stage_tile(F, b, n, ZC_AQ + h * 64, 64, 1.f, qL, LP);
    __syncthreads();
    float o[64];
#pragma unroll
    for (int c = 0; c < 64; ++c) o[c] = 0.f;
    float m = -1e30f, l = 0.f;
    const float* rb = F_rel_bias + (size_t)(layer * 6 + h) * 257;
    for (int i = 0; i < 72; ++i) {
        const int jb = kg + 8 * i, kpos = n * CH - 512 + jb;
        if (kpos < 0) continue;
        const bf16* kr = F_Z + (size_t)(b * SEQ + kpos) * LDZ + ZC_AK + h * 64;
        float s = 0.f;
#pragma unroll
        for (int c = 0; c < 8; ++c) { float kf[8]; ld8(kr + c * 8, kf);
#pragma unroll
            for (int e = 0; e < 8; ++e) s += qL[t * LP + c * 8 + e] * kf[e]; }
        int rel = t + 512 - jb; rel = rel < -128 ? -128 : (rel > 128 ? 128 : rel);
        s = s * 0.125f + rb[rel + 128];
        const float mn = fmaxf(m, s), a = expf(m - mn), p = expf(s - mn);
        l = l * a + p; m = mn;
        const bf16* vr = F_Z + (size_t)(b * SEQ + kpos) * LDZ + ZC_AV + h * 64;
#pragma unroll
        for (int c = 0; c < 8; ++c) { float vf[8]; ld8(vr + c * 8, vf);
#pragma unroll
            for (int e = 0; e < 8; ++e) o[c * 8 + e] = o[c * 8 + e] * a + p * vf[e]; }
    }
#pragma unroll
    for (int off = 1; off < 8; off <<= 1) {
        const float m2 = __shfl_xor(m, off), l2 = __shfl_xor(l, off);
        const float mn = fmaxf(m, m2), a = expf(m - mn), bb = expf(m2 - mn);
        l = l * a + l2 * bb; m = mn;
#pragma unroll
        for (int c = 0; c < 64; ++c) { const float o2 = __shfl_xor(o[c], off); o[c] = o[c] * a + o2 * bb; }
    }
    const float inv = 1.0f / l;
    const bf16* gr = F_Z + (size_t)row * LDZ + ZC_AG + h * 64;
    bf16* yrow = F_Y + (size_t)row * DM + h * 64;
    P4_STORE8(o, kg, yrow, inv * siluf(bf2f(gr[v])));
}

__device__ __forceinline__ void p4_mlstm(Frame& F, int layer, int b, int n, int h) {
    LAS float* L = (LAS float*)(F.lds + RING_OFF);
    LAS float* qc = L; LAS float* kc = qc + 64 * LP; LAS float* vv = kc + 64 * LP; LAS float* Cp = vv + 64 * LP;
    LAS float* np = Cp + 64 * LP; LAS float* ig = np + 64; LAS float* bc = ig + 64; LAS float* lf = bc + 64;
    const int cn = b * NCHS + n, r0 = b * SEQ + n * CH;
    stage_conv(F, layer, b, n, ZC_MQ + h * 64, h * 64, 1.f, qc);
    stage_conv(F, layer, b, n, ZC_MK + h * 64, 384 + h * 64, 0.125f, kc);
    stage_tile(F, b, n, ZC_MV + h * 64, 64, 1.f, vv, LP);
    { const float* cs = F_CST + ((size_t)cn * 6 + h) * 4096; for (int idx = F_tid; idx < 4096; idx += NTHR) Cp[(idx >> 6) * LP + (idx & 63)] = cs[idx]; }
    if (F_tid < 64) np[F_tid] = F_NST[((size_t)cn * 6 + h) * 64 + F_tid];
    stage_mgates(F, layer, b, n, h, ig, bc, lf);
    __syncthreads();
    const float mprev = F_MP[cn * 6 + h];
    const int t = F_tid >> 3, jg = F_tid & 7, row = r0 + t;
    const float bt = bc[t], il = bt + mprev;
    float mx = il;
    for (int i = 0; i < 8; ++i) { const int j = jg + 8 * i; if (j <= t) mx = fmaxf(mx, bt - bc[j] + ig[j]); }
    mx = fmaxf(mx, __shfl_xor(mx, 1)); mx = fmaxf(mx, __shfl_xor(mx, 2)); mx = fmaxf(mx, __shfl_xor(mx, 4));
    float num[64]; float den = 0.f;
#pragma unroll
    for (int c = 0; c < 64; ++c) num[c] = 0.f;
    for (int i = 0; i < 8; ++i) { const int j = jg + 8 * i;
        if (j <= t) { float dot = 0.f;
#pragma unroll 8
            for (int k = 0; k < 64; ++k) dot += qc[t * LP + k] * kc[j * LP + k];
            const float sc = dot * expf(bt - bc[j] + ig[j] - mx); den += sc;
#pragma unroll
            for (int c = 0; c < 64; ++c) num[c] += sc * vv[j * LP + c]; } }
    const float iw = expf(il - mx);
#pragma unroll 2
    for (int kk = 0; kk < 8; ++kk) { const int k = jg * 8 + kk; const float qk = qc[t * LP + k] * iw; den += qk * np[k];
#pragma unroll
        for (int c = 0; c < 64; ++c) num[c] += qk * Cp[c * LP + k]; }
#pragma unroll
    for (int off = 1; off < 8; off <<= 1) { den += __shfl_xor(den, off);
#pragma unroll
        for (int c = 0; c < 64; ++c) num[c] += __shfl_xor(num[c], off); }
    den = fmaxf(fabsf(den), expf(-mx));
    const float rden = 1.0f / den; float ss = 0.f;
#pragma unroll
    for (int c = 0; c < 64; ++c) { num[c] *= rden; ss += num[c] * num[c]; }
    const float rn = 1.0f / sqrtf(ss * (1.0f / 64.0f) + EPS);
    const bf16* mo = F_Z + (size_t)row * LDZ + ZC_MO + h * 64; const bf16* mg = F_Z + (size_t)row * LDZ + ZC_MG + h * 64;
    const float* gn = F_ml_norm_g + layer * 384 + h * 64;
    bf16* yrow = F_Y + (size_t)row * DM + 384 + h * 64;
    P4_STORE8(num, jg, yrow, rn * gn[v] * sigmf(bf2f(mo[v])) * siluf(bf2f(mg[v])));
}

__device__ __forceinline__ void p4_gla(Frame& F, int layer, int b, int n, int hh) {
    LAS float* L = (LAS float*)(F.lds + RING_OFF);
    LAS float* qx = L; LAS float* kk = qx + 64 * 33; LAS float* vv = kk + 64 * 33; LAS float* bcum = vv + 64 * LP; LAS float* Sp = bcum + 64 * 33;
    const int cn = b * NCHS + n, r0 = b * SEQ + n * CH;
    stage_tile(F, b, n, ZC_GQ + hh * 32, 32, 0.17677669529663687f, qx, 33);
    stage_tile(F, b, n, ZC_GK + hh * 32, 32, 1.f, kk, 33);
    stage_tile(F, b, n, ZC_GV + hh * 64, 64, 1.f, vv, LP);
    { const float* ss = F_SST + ((size_t)cn * 4 + hh) * 2048; for (int idx = F_tid; idx < 2048; idx += NTHR) Sp[(idx >> 6) * LP + (idx & 63)] = ss[idx]; }
    stage_gla_decay(F, layer, b, n, hh, bcum);
    const int t = F_tid >> 3, jg = F_tid & 7, row = r0 + t;
    float num[64];
#pragma unroll
    for (int c = 0; c < 64; ++c) num[c] = 0.f;
    for (int i = 0; i < 8; ++i) { const int j = jg + 8 * i;
        if (j <= t) { float att = 0.f;
#pragma unroll 4
            for (int d = 0; d < 32; ++d) att += qx[t * 33 + d] * kk[j * 33 + d] * expf(bcum[t * 33 + d] - bcum[j * 33 + d]);
#pragma unroll
            for (int c = 0; c < 64; ++c) num[c] += att * vv[j * LP + c]; } }
#pragma unroll 2
    for (int dd = 0; dd < 4; ++dd) { const int d = jg * 4 + dd; const float w = qx[t * 33 + d] * expf(bcum[t * 33 + d]);
#pragma unroll
        for (int c = 0; c < 64; ++c) num[c] += w * Sp[d * LP + c]; }
    float ss = 0.f;
#pragma unroll
    for (int off = 1; off < 8; off <<= 1) {
#pragma unroll
        for (int c = 0; c < 64; ++c) num[c] += __shfl_xor(num[c], off); }
#pragma unroll
    for (int c = 0; c < 64; ++c) ss += num[c] * num[c];
    const float rn = 1.0f / sqrtf(ss * (1.0f / 64.0f) + EPS);
    const bf16* gg = F_Z + (size_t)row * LDZ + ZC_GG + hh * 64;
    const float* gn = F_gla_norm_g + layer * 256 + hh * 64;
    bf16* yrow = F_Y + (size_t)row * DM + 768 + hh * 64;
    P4_STORE8(num, jg, yrow, rn * gn[v] * siluf(bf2f(gg[v])));
}

typedef float f32x16 __attribute__((ext_vector_type(16)));
typedef short s16x4 __attribute__((ext_vector_type(4)));
typedef short v4i16_t __attribute__((ext_vector_type(4)));
typedef float f32x2_t __attribute__((ext_vector_type(2))); typedef __bf16 bf16x2_t __attribute__((ext_vector_type(2)));
__device__ __forceinline__ unsigned cvtpk(float lo, float hi) { f32x2_t v = {lo, hi}; bf16x2_t b = __builtin_convertvector(v, bf16x2_t); return __builtin_bit_cast(unsigned, b); }
__device__ __forceinline__ s16x4 lds_tr(LAS const unsigned char* p) { return __builtin_bit_cast(s16x4, __builtin_amdgcn_ds_read_tr16_b64_v4i16((LAS v4i16_t*)p)); }
__device__ __forceinline__ bf16x8 pack8(float a0, float a1, float a2, float a3, float a4, float a5, float a6, float a7) {
    v4u w; w.x = cvtpk(a0, a1); w.y = cvtpk(a2, a3); w.z = cvtpk(a4, a5); w.w = cvtpk(a6, a7); return __builtin_bit_cast(bf16x8, w); }
#define MFMA32(a, b, c) __builtin_amdgcn_mfma_f32_32x32x16_bf16((a), (b), (c), 0, 0, 0)
constexpr float LOG2E = 1.4426950408889634f;
__device__ __forceinline__ float fexp(float x) { return __builtin_amdgcn_exp2f(x * LOG2E); }
__device__ __forceinline__ float fsigm(float x) { return __builtin_amdgcn_rcpf(1.0f + fexp(-x)); }
__device__ __forceinline__ float fsilu(float x) { return x * fsigm(x); }
__device__ __forceinline__ int tile_off(int row, int bytecol) { return row * 128 + ((((bytecol >> 4) ^ (((row >> 1) & 1) << 2)) << 4) | (bytecol & 15)); }
__device__ __forceinline__ void dma_tile(const bf16* g, LAS unsigned char* tile, int lane) {
    const int rr = lane >> 3, cpos = lane & 7;
#pragma unroll
    for (int it = 0; it < 8; ++it) { const int row = 8 * it + rr, ch = cpos ^ (((row >> 1) & 1) << 2);
        __builtin_amdgcn_global_load_lds((const unsigned*)(g + (size_t)row * LDZ + ch * 8), (LAS unsigned*)(tile + it * 1024), 16, 0, 0); }
}
__device__ __forceinline__ bf16x8 tr_frag(LAS const unsigned char* tile, int lane, int c0, int ks) {
    const int g = lane >> 4, i = lane & 15, hf = g >> 1;
    const int row = 16 * ks + 4 * hf + (i >> 2), bc = (c0 + 16 * (g & 1) + 4 * (i & 3)) * 2;
    const s16x4 lo = lds_tr(tile + tile_off(row, bc)), hi = lds_tr(tile + tile_off(row + 8, bc));
    return (bf16x8){lo[0], lo[1], lo[2], lo[3], hi[0], hi[1], hi[2], hi[3]};
}

__device__ __forceinline__ const char* uptr(const void* p) { const unsigned long long v = (unsigned long long)p;
    const unsigned lo = __builtin_amdgcn_readfirstlane((unsigned)v), hi = __builtin_amdgcn_readfirstlane((unsigned)(v >> 32)); return (const char*)(((unsigned long long)hi << 32) | lo); }
__device__ __forceinline__ bf16x8 ldfrag(const char* ub, unsigned voff) { return *(const bf16x8*)(ub + voff); }
__device__ __forceinline__ unsigned dma_voff(int lane) { const int rr = lane >> 3; return (unsigned)(rr * LDZ + (((lane & 7) ^ (((rr >> 1) & 1) << 2)) * 8)) * 2u; }
__device__ __forceinline__ void dma_tile_u(const char* ub, unsigned voff, LAS unsigned char* tile) {
#pragma unroll
    for (int it = 0; it < 8; ++it) __builtin_amdgcn_global_load_lds((const unsigned*)(ub + (size_t)it * 8 * LDZ * 2 + voff), (LAS unsigned*)(tile + it * 1024), 16, 0, 0);
}
__device__ __forceinline__ void tr_bases(int lane, unsigned& b0, unsigned& b1) {
    const int g = lane >> 4, i = lane & 15, hf = g >> 1, row = 4 * hf + (i >> 2), bc = (16 * (g & 1) + 4 * (i & 3)) * 2;
    b0 = (unsigned)tile_off(row, bc); b1 = (unsigned)tile_off(row, bc + 64);
}
__device__ __forceinline__ bf16x8 tr_frag_b(LAS const unsigned char* tile, unsigned base, int ks) {
    const s16x4 lo = lds_tr(tile + base + ks * 2048), hi = lds_tr(tile + base + ks * 2048 + 1024);
    return (bf16x8){lo[0], lo[1], lo[2], lo[3], hi[0], hi[1], hi[2], hi[3]};
}

__device__ __forceinline__ void attn_wave(Frame& F, int layer, int cn, int h, LAS unsigned char* wl) {
    const int lane = F_lane, r = lane & 31, hf = lane >> 5;
    const int b = cn / NCHS, n = cn % NCHS;
    const size_t row0 = (size_t)b * SEQ + (size_t)n * CH;
    const bf16* Z = F_Z;
    LAS float* rbl = (LAS float*)(wl + 16384);
    const float* rb = F_rel_bias + (size_t)(layer * 6 + h) * 257;
    for (int i = lane; i < 257; i += 64) rbl[i] = rb[i] * LOG2E;
    const float bfar = rb[256] * LOG2E;
    constexpr float C1 = 0.125f * LOG2E;
    const unsigned voffK = (unsigned)(r * LDZ + 8 * hf) * 2u, voffV = dma_voff(lane);
    unsigned trb0, trb1; tr_bases(lane, trb0, trb1);
    bf16x8 qf[2][4];
    { const char* qb_ = uptr(Z + row0 * LDZ + ZC_AQ + h * 64);
#pragma unroll
    for (int qb = 0; qb < 2; ++qb)
#pragma unroll
        for (int s = 0; s < 4; ++s) qf[qb][s] = ldfrag(qb_ + ((size_t)32 * qb * LDZ + 16 * s) * 2, voffK); }
    f32x16 o[2][2];
#pragma unroll
    for (int a = 0; a < 2; ++a)
#pragma unroll
        for (int c = 0; c < 2; ++c)
#pragma unroll
            for (int i = 0; i < 16; ++i) o[a][c][i] = 0.f;
    float m[2] = {-1e30f, -1e30f}, lsum[2] = {0.f, 0.f};
    const int i0 = (n >= 8) ? 0 : 8 - n;
    dma_tile_u(uptr(Z + (row0 - 512 + 64 * i0) * LDZ + ZC_AV + h * 64), voffV, wl + (i0 & 1) * 8192);
#pragma unroll 1
    for (int ti = i0; ti < 9; ++ti) {
        const size_t kr0 = row0 - 512 + 64 * ti;
        LAS const unsigned char* vt = wl + (ti & 1) * 8192;
        const char* kb_ = uptr(Z + kr0 * LDZ + ZC_AK + h * 64);
#pragma unroll
        for (int kb = 0; kb < 2; ++kb) {
            bf16x8 kf[4];
#pragma unroll
            for (int s = 0; s < 4; ++s) kf[s] = ldfrag(kb_ + ((size_t)32 * kb * LDZ + 16 * s) * 2, voffK);
            if (kb == 0 && ti < 8) dma_tile_u(uptr(Z + (kr0 + 64) * LDZ + ZC_AV + h * 64), voffV, wl + ((ti + 1) & 1) * 8192);
            f32x16 st[2];
#pragma unroll
            for (int qb = 0; qb < 2; ++qb) {
#pragma unroll
                for (int i = 0; i < 16; ++i) st[qb][i] = 0.f;
#pragma unroll
                for (int s = 0; s < 4; ++s) st[qb] = MFMA32(kf[s], qf[qb][s], st[qb]);
            }
            if (ti <= 5) {
#pragma unroll
                for (int qb = 0; qb < 2; ++qb)
#pragma unroll
                    for (int i = 0; i < 16; ++i) st[qb][i] = st[qb][i] * C1 + bfar;
            } else {
#pragma unroll
                for (int qb = 0; qb < 2; ++qb)
#pragma unroll
                    for (int i = 0; i < 16; ++i) {
                        const int kk = 32 * kb + (i & 3) + 8 * (i >> 2) + 4 * hf, t = 32 * qb + r;
                        int rel = t + 512 - 64 * ti - kk; rel = rel < -128 ? -128 : (rel > 128 ? 128 : rel);
                        st[qb][i] = st[qb][i] * C1 + rbl[rel + 128];
                    }
            }
            bf16x8 pf[2][2];
#pragma unroll
            for (int qb = 0; qb < 2; ++qb) {
                float mx = st[qb][0];
#pragma unroll
                for (int i = 1; i < 16; ++i) mx = fmaxf(mx, st[qb][i]);
                mx = fmaxf(mx, __shfl_xor(mx, 32));
                const float mn = fmaxf(m[qb], mx), alpha = __builtin_amdgcn_exp2f(m[qb] - mn);
                m[qb] = mn;
                float ps = 0.f;
#pragma unroll
                for (int i = 0; i < 16; ++i) { const float p = __builtin_amdgcn_exp2f(st[qb][i] - mn); st[qb][i] = p; ps += p; }
                lsum[qb] = lsum[qb] * alpha + ps;
#pragma unroll
                for (int i = 0; i < 16; ++i) { o[0][qb][i] *= alpha; o[1][qb][i] *= alpha; }
                pf[qb][0] = pack8(st[qb][0], st[qb][1], st[qb][2], st[qb][3], st[qb][4], st[qb][5], st[qb][6], st[qb][7]);
                pf[qb][1] = pack8(st[qb][8], st[qb][9], st[qb][10], st[qb][11], st[qb][12], st[qb][13], st[qb][14], st[qb][15]);
            }
            if (kb == 0) { if (ti < 8) asm volatile("s_waitcnt vmcnt(8)" ::: "memory"); else asm volatile("s_waitcnt vmcnt(0)" ::: "memory"); }
#pragma unroll
            for (int k2 = 0; k2 < 2; ++k2)
#pragma unroll
                for (int dvb = 0; dvb < 2; ++dvb) {
                    const bf16x8 vf = tr_frag_b(vt, dvb ? trb1 : trb0, 2 * kb + k2);
                    o[dvb][0] = MFMA32(vf, pf[0][k2], o[dvb][0]);
                    o[dvb][1] = MFMA32(vf, pf[1][k2], o[dvb][1]);
                }
        }
    }
#pragma unroll
    for (int qb = 0; qb < 2; ++qb) {
        const float l = lsum[qb] + __shfl_xor(lsum[qb], 32), inv = 1.0f / l;
        const size_t row = row0 + 32 * qb + r;
#pragma unroll
        for (int dvb = 0; dvb < 2; ++dvb)
#pragma unroll
            for (int i4 = 0; i4 < 4; ++i4) {
                const int dv = 32 * dvb + 8 * i4 + 4 * hf;
                const unsigned long long gw = *(const unsigned long long*)(Z + row * LDZ + ZC_AG + h * 64 + dv);
                const float g0 = __uint_as_float((unsigned)gw << 16), g1 = __uint_as_float((unsigned)gw & 0xffff0000u);
                const float g2 = __uint_as_float((unsigned)(gw >> 32) << 16), g3 = __uint_as_float((unsigned)(gw >> 32) & 0xffff0000u);
                const float y0 = o[dvb][qb][4 * i4] * inv * fsilu(g0), y1 = o[dvb][qb][4 * i4 + 1] * inv * fsilu(g1);
                const float y2 = o[dvb][qb][4 * i4 + 2] * inv * fsilu(g2), y3 = o[dvb][qb][4 * i4 + 3] * inv * fsilu(g3);
                *(unsigned long long*)(F_Y + row * DM + h * 64 + dv) = (unsigned long long)cvtpk(y0, y1) | ((unsigned long long)cvtpk(y2, y3) << 32);
            }
    }
}

__device__ __forceinline__ float wave_scan_add(float x, int lane) {
#pragma unroll
    for (int o = 1; o < 64; o <<= 1) { const float y = __shfl_up(x, o); if (lane >= o) x += y; }
    return x;
}
__device__ __forceinline__ float wave_scan_max(float x, int lane) {
#pragma unroll
    for (int o = 1; o < 64; o <<= 1) { const float y = __shfl_up(x, o); if (lane >= o) x = fmaxf(x, y); }
    return x;
}
__device__ __forceinline__ float wave_max(float x) {
#pragma unroll
    for (int o = 1; o < 64; o <<= 1) x = fmaxf(x, __shfl_xor(x, o));
    return x;
}
__device__ __forceinline__ void unpack8(v4u w, float* o) {
    o[0] = __uint_as_float(w.x << 16); o[1] = __uint_as_float(w.x & 0xffff0000u); o[2] = __uint_as_float(w.y << 16); o[3] = __uint_as_float(w.y & 0xffff0000u);
    o[4] = __uint_as_float(w.z << 16); o[5] = __uint_as_float(w.z & 0xffff0000u); o[6] = __uint_as_float(w.w << 16); o[7] = __uint_as_float(w.w & 0xffff0000u);
}
__device__ __forceinline__ void conv8(const char* zub, unsigned voff, int blk, int s, int tt, int n, LAS const float* w, int c0, float scale, float* out) {
    float acc[8];
#pragma unroll
    for (int e = 0; e < 8; ++e) acc[e] = 0.f;
#pragma unroll
    for (int j = 0; j < 4; ++j) {
        v4u raw = *(const v4u*)(zub + ((long)(32 * blk + j - 3) * LDZ + 16 * s) * 2 + voff);
        if (!(n > 0 || tt + j - 3 >= 0)) raw = (v4u){0u, 0u, 0u, 0u};
        float z[8]; unpack8(raw, z);
        const f32x4 w0 = *(LAS const f32x4*)(w + j * 64 + c0), w1 = *(LAS const f32x4*)(w + j * 64 + c0 + 4);
        acc[0] += z[0] * w0[0]; acc[1] += z[1] * w0[1]; acc[2] += z[2] * w0[2]; acc[3] += z[3] * w0[3];
        acc[4] += z[4] * w1[0]; acc[5] += z[5] * w1[1]; acc[6] += z[6] * w1[2]; acc[7] += z[7] * w1[3];
    }
#pragma unroll
    for (int e = 0; e < 8; ++e) out[e] = fsilu(acc[e]) * scale;
}
__device__ __forceinline__ bf16x8 ld_f32_frag(const char* ub, unsigned voff) {
    const f32x4 a = *(const f32x4*)(ub + voff), b = *(const f32x4*)(ub + voff + 16);
    return pack8(a[0], a[1], a[2], a[3], b[0], b[1], b[2], b[3]);
}

__device__ __forceinline__ void ml_out_wave(Frame& F, int layer, int cn, int h, LAS unsigned char* wl) {
    const int lane = F_lane, r = lane & 31, hf = lane >> 5;
    const int b = cn / NCHS, n = cn % NCHS;
    const size_t row0 = (size_t)b * SEQ + (size_t)n * CH;
    const bf16* Z = F_Z;
    dma_tile_u(uptr(Z + row0 * LDZ + ZC_MV + h * 64), dma_voff(lane), wl);
    LAS float* wq = (LAS float*)(wl + 16384); LAS float* wk = wq + 256;
    { const float* cw = F_conv_w + (size_t)layer * 4 * 768;
#pragma unroll
      for (int i = lane; i < 256; i += 64) { const int j = i >> 6, c = i & 63; wq[i] = cw[j * 768 + h * 64 + c]; wk[i] = cw[j * 768 + 384 + h * 64 + c]; } }
    const float* g32 = F_G32 + (row0 + lane) * 32;
    const float ig = g32[h] + F_b_gates[layer * 12 + h];
    const float lf = logsigf(g32[6 + h] + F_b_gates[layer * 12 + 6 + h]);
    const float bc = wave_scan_add(lf, lane);
    const float av = ig - bc;
    const float amax = wave_scan_max(av, lane);
    const float mprev = F_MP[cn * 6 + h];
    float bct[2], mt[2], iw[2];
#pragma unroll
    for (int tb = 0; tb < 2; ++tb) { bct[tb] = __shfl(bc, 32 * tb + r); mt[tb] = fmaxf(mprev, __shfl(amax, 32 * tb + r)); iw[tb] = fexp(mprev - mt[tb]); }
    const unsigned voffK = (unsigned)(r * LDZ + 8 * hf) * 2u;
    bf16x8 qcf[2][4], kcf[2][4];
    float nq[2] = {0.f, 0.f};
    {
        const char* zq = uptr(Z + row0 * LDZ + ZC_MQ + h * 64); const char* zk = uptr(Z + row0 * LDZ + ZC_MK + h * 64);
        const char* npb = uptr(F_NST + ((size_t)cn * 6 + h) * 64);
#pragma unroll
        for (int s = 0; s < 4; ++s) {
            const f32x4 n0 = *(const f32x4*)(npb + (16 * s + 8 * hf) * 4), n1 = *(const f32x4*)(npb + (16 * s + 8 * hf) * 4 + 16);
#pragma unroll
            for (int blk = 0; blk < 2; ++blk) {
                float q8[8]; conv8(zq, voffK, blk, s, 32 * blk + r, n, wq, 16 * s + 8 * hf, 1.f, q8);
                nq[blk] += q8[0] * n0[0] + q8[1] * n0[1] + q8[2] * n0[2] + q8[3] * n0[3] + q8[4] * n1[0] + q8[5] * n1[1] + q8[6] * n1[2] + q8[7] * n1[3];
                qcf[blk][s] = pack8(q8[0], q8[1], q8[2], q8[3], q8[4], q8[5], q8[6], q8[7]);
                float k8[8]; conv8(zk, voffK, blk, s, 32 * blk + r, n, wk, 16 * s + 8 * hf, 0.125f, k8);
                kcf[blk][s] = pack8(k8[0], k8[1], k8[2], k8[3], k8[4], k8[5], k8[6], k8[7]);
            }
            asm volatile("" ::: "memory");
        }
    }
    bf16x8 pf0[2], pf1[4];
    float den[2] = {0.f, 0.f};
    {
        f32x16 s00, s01, s11;
#pragma unroll
        for (int i = 0; i < 16; ++i) { s00[i] = 0.f; s01[i] = 0.f; s11[i] = 0.f; }
#pragma unroll
        for (int s = 0; s < 4; ++s) { s00 = MFMA32(kcf[0][s], qcf[0][s], s00); s01 = MFMA32(kcf[0][s], qcf[1][s], s01); s11 = MFMA32(kcf[1][s], qcf[1][s], s11); }
#pragma unroll
        for (int i = 0; i < 16; ++i) {
            const int jr = (i & 3) + 8 * (i >> 2) + 4 * hf;
            const float a0 = __shfl(av, jr), a1 = __shfl(av, 32 + jr);
            const float d00 = (jr <= r) ? fexp(a0 - mt[0]) : 0.f, d01 = fexp(a0 - mt[1]), d11 = (jr <= r) ? fexp(a1 - mt[1]) : 0.f;
            s00[i] *= d00; s01[i] *= d01; s11[i] *= d11;
            den[0] += s00[i]; den[1] += s01[i] + s11[i];
        }
        pf0[0] = pack8(s00[0], s00[1], s00[2], s00[3], s00[4], s00[5], s00[6], s00[7]); pf0[1] = pack8(s00[8], s00[9], s00[10], s00[11], s00[12], s00[13], s00[14], s00[15]);
        pf1[0] = pack8(s01[0], s01[1], s01[2], s01[3], s01[4], s01[5], s01[6], s01[7]); pf1[1] = pack8(s01[8], s01[9], s01[10], s01[11], s01[12], s01[13], s01[14], s01[15]);
        pf1[2] = pack8(s11[0], s11[1], s11[2], s11[3], s11[4], s11[5], s11[6], s11[7]); pf1[3] = pack8(s11[8], s11[9], s11[10], s11[11], s11[12], s11[13], s11[14], s11[15]);
    }
#pragma unroll
    for (int tb = 0; tb < 2; ++tb) {
        den[tb] += __shfl_xor(den[tb], 32); nq[tb] += __shfl_xor(nq[tb], 32);
        den[tb] = fmaxf(fabsf(den[tb] + iw[tb] * nq[tb]), fexp(-(bct[tb] + mt[tb])));
    }
    unsigned trb0, trb1; tr_bases(lane, trb0, trb1);
    const char* cpb = uptr(F_CST + ((size_t)cn * 6 + h) * 4096);
    f32x16 num[2][2];
#pragma unroll
    for (int vb = 0; vb < 2; ++vb) {
        bf16x8 cf[4];
#pragma unroll
        for (int s = 0; s < 4; ++s) cf[s] = ld_f32_frag(cpb + ((size_t)32 * vb * 64 + 16 * s) * 4, (unsigned)(r * 64 + 8 * hf) * 4u);
#pragma unroll
        for (int tb = 0; tb < 2; ++tb) {
#pragma unroll
            for (int i = 0; i < 16; ++i) num[vb][tb][i] = 0.f;
#pragma unroll
            for (int s = 0; s < 4; ++s) num[vb][tb] = MFMA32(cf[s], qcf[tb][s], num[vb][tb]);
#pragma unroll
            for (int i = 0; i < 16; ++i) num[vb][tb][i] *= iw[tb];
        }
    }
    asm volatile("s_waitcnt vmcnt(0)" ::: "memory");
#pragma unroll
    for (int vb = 0; vb < 2; ++vb)
#pragma unroll
        for (int ks = 0; ks < 4; ++ks) {
            const bf16x8 vf = tr_frag_b(wl, vb ? trb1 : trb0, ks);
            if (ks < 2) num[vb][0] = MFMA32(vf, pf0[ks], num[vb][0]);
            num[vb][1] = MFMA32(vf, pf1[ks], num[vb][1]);
        }
#pragma unroll
    for (int tb = 0; tb < 2; ++tb) {
        const float rden = 1.0f / den[tb]; float ss = 0.f;
#pragma unroll
        for (int vb = 0; vb < 2; ++vb)
#pragma unroll
            for (int i = 0; i < 16; ++i) { num[vb][tb][i] *= rden; ss += num[vb][tb][i] * num[vb][tb][i]; }
        ss += __shfl_xor(ss, 32);
        const float rn = 1.0f / sqrtf(ss * (1.0f / 64.0f) + EPS);
        const size_t row = row0 + 32 * tb + r;
#pragma unroll
        for (int vb = 0; vb < 2; ++vb)
#pragma unroll
            for (int i4 = 0; i4 < 4; ++i4) {
                const int v = 32 * vb + 8 * i4 + 4 * hf;
                const f32x4 gn = *(const f32x4*)(F_ml_norm_g + layer * 384 + h * 64 + v);
                float mo[4], mg[4];
                { const unsigned long long w = *(const unsigned long long*)(Z + row * LDZ + ZC_MO + h * 64 + v);
                  mo[0] = __uint_as_float((unsigned)w << 16); mo[1] = __uint_as_float((unsigned)w & 0xffff0000u); mo[2] = __uint_as_float((unsigned)(w >> 32) << 16); mo[3] = __uint_as_float((unsigned)(w >> 32) & 0xffff0000u); }
                { const unsigned long long w = *(const unsigned long long*)(Z + row * LDZ + ZC_MG + h * 64 + v);
                  mg[0] = __uint_as_float((unsigned)w << 16); mg[1] = __uint_as_float((unsigned)w & 0xffff0000u); mg[2] = __uint_as_float((unsigned)(w >> 32) << 16); mg[3] = __uint_as_float((unsigned)(w >> 32) & 0xffff0000u); }
                float y[4];
#pragma unroll
                for (int e = 0; e < 4; ++e) y[e] = num[vb][tb][4 * i4 + e] * rn * gn[e] * fsigm(mo[e]) * fsilu(mg[e]);
                *(unsigned long long*)(F_Y + row * DM + 384 + h * 64 + v) = (unsigned long long)cvtpk(y[0], y[1]) | ((unsigned long long)cvtpk(y[2], y[3]) << 32);
                if (i4 & 1) asm volatile("" ::: "memory");
            }
    }
}

__device__ __forceinline__ void ml_loc_wave(Frame& F, int layer, int cn, int h, LAS unsigned char* wl) {
    const int lane = F_lane, r = lane & 31, hf = lane >> 5;
    const int b = cn / NCHS, n = cn % NCHS;
    const size_t row0 = (size_t)b * SEQ + (size_t)n * CH;
    const bf16* Z = F_Z;
    const float* g32 = F_G32 + (row0 + lane) * 32;
    const float ig = g32[h] + F_b_gates[layer * 12 + h];
    const float lf = logsigf(g32[6 + h] + F_b_gates[layer * 12 + 6 + h]);
    const float bc = wave_scan_add(lf, lane);
    const float g = __shfl(bc, 63);
    const float av = g - bc + ig;
    const float mloc = wave_max(av);
    const float w = fexp(av - mloc);
    const int rr = lane >> 3, ch = lane & 7;
    float wk[4][8];
    { const float* cw = F_conv_w + (size_t)layer * 4 * 768 + 384 + h * 64 + ch * 8;
#pragma unroll
      for (int j = 0; j < 4; ++j) { const f32x4 a = *(const f32x4*)(cw + j * 768), c = *(const f32x4*)(cw + j * 768 + 4);
          wk[j][0] = a[0]; wk[j][1] = a[1]; wk[j][2] = a[2]; wk[j][3] = a[3]; wk[j][4] = c[0]; wk[j][5] = c[1]; wk[j][6] = c[2]; wk[j][7] = c[3]; } }
    const char* zk = uptr(Z + row0 * LDZ + ZC_MK + h * 64); const char* zv = uptr(Z + row0 * LDZ + ZC_MV + h * 64);
    const unsigned voffT = (unsigned)(rr * LDZ + ch * 8) * 2u;
#pragma unroll
    for (int it = 0; it < 8; ++it) {
        const int row = 8 * it + rr;
        float acc[8];
#pragma unroll
        for (int e = 0; e < 8; ++e) acc[e] = 0.f;
#pragma unroll
        for (int j = 0; j < 4; ++j) {
            v4u raw = *(const v4u*)(zk + (long)(8 * it + j - 3) * LDZ * 2 + voffT);
            if (!(n > 0 || row + j - 3 >= 0)) raw = (v4u){0u, 0u, 0u, 0u};
            float z[8]; unpack8(raw, z);
#pragma unroll
            for (int e = 0; e < 8; ++e) acc[e] += z[e] * wk[j][e];
        }
        const int lo = tile_off(row, ch * 16);
        *(LAS v4u*)(wl + lo) = __builtin_bit_cast(v4u, pack8(fsilu(acc[0]) * 0.125f, fsilu(acc[1]) * 0.125f, fsilu(acc[2]) * 0.125f, fsilu(acc[3]) * 0.125f,
                                                              fsilu(acc[4]) * 0.125f, fsilu(acc[5]) * 0.125f, fsilu(acc[6]) * 0.125f, fsilu(acc[7]) * 0.125f));
        float v8[8]; unpack8(*(const v4u*)(zv + (long)(8 * it) * LDZ * 2 + voffT), v8);
        const float wr = __shfl(w, row);
        *(LAS v4u*)(wl + 8192 + lo) = __builtin_bit_cast(v4u, pack8(v8[0] * wr, v8[1] * wr, v8[2] * wr, v8[3] * wr, v8[4] * wr, v8[5] * wr, v8[6] * wr, v8[7] * wr));
        if (it & 1) asm volatile("" ::: "memory");
    }
    unsigned trb0, trb1; tr_bases(lane, trb0, trb1);
    f32x16 acc[2][2];
#pragma unroll
    for (int a = 0; a < 2; ++a)
#pragma unroll
        for (int c = 0; c < 2; ++c)
#pragma unroll
            for (int i = 0; i < 16; ++i) acc[a][c][i] = 0.f;
#pragma unroll
    for (int ks = 0; ks < 4; ++ks) {
        const bf16x8 a0 = tr_frag_b(wl + 8192, trb0, ks), a1 = tr_frag_b(wl + 8192, trb1, ks), b0 = tr_frag_b(wl, trb0, ks), b1 = tr_frag_b(wl, trb1, ks);
        acc[0][0] = MFMA32(a0, b0, acc[0][0]); acc[0][1] = MFMA32(a0, b1, acc[0][1]); acc[1][0] = MFMA32(a1, b0, acc[1][0]); acc[1][1] = MFMA32(a1, b1, acc[1][1]);
    }
    float* cst = F_CST + ((size_t)cn * 6 + h) * 4096;
#pragma unroll
    for (int vb = 0; vb < 2; ++vb)
#pragma unroll
        for (int kb = 0; kb < 2; ++kb)
#pragma unroll
            for (int i = 0; i < 16; ++i) cst[(32 * vb + (i & 3) + 8 * (i >> 2) + 4 * hf) * 64 + 32 * kb + r] = acc[vb][kb][i];
    float s = 0.f;
#pragma unroll 8
    for (int j = 0; j < 64; ++j) s += __shfl(w, j) * bf2f(*(LAS const unsigned short*)(wl + tile_off(j, 2 * lane)));
    F_NST[((size_t)cn * 6 + h) * 64 + lane] = s;
    if (lane == 0) { F_GS[cn * 6 + h] = g; F_MS[cn * 6 + h] = mloc; }
}

__device__ __forceinline__ float flogsig(float x) { return fminf(x, 0.f) - 0.6931471805599453f * __builtin_amdgcn_logf(1.0f + fexp(-fabsf(x))); }
__device__ __forceinline__ void gla_loc_wave(Frame& F, int layer, int cn, int hh, LAS unsigned char* wl) {
    const int lane = F_lane, hf = lane >> 5;
    const int b = cn / NCHS, n = cn % NCHS;
    const size_t row0 = (size_t)b * SEQ + (size_t)n * CH, row = row0 + lane;
    const bf16* Z = F_Z;
    dma_tile_u(uptr(Z + row0 * LDZ + ZC_GV + hh * 64), dma_voff(lane), wl + 8192);
    float ga[16];
    { const f32x4* gp = (const f32x4*)(F_G32 + row * 32 + 12);
#pragma unroll
      for (int q = 0; q < 4; ++q) { const f32x4 v = gp[q]; ga[4 * q] = v[0]; ga[4 * q + 1] = v[1]; ga[4 * q + 2] = v[2]; ga[4 * q + 3] = v[3]; } }
    const float* wa = F_w_alpha + (size_t)layer * 16 * 128 + hh * 32; const float* ba = F_b_alpha + layer * 128 + hh * 32;
    LAS float* wsl = (LAS float*)(wl + 16384);
#pragma unroll
    for (int i = lane; i < 512; i += 64) wsl[i] = wa[(i >> 5) * 128 + (i & 31)];
    float bcv[32];
#pragma unroll
    for (int d4 = 0; d4 < 8; ++d4) {
        f32x4 a = *(const f32x4*)(ba + 4 * d4);
#pragma unroll
        for (int q = 0; q < 16; ++q) a += *(LAS const f32x4*)(wsl + q * 32 + 4 * d4) * ga[q];
#pragma unroll
        for (int e = 0; e < 4; ++e) bcv[4 * d4 + e] = wave_scan_add(flogsig(a[e]) * (1.0f / 16.0f), lane);
    }
    { f32x4* bp = (f32x4*)(F_BC + row * 128 + hh * 32);
#pragma unroll
      for (int q = 0; q < 8; ++q) bp[q] = (f32x4){bcv[4 * q], bcv[4 * q + 1], bcv[4 * q + 2], bcv[4 * q + 3]}; }
#pragma unroll
    for (int c = 0; c < 4; ++c) {
        float k8[8]; unpack8(*(const v4u*)(Z + row * LDZ + ZC_GK + hh * 32 + 8 * c), k8);
#pragma unroll
        for (int e = 0; e < 8; ++e) k8[e] *= fexp(__shfl(bcv[8 * c + e], 63) - bcv[8 * c + e]);
        *(LAS v4u*)(wl + tile_off(lane, c * 16)) = __builtin_bit_cast(v4u, pack8(k8[0], k8[1], k8[2], k8[3], k8[4], k8[5], k8[6], k8[7]));
    }
    if (lane == 63) { f32x4* ap = (f32x4*)(F_ADEC + ((size_t)cn * 4 + hh) * 32);
#pragma unroll
        for (int q = 0; q < 8; ++q) ap[q] = (f32x4){fexp(bcv[4 * q]), fexp(bcv[4 * q + 1]), fexp(bcv[4 * q + 2]), fexp(bcv[4 * q + 3])}; }
    unsigned trb0, trb1; tr_bases(lane, trb0, trb1);
    f32x16 u0, u1;
#pragma unroll
    for (int i = 0; i < 16; ++i) { u0[i] = 0.f; u1[i] = 0.f; }
    asm volatile("s_waitcnt vmcnt(0)" ::: "memory");
#pragma unroll
    for (int ks = 0; ks < 4; ++ks) { const bf16x8 kd = tr_frag_b(wl, trb0, ks);
        u0 = MFMA32(tr_frag_b(wl + 8192, trb0, ks), kd, u0); u1 = MFMA32(tr_frag_b(wl + 8192, trb1, ks), kd, u1); }
    float* sst = F_SST + ((size_t)cn * 4 + hh) * 2048;
#pragma unroll
    for (int i = 0; i < 16; ++i) { const int v = (i & 3) + 8 * (i >> 2) + 4 * hf; sst[v * 32 + (lane & 31)] = u0[i]; sst[(32 + v) * 32 + (lane & 31)] = u1[i]; }
}

__device__ __forceinline__ void gla_out_wave(Frame& F, int layer, int cn, int hh, LAS unsigned char* wl) {
    const int lane = F_lane, r = lane & 31, hf = lane >> 5;
    const int b = cn / NCHS, n = cn % NCHS;
    const size_t row0 = (size_t)b * SEQ + (size_t)n * CH;
    const bf16* Z = F_Z;
    dma_tile_u(uptr(Z + row0 * LDZ + ZC_GV + hh * 64), dma_voff(lane), wl);
    const unsigned voffK = (unsigned)(r * LDZ + 8 * hf) * 2u, voffB = (unsigned)(r * 128 + 8 * hf) * 4u;
    const char* zq = uptr(Z + row0 * LDZ + ZC_GQ + hh * 32); const char* zk = uptr(Z + row0 * LDZ + ZC_GK + hh * 32); const char* bcb = uptr(F_BC + row0 * 128 + hh * 32);
    bf16x8 qf[2][2], kf[2][2];
#pragma unroll
    for (int blk = 0; blk < 2; ++blk)
#pragma unroll
        for (int s = 0; s < 2; ++s) {
            float q8[8], k8[8];
            unpack8(*(const v4u*)(zq + ((size_t)32 * blk * LDZ + 16 * s) * 2 + voffK), q8); unpack8(*(const v4u*)(zk + ((size_t)32 * blk * LDZ + 16 * s) * 2 + voffK), k8);
            const f32x4 c0 = *(const f32x4*)(bcb + ((size_t)32 * blk * 128 + 16 * s) * 4 + voffB), c1 = *(const f32x4*)(bcb + ((size_t)32 * blk * 128 + 16 * s) * 4 + voffB + 16);
            const float bc8[8] = {c0[0], c0[1], c0[2], c0[3], c1[0], c1[1], c1[2], c1[3]};
#pragma unroll
            for (int e = 0; e < 8; ++e) { q8[e] *= 0.17677669529663687f * fexp(bc8[e]); k8[e] *= fexp(-bc8[e]); }
            qf[blk][s] = pack8(q8[0], q8[1], q8[2], q8[3], q8[4], q8[5], q8[6], q8[7]);
            kf[blk][s] = pack8(k8[0], k8[1], k8[2], k8[3], k8[4], k8[5], k8[6], k8[7]);
        }
    bf16x8 pf0[2], pf1[4];
    {
        f32x16 s00, s01, s11;
#pragma unroll
        for (int i = 0; i < 16; ++i) { s00[i] = 0.f; s01[i] = 0.f; s11[i] = 0.f; }
#pragma unroll
        for (int s = 0; s < 2; ++s) { s00 = MFMA32(kf[0][s], qf[0][s], s00); s01 = MFMA32(kf[0][s], qf[1][s], s01); s11 = MFMA32(kf[1][s], qf[1][s], s11); }
#pragma unroll
        for (int i = 0; i < 16; ++i) { const int jr = (i & 3) + 8 * (i >> 2) + 4 * hf; if (jr > r) { s00[i] = 0.f; s11[i] = 0.f; } }
        pf0[0] = pack8(s00[0], s00[1], s00[2], s00[3], s00[4], s00[5], s00[6], s00[7]); pf0[1] = pack8(s00[8], s00[9], s00[10], s00[11], s00[12], s00[13], s00[14], s00[15]);
        pf1[0] = pack8(s01[0], s01[1], s01[2], s01[3], s01[4], s01[5], s01[6], s01[7]); pf1[1] = pack8(s01[8], s01[9], s01[10], s01[11], s01[12], s01[13], s01[14], s01[15]);
        pf1[2] = pack8(s11[0], s11[1], s11[2], s11[3], s11[4], s11[5], s11[6], s11[7]); pf1[3] = pack8(s11[8], s11[9], s11[10], s11[11], s11[12], s11[13], s11[14], s11[15]);
    }
    unsigned trb0, trb1; tr_bases(lane, trb0, trb1);
    const char* spb = uptr(F_SST + ((size_t)cn * 4 + hh) * 2048);
    f32x16 num[2][2];
#pragma unroll
    for (int vb = 0; vb < 2; ++vb) {
        bf16x8 sf[2];
#pragma unroll
        for (int s = 0; s < 2; ++s) sf[s] = ld_f32_frag(spb + ((size_t)32 * vb * 32 + 16 * s) * 4, (unsigned)(r * 32 + 8 * hf) * 4u);
#pragma unroll
        for (int tb = 0; tb < 2; ++tb) {
#pragma unroll
            for (int i = 0; i < 16; ++i) num[vb][tb][i] = 0.f;
#pragma unroll
            for (int s = 0; s < 2; ++s) num[vb][tb] = MFMA32(sf[s], qf[tb][s], num[vb][tb]);
        }
    }
    asm volatile("s_waitcnt vmcnt(0)" ::: "memory");
#pragma unroll
    for (int vb = 0; vb < 2; ++vb)
#pragma unroll
        for (int ks = 0; ks < 4; ++ks) {
            const bf16x8 vf = tr_frag_b(wl, vb ? trb1 : trb0, ks);
            if (ks < 2) num[vb][0] = MFMA32(vf, pf0[ks], num[vb][0]);
            num[vb][1] = MFMA32(vf, pf1[ks], num[vb][1]);
        }
#pragma unroll
    for (int tb = 0; tb < 2; ++tb) {
        float ss = 0.f;
#pragma unroll
        for (int vb = 0; vb < 2; ++vb)
#pragma unroll
            for (int i = 0; i < 16; ++i) ss += num[vb][tb][i] * num[vb][tb][i];
        ss += __shfl_xor(ss, 32);
        const float rn = 1.0f / sqrtf(ss * (1.0f / 64.0f) + EPS);
        const size_t row = row0 + 32 * tb + r;
#pragma unroll
        for (int vb = 0; vb < 2; ++vb)
#pragma unroll
            for (int i4 = 0; i4 < 4; ++i4) {
                const int v = 32 * vb + 8 * i4 + 4 * hf;
                const f32x4 gn = *(const f32x4*)(F_gla_norm_g + layer * 256 + hh * 64 + v);
                float gg[4];
                { const unsigned long long w = *(const unsigned long long*)(Z + row * LDZ + ZC_GG + hh * 64 + v);
                  gg[0] = __uint_as_float((unsigned)w << 16); gg[1] = __uint_as_float((unsigned)w & 0xffff0000u); gg[2] = __uint_as_float((unsigned)(w >> 32) << 16); gg[3] = __uint_as_float((unsigned)(w >> 32) & 0xffff0000u); }
                float y[4];
#pragma unroll
                for (int e = 0; e < 4; ++e) y[e] = num[vb][tb][4 * i4 + e] * rn * gn[e] * fsilu(gg[e]);
                *(unsigned long long*)(F_Y + row * DM + 768 + hh * 64 + v) = (unsigned long long)cvtpk(y[0], y[1]) | ((unsigned long long)cvtpk(y[2], y[3]) << 32);
                if (i4 & 1) asm volatile("" ::: "memory");
            }
    }
}

__device__ __forceinline__ void p2_local(Frame& F, int layer) {
    const int gw = F.vcu * NWAVES + F.wave, NGW = F.G * NWAVES;
    LAS unsigned char* wl = F.lds + RING_OFF + F.wave * WL_BYTES;
    constexpr int NA = NCHT * 6, NL = NCHT * 10;
    if (NGW == 2048) {
        if (gw < NA) attn_wave(F, layer, gw / 6, gw % 6, wl);
        else for (int q = gw - NA; q < NL; q += 512) { if (q < NA) ml_loc_wave(F, layer, q / 6, q % 6, wl); else gla_loc_wave(F, layer, (q - NA) >> 2, (q - NA) & 3, wl); }
    } else {
        for (int a = gw; a < NA; a += NGW) attn_wave(F, layer, a / 6, a % 6, wl);
        for (int q = gw; q < NL; q += NGW) { if (q < NA) ml_loc_wave(F, layer, q / 6, q % 6, wl); else gla_loc_wave(F, layer, (q - NA) >> 2, (q - NA) & 3, wl); }
    }
}
__device__ __forceinline__ void p4_outputs(Frame& F, int layer) {
    const int gw = F.vcu * NWAVES + F.wave, NGW = F.G * NWAVES;
    LAS unsigned char* wl = F.lds + RING_OFF + F.wave * WL_BYTES;
    constexpr int NA = NCHT * 6, NG = NCHT * 4;
    if (NGW == 2048) {
        if (gw < NA) ml_out_wave(F, layer, gw / 6, gw % 6, wl);
        else for (int q = gw - NA; q < NG; q += 512) gla_out_wave(F, layer, q >> 2, q & 3, wl);
    } else {
        for (int a = gw; a < NA; a += NGW) ml_out_wave(F, layer, a / 6, a % 6, wl);
        for (int q = gw; q < NG; q += NGW) gla_out_wave(F, layer, q >> 2, q & 3, wl);
    }
}

__device__ __forceinline__ void p11_final(Frame& F) {
    const int gw = F.vcu * NWAVES + F.wave, NGW = F.G * NWAVES;
    const float* ssq = F_SSQ + 2 * T;
    for (int m = gw; m < T; m += NGW) {
        const float rs = 1.0f / sqrtf(ssq[m] * (1.0f / 1024.0f) + EPS);
        GAS f32x4* xr = (GAS f32x4*)(F_out + (size_t)m * DM) + F_lane; const GAS f32x4* gr = (const GAS f32x4*)F_final_g + F_lane;
#pragma unroll
        for (int j = 0; j < 4; ++j) { const f32x4 v = xr[64 * j], g = gr[64 * j]; xr[64 * j] = v * rs * g; }
    }
}

__global__ void __launch_bounds__(NTHR, 2) hymba_fwd(Args args) {
    extern __shared__ __attribute__((aligned(16))) unsigned char lds[];
    Frame F;
    F.lds = (LAS unsigned char*)lds;
    F.MISC = (volatile LAS unsigned*)(F.lds + MISC_OFF);
    F.wave = __builtin_amdgcn_readfirstlane(F_tid >> 6);
    F.G = gridDim.x; { const int bx = blockIdx.x; F.vcu = (F.G % 8 == 0) ? (bx % 8) * (F.G / 8) + bx / 8 : bx; }
    F.A = &args;
    for (int u = F_tid; u < (LDS_BYTES - LDSCTL_OFF) / 4; u += NTHR) ((LAS unsigned*)(F.lds + LDSCTL_OFF))[u] = 0u;
    __syncthreads();
    XcdBarrier bar; bar.bar = (unsigned*)(F_ctl + CW_BAR); bar.x = 0; bar.st = nullptr;
    if (N_LAUNCHES == 1) bar = xcd_barrier_post((unsigned*)(F_ctl + CW_BAR), F.MISC + 8);
#define GRID_BAR() do { if (N_LAUNCHES == 1) xcd_barrier(bar); } while (0)
    const int lo = args.ph_lo, hi = args.ph_hi;
#define IN(k) (lo <= (k) && (k) < hi)
#define BOTH(k) (IN(k) && IN((k) + 1))
    if (IN(0)) { p0_prologue(F); if (BOTH(0)) GRID_BAR(); }
#pragma unroll 1
    for (int step = 0; step < 2 * DEPTH; ++step) {
        const int layer = step >> 1, which = step & 1, pb = 1 + 5 * layer, pid = which ? pb + 4 : pb;
        if (IN(pid)) {
            const int N = which ? DM : NP;
            pg8::Gemm g{which ? F_Y : F_XB, which ? F_Wout_t + (size_t)layer * DM * DM : F_Win_t + (size_t)layer * NP * DM, T, N, DM};
            pg8::StaticOrder S; S.init(T, N, F.G, (int)blockIdx.x);
            pg8::EpiBoth E{which, pg8::EpiZ{F_Z, LDZ, F_SSQ + layer * T, F_G32, ZC_SM},
                           pg8::EpiRes{layer == 0 ? F_x : (const float*)F_out, F_out, layer == 0 ? F_XB : (bf16*)nullptr, F_SSQ + (layer + 1) * T}};
            pg8::gemm_phase<pg8::EpiBoth, pg8::StaticOrder, true, true>(F.lds + RING_OFF, g, S, E);
            if (BOTH(pid)) GRID_BAR();
        }
        if (which == 0) {
            if (IN(pb + 1)) { p2_local(F, layer); if (BOTH(pb + 1)) GRID_BAR(); }
            if (IN(pb + 2)) { p3_scan(F); if (BOTH(pb + 2)) GRID_BAR(); }
            if (IN(pb + 3)) { p4_outputs(F, layer); if (BOTH(pb + 3)) GRID_BAR(); }
        }
    }
    if (IN(11)) p11_final(F);
#undef IN
#undef BOTH
}

extern "C" void kernel_launch(void* const* d_in, const int* in_sizes, int n_in, void* d_out, int out_size, void* d_ws, size_t ws_size, hipStream_t stream) {
    static int grid = 0;
    if (grid == 0) {
        if (n_in != 12 || in_sizes[0] != T * DM || out_size != T * DM || ws_size < WS_END) {
            fprintf(stderr, "kernel_launch: unexpected shapes (n_in %d, in0 %d, out %d, ws %zu, need %zu); nothing launched\n", n_in, n_in > 0 ? in_sizes[0] : -1, out_size, ws_size, (size_t)WS_END); grid = -1; return; }
        int dev = 0, cus = 0, per_cu = 0;
        if (hipGetDevice(&dev) != hipSuccess || hipDeviceGetAttribute(&cus, hipDeviceAttributeMultiprocessorCount, dev) != hipSuccess) { fprintf(stderr, "kernel_launch: device query failed\n"); grid = -1; return; }
        if (hipFuncSetAttribute((const void*)hymba_fwd, hipFuncAttributeMaxDynamicSharedMemorySize, LDS_BYTES) != hipSuccess) { fprintf(stderr, "kernel_launch: hipFuncSetAttribute failed\n"); grid = -1; return; }
        if (hipOccupancyMaxActiveBlocksPerMultiprocessor(&per_cu, (const void*)hymba_fwd, NTHR, LDS_BYTES) != hipSuccess || per_cu < 1) {
            fprintf(stderr, "kernel_launch: occupancy query reports %d workgroups per CU; nothing launched\n", per_cu); (void)hipGetLastError(); grid = -1; return; }
        grid = cus;
        fprintf(stderr, "kernel_launch: grid %d x %d threads, %d B LDS, occupancy query %d/CU\n", grid, NTHR, LDS_BYTES, per_cu);
    }
    if (grid < 0) return;
    if (hipMemsetAsync((char*)d_ws + WS_CTL, 0, CTL_ZERO_BYTES, stream) != hipSuccess) { fprintf(stderr, "kernel_launch: memset failed\n"); return; }
    Args a{};
    for (int i = 0; i < 12; ++i) a.in[i] = (const float*)d_in[i];
    a.out = (float*)d_out; a.ws = (unsigned char*)d_ws;
    if (N_LAUNCHES == 1) {
        a.ph_lo = 0; a.ph_hi = NPHASE; a.li = 0;
        void* kargs[] = {&a};
        hipError_t e = hipLaunchCooperativeKernel((const void*)hymba_fwd, dim3(grid), dim3(NTHR), kargs, LDS_BYTES, stream);
        if (e != hipSuccess) fprintf(stderr, "kernel_launch: cooperative launch failed: %s\n", hipGetErrorString(e));
    } else {
        for (int p = 0; p < NPHASE; ++p) { a.ph_lo = p; a.ph_hi = p + 1; a.li = p;
            hipLaunchKernelGGL(hymba_fwd, dim3(grid), dim3(NTHR), LDS_BYTES, stream, a);
            if (hipPeekAtLastError() != hipSuccess) { fprintf(stderr, "kernel_launch: launch %d failed\n", p); break; } }
    }
}
```

```cpp
#include <hip/hip_runtime.h>
#include <cstdio>
#include <cstdint>
#include <cmath>

#ifndef PROBE_DUP
#define PROBE_DUP 0
#endif
#ifndef MK_N_LAUNCHES
#define MK_N_LAUNCHES 1
#endif

namespace pg8 {
#define PG8_LAS __attribute__((address_space(3)))
typedef unsigned short bf16_t;
typedef short bf16x8 __attribute__((ext_vector_type(8)));
typedef float f32x4 __attribute__((ext_vector_type(4)));
typedef unsigned u32x4 __attribute__((ext_vector_type(4)));
constexpr int BM = 256, BK = 64, HALF = 128, HTB = HALF * BK * 2  , STAGE_BYTES = 8 * HTB, NXCD = 8, WGM = 8;

__host__ __device__ __forceinline__ int lds_byte(int r, int c) { const int st = (r >> 4) * 2 + (c >> 5), rr = r & 15, cc = c & 31, ob = rr * 64 + cc * 2; return st * 1024 + (ob ^ (((ob >> 9) & 1) << 5)); }
__host__ __device__ __forceinline__ void stage_rc(int b, int& R, int& C) { const int st = b / 1024, sb = b % 1024, swz = sb ^ (((sb >> 9) & 1) << 5); R = (st >> 1) * 16 + swz / 64; C = (st & 1) * 32 + (swz % 64) / 2; }
__host__ __device__ __forceinline__ int perm32(int rho) { const int n = rho >> 4, i = rho & 15; return 8 * (i >> 2) + 4 * n + (i & 3); }

struct Unit { int pm, pn; };
struct Gemm { const bf16_t* A; const bf16_t* Bt; int M, N, K; };

struct StaticOrder {
    int nM, nN, nwg, G, c;
    __host__ __device__ void init(int M, int N, int G_, int c_) { nM = M / BM; nN = N / BM; nwg = nM * nN; G = G_; c = c_; }
    __host__ __device__ bool next(int i, Unit& u) const {
        const long L = (long)i * G + c; if (L >= nwg) return false;
        int wgid = (int)L; { const int q = nwg / NXCD, r = nwg % NXCD, xcd = wgid % NXCD, off = wgid / NXCD; wgid = (xcd < r ? xcd * (q + 1) : r * (q + 1) + (xcd - r) * q) + off; }
        const int nig = WGM * nN, gid = wgid / nig, fm = gid * WGM, gsz = (nM - fm) < WGM ? (nM - fm) : WGM;
        u.pm = fm + ((wgid % nig) % gsz); u.pn = (wgid % nig) / gsz; return true;
    }
    __device__ __forceinline__ void a_ready(const Unit&) const {}
    __device__ __forceinline__ void done(const Unit&) const {}
};

__device__ __forceinline__ unsigned cvt_pk_bf16(float lo, float hi) { unsigned r; asm volatile("v_cvt_pk_bf16_f32 %0, %1, %2" : "=v"(r) : "v"(lo), "v"(hi)); return r; }

typedef unsigned u32x2 __attribute__((ext_vector_type(2)));
struct EpiZ {
    bf16_t* Z; int ldz; const float* ssq; float* G32; int gcol0;
    __device__ __forceinline__ void operator()(const f32x4 (&acc)[2][2][4][2], const Unit& u, int wr, int wc, int fr, int fq) const {
        const int row0 = u.pm * BM + wr * 64 + fr, col0 = u.pn * BM + wc * 32 + 8 * fq;
#pragma unroll
        for (int ai = 0; ai < 2; ++ai)
#pragma unroll
            for (int m = 0; m < 4; ++m) {
                const int row = row0 + ai * HALF + m * 16;
                const float rs = 1.0f / sqrtf(ssq[row] * (1.0f / 1024.0f) + 1e-6f);
#pragma unroll
                for (int bj = 0; bj < 2; ++bj) {
                    const int col = col0 + bj * HALF;
                    const f32x4 v0 = acc[ai][bj][m][0] * rs, v1 = acc[ai][bj][m][1] * rs;
                    if (col < ldz) {
                        u32x4 w; w.x = cvt_pk_bf16(v0[0], v0[1]); w.y = cvt_pk_bf16(v0[2], v0[3]); w.z = cvt_pk_bf16(v1[0], v1[1]); w.w = cvt_pk_bf16(v1[2], v1[3]);
                        *(u32x4*)(Z + (size_t)row * ldz + col) = w;
                    } else if (col < gcol0 + 32) {
                        float* gp = G32 + (size_t)row * 32 + (col - gcol0);
                        *(f32x4*)gp = v0; *(f32x4*)(gp + 4) = v1;
                    }
                }
            }
    }
};
struct EpiRes {
    const float* base; float* out; bf16_t* xb; float* ssq;
    __device__ __forceinline__ void operator()(const f32x4 (&acc)[2][2][4][2], const Unit& u, int wr, int wc, int fr, int fq) const {
        const int col0 = u.pn * BM + wc * 32 + 8 * fq;
#pragma unroll
        for (int ai = 0; ai < 2; ++ai)
#pragma unroll
            for (int m = 0; m < 4; ++m) {
                const int row = u.pm * BM + ai * HALF + wr * 64 + m * 16 + fr;
                float s = 0.f;
#pragma unroll
                for (int bj = 0; bj < 2; ++bj) {
                    const size_t off = (size_t)row * 1024 + col0 + bj * HALF;
                    const f32x4 o0 = *(const f32x4*)(base + off) + acc[ai][bj][m][0], o1 = *(const f32x4*)(base + off + 4) + acc[ai][bj][m][1];
                    *(f32x4*)(out + off) = o0; *(f32x4*)(out + off + 4) = o1;
                    s += (o0[0] * o0[0] + o0[1] * o0[1]) + (o0[2] * o0[2] + o0[3] * o0[3]) + (o1[0] * o1[0] + o1[1] * o1[1]) + (o1[2] * o1[2] + o1[3] * o1[3]);
                    if (xb) { u32x4 w; w.x = cvt_pk_bf16(o0[0], o0[1]); w.y = cvt_pk_bf16(o0[2], o0[3]); w.z = cvt_pk_bf16(o1[0], o1[1]); w.w = cvt_pk_bf16(o1[2], o1[3]); *(u32x4*)(xb + off) = w; }
                }
                s += __shfl_xor(s, 16); s += __shfl_xor(s, 32);
                if (fq == 0) atomicAdd(ssq + row, s);
                asm volatile("" ::: "memory");
            }
    }
};
struct EpiBoth {
    static constexpr bool PERM = true, AFTER_DRAIN = false;
    int mode; EpiZ z; EpiRes r;
    __device__ __forceinline__ void operator()(const f32x4 (&acc)[2][2][4][2], const Unit& u, int wr, int wc, int fr, int fq) const {
        if (mode == 0) z(acc, u, wr, wc, fr, fq); else r(acc, u, wr, wc, fr, fq);
    }
};

template <class Epi, class Sched, bool ALIGN_EPI = false, bool SP2 = false>
__device__ __forceinline__ void gemm_phase(PG8_LAS unsigned char* lds, const Gemm g, const Sched& S, const Epi& E) {
    int tid_ = threadIdx.x; asm volatile("" : "+v"(tid_));
    const int tid = tid_, wid = __builtin_amdgcn_readfirstlane(tid >> 6), lane = tid & 63, wr = wid >> 2, wc = wid & 3, fr = lane & 15, fq = lane >> 4;
    const int K = g.K, nt = K / BK;
    unsigned voffA[2], voffB[2];
#pragma unroll
    for (int i = 0; i < 2; ++i) { int R, C; stage_rc(tid * 16 + i * 8192, R, C); const int Rb = Epi::PERM ? ((R & ~31) + perm32(R & 31)) : R;
        voffA[i] = (unsigned)(R * K + C) * 2u; voffB[i] = (unsigned)(Rb * K + C) * 2u; }
    const size_t kstep = (size_t)(BK * 2);
    const size_t hstep = (size_t)HALF * K * 2;
    const size_t tstep = 2 * hstep;
    const unsigned ldsw = (unsigned)wid * 1024u;
    const int aoff = lds_byte(wr * 64 + fr, fq * 8), boff = lds_byte(wc * 32 + fr, fq * 8);
#define PG8_SA(b, h) (((b) * 2 + (h)) * HTB)
#define PG8_SB(b, h) ((4 + (b) * 2 + (h)) * HTB)
#define PG8_STAGE(bufoff, gbase, voff) do { _Pragma("unroll") for (int _i = 0; _i < 2; ++_i) \
        __builtin_amdgcn_global_load_lds((const unsigned*)((const char*)(gbase) + (voff)[_i]), (PG8_LAS unsigned*)(lds + (bufoff) + ldsw + _i * 8192), 16, 0, 0); } while (0)
#define PG8_LDA(dst, b, h) do { _Pragma("unroll") for (int m = 0; m < 4; ++m) _Pragma("unroll") for (int k = 0; k < 2; ++k) dst[m][k] = *(const PG8_LAS bf16x8*)(lds + PG8_SA(b, h) + aoff + m * 2048 + k * 1024); } while (0)
#define PG8_LDB(dst, b, h) do { _Pragma("unroll") for (int n = 0; n < 2; ++n) _Pragma("unroll") for (int k = 0; k < 2; ++k) dst[n][k] = *(const PG8_LAS bf16x8*)(lds + PG8_SB(b, h) + boff + n * 2048 + k * 1024); } while (0)
#define PG8_MMA(ai, bj, At, Bt) do { __builtin_amdgcn_s_setprio(1); _Pragma("unroll") for (int m = 0; m < 4; ++m) _Pragma("unroll") for (int n = 0; n < 2; ++n) _Pragma("unroll") for (int k = 0; k < 2; ++k) \
        acc[ai][bj][m][n] = __builtin_amdgcn_mfma_f32_16x16x32_bf16(Bt[n][k], At[m][k], acc[ai][bj][m][n], 0, 0, 0); __builtin_amdgcn_s_setprio(0); } while (0)
#define PG8_WAIT_V(n) asm volatile("s_waitcnt vmcnt(" #n ")" ::: "memory")
#define PG8_WAIT_L(n) asm volatile("s_waitcnt lgkmcnt(" #n ")" ::: "memory")
#define PG8_BAR __builtin_amdgcn_s_barrier()
#define PG8_SCHED __builtin_amdgcn_sched_barrier(0)
    Unit cur, nxt; int ui = 0;
    if (!S.next(0, cur)) return;
    f32x4 acc[2][2][4][2];
#pragma unroll
    for (int a = 0; a < 2; ++a)
#pragma unroll
        for (int b = 0; b < 2; ++b)
#pragma unroll
            for (int m = 0; m < 4; ++m)
#pragma unroll
                for (int n = 0; n < 2; ++n) acc[a][b][m][n] = (f32x4){0.f, 0.f, 0.f, 0.f};
    bf16x8 At[4][2], B0[2][2], B1[2][2];
    const char* cA = (const char*)g.A + (size_t)cur.pm * tstep; const char* cB = (const char*)g.Bt + (size_t)cur.pn * tstep;
    S.a_ready(cur);
    if constexpr (SP2) {
        PG8_STAGE(PG8_SB(0, 0), cB, voffB); PG8_STAGE(PG8_SB(0, 1), cB + hstep, voffB); PG8_STAGE(PG8_SA(0, 0), cA, voffA); PG8_STAGE(PG8_SA(0, 1), cA + hstep, voffA);
        if (wr == 1) PG8_BAR;
        PG8_WAIT_V(2); PG8_BAR;
        PG8_STAGE(PG8_SB(1, 0), cB + kstep, voffB); PG8_STAGE(PG8_SA(1, 0), cA + kstep, voffA); PG8_STAGE(PG8_SB(1, 1), cB + hstep + kstep, voffB);
        PG8_WAIT_V(6); PG8_BAR;
    } else {
        PG8_STAGE(PG8_SB(0, 0), cB, voffB); PG8_STAGE(PG8_SA(0, 0), cA, voffA); PG8_STAGE(PG8_SB(0, 1), cB + hstep, voffB); PG8_STAGE(PG8_SA(0, 1), cA + hstep, voffA);
        if (wr == 1) PG8_BAR;
        PG8_WAIT_V(4); PG8_BAR;
        PG8_STAGE(PG8_SB(1, 0), cB + kstep, voffB); PG8_STAGE(PG8_SA(1, 0), cA + kstep, voffA); PG8_STAGE(PG8_SB(1, 1), cB + hstep + kstep, voffB);
        PG8_WAIT_V(6); PG8_BAR;
    }
    for (;;) {
        const bool has_next = S.next(ui + 1, nxt);
        const char* nA = has_next ? (const char*)g.A + (size_t)nxt.pm * tstep : cA; const char* nB = has_next ? (const char*)g.Bt + (size_t)nxt.pn * tstep : cB;
        for (int t = 0; t < nt; t += 2) {
            const bool last = (t == nt - 2);
            const char* a1 = cA + (size_t)(t + 1) * kstep;
            const char* a2 = last ? nA : cA + (size_t)(t + 2) * kstep; const char* b2 = last ? nB : cB + (size_t)(t + 2) * kstep;
            const char* a3 = a2 + kstep; const char* b3 = b2 + kstep;
            if (last && has_next) S.a_ready(nxt);
            if constexpr (SP2) {
            PG8_LDB(B0, 0, 0); PG8_LDB(B1, 0, 1); PG8_SCHED; PG8_LDA(At, 0, 0); PG8_STAGE(PG8_SA(1, 1), a1 + hstep, voffA);
            PG8_WAIT_V(8); PG8_WAIT_L(0); PG8_BAR; PG8_MMA(0, 0, At, B0); PG8_MMA(0, 1, At, B1); PG8_BAR; PG8_SCHED;
            PG8_LDA(At, 0, 1); PG8_STAGE(PG8_SB(0, 0), b2, voffB); PG8_STAGE(PG8_SB(0, 1), b2 + hstep, voffB); PG8_STAGE(PG8_SA(0, 0), a2, voffA);
            PG8_WAIT_V(8); PG8_WAIT_L(0); PG8_BAR; PG8_MMA(1, 0, At, B0); PG8_MMA(1, 1, At, B1); PG8_BAR; PG8_SCHED;
            PG8_LDB(B0, 1, 0); PG8_LDB(B1, 1, 1); PG8_SCHED; PG8_LDA(At, 1, 0); PG8_STAGE(PG8_SA(0, 1), a2 + hstep, voffA);
            PG8_WAIT_V(8); PG8_WAIT_L(0); PG8_BAR; PG8_MMA(0, 0, At, B0); PG8_MMA(0, 1, At, B1); PG8_BAR; PG8_SCHED;
            PG8_LDA(At, 1, 1); PG8_STAGE(PG8_SB(1, 0), b3, voffB); PG8_STAGE(PG8_SB(1, 1), b3 + hstep, voffB); PG8_STAGE(PG8_SA(1, 0), a3, voffA);
            PG8_WAIT_V(8); PG8_WAIT_L(0); PG8_BAR; PG8_MMA(1, 0, At, B0); PG8_MMA(1, 1, At, B1); PG8_BAR; PG8_SCHED;
            } else {
            PG8_LDB(B0, 0, 0); PG8_SCHED; PG8_LDA(At, 0, 0); PG8_STAGE(PG8_SA(1, 1), a1 + hstep, voffA);
            PG8_WAIT_L(8); PG8_BAR; PG8_WAIT_L(0); PG8_MMA(0, 0, At, B0); PG8_BAR; PG8_SCHED;
            PG8_LDB(B1, 0, 1); PG8_STAGE(PG8_SB(0, 0), b2, voffB);
            PG8_BAR; PG8_WAIT_L(0); PG8_MMA(0, 1, At, B1); PG8_BAR;
            PG8_LDA(At, 0, 1); PG8_STAGE(PG8_SA(0, 0), a2, voffA);
            PG8_BAR; PG8_WAIT_L(0); PG8_MMA(1, 0, At, B0); PG8_BAR; PG8_SCHED;
            PG8_STAGE(PG8_SB(0, 1), b2 + hstep, voffB);
            PG8_WAIT_V(6); PG8_BAR; PG8_MMA(1, 1, At, B1); PG8_BAR;
            PG8_LDB(B0, 1, 0); PG8_SCHED; PG8_LDA(At, 1, 0); PG8_STAGE(PG8_SA(0, 1), a2 + hstep, voffA);
            PG8_WAIT_L(8); PG8_BAR; PG8_WAIT_L(0); PG8_MMA(0, 0, At, B0); PG8_BAR; PG8_SCHED;
            PG8_LDB(B1, 1, 1); PG8_STAGE(PG8_SB(1, 0), b3, voffB);
            PG8_BAR; PG8_WAIT_L(0); PG8_MMA(0, 1, At, B1); PG8_BAR;
            PG8_LDA(At, 1, 1); PG8_STAGE(PG8_SA(1, 0), a3, voffA);
            PG8_BAR; PG8_WAIT_L(0); PG8_MMA(1, 0, At, B0); PG8_BAR; PG8_SCHED;
            PG8_STAGE(PG8_SB(1, 1), b3 + hstep, voffB);
            PG8_WAIT_V(6); PG8_BAR; PG8_MMA(1, 1, At, B1); PG8_BAR;
            }
        }
        if constexpr (ALIGN_EPI) { if (wr == 0) PG8_BAR; }
        if constexpr (!Epi::AFTER_DRAIN) { E(acc, cur, wr, wc, fr, fq); S.done(cur); }
        if (!has_next) break;
#pragma unroll
        for (int a = 0; a < 2; ++a)
#pragma unroll
            for (int b = 0; b < 2; ++b)
#pragma unroll
                for (int m = 0; m < 4; ++m)
#pragma unroll
                    for (int n = 0; n < 2; ++n) acc[a][b][m][n] = (f32x4){0.f, 0.f, 0.f, 0.f};
        cur = nxt; cA = nA; cB = nB; ++ui;
        if constexpr (ALIGN_EPI) { if (wr == 1) PG8_BAR; }
    }
    PG8_WAIT_V(0);
    if constexpr (!ALIGN_EPI) { if (wr == 0) PG8_BAR; }
    PG8_BAR;
    if constexpr (Epi::AFTER_DRAIN) { E.fused(acc, cur, wr, wc, fr, fq, lds, wid, lane); S.done(cur); }
#undef PG8_SA
#undef PG8_SB
#undef PG8_STAGE
#undef PG8_LDA
#undef PG8_LDB
#undef PG8_MMA
#undef PG8_WAIT_V
#undef PG8_WAIT_L
#undef PG8_BAR
#undef PG8_SCHED
}
}

constexpr int NWAVES = 8, NTHR = 512;
constexpr int N_LAUNCHES = MK_N_LAUNCHES;
constexpr int NPHASE = 12;
constexpr int BATCH = 2, SEQ = 8192, DM = 1024, T = BATCH * SEQ, DEPTH = 2, CH = 64, NCHT = T / CH  , NCHS = SEQ / CH  ;
constexpr int DIN = 4252, NP = 4352, LDZ = 4224;
constexpr int ZC_AQ = 0, ZC_AK = 384, ZC_AV = 768, ZC_AG = 1152, ZC_MQ = 1536, ZC_MK = 1920, ZC_MV = 2304, ZC_MO = 2688, ZC_MG = 3072, ZC_GQ = 3456, ZC_GK = 3584, ZC_GV = 3712, ZC_GG = 3968, ZC_SM = 4224;
constexpr float EPS = 1e-6f;
__host__ __device__ __forceinline__ int src_col(int n) {
    if (n < 3072) return n;
    if (n < 3968) return n + 12;
    if (n < 4224) return n + 28;
    if (n < 4236) return n - 1152;
    if (n < 4252) return n - 256;
    return -1;
}

constexpr size_t MiB = 1u << 20;
constexpr size_t WS_CTL = 0, CTL_ZERO_BYTES = 1 * MiB;
constexpr size_t WS_SSQ = 512 * 1024;
constexpr size_t WS_WIN = 1 * MiB;
constexpr size_t WS_WOUT = WS_WIN + (size_t)2 * NP * DM * 2;
constexpr size_t WS_XB = WS_WOUT + (size_t)2 * DM * DM * 2;
constexpr size_t WS_Y = WS_XB + (size_t)T * DM * 2;
constexpr size_t WS_Z = WS_Y + (size_t)T * DM * 2;
constexpr size_t WS_G32 = WS_Z + (size_t)T * LDZ * 2;
constexpr size_t WS_CST = WS_G32 + (size_t)T * 32 * 4;
constexpr size_t WS_NST = WS_CST + (size_t)NCHT * 6 * 4096 * 4;
constexpr size_t WS_SST = WS_NST + (size_t)NCHT * 6 * 64 * 4;
constexpr size_t WS_ADEC = WS_SST + (size_t)NCHT * 4 * 2048 * 4;
constexpr size_t WS_GS = WS_ADEC + (size_t)NCHT * 4 * 32 * 4;
constexpr size_t WS_MS = WS_GS + 8192;
constexpr size_t WS_MP = WS_MS + 8192;
constexpr size_t WS_END = WS_MP + 8192;
static_assert(WS_END <= 268435456, "d_ws map exceeds 256 MiB");
constexpr int CW_BAR = 4096;

constexpr int RING_OFF = 0, RING_BYTES = 162816;
constexpr int WL_BYTES = 20352;
constexpr int LDSCTL_OFF = RING_BYTES, MISC_OFF = LDSCTL_OFF + 320;
constexpr int LDS_BYTES = 163840;
#define GAS __attribute__((address_space(1)))
#define LAS __attribute__((address_space(3)))
typedef unsigned short bf16;
typedef unsigned v4u __attribute__((ext_vector_type(4)));
typedef float f32x4 __attribute__((ext_vector_type(4)));
typedef short bf16x8 __attribute__((ext_vector_type(8)));
typedef GAS unsigned gu32;
typedef GAS unsigned long long gu64;
#define RLX_AGENT __ATOMIC_RELAXED, __HIP_MEMORY_SCOPE_AGENT
#define LDS_WAIT() asm volatile("s_waitcnt lgkmcnt(0)" ::: "memory")
#define VM_WAIT() asm volatile("s_waitcnt vmcnt(0)" ::: "memory")
__device__ __forceinline__ unsigned long long rt() { return __builtin_amdgcn_s_memrealtime(); }
__device__ __forceinline__ unsigned f2bf(float f) { unsigned u = __builtin_bit_cast(unsigned, f); return (u + 0x7fffu + ((u >> 16) & 1u)) >> 16; }
__device__ __forceinline__ unsigned pk2(float lo, float hi) { return f2bf(lo) | (f2bf(hi) << 16); }

#define XB_TMO      128
#define XB_XCNT(j)  (256  + 64 * (j))
#define XB_XSUB(j)  (1280 + 64 * (j))
#define XB_XGEN(j)  (2304 + 64 * (j))
#define XB_TOP      3328
#define XB_TOPGEN   3392
#define XCD_BAR_WORDS 3456
#define XB_SPIN_CAP (1u << 18)

__device__ __forceinline__ unsigned xb_ld(unsigned* p)              { return __hip_atomic_load(p, __ATOMIC_RELAXED, __HIP_MEMORY_SCOPE_AGENT); }
__device__ __forceinline__ unsigned xb_add(unsigned* p, unsigned v) { return __hip_atomic_fetch_add(p, v, __ATOMIC_RELAXED, __HIP_MEMORY_SCOPE_AGENT); }
__device__ __forceinline__ unsigned xb_xcc_id() { return (unsigned)__builtin_amdgcn_s_getreg((3 << 11) | 20) & 0xFu; }
#define XB_SPIN(cond, bar) do { unsigned _sp = 0; while (cond) { __builtin_amdgcn_s_sleep(1); \
    if ((++_sp & 255u) == 0u) { if (xb_ld(&(bar)[XB_TMO])) break; if (_sp > XB_SPIN_CAP) { atomicAdd(&(bar)[XB_TMO], 1u); break; } } } } while (0)

struct XcdBarrier {
    unsigned* bar; unsigned x;
    volatile LAS unsigned* st;
};

__device__ __forceinline__ XcdBarrier xcd_barrier_post(unsigned* bar, volatile LAS unsigned* st) {
    XcdBarrier b; b.bar = bar; b.x = xb_xcc_id(); b.st = st;
    if (threadIdx.x == 0) (void)xb_add(&bar[XB_XCNT(b.x)], 1u);
    return b;
}
__device__ __forceinline__ void xcd_barrier_complete(unsigned* bar, unsigned x, unsigned& nloc, unsigned& nx) {
    const unsigned G = gridDim.x * gridDim.y * gridDim.z;
    unsigned sum, cnt, mine, sp = 0u;
    for (;;) {
        sum = 0u; cnt = 0u; mine = 0u;
#pragma unroll 1
        for (unsigned j = 0; j < 16; ++j) { const unsigned c = xb_ld(&bar[XB_XCNT(j)]); sum += c; cnt += (c > 0u) ? 1u : 0u; mine = (j == x) ? c : mine; }
        if (sum == G) break;
        __builtin_amdgcn_s_sleep(1);
        if ((++sp & 255u) == 0u) { if (xb_ld(&bar[XB_TMO])) break; if (sp > XB_SPIN_CAP) { atomicAdd(&bar[XB_TMO], 1u); break; } }
    }
    nloc = mine > 0u ? mine : 1u; nx = cnt > 0u ? cnt : 1u;
}

__device__ __forceinline__ void xcd_barrier(const XcdBarrier& b) {
    asm volatile("s_waitcnt vmcnt(0)" ::: "memory");
    __syncthreads();
    if (threadIdx.x == 0) {
        unsigned* bar = b.bar;
        __builtin_amdgcn_s_waitcnt(0);
        unsigned nloc = b.st[0], nx = b.st[1];
        if (nloc == 0u) { xcd_barrier_complete(bar, b.x, nloc, nx); b.st[0] = nloc; b.st[1] = nx; }
        const unsigned old = xb_add(&bar[XB_XSUB(b.x)], 1u);
        const unsigned gen = old / nloc;
        if (old + 1u == (gen + 1u) * nloc) {
            __builtin_amdgcn_fence(__ATOMIC_RELEASE, "agent");
            asm volatile("s_waitcnt vmcnt(0)" ::: "memory");
            const unsigned og = xb_add(&bar[XB_TOP], 1u);
            const unsigned tg = og / nx;
            if (og + 1u == (tg + 1u) * nx) xb_add(&bar[XB_TOPGEN], 1u);
            else XB_SPIN(xb_ld(&bar[XB_TOPGEN]) == tg, bar);
            __builtin_amdgcn_fence(__ATOMIC_ACQUIRE, "agent");
            xb_add(&bar[XB_XGEN(b.x)], 1u);
            asm volatile("s_waitcnt vmcnt(0)" ::: "memory");
        } else {
            XB_SPIN(xb_ld(&bar[XB_XGEN(b.x)]) == gen, bar);
            __builtin_amdgcn_fence(__ATOMIC_ACQUIRE, "agent");
            asm volatile("s_waitcnt vmcnt(0)" ::: "memory");
        }
    }
    __syncthreads();
}


struct Args { const float* in[12]; float* out; unsigned char* ws; int ph_lo, ph_hi, li, pad; };
struct Frame {
    LAS unsigned char* lds;
    volatile LAS unsigned* MISC;
    const Args* A;
    int wave, vcu, G;
};
__device__ __forceinline__ int opaque_tid() { int t = threadIdx.x; asm volatile("" : "+v"(t)); return t; }
#define F_tid (opaque_tid())
#define F_lane (opaque_tid() & 63)
__device__ __forceinline__ const Args* opaque_args(const Args* a) { unsigned long long v = (unsigned long long)a; asm volatile("" : "+s"(v)); return (const Args*)v; }
#define F_A (F.A)
#define F_x          (F_A->in[0])
#define F_norm_g     (F_A->in[1])
#define F_w_in       (F_A->in[2])
#define F_b_gates    (F_A->in[3])
#define F_conv_w     (F_A->in[4])
#define F_w_alpha    (F_A->in[5])
#define F_b_alpha    (F_A->in[6])
#define F_rel_bias   (F_A->in[7])
#define F_ml_norm_g  (F_A->in[8])
#define F_gla_norm_g (F_A->in[9])
#define F_w_out      (F_A->in[10])
#define F_final_g    (F_A->in[11])
#define F_out        (F_A->out)
#define F_ws         (F_A->ws)
#define F_ctl        ((gu32*)(F_ws + WS_CTL))
#define F_Win_t      ((bf16*)(F_ws + WS_WIN))
#define F_Wout_t     ((bf16*)(F_ws + WS_WOUT))
#define F_XB         ((bf16*)(F_ws + WS_XB))
#define F_Y          ((bf16*)(F_ws + WS_Y))
#define F_Z          ((bf16*)(F_ws + WS_Z))
#define F_G32        ((float*)(F_ws + WS_G32))
#define F_SSQ        ((float*)(F_ws + WS_SSQ))
#define F_CST        ((float*)(F_ws + WS_CST))
#define F_NST        ((float*)(F_ws + WS_NST))
#define F_SST        ((float*)(F_ws + WS_SST))
#define F_ADEC       ((float*)(F_ws + WS_ADEC))
#define F_GS         ((float*)(F_ws + WS_GS))
#define F_MS         ((float*)(F_ws + WS_MS))
#define F_MP         ((float*)(F_ws + WS_MP))
#define F_CPB        ((bf16*)(F_ws + WS_XB + (size_t)T * 128 * 4))
#define F_BC         ((float*)(F_ws + WS_XB))
__device__ __forceinline__ float bf2f(unsigned short u) { return __uint_as_float((unsigned)u << 16); }
__device__ __forceinline__ float wave_sum(float v) {
#pragma unroll
    for (int o = 1; o < 64; o <<= 1) v += __shfl_xor(v, o);
    return v;
}
__device__ __forceinline__ float siluf(float x) { return x / (1.0f + expf(-x)); }
__device__ __forceinline__ float sigmf(float x) { return 1.0f / (1.0f + expf(-x)); }
__device__ __forceinline__ float logsigf(float x) { return fminf(x, 0.f) - log1pf(expf(-fabsf(x))); }
__device__ __forceinline__ void ld8(const bf16* p, float* o) {
    const v4u w = *(const v4u*)p;
    o[0] = __uint_as_float(w.x << 16); o[1] = __uint_as_float(w.x & 0xffff0000u); o[2] = __uint_as_float(w.y << 16); o[3] = __uint_as_float(w.y & 0xffff0000u);
    o[4] = __uint_as_float(w.z << 16); o[5] = __uint_as_float(w.z & 0xffff0000u); o[6] = __uint_as_float(w.w << 16); o[7] = __uint_as_float(w.w & 0xffff0000u);
}

template <bool PERMUTE>
__device__ __forceinline__ void p0_transpose_item(const float* W, int Nsrc, int Ndst, const float* gk, bf16* WT, LAS float* scr, int item, int lane) {
    const int nblk = Ndst / 32, kb = item / nblk, nb = item % nblk, k0 = 64 * kb, n0 = 32 * nb;
    const int nd = n0 + (lane & 31), ns = PERMUTE ? src_col(nd) : nd;
#pragma unroll 8
    for (int i = 0; i < 32; ++i) { const int kk = 2 * i + (lane >> 5);
        float v = 0.f; if (ns >= 0) { v = W[(size_t)(k0 + kk) * Nsrc + ns]; if (gk) v *= gk[k0 + kk]; }
        scr[kk * 33 + (lane & 31)] = v; }
    LDS_WAIT(); asm volatile("" ::: "memory");
    const int c = lane & 7;
#pragma unroll
    for (int j = 0; j < 4; ++j) { const int n = (lane >> 3) + 8 * j; const LAS float* s = scr + (8 * c) * 33 + n;
        v4u o; o.x = pk2(s[0 * 33], s[1 * 33]); o.y = pk2(s[2 * 33], s[3 * 33]); o.z = pk2(s[4 * 33], s[5 * 33]); o.w = pk2(s[6 * 33], s[7 * 33]);
        *(GAS v4u*)(WT + (size_t)(n0 + n) * 1024 + k0 + 8 * c) = o; }
    LDS_WAIT(); asm volatile("" ::: "memory");
}
__device__ __forceinline__ void p0_prologue(Frame& F) {
    LAS float* scr = (LAS float*)(F.lds + RING_OFF + F.wave * 16384);
    int gw_ = F.vcu * NWAVES + F.wave; asm volatile("" : "+s"(gw_));
    const int gw = gw_, NGW = F.G * NWAVES;
    constexpr int I_IN = 16 * (NP / 32), I_OUT = 16 * (DM / 32);
    constexpr int NITEMS = 2 * I_IN + 2 * I_OUT;
    for (int it = gw; it < NITEMS; it += NGW) {
        int r = it;
        if (r < 2 * I_IN) { const int l = r / I_IN; r -= l * I_IN;
            p0_transpose_item<true>(F_w_in + (size_t)l * DM * DIN, DIN, NP, F_norm_g + l * DM, F_Win_t + (size_t)l * NP * DM, scr, r, F_lane); continue; }
        r -= 2 * I_IN;
        { const int l = r / I_OUT; r -= l * I_OUT;
            p0_transpose_item<false>(F_w_out + (size_t)l * DM * DM, DM, DM, nullptr, F_Wout_t + (size_t)l * DM * DM, scr, r, F_lane); }
    }
    for (int m = gw; m < T; m += NGW) {
        const GAS f32x4* xr = (const GAS f32x4*)(F_x + (size_t)m * DM) + F_lane;
        GAS unsigned long long* o8 = (GAS unsigned long long*)(F_XB + (size_t)m * DM) + F_lane;
        float s = 0.f;
#pragma unroll
        for (int j = 0; j < 4; ++j) { const f32x4 v = xr[64 * j]; s += (v.x * v.x + v.y * v.y) + (v.z * v.z + v.w * v.w);
            o8[64 * j] = (unsigned long long)pk2(v.x, v.y) | ((unsigned long long)pk2(v.z, v.w) << 32); }
        s = wave_sum(s);
        if (F_lane == 0) F_SSQ[m] = s;
    }
}

constexpr int LP = 65;
__device__ __forceinline__ void stage_conv(Frame& F, int layer, int b, int n, int zcol, int wch, float scale, LAS float* dst) {
    const float* cw = F_conv_w + (size_t)layer * 4 * 768;
    const int r0 = b * SEQ + n * CH;
    for (int idx = F_tid; idx < 4096; idx += NTHR) {
        const int t = idx >> 6, c = idx & 63;
        float a = 0.f;
#pragma unroll
        for (int j = 0; j < 4; ++j) { const int tt = t + j - 3;
            if (n * CH + tt >= 0) a += bf2f(F_Z[(size_t)(r0 + tt) * LDZ + zcol + c]) * cw[j * 768 + wch + c]; }
        dst[t * LP + c] = siluf(a) * scale;
    }
}
__device__ __forceinline__ void stage_tile(Frame& F, int b, int n, int zcol, int W, float scale, LAS float* dst, int pitch) {
    const int r0 = b * SEQ + n * CH;
    for (int idx = F_tid; idx < 64 * W; idx += NTHR) { const int t = idx / W, c = idx % W; dst[t * pitch + c] = bf2f(F_Z[(size_t)(r0 + t) * LDZ + zcol + c]) * scale; }
}
__device__ __forceinline__ void stage_mgates(Frame& F, int layer, int b, int n, int h, LAS float* ig, LAS float* bc, LAS float* lf) {
    const int r0 = b * SEQ + n * CH;
    if (F_tid < 64) { const float* g = F_G32 + (size_t)(r0 + F_tid) * 32;
        ig[F_tid] = g[h] + F_b_gates[layer * 12 + h]; lf[F_tid] = logsigf(g[6 + h] + F_b_gates[layer * 12 + 6 + h]); }
    __syncthreads();
    if (F_tid < 64) { float s = 0.f; for (int j = 0; j <= F_tid; ++j) s += lf[j]; bc[F_tid] = s; }
}
__device__ __forceinline__ void stage_gla_decay(Frame& F, int layer, int b, int n, int hh, LAS float* bcum) {
    const int r0 = b * SEQ + n * CH;
    const float* wa = F_w_alpha + (size_t)layer * 16 * 128; const float* ba = F_b_alpha + layer * 128;
    for (int idx = F_tid; idx < 2048; idx += NTHR) { const int t = idx >> 5, d = idx & 31;
        const float* g = F_G32 + (size_t)(r0 + t) * 32 + 12; float a = ba[hh * 32 + d];
#pragma unroll
        for (int r = 0; r < 16; ++r) a += g[r] * wa[r * 128 + hh * 32 + d];
        bcum[t * 33 + d] = logsigf(a) * (1.0f / 16.0f); }
    __syncthreads();
    if (F_tid < 32) { float s = 0.f; for (int t = 0; t < 64; ++t) { s += bcum[t * 33 + F_tid]; bcum[t * 33 + F_tid] = s; } }
    __syncthreads();
}

__device__ __forceinline__ void p3_scan(Frame& F) {
    LAS float* L = (LAS float*)(F.lds + RING_OFF);
    LAS float* so = L; LAS float* sn = L + 128; LAS float* gl = L + 256; LAS float* ml = L + 384; LAS float* ex = L + 512;
    const int tid = F_tid, w = tid >> 6, l = tid & 63;
    constexpr int NU_M = 12 * 65, NU = NU_M + 8 * 32;
    const int u0 = (int)(((long)F.vcu * NU) / F.G), u1 = (int)(((long)(F.vcu + 1) * NU) / F.G);
    int cur_bh = -1, par = 0;
    for (int u = u0; u < u1; ++u, par ^= 1) {
        LAS float* exu = ex + par * 1024;
        float c[16], dcy[16];
        float* p; size_t stride;
        if (u < NU_M) {
            const int bh = u / 65, eu = u % 65, b = bh / 6, h = bh % 6;
            if (bh != cur_bh) {
                __syncthreads();
                if (tid < 128) { const int ci = (b * NCHS + tid) * 6 + h; gl[tid] = F_GS[ci]; ml[tid] = F_MS[ci]; }
                __syncthreads();
                if (tid == 0) { float m = 0.f;
                    for (int n = 0; n < NCHS; ++n) { const float g = gl[n], mloc = ml[n], mn = fmaxf(g + m, mloc);
                        so[n] = expf(g + m - mn); sn[n] = expf(mloc - mn); gl[n] = m; m = mn; } }
                __syncthreads();
                if (eu == 0 && tid < 128) F_MP[(b * NCHS + tid) * 6 + h] = gl[tid];
                cur_bh = bh;
            }
            if (eu < 64) { p = F_CST + ((size_t)(b * NCHS + 16 * w) * 6 + h) * 4096 + eu * 64 + l; stride = (size_t)6 * 4096; }
            else { p = F_NST + ((size_t)(b * NCHS + 16 * w) * 6 + h) * 64 + l; stride = (size_t)6 * 64; }
#pragma unroll
            for (int i = 0; i < 16; ++i) { c[i] = p[i * stride] * sn[16 * w + i]; dcy[i] = so[16 * w + i]; }
        } else {
            const int v = u - NU_M, bh = v >> 5, eu = v & 31, b = bh >> 2, hh = bh & 3;
            p = F_SST + ((size_t)(b * NCHS + 16 * w) * 4 + hh) * 2048 + eu * 64 + l; stride = (size_t)4 * 2048;
            const float* ad = F_ADEC + ((size_t)(b * NCHS + 16 * w) * 4 + hh) * 32 + (l & 31);
#pragma unroll
            for (int i = 0; i < 16; ++i) { c[i] = p[i * stride]; dcy[i] = ad[(size_t)i * 4 * 32]; }
        }
        float st = 0.f, P = 1.f;
#pragma unroll
        for (int i = 0; i < 16; ++i) { const float ci = c[i]; c[i] = st; st = dcy[i] * st + ci; P *= dcy[i]; }
        exu[(w * 64 + l) * 2] = P; exu[(w * 64 + l) * 2 + 1] = st;
        __syncthreads();
        float sin = 0.f;
        for (int w2 = 0; w2 < w; ++w2) sin = exu[(w2 * 64 + l) * 2] * sin + exu[(w2 * 64 + l) * 2 + 1];
        float q = sin;
        if (u < NU_M && (u % 65) < 64) {
            const int bh = u / 65, eu = u % 65, b = bh / 6, h = bh % 6;
            bf16* pb = F_CPB + ((size_t)(b * NCHS + 16 * w) * 6 + h) * 4096 + eu * 64 + l;
#pragma unroll
            for (int i = 0; i < 16; ++i) { pb[(size_t)i * 6 * 4096] = (bf16)f2bf(c[i] + q); q *= dcy[i]; }
        } else {
#pragma unroll
            for (int i = 0; i < 16; ++i) { p[i * stride] = c[i] + q; q *= dcy[i]; }
        }
    }
    __syncthreads();
}

#define P4_STORE8(o, kg, yrow, GATE_EXPR) do { _Pragma("unroll") for (int c8 = 0; c8 < 8; ++c8) if ((kg) == c8) { float yv[8]; \
    _Pragma("unroll") for (int i = 0; i < 8; ++i) { const int v = c8 * 8 + i; yv[i] = (o)[v] * (GATE_EXPR); } \
    v4u w; w.x = pk2(yv[0], yv[1]); w.y = pk2(yv[2], yv[3]); w.z = pk2(yv[4], yv[5]); w.w = pk2(yv[6], yv[7]); *(GAS v4u*)((yrow) + c8 * 8) = w; } } while (0)

__device__ __forceinline__ void p4_attn(Frame& F, int layer, int b, int n, int h) {
    const int t = F_tid >> 3, kg = F_tid & 7;
    const int r0 = b * SEQ + n * CH, row = r0 + t;
    LAS float* qL = (LAS float*)(F.lds + RING_OFF);
    stage_tile(F, b, n, ZC_AQ + h * 64, 64, 1.f, qL, LP);
    __syncthreads();
    float o[64];
#pragma unroll
    for (int c = 0; c < 64; ++c) o[c] = 0.f;
    float m = -1e30f, l = 0.f;
    const float* rb = F_rel_bias + (size_t)(layer * 6 + h) * 257;
    for (int i = 0; i < 72; ++i) {
        const int jb = kg + 8 * i, kpos = n * CH - 512 + jb;
        if (kpos < 0) continue;
        const bf16* kr = F_Z + (size_t)(b * SEQ + kpos) * LDZ + ZC_AK + h * 64;
        float s = 0.f;
#pragma unroll
        for (int c = 0; c < 8; ++c) { float kf[8]; ld8(kr + c * 8, kf);
#pragma unroll
            for (int e = 0; e < 8; ++e) s += qL[t * LP + c * 8 + e] * kf[e]; }
        int rel = t + 512 - jb; rel = rel < -128 ? -128 : (rel > 128 ? 128 : rel);
        s = s * 0.125f + rb[rel + 128];
        const float mn = fmaxf(m, s), a = expf(m - mn), p = expf(s - mn);
        l = l * a + p; m = mn;
        const bf16* vr = F_Z + (size_t)(b * SEQ + kpos) * LDZ + ZC_AV + h * 64;
#pragma unroll
        for (int c = 0; c < 8; ++c) { float vf[8]; ld8(vr + c * 8, vf);
#pragma unroll
            for (int e = 0; e < 8; ++e) o[c * 8 + e] = o[c * 8 + e] * a + p * vf[e]; }
    }
#pragma unroll
    for (int off = 1; off < 8; off <<= 1) {
        const float m2 = __shfl_xor(m, off), l2 = __shfl_xor(l, off);
        const float mn = fmaxf(m, m2), a = expf(m - mn), bb = expf(m2 - mn);
        l = l * a + l2 * bb; m = mn;
#pragma unroll
        for (int c = 0; c < 64; ++c) { const float o2 = __shfl_xor(o[c], off); o[c] = o[c] * a + o2 * bb; }
    }
    const float inv = 1.0f / l;
    const bf16* gr = F_Z + (size_t)row * LDZ + ZC_AG + h * 64;
    bf16* yrow = F_Y + (size_t)row * DM + h * 64;
    P4_STORE8(o, kg, yrow, inv * siluf(bf2f(gr[v])));
}

__device__ __forceinline__ void p4_mlstm(Frame& F, int layer, int b, int n, int h) {
    LAS float* L = (LAS float*)(F.lds + RING_OFF);
    LAS float* qc = L; LAS float* kc = qc + 64 * LP; LAS float* vv = kc + 64 * LP; LAS float* Cp = vv + 64 * LP;
    LAS float* np = Cp + 64 * LP; LAS float* ig = np + 64; LAS float* bc = ig + 64; LAS float* lf = bc + 64;
    const int cn = b * NCHS + n, r0 = b * SEQ + n * CH;
    stage_conv(F, layer, b, n, ZC_MQ + h * 64, h * 64, 1.f, qc);
    stage_conv(F, layer, b, n, ZC_MK + h * 64, 384 + h * 64, 0.125f, kc);
    stage_tile(F, b, n, ZC_MV + h * 64, 64, 1.f, vv, LP);
    { const float* cs = F_CST + ((size_t)cn * 6 + h) * 4096; for (int idx = F_tid; idx < 4096; idx += NTHR) Cp[(idx >> 6) * LP + (idx & 63)] = cs[idx]; }
    if (F_tid < 64) np[F_tid] = F_NST[((size_t)cn * 6 + h) * 64 + F_tid];
    stage_mgates(F, layer, b, n, h, ig, bc, lf);
    __syncthreads();
    const float mprev = F_MP[cn * 6 + h];
    const int t = F_tid >> 3, jg = F_tid & 7, row = r0 + t;
    const float bt = bc[t], il = bt + mprev;
    float mx = il;
    for (int i = 0; i < 8; ++i) { const int j = jg + 8 * i; if (j <= t) mx = fmaxf(mx, bt - bc[j] + ig[j]); }
    mx = fmaxf(mx, __shfl_xor(mx, 1)); mx = fmaxf(mx, __shfl_xor(mx, 2)); mx = fmaxf(mx, __shfl_xor(mx, 4));
    float num[64]; float den = 0.f;
#pragma unroll
    for (int c = 0; c < 64; ++c) num[c] = 0.f;
    for (int i = 0; i < 8; ++i) { const int j = jg + 8 * i;
        if (j <= t) { float dot = 0.f;
#pragma unroll 8
            for (int k = 0; k < 64; ++k) dot += qc[t * LP + k] * kc[j * LP + k];
            const float sc = dot * expf(bt - bc[j] + ig[j] - mx); den += sc;
#pragma unroll
            for (int c = 0; c < 64; ++c) num[c] += sc * vv[j * LP + c]; } }
    const float iw = expf(il - mx);
#pragma unroll 2
    for (int kk = 0; kk < 8; ++kk) { const int k = jg * 8 + kk; const float qk = qc[t * LP + k] * iw; den += qk * np[k];
#pragma unroll
        for (int c = 0; c < 64; ++c) num[c] += qk * Cp[c * LP + k]; }
#pragma unroll
    for (int off = 1; off < 8; off <<= 1) { den += __shfl_xor(den, off);
#pragma unroll
        for (int c = 0; c < 64; ++c) num[c] += __shfl_xor(num[c], off); }
    den = fmaxf(fabsf(den), expf(-mx));
    const float rden = 1.0f / den; float ss = 0.f;
#pragma unroll
    for (int c = 0; c < 64; ++c) { num[c] *= rden; ss += num[c] * num[c]; }
    const float rn = 1.0f / sqrtf(ss * (1.0f / 64.0f) + EPS);
    const bf16* mo = F_Z + (size_t)row * LDZ + ZC_MO + h * 64; const bf16* mg = F_Z + (size_t)row * LDZ + ZC_MG + h * 64;
    const float* gn = F_ml_norm_g + layer * 384 + h * 64;
    bf16* yrow = F_Y + (size_t)row * DM + 384 + h * 64;
    P4_STORE8(num, jg, yrow, rn * gn[v] * sigmf(bf2f(mo[v])) * siluf(bf2f(mg[v])));
}

__device__ __forceinline__ void p4_gla(Frame& F, int layer, int b, int n, int hh) {
    LAS float* L = (LAS float*)(F.lds + RING_OFF);
    LAS float* qx = L; LAS float* kk = qx + 64 * 33; LAS float* vv = kk + 64 * 33; LAS float* bcum = vv + 64 * LP; LAS float* Sp = bcum + 64 * 33;
    const int cn = b * NCHS + n, r0 = b * SEQ + n * CH;
    stage_tile(F, b, n, ZC_GQ + hh * 32, 32, 0.17677669529663687f, qx, 33);
    stage_tile(F, b, n, ZC_GK + hh * 32, 32, 1.f, kk, 33);
    stage_tile(F, b, n, ZC_GV + hh * 64, 64, 1.f, vv, LP);
    { const float* ss = F_SST + ((size_t)cn * 4 + hh) * 2048; for (int idx = F_tid; idx < 2048; idx += NTHR) Sp[(idx >> 6) * LP + (idx & 63)] = ss[idx]; }
    stage_gla_decay(F, layer, b, n, hh, bcum);
    const int t = F_tid >> 3, jg = F_tid & 7, row = r0 + t;
    float num[64];
#pragma unroll
    for (int c = 0; c < 64; ++c) num[c] = 0.f;
    for (int i = 0; i < 8; ++i) { const int j = jg + 8 * i;
        if (j <= t) { float att = 0.f;
#pragma unroll 4
            for (int d = 0; d < 32; ++d) att += qx[t * 33 + d] * kk[j * 33 + d] * expf(bcum[t * 33 + d] - bcum[j * 33 + d]);
#pragma unroll
            for (int c = 0; c < 64; ++c) num[c] += att * vv[j * LP + c]; } }
#pragma unroll 2
    for (int dd = 0; dd < 4; ++dd) { const int d = jg * 4 + dd; const float w = qx[t * 33 + d] * expf(bcum[t * 33 + d]);
#pragma unroll
        for (int c = 0; c < 64; ++c) num[c] += w * Sp[d * LP + c]; }
    float ss = 0.f;
#pragma unroll
    for (int off = 1; off < 8; off <<= 1) {
#pragma unroll
        for (int c = 0; c < 64; ++c) num[c] += __shfl_xor(num[c], off); }
#pragma unroll
    for (int c = 0; c < 64; ++c) ss += num[c] * num[c];
    const float rn = 1.0f / sqrtf(ss * (1.0f / 64.0f) + EPS);
    const bf16* gg = F_Z + (size_t)row * LDZ + ZC_GG + hh * 64;
    const float* gn = F_gla_norm_g + layer * 256 + hh * 64;
    bf16* yrow = F_Y + (size_t)row * DM + 768 + hh * 64;
    P4_STORE8(num, jg, yrow, rn * gn[v] * siluf(bf2f(gg[v])));
}

typedef float f32x16 __attribute__((ext_vector_type(16)));
typedef short s16x4 __attribute__((ext_vector_type(4)));
typedef short v4i16_t __attribute__((ext_vector_type(4)));
typedef float f32x2_t __attribute__((ext_vector_type(2))); typedef __bf16 bf16x2_t __attribute__((ext_vector_type(2)));
__device__ __forceinline__ unsigned cvtpk(float lo, float hi) { f32x2_t v = {lo, hi}; bf16x2_t b = __builtin_convertvector(v, bf16x2_t); return __builtin_bit_cast(unsigned, b); }
__device__ __forceinline__ s16x4 lds_tr(LAS const unsigned char* p) { return __builtin_bit_cast(s16x4, __builtin_amdgcn_ds_read_tr16_b64_v4i16((LAS v4i16_t*)p)); }
__device__ __forceinline__ bf16x8 pack8(float a0, float a1, float a2, float a3, float a4, float a5, float a6, float a7) {
    v4u w; w.x = cvtpk(a0, a1); w.y = cvtpk(a2, a3); w.z = cvtpk(a4, a5); w.w = cvtpk(a6, a7); return __builtin_bit_cast(bf16x8, w); }
#define MFMA32(a, b, c) __builtin_amdgcn_mfma_f32_32x32x16_bf16((a), (b), (c), 0, 0, 0)
constexpr float LOG2E = 1.4426950408889634f;
__device__ __forceinline__ float fexp(float x) { return __builtin_amdgcn_exp2f(x * LOG2E); }
__device__ __forceinline__ float fsigm(float x) { return __builtin_amdgcn_rcpf(1.0f + fexp(-x)); }
__device__ __forceinline__ float fsilu(float x) { return x * fsigm(x); }
__device__ __forceinline__ int tile_off(int row, int bytecol) { return row * 128 + ((((bytecol >> 4) ^ (((row >> 1) & 1) << 2)) << 4) | (bytecol & 15)); }
__device__ __forceinline__ void dma_tile(const bf16* g, LAS unsigned char* tile, int lane) {
    const int rr = lane >> 3, cpos = lane & 7;
#pragma unroll
    for (int it = 0; it < 8; ++it) { const int row = 8 * it + rr, ch = cpos ^ (((row >> 1) & 1) << 2);
        __builtin_amdgcn_global_load_lds((const unsigned*)(g + (size_t)row * LDZ + ch * 8), (LAS unsigned*)(tile + it * 1024), 16, 0, 0); }
}
__device__ __forceinline__ bf16x8 tr_frag(LAS const unsigned char* tile, int lane, int c0, int ks) {
    const int g = lane >> 4, i = lane & 15, hf = g >> 1;
    const int row = 16 * ks + 4 * hf + (i >> 2), bc = (c0 + 16 * (g & 1) + 4 * (i & 3)) * 2;
    const s16x4 lo = lds_tr(tile + tile_off(row, bc)), hi = lds_tr(tile + tile_off(row + 8, bc));
    return (bf16x8){lo[0], lo[1], lo[2], lo[3], hi[0], hi[1], hi[2], hi[3]};
}

typedef const GAS char* gcp;
__device__ __forceinline__ gcp uptr(const void* p) { const unsigned long long v = (unsigned long long)p;
    const unsigned lo = __builtin_amdgcn_readfirstlane((unsigned)v), hi = __builtin_amdgcn_readfirstlane((unsigned)(v >> 32)); return (gcp)(((unsigned long long)hi << 32) | lo); }
__device__ __forceinline__ bf16x8 ldfrag(gcp ub, unsigned voff) { return *(const GAS bf16x8*)(ub + voff); }
__device__ __forceinline__ unsigned dma_voff(int lane) { const int rr = lane >> 3; return (unsigned)(rr * LDZ + (((lane & 7) ^ (((rr >> 1) & 1) << 2)) * 8)) * 2u; }
__device__ __forceinline__ void dma_tile_u(gcp ub, unsigned voff, LAS unsigned char* tile) {
#pragma unroll
    for (int it = 0; it < 8; ++it) __builtin_amdgcn_global_load_lds((const GAS unsigned*)(ub + (size_t)it * 8 * LDZ * 2 + voff), (LAS unsigned*)(tile + it * 1024), 16, 0, 0);
}
__device__ __forceinline__ void tr_bases(int lane, unsigned& b0, unsigned& b1) {
    const int g = lane >> 4, i = lane & 15, hf = g >> 1, row = 4 * hf + (i >> 2), bc = (16 * (g & 1) + 4 * (i & 3)) * 2;
    b0 = (unsigned)tile_off(row, bc); b1 = (unsigned)tile_off(row, bc + 64);
}
__device__ __forceinline__ bf16x8 tr_frag_b(LAS const unsigned char* tile, unsigned base, int ks) {
    const s16x4 lo = lds_tr(tile + base + ks * 2048), hi = lds_tr(tile + base + ks * 2048 + 1024);
    return (bf16x8){lo[0], lo[1], lo[2], lo[3], hi[0], hi[1], hi[2], hi[3]};
}

__device__ __forceinline__ void unpack8(v4u w, float* o) {
    o[0] = __uint_as_float(w.x << 16); o[1] = __uint_as_float(w.x & 0xffff0000u); o[2] = __uint_as_float(w.y << 16); o[3] = __uint_as_float(w.y & 0xffff0000u);
    o[4] = __uint_as_float(w.z << 16); o[5] = __uint_as_float(w.z & 0xffff0000u); o[6] = __uint_as_float(w.w << 16); o[7] = __uint_as_float(w.w & 0xffff0000u);
}
__device__ __forceinline__ float xh_max(float x) { const auto rr = __builtin_amdgcn_permlane32_swap(__float_as_uint(x), __float_as_uint(x), false, false); return fmaxf(__uint_as_float(rr[0]), __uint_as_float(rr[1])); }
__device__ __forceinline__ float xh_sum(float x) { const auto rr = __builtin_amdgcn_permlane32_swap(__float_as_uint(x), __float_as_uint(x), false, false); return __uint_as_float(rr[0]) + __uint_as_float(rr[1]); }
constexpr int TLP = 68;
__device__ __forceinline__ void tl_put4(LAS unsigned char* wl, int t, int v, float a, float b, float c, float e) { *(LAS f32x4*)(wl + ((t * TLP + v) << 2)) = (f32x4){a, b, c, e}; }
template <int GATE>
__device__ __forceinline__ void tl_emit(LAS const unsigned char* wl, int lane, gcp g0, gcp g1, const float* gn, GAS char* yb) {
    const int rr = lane >> 3, c = lane & 7;
    float gnv[8];
    if (GATE != 0) { const f32x4 a = *(const f32x4*)(gn + 8 * c), b = *(const f32x4*)(gn + 8 * c + 4); gnv[0] = a[0]; gnv[1] = a[1]; gnv[2] = a[2]; gnv[3] = a[3]; gnv[4] = b[0]; gnv[5] = b[1]; gnv[6] = b[2]; gnv[7] = b[3]; }
    const unsigned voff = (unsigned)(rr * LDZ + 8 * c) * 2u, yoff = (unsigned)(rr * DM + 8 * c) * 2u;
    v4u ga[8], gb[8];
#pragma unroll
    for (int it = 0; it < 8; ++it) { ga[it] = *(const GAS v4u*)(g0 + (size_t)it * 8 * LDZ * 2 + voff); if (GATE == 1) gb[it] = *(const GAS v4u*)(g1 + (size_t)it * 8 * LDZ * 2 + voff); }
#pragma unroll
    for (int it = 0; it < 8; ++it) {
        const int row = 8 * it + rr;
        const f32x4 x0 = *(LAS const f32x4*)(wl + ((row * TLP + 8 * c) << 2)), x1 = *(LAS const f32x4*)(wl + ((row * TLP + 8 * c + 4) << 2));
        float x[8] = {x0[0], x0[1], x0[2], x0[3], x1[0], x1[1], x1[2], x1[3]}, p[8], q[8];
        unpack8(ga[it], p); if (GATE == 1) unpack8(gb[it], q);
#pragma unroll
        for (int e = 0; e < 8; ++e) {
            if (GATE == 0) x[e] *= fsilu(p[e]);
            else if (GATE == 1) x[e] *= gnv[e] * fsigm(p[e]) * fsilu(q[e]);
            else x[e] *= gnv[e] * fsilu(p[e]);
        }
        *(GAS v4u*)(yb + (size_t)it * 8 * DM * 2 + yoff) = __builtin_bit_cast(v4u, pack8(x[0], x[1], x[2], x[3], x[4], x[5], x[6], x[7]));
    }
}

__device__ __forceinline__ void attn_wave(Frame& F, int layer, int cn, int h, LAS unsigned char* wl) {
    const int lane = F_lane, r = lane & 31, hf = lane >> 5;
    const int b = cn / NCHS, n = cn % NCHS;
    const size_t row0 = (size_t)b * SEQ + (size_t)n * CH;
    const bf16* Z = F_Z;
    LAS float* rbl = (LAS float*)(wl + 16384);
    const float* rb = F_rel_bias + (size_t)(layer * 6 + h) * 257;
    for (int i = lane; i < 257; i += 64) rbl[i] = rb[i] * LOG2E;
    const float bfar = rb[256] * LOG2E;
    constexpr float C1 = 0.125f * LOG2E;
    const unsigned voffK = (unsigned)(r * LDZ + 8 * hf) * 2u, voffV = dma_voff(lane);
    unsigned trb0, trb1; tr_bases(lane, trb0, trb1);
    bf16x8 qf[2][4];
    { gcp qb_ = uptr(Z + row0 * LDZ + ZC_AQ + h * 64);
#pragma unroll
    for (int qb = 0; qb < 2; ++qb)
#pragma unroll
        for (int s = 0; s < 4; ++s) qf[qb][s] = ldfrag(qb_ + ((size_t)32 * qb * LDZ + 16 * s) * 2, voffK); }
    f32x16 o[2][2];
#pragma unroll
    for (int a = 0; a < 2; ++a)
#pragma unroll
        for (int c = 0; c < 2; ++c)
#pragma unroll
            for (int i = 0; i < 16; ++i) o[a][c][i] = 0.f;
    float m[2] = {-1e30f, -1e30f}, lsum[2] = {0.f, 0.f};
    const int i0 = (n >= 8) ? 0 : 8 - n;
    dma_tile_u(uptr(Z + (row0 - 512 + 64 * i0) * LDZ + ZC_AV + h * 64), voffV, wl + (i0 & 1) * 8192);
#define ATTN_STEP(KF, KB) do { \
        f32x16 st[2]; \
        _Pragma("unroll") for (int qb = 0; qb < 2; ++qb) { _Pragma("unroll") for (int i = 0; i < 16; ++i) st[qb][i] = 0.f; \
            _Pragma("unroll") for (int s = 0; s < 4; ++s) st[qb] = MFMA32(KF[s], qf[qb][s], st[qb]); } \
        if (ti <= 5) { _Pragma("unroll") for (int qb = 0; qb < 2; ++qb) _Pragma("unroll") for (int i = 0; i < 16; ++i) st[qb][i] = st[qb][i] * C1 + bfar; } \
        else { _Pragma("unroll") for (int qb = 0; qb < 2; ++qb) _Pragma("unroll") for (int i = 0; i < 16; ++i) { \
            const int kk = 32 * (KB) + (i & 3) + 8 * (i >> 2) + 4 * hf, t = 32 * qb + r; \
            int rel = t + 512 - 64 * ti - kk; rel = rel < -128 ? -128 : (rel > 128 ? 128 : rel); \
            st[qb][i] = st[qb][i] * C1 + rbl[rel + 128]; } } \
        bf16x8 pf[2][2]; \
        _Pragma("unroll") for (int qb = 0; qb < 2; ++qb) { \
            float mx = st[qb][0]; \
            _Pragma("unroll") for (int i = 1; i < 16; ++i) mx = fmaxf(mx, st[qb][i]); \
            mx = xh_max(mx); \
            if (__any(mx > m[qb] + 8.0f)) { const float mn = fmaxf(m[qb], mx), alpha = __builtin_amdgcn_exp2f(m[qb] - mn); m[qb] = mn; lsum[qb] *= alpha; \
                _Pragma("unroll") for (int i = 0; i < 16; ++i) { o[0][qb][i] *= alpha; o[1][qb][i] *= alpha; } } \
            const float mq = m[qb]; float ps = 0.f; \
            _Pragma("unroll") for (int i = 0; i < 16; ++i) { const float p = __builtin_amdgcn_exp2f(st[qb][i] - mq); st[qb][i] = p; ps += p; } \
            lsum[qb] += ps; \
            pf[qb][0] = pack8(st[qb][0], st[qb][1], st[qb][2], st[qb][3], st[qb][4], st[qb][5], st[qb][6], st[qb][7]); \
            pf[qb][1] = pack8(st[qb][8], st[qb][9], st[qb][10], st[qb][11], st[qb][12], st[qb][13], st[qb][14], st[qb][15]); } \
        if ((KB) == 0) { if (ti < 8) asm volatile("s_waitcnt vmcnt(8)" ::: "memory"); else asm volatile("s_waitcnt vmcnt(0)" ::: "memory"); }     \
        _Pragma("unroll") for (int k2 = 0; k2 < 2; ++k2) _Pragma("unroll") for (int dvb = 0; dvb < 2; ++dvb) { \
            const bf16x8 vf = tr_frag_b(vt, dvb ? trb1 : trb0, 2 * (KB) + k2); \
            o[dvb][0] = MFMA32(vf, pf[0][k2], o[dvb][0]); o[dvb][1] = MFMA32(vf, pf[1][k2], o[dvb][1]); } \
    } while (0)
    bf16x8 kfa[4], kfb[4];
    { gcp kb_ = uptr(Z + (row0 - 512 + 64 * i0) * LDZ + ZC_AK + h * 64);
#pragma unroll
      for (int s = 0; s < 4; ++s) kfa[s] = ldfrag(kb_ + (size_t)16 * s * 2, voffK); }
#pragma unroll 1
    for (int ti = i0; ti < 9; ++ti) {
        const size_t kr0 = row0 - 512 + 64 * ti;
        LAS const unsigned char* vt = wl + (ti & 1) * 8192;
        gcp kb_ = uptr(Z + kr0 * LDZ + ZC_AK + h * 64);
#pragma unroll
        for (int s = 0; s < 4; ++s) kfb[s] = ldfrag(kb_ + ((size_t)32 * LDZ + 16 * s) * 2, voffK);
        if (ti < 8) dma_tile_u(uptr(Z + (kr0 + 64) * LDZ + ZC_AV + h * 64), voffV, wl + ((ti + 1) & 1) * 8192);
        ATTN_STEP(kfa, 0);
#pragma unroll
        for (int s = 0; s < 4; ++s) kfa[s] = ldfrag(kb_ + ((size_t)64 * LDZ + 16 * s) * 2, voffK);
        ATTN_STEP(kfb, 1);
    }
#undef ATTN_STEP
#pragma unroll
    for (int qb = 0; qb < 2; ++qb) {
        const float l = xh_sum(lsum[qb]), inv = 1.0f / l;
#pragma unroll
        for (int dvb = 0; dvb < 2; ++dvb)
#pragma unroll
            for (int i4 = 0; i4 < 4; ++i4) tl_put4(wl, 32 * qb + r, 32 * dvb + 8 * i4 + 4 * hf, o[dvb][qb][4 * i4] * inv, o[dvb][qb][4 * i4 + 1] * inv, o[dvb][qb][4 * i4 + 2] * inv, o[dvb][qb][4 * i4 + 3] * inv);
    }
    tl_emit<0>(wl, lane, uptr(Z + row0 * LDZ + ZC_AG + h * 64), (gcp)nullptr, nullptr, (GAS char*)uptr(F_Y + row0 * DM + h * 64));
}

#define DPPF(old, x, ctrl, rmask) __uint_as_float(__builtin_amdgcn_update_dpp(__float_as_uint(old), __float_as_uint(x), (ctrl), (rmask), 0xf, false))
__device__ __forceinline__ float wave_scan_add(float x, int) {
    x += DPPF(0.f, x, 0x111, 0xf);
    x += DPPF(0.f, x, 0x112, 0xf);
    x += DPPF(0.f, x, 0x114, 0xf);
    x += DPPF(0.f, x, 0x118, 0xf);
    x += DPPF(0.f, x, 0x142, 0xa);
    x += DPPF(0.f, x, 0x143, 0xc);
    return x;
}
__device__ __forceinline__ float wave_scan_max(float x, int) {
    const float ninf = -3.0e38f;
    x = fmaxf(x, DPPF(ninf, x, 0x111, 0xf));
    x = fmaxf(x, DPPF(ninf, x, 0x112, 0xf));
    x = fmaxf(x, DPPF(ninf, x, 0x114, 0xf));
    x = fmaxf(x, DPPF(ninf, x, 0x118, 0xf));
    x = fmaxf(x, DPPF(ninf, x, 0x142, 0xa));
    x = fmaxf(x, DPPF(ninf, x, 0x143, 0xc));
    return x;
}
__device__ __forceinline__ float wave_max(float x) {
#pragma unroll
    for (int o = 1; o < 64; o <<= 1) x = fmaxf(x, __shfl_xor(x, o));
    return x;
}
__device__ __forceinline__ void conv8(const char* zub, unsigned voff, int blk, int s, int tt, int n, LAS const float* w, int c0, float scale, float* out) {
    float acc[8];
#pragma unroll
    for (int e = 0; e < 8; ++e) acc[e] = 0.f;
#pragma unroll
    for (int j = 0; j < 4; ++j) {
        v4u raw = *(const v4u*)(zub + ((long)(32 * blk + j - 3) * LDZ + 16 * s) * 2 + voff);
        if (!(n > 0 || tt + j - 3 >= 0)) raw = (v4u){0u, 0u, 0u, 0u};
        float z[8]; unpack8(raw, z);
        const f32x4 w0 = *(LAS const f32x4*)(w + j * 64 + c0), w1 = *(LAS const f32x4*)(w + j * 64 + c0 + 4);
        acc[0] += z[0] * w0[0]; acc[1] += z[1] * w0[1]; acc[2] += z[2] * w0[2]; acc[3] += z[3] * w0[3];
        acc[4] += z[4] * w1[0]; acc[5] += z[5] * w1[1]; acc[6] += z[6] * w1[2]; acc[7] += z[7] * w1[3];
    }
#pragma unroll
    for (int e = 0; e < 8; ++e) out[e] = fsilu(acc[e]) * scale;
}
__device__ __forceinline__ bf16x8 ld_f32_frag(gcp ub, unsigned voff) {
    const f32x4 a = *(const GAS f32x4*)(ub + voff), b = *(const GAS f32x4*)(ub + voff + 16);
    return pack8(a[0], a[1], a[2], a[3], b[0], b[1], b[2], b[3]);
}

__device__ __forceinline__ void dma_rows67(gcp ub, unsigned voff, LAS unsigned char* img, int lane) {
#pragma unroll
    for (int it = 0; it < 8; ++it) __builtin_amdgcn_global_load_lds((const GAS unsigned*)(ub + (size_t)it * 8 * LDZ * 2 + voff), (LAS unsigned*)(img + it * 1024), 16, 0, 0);
    if (lane < 24) __builtin_amdgcn_global_load_lds((const GAS unsigned*)(ub + (size_t)64 * LDZ * 2 + voff), (LAS unsigned*)(img + 8192), 16, 0, 0);
}
constexpr int IMG1 = 8704;
__device__ __forceinline__ void ml_out_wave(Frame& F, int layer, int cn, int h, LAS unsigned char* wl) {
    const int lane = F_lane, r = lane & 31, hf = lane >> 5;
    const int b = cn / NCHS, n = cn % NCHS;
    const size_t row0 = (size_t)b * SEQ + (size_t)n * CH;
    const bf16* Z = F_Z;
    LAS unsigned char* img0 = wl; LAS unsigned char* img1 = wl + IMG1;
    LAS float* wq = (LAS float*)(wl + 17408); LAS float* wk = wq + 256; LAS float* npl = wq + 512;
    const unsigned dvo = dma_voff(lane);
    dma_rows67(uptr(Z + (row0 - 3) * LDZ + ZC_MQ + h * 64), dvo, img0, lane);
    dma_rows67(uptr(Z + (row0 - 3) * LDZ + ZC_MK + h * 64), dvo, img1, lane);
    { const float* cw = F_conv_w + (size_t)layer * 4 * 768 + h * 64 + lane;
#pragma unroll
      for (int j = 0; j < 4; ++j) { wq[j * 64 + lane] = cw[j * 768]; wk[j * 64 + lane] = cw[j * 768 + 384]; } }
    npl[lane] = F_NST[((size_t)cn * 6 + h) * 64 + lane];
    const float* g32 = F_G32 + (row0 + lane) * 32;
    const float ig = g32[h] + F_b_gates[layer * 12 + h];
    const float lf = logsigf(g32[6 + h] + F_b_gates[layer * 12 + 6 + h]);
    const float bc = wave_scan_add(lf, lane);
    const float av = ig - bc;
    const float amax = wave_scan_max(av, lane);
    const float mprev = F_MP[cn * 6 + h];
    float bct[2], mt[2], iw[2];
#pragma unroll
    for (int tb = 0; tb < 2; ++tb) { bct[tb] = __shfl(bc, 32 * tb + r); mt[tb] = fmaxf(mprev, __shfl(amax, 32 * tb + r)); iw[tb] = fexp(mprev - mt[tb]); }
    asm volatile("s_waitcnt vmcnt(0)" ::: "memory");
    bf16x8 qcf[2][4], kcf[2][4];
    float nq[2] = {0.f, 0.f};
#pragma unroll
    for (int s = 0; s < 4; ++s) {
        const int c0 = 16 * s + 8 * hf;
        const f32x4 n0 = *(LAS const f32x4*)(npl + c0), n1 = *(LAS const f32x4*)(npl + c0 + 4);
#pragma unroll
        for (int blk = 0; blk < 2; ++blk) {
            float aq[8], ak[8];
#pragma unroll
            for (int e = 0; e < 8; ++e) { aq[e] = 0.f; ak[e] = 0.f; }
#pragma unroll
            for (int j = 0; j < 4; ++j) {
                const int rho = 32 * blk + r + j, off = tile_off(rho, c0 * 2);
                v4u rq = *(LAS const v4u*)(img0 + off), rk = *(LAS const v4u*)(img1 + off);
                if (n == 0 && rho < 3) { rq = (v4u){0u, 0u, 0u, 0u}; rk = (v4u){0u, 0u, 0u, 0u}; }
                float zq[8], zk[8]; unpack8(rq, zq); unpack8(rk, zk);
                const f32x4 a0 = *(LAS const f32x4*)(wq + j * 64 + c0), a1 = *(LAS const f32x4*)(wq + j * 64 + c0 + 4), b0 = *(LAS const f32x4*)(wk + j * 64 + c0), b1 = *(LAS const f32x4*)(wk + j * 64 + c0 + 4);
                aq[0] += zq[0] * a0[0]; aq[1] += zq[1] * a0[1]; aq[2] += zq[2] * a0[2]; aq[3] += zq[3] * a0[3]; aq[4] += zq[4] * a1[0]; aq[5] += zq[5] * a1[1]; aq[6] += zq[6] * a1[2]; aq[7] += zq[7] * a1[3];
                ak[0] += zk[0] * b0[0]; ak[1] += zk[1] * b0[1]; ak[2] += zk[2] * b0[2]; ak[3] += zk[3] * b0[3]; ak[4] += zk[4] * b1[0]; ak[5] += zk[5] * b1[1]; ak[6] += zk[6] * b1[2]; ak[7] += zk[7] * b1[3];
            }
#pragma unroll
            for (int e = 0; e < 8; ++e) { aq[e] = fsilu(aq[e]); ak[e] = fsilu(ak[e]) * 0.125f; }
            nq[blk] += aq[0] * n0[0] + aq[1] * n0[1] + aq[2] * n0[2] + aq[3] * n0[3] + aq[4] * n1[0] + aq[5] * n1[1] + aq[6] * n1[2] + aq[7] * n1[3];
            qcf[blk][s] = pack8(aq[0], aq[1], aq[2], aq[3], aq[4], aq[5], aq[6], aq[7]);
            kcf[blk][s] = pack8(ak[0], ak[1], ak[2], ak[3], ak[4], ak[5], ak[6], ak[7]);
        }
    }
    dma_tile_u(uptr(Z + row0 * LDZ + ZC_MV + h * 64), dvo, img0);
    bf16x8 pf0[2], pf1[4];
    float den[2] = {0.f, 0.f};
    {
        f32x16 s00, s01, s11;
#pragma unroll
        for (int i = 0; i < 16; ++i) { s00[i] = 0.f; s01[i] = 0.f; s11[i] = 0.f; }
#pragma unroll
        for (int s = 0; s < 4; ++s) { s00 = MFMA32(kcf[0][s], qcf[0][s], s00); s01 = MFMA32(kcf[0][s], qcf[1][s], s01); s11 = MFMA32(kcf[1][s], qcf[1][s], s11); }
#pragma unroll
        for (int i = 0; i < 16; ++i) {
            const int jr = (i & 3) + 8 * (i >> 2) + 4 * hf;
            const float a0 = __shfl(av, jr), a1 = __shfl(av, 32 + jr);
            const float d00 = (jr <= r) ? fexp(a0 - mt[0]) : 0.f, d01 = fexp(a0 - mt[1]), d11 = (jr <= r) ? fexp(a1 - mt[1]) : 0.f;
            s00[i] *= d00; s01[i] *= d01; s11[i] *= d11;
            den[0] += s00[i]; den[1] += s01[i] + s11[i];
        }
        pf0[0] = pack8(s00[0], s00[1], s00[2], s00[3], s00[4], s00[5], s00[6], s00[7]); pf0[1] = pack8(s00[8], s00[9], s00[10], s00[11], s00[12], s00[13], s00[14], s00[15]);
        pf1[0] = pack8(s01[0], s01[1], s01[2], s01[3], s01[4], s01[5], s01[6], s01[7]); pf1[1] = pack8(s01[8], s01[9], s01[10], s01[11], s01[12], s01[13], s01[14], s01[15]);
        pf1[2] = pack8(s11[0], s11[1], s11[2], s11[3], s11[4], s11[5], s11[6], s11[7]); pf1[3] = pack8(s11[8], s11[9], s11[10], s11[11], s11[12], s11[13], s11[14], s11[15]);
    }
#pragma unroll
    for (int tb = 0; tb < 2; ++tb) {
        den[tb] = xh_sum(den[tb]); nq[tb] = xh_sum(nq[tb]);
        den[tb] = fmaxf(fabsf(den[tb] + iw[tb] * nq[tb]), fexp(-(bct[tb] + mt[tb])));
    }
    unsigned trb0, trb1; tr_bases(lane, trb0, trb1);
    gcp cpb = uptr(F_CPB + ((size_t)cn * 6 + h) * 4096);
    f32x16 num[2][2];
#pragma unroll
    for (int vb = 0; vb < 2; ++vb) {
        bf16x8 cf[4];
#pragma unroll
        for (int s = 0; s < 4; ++s) cf[s] = ldfrag(cpb + ((size_t)32 * vb * 64 + 16 * s) * 2, (unsigned)(r * 64 + 8 * hf) * 2u);
#pragma unroll
        for (int tb = 0; tb < 2; ++tb) {
#pragma unroll
            for (int i = 0; i < 16; ++i) num[vb][tb][i] = 0.f;
#pragma unroll
            for (int s = 0; s < 4; ++s) num[vb][tb] = MFMA32(cf[s], qcf[tb][s], num[vb][tb]);
#pragma unroll
            for (int i = 0; i < 16; ++i) num[vb][tb][i] *= iw[tb];
        }
    }
    asm volatile("s_waitcnt vmcnt(0)" ::: "memory");
#pragma unroll
    for (int vb = 0; vb < 2; ++vb)
#pragma unroll
        for (int ks = 0; ks < 4; ++ks) {
            const bf16x8 vf = tr_frag_b(img0, vb ? trb1 : trb0, ks);
            if (ks < 2) num[vb][0] = MFMA32(vf, pf0[ks], num[vb][0]);
            num[vb][1] = MFMA32(vf, pf1[ks], num[vb][1]);
        }
#pragma unroll
    for (int tb = 0; tb < 2; ++tb) {
        const float rden = 1.0f / den[tb]; float ss = 0.f;
#pragma unroll
        for (int vb = 0; vb < 2; ++vb)
#pragma unroll
            for (int i = 0; i < 16; ++i) { num[vb][tb][i] *= rden; ss += num[vb][tb][i] * num[vb][tb][i]; }
        ss = xh_sum(ss);
        const float rn = 1.0f / sqrtf(ss * (1.0f / 64.0f) + EPS);
#pragma unroll
        for (int vb = 0; vb < 2; ++vb)
#pragma unroll
            for (int i4 = 0; i4 < 4; ++i4) tl_put4(wl, 32 * tb + r, 32 * vb + 8 * i4 + 4 * hf, num[vb][tb][4 * i4] * rn, num[vb][tb][4 * i4 + 1] * rn, num[vb][tb][4 * i4 + 2] * rn, num[vb][tb][4 * i4 + 3] * rn);
    }
    tl_emit<1>(wl, lane, uptr(Z + row0 * LDZ + ZC_MO + h * 64), uptr(Z + row0 * LDZ + ZC_MG + h * 64), F_ml_norm_g + layer * 384 + h * 64, (GAS char*)uptr(F_Y + row0 * DM + 384 + h * 64));
}

__device__ __forceinline__ void ml_loc_wave(Frame& F, int layer, int cn, int h, LAS unsigned char* wl) {
    const int lane = F_lane, r = lane & 31, hf = lane >> 5;
    const int b = cn / NCHS, n = cn % NCHS;
    const size_t row0 = (size_t)b * SEQ + (size_t)n * CH;
    const bf16* Z = F_Z;
    LAS unsigned char* img0 = wl; LAS unsigned char* img1 = wl + IMG1;
    const unsigned dvo = dma_voff(lane);
    dma_rows67(uptr(Z + (row0 - 3) * LDZ + ZC_MK + h * 64), dvo, img0, lane);
    dma_tile_u(uptr(Z + row0 * LDZ + ZC_MV + h * 64), dvo, img1);
    const int rr = lane >> 3, ch = lane & 7;
    float wk[4][8];
    { const float* cw = F_conv_w + (size_t)layer * 4 * 768 + 384 + h * 64 + ch * 8;
#pragma unroll
      for (int j = 0; j < 4; ++j) { const f32x4 a = *(const f32x4*)(cw + j * 768), c = *(const f32x4*)(cw + j * 768 + 4);
          wk[j][0] = a[0]; wk[j][1] = a[1]; wk[j][2] = a[2]; wk[j][3] = a[3]; wk[j][4] = c[0]; wk[j][5] = c[1]; wk[j][6] = c[2]; wk[j][7] = c[3]; } }
    const float* g32 = F_G32 + (row0 + lane) * 32;
    const float ig = g32[h] + F_b_gates[layer * 12 + h];
    const float lf = logsigf(g32[6 + h] + F_b_gates[layer * 12 + 6 + h]);
    const float bc = wave_scan_add(lf, lane);
    const float g = __shfl(bc, 63);
    const float av = g - bc + ig;
    const float mloc = wave_max(av);
    const float w = fexp(av - mloc);
    asm volatile("s_waitcnt vmcnt(0)" ::: "memory");
#pragma unroll 2
    for (int it = 0; it < 8; ++it) {
        const int row = 8 * it + rr;
        float acc[8];
#pragma unroll
        for (int e = 0; e < 8; ++e) acc[e] = 0.f;
#pragma unroll
        for (int j = 0; j < 4; ++j) {
            v4u raw = *(LAS const v4u*)(img0 + tile_off(row + j, ch * 16));
            if (n == 0 && row + j < 3) raw = (v4u){0u, 0u, 0u, 0u};
            float z[8]; unpack8(raw, z);
#pragma unroll
            for (int e = 0; e < 8; ++e) acc[e] += z[e] * wk[j][e];
        }
        const int lo = tile_off(row, ch * 16);
        float v8[8]; unpack8(*(LAS const v4u*)(img1 + lo), v8);
        const float wr = __shfl(w, row);
        *(LAS v4u*)(img0 + lo) = __builtin_bit_cast(v4u, pack8(fsilu(acc[0]) * 0.125f, fsilu(acc[1]) * 0.125f, fsilu(acc[2]) * 0.125f, fsilu(acc[3]) * 0.125f,
                                                                fsilu(acc[4]) * 0.125f, fsilu(acc[5]) * 0.125f, fsilu(acc[6]) * 0.125f, fsilu(acc[7]) * 0.125f));
        *(LAS v4u*)(img1 + lo) = __builtin_bit_cast(v4u, pack8(v8[0] * wr, v8[1] * wr, v8[2] * wr, v8[3] * wr, v8[4] * wr, v8[5] * wr, v8[6] * wr, v8[7] * wr));
    }
    unsigned trb0, trb1; tr_bases(lane, trb0, trb1);
    f32x16 acc[2][2];
#pragma unroll
    for (int a = 0; a < 2; ++a)
#pragma unroll
        for (int c = 0; c < 2; ++c)
#pragma unroll
            for (int i = 0; i < 16; ++i) acc[a][c][i] = 0.f;
#pragma unroll
    for (int ks = 0; ks < 4; ++ks) {
        const bf16x8 a0 = tr_frag_b(img1, trb0, ks), a1 = tr_frag_b(img1, trb1, ks), b0 = tr_frag_b(img0, trb0, ks), b1 = tr_frag_b(img0, trb1, ks);
        acc[0][0] = MFMA32(a0, b0, acc[0][0]); acc[0][1] = MFMA32(a0, b1, acc[0][1]); acc[1][0] = MFMA32(a1, b0, acc[1][0]); acc[1][1] = MFMA32(a1, b1, acc[1][1]);
    }
    float* cst = F_CST + ((size_t)cn * 6 + h) * 4096;
#pragma unroll
    for (int vb = 0; vb < 2; ++vb)
#pragma unroll
        for (int kb = 0; kb < 2; ++kb)
#pragma unroll
            for (int i = 0; i < 16; ++i) cst[(32 * vb + (i & 3) + 8 * (i >> 2) + 4 * hf) * 64 + 32 * kb + r] = acc[vb][kb][i];
    float s = 0.f;
#pragma unroll 8
    for (int j = 0; j < 64; ++j) s += __shfl(w, j) * bf2f(*(LAS const unsigned short*)(img0 + tile_off(j, 2 * lane)));
    F_NST[((size_t)cn * 6 + h) * 64 + lane] = s;
    if (lane == 0) { F_GS[cn * 6 + h] = g; F_MS[cn * 6 + h] = mloc; }
}

__device__ __forceinline__ float flogsig(float x) { return fminf(x, 0.f) - 0.6931471805599453f * __builtin_amdgcn_logf(1.0f + fexp(-fabsf(x))); }
__device__ __forceinline__ void gla_loc_wave(Frame& F, int layer, int cn, int hh, LAS unsigned char* wl) {
    const int lane = F_lane, hf = lane >> 5;
    const int b = cn / NCHS, n = cn % NCHS;
    const size_t row0 = (size_t)b * SEQ + (size_t)n * CH, row = row0 + lane;
    const bf16* Z = F_Z;
    dma_tile_u(uptr(Z + row0 * LDZ + ZC_GV + hh * 64), dma_voff(lane), wl + 8192);
    float ga[16];
    { const f32x4* gp = (const f32x4*)(F_G32 + row * 32 + 12);
#pragma unroll
      for (int q = 0; q < 4; ++q) { const f32x4 v = gp[q]; ga[4 * q] = v[0]; ga[4 * q + 1] = v[1]; ga[4 * q + 2] = v[2]; ga[4 * q + 3] = v[3]; } }
    const float* wa = F_w_alpha + (size_t)layer * 16 * 128 + hh * 32; const float* ba = F_b_alpha + layer * 128 + hh * 32;
    LAS float* wsl = (LAS float*)(wl + 16384);
#pragma unroll
    for (int i = lane; i < 512; i += 64) wsl[i] = wa[(i >> 5) * 128 + (i & 31)];
    float bcv[32];
#pragma unroll
    for (int d4 = 0; d4 < 8; ++d4) {
        f32x4 a = *(const f32x4*)(ba + 4 * d4);
#pragma unroll
        for (int q = 0; q < 16; ++q) a += *(LAS const f32x4*)(wsl + q * 32 + 4 * d4) * ga[q];
#pragma unroll
        for (int e = 0; e < 4; ++e) bcv[4 * d4 + e] = wave_scan_add(flogsig(a[e]) * (1.0f / 16.0f), lane);
    }
    { f32x4* bp = (f32x4*)(F_BC + row * 128 + hh * 32);
#pragma unroll
      for (int q = 0; q < 8; ++q) bp[q] = (f32x4){bcv[4 * q], bcv[4 * q + 1], bcv[4 * q + 2], bcv[4 * q + 3]}; }
#pragma unroll
    for (int c = 0; c < 4; ++c) {
        float k8[8]; unpack8(*(const v4u*)(Z + row * LDZ + ZC_GK + hh * 32 + 8 * c), k8);
#pragma unroll
        for (int e = 0; e < 8; ++e) k8[e] *= fexp(__shfl(bcv[8 * c + e], 63) - bcv[8 * c + e]);
        *(LAS v4u*)(wl + tile_off(lane, c * 16)) = __builtin_bit_cast(v4u, pack8(k8[0], k8[1], k8[2], k8[3], k8[4], k8[5], k8[6], k8[7]));
    }
    if (lane == 63) { f32x4* ap = (f32x4*)(F_ADEC + ((size_t)cn * 4 + hh) * 32);
#pragma unroll
        for (int q = 0; q < 8; ++q) ap[q] = (f32x4){fexp(bcv[4 * q]), fexp(bcv[4 * q + 1]), fexp(bcv[4 * q + 2]), fexp(bcv[4 * q + 3])}; }
    unsigned trb0, trb1; tr_bases(lane, trb0, trb1);
    f32x16 u0, u1;
#pragma unroll
    for (int i = 0; i < 16; ++i) { u0[i] = 0.f; u1[i] = 0.f; }
    asm volatile("s_waitcnt vmcnt(0)" ::: "memory");
#pragma unroll
    for (int ks = 0; ks < 4; ++ks) { const bf16x8 kd = tr_frag_b(wl, trb0, ks);
        u0 = MFMA32(tr_frag_b(wl + 8192, trb0, ks), kd, u0); u1 = MFMA32(tr_frag_b(wl + 8192, trb1, ks), kd, u1); }
    float* sst = F_SST + ((size_t)cn * 4 + hh) * 2048;
#pragma unroll
    for (int i = 0; i < 16; ++i) { const int v = (i & 3) + 8 * (i >> 2) + 4 * hf; sst[v * 32 + (lane & 31)] = u0[i]; sst[(32 + v) * 32 + (lane & 31)] = u1[i]; }
}

__device__ __forceinline__ void gla_out_wave(Frame& F, int layer, int cn, int hh, LAS unsigned char* wl) {
    const int lane = F_lane, r = lane & 31, hf = lane >> 5;
    const int b = cn / NCHS, n = cn % NCHS;
    const size_t row0 = (size_t)b * SEQ + (size_t)n * CH;
    const bf16* Z = F_Z;
    dma_tile_u(uptr(Z + row0 * LDZ + ZC_GV + hh * 64), dma_voff(lane), wl);
    const unsigned voffK = (unsigned)(r * LDZ + 8 * hf) * 2u, voffB = (unsigned)(r * 128 + 8 * hf) * 4u;
    gcp zq = uptr(Z + row0 * LDZ + ZC_GQ + hh * 32); gcp zk = uptr(Z + row0 * LDZ + ZC_GK + hh * 32); gcp bcb = uptr(F_BC + row0 * 128 + hh * 32);
    bf16x8 qf[2][2], kf[2][2];
#pragma unroll
    for (int blk = 0; blk < 2; ++blk)
#pragma unroll
        for (int s = 0; s < 2; ++s) {
            float q8[8], k8[8];
            unpack8(*(const GAS v4u*)(zq + ((size_t)32 * blk * LDZ + 16 * s) * 2 + voffK), q8); unpack8(*(const GAS v4u*)(zk + ((size_t)32 * blk * LDZ + 16 * s) * 2 + voffK), k8);
            const f32x4 c0 = *(const GAS f32x4*)(bcb + ((size_t)32 * blk * 128 + 16 * s) * 4 + voffB), c1 = *(const GAS f32x4*)(bcb + ((size_t)32 * blk * 128 + 16 * s) * 4 + voffB + 16);
            const float bc8[8] = {c0[0], c0[1], c0[2], c0[3], c1[0], c1[1], c1[2], c1[3]};
#pragma unroll
            for (int e = 0; e < 8; ++e) { q8[e] *= 0.17677669529663687f * fexp(bc8[e]); k8[e] *= fexp(-bc8[e]); }
            qf[blk][s] = pack8(q8[0], q8[1], q8[2], q8[3], q8[4], q8[5], q8[6], q8[7]);
            kf[blk][s] = pack8(k8[0], k8[1], k8[2], k8[3], k8[4], k8[5], k8[6], k8[7]);
        }
    bf16x8 pf0[2], pf1[4];
    {
        f32x16 s00, s01, s11;
#pragma unroll
        for (int i = 0; i < 16; ++i) { s00[i] = 0.f; s01[i] = 0.f; s11[i] = 0.f; }
#pragma unroll
        for (int s = 0; s < 2; ++s) { s00 = MFMA32(kf[0][s], qf[0][s], s00); s01 = MFMA32(kf[0][s], qf[1][s], s01); s11 = MFMA32(kf[1][s], qf[1][s], s11); }
#pragma unroll
        for (int i = 0; i < 16; ++i) { const int jr = (i & 3) + 8 * (i >> 2) + 4 * hf; if (jr > r) { s00[i] = 0.f; s11[i] = 0.f; } }
        pf0[0] = pack8(s00[0], s00[1], s00[2], s00[3], s00[4], s00[5], s00[6], s00[7]); pf0[1] = pack8(s00[8], s00[9], s00[10], s00[11], s00[12], s00[13], s00[14], s00[15]);
        pf1[0] = pack8(s01[0], s01[1], s01[2], s01[3], s01[4], s01[5], s01[6], s01[7]); pf1[1] = pack8(s01[8], s01[9], s01[10], s01[11], s01[12], s01[13], s01[14], s01[15]);
        pf1[2] = pack8(s11[0], s11[1], s11[2], s11[3], s11[4], s11[5], s11[6], s11[7]); pf1[3] = pack8(s11[8], s11[9], s11[10], s11[11], s11[12], s11[13], s11[14], s11[15]);
    }
    unsigned trb0, trb1; tr_bases(lane, trb0, trb1);
    gcp spb = uptr(F_SST + ((size_t)cn * 4 + hh) * 2048);
    f32x16 num[2][2];
#pragma unroll
    for (int vb = 0; vb < 2; ++vb) {
        bf16x8 sf[2];
#pragma unroll
        for (int s = 0; s < 2; ++s) sf[s] = ld_f32_frag(spb + ((size_t)32 * vb * 32 + 16 * s) * 4, (unsigned)(r * 32 + 8 * hf) * 4u);
#pragma unroll
        for (int tb = 0; tb < 2; ++tb) {
#pragma unroll
            for (int i = 0; i < 16; ++i) num[vb][tb][i] = 0.f;
#pragma unroll
            for (int s = 0; s < 2; ++s) num[vb][tb] = MFMA32(sf[s], qf[tb][s], num[vb][tb]);
        }
    }
    asm volatile("s_waitcnt vmcnt(0)" ::: "memory");
#pragma unroll
    for (int vb = 0; vb < 2; ++vb)
#pragma unroll
        for (int ks = 0; ks < 4; ++ks) {
            const bf16x8 vf = tr_frag_b(wl, vb ? trb1 : trb0, ks);
            if (ks < 2) num[vb][0] = MFMA32(vf, pf0[ks], num[vb][0]);
            num[vb][1] = MFMA32(vf, pf1[ks], num[vb][1]);
        }
#pragma unroll
    for (int tb = 0; tb < 2; ++tb) {
        float ss = 0.f;
#pragma unroll
        for (int vb = 0; vb < 2; ++vb)
#pragma unroll
            for (int i = 0; i < 16; ++i) ss += num[vb][tb][i] * num[vb][tb][i];
        ss = xh_sum(ss);
        const float rn = 1.0f / sqrtf(ss * (1.0f / 64.0f) + EPS);
#pragma unroll
        for (int vb = 0; vb < 2; ++vb)
#pragma unroll
            for (int i4 = 0; i4 < 4; ++i4) tl_put4(wl, 32 * tb + r, 32 * vb + 8 * i4 + 4 * hf, num[vb][tb][4 * i4] * rn, num[vb][tb][4 * i4 + 1] * rn, num[vb][tb][4 * i4 + 2] * rn, num[vb][tb][4 * i4 + 3] * rn);
    }
    tl_emit<2>(wl, lane, uptr(Z + row0 * LDZ + ZC_GG + hh * 64), (gcp)nullptr, F_gla_norm_g + layer * 256 + hh * 64, (GAS char*)uptr(F_Y + row0 * DM + 768 + hh * 64));
}

__device__ __forceinline__ void p2_local(Frame& F, int layer) {
    int gw_ = F.vcu * NWAVES + F.wave; asm volatile("" : "+s"(gw_));
    const int gw = gw_, NGW = F.G * NWAVES;
    LAS unsigned char* wl = F.lds + RING_OFF + F.wave * WL_BYTES;
    constexpr int NA = NCHT * 6, NL = NCHT * 10;
    if (NGW == 2048) {
#define LOCAL_TASK(q) do { const int q_ = (q); if (q_ < NA) ml_loc_wave(F, layer, q_ / 6, q_ % 6, wl); else gla_loc_wave(F, layer, (q_ - NA) >> 2, (q_ - NA) & 3, wl); } while (0)
        if (gw < NA) { LOCAL_TASK(gw); attn_wave(F, layer, gw / 6, gw % 6, wl); }
        else { const int q0 = NA + 2 * (gw - NA); for (int q = q0; q < q0 + 2; ++q) LOCAL_TASK(q); }
#undef LOCAL_TASK
    } else {
        for (int a = gw; a < NA; a += NGW) attn_wave(F, layer, a / 6, a % 6, wl);
        for (int q = gw; q < NL; q += NGW) { if (q < NA) ml_loc_wave(F, layer, q / 6, q % 6, wl); else gla_loc_wave(F, layer, (q - NA) >> 2, (q - NA) & 3, wl); }
    }
}
__device__ __forceinline__ void p4_outputs(Frame& F, int layer) {
    int gw_ = F.vcu * NWAVES + F.wave; asm volatile("" : "+s"(gw_));
    const int gw = gw_, NGW = F.G * NWAVES;
    LAS unsigned char* wl = F.lds + RING_OFF + F.wave * WL_BYTES;
    constexpr int NA = NCHT * 6, NG = NCHT * 4;
    if (NGW == 2048) {
        if (gw < NA) { ml_out_wave(F, layer, gw / 6, gw % 6, wl);
#if PROBE_DUP == 8
            ml_out_wave(F, layer, gw / 6, gw % 6, wl);
#endif
        }
        else { for (int q = gw - NA; q < NG; q += 512) gla_out_wave(F, layer, q >> 2, q & 3, wl);
#if PROBE_DUP == 9
            for (int q = gw - NA; q < NG; q += 512) gla_out_wave(F, layer, q >> 2, q & 3, wl);
#endif
        }
    } else {
        for (int a = gw; a < NA; a += NGW) ml_out_wave(F, layer, a / 6, a % 6, wl);
        for (int q = gw; q < NG; q += NGW) gla_out_wave(F, layer, q >> 2, q & 3, wl);
    }
}

__device__ __forceinline__ void p11_final(Frame& F) {
    int gw_ = F.vcu * NWAVES + F.wave; asm volatile("" : "+s"(gw_));
    const int gw = gw_, NGW = F.G * NWAVES;
    const float* ssq = F_SSQ + 2 * T;
    for (int m = gw; m < T; m += NGW) {
        const float rs = 1.0f / sqrtf(ssq[m] * (1.0f / 1024.0f) + EPS);
        GAS f32x4* xr = (GAS f32x4*)(F_out + (size_t)m * DM) + F_lane; const GAS f32x4* gr = (const GAS f32x4*)F_final_g + F_lane;
#pragma unroll
        for (int j = 0; j < 4; ++j) { const f32x4 v = xr[64 * j], g = gr[64 * j]; xr[64 * j] = v * rs * g; }
    }
}

__global__ void __launch_bounds__(NTHR, 2) hymba_fwd(Args args) {
    extern __shared__ __attribute__((aligned(16))) unsigned char lds[];
    Frame F;
    F.lds = (LAS unsigned char*)lds;
    F.MISC = (volatile LAS unsigned*)(F.lds + MISC_OFF);
    F.wave = __builtin_amdgcn_readfirstlane(F_tid >> 6);
    F.G = gridDim.x; { const int bx = blockIdx.x; F.vcu = (F.G % 8 == 0) ? (bx % 8) * (F.G / 8) + bx / 8 : bx; }
    F.A = &args;
    for (int u = F_tid; u < (LDS_BYTES - LDSCTL_OFF) / 4; u += NTHR) ((LAS unsigned*)(F.lds + LDSCTL_OFF))[u] = 0u;
    __syncthreads();
    XcdBarrier bar; bar.bar = (unsigned*)(F_ctl + CW_BAR); bar.x = 0; bar.st = nullptr;
    if (N_LAUNCHES == 1) bar = xcd_barrier_post((unsigned*)(F_ctl + CW_BAR), F.MISC + 8);
#define GRID_BAR() do { if (N_LAUNCHES == 1) { XcdBarrier b2_ = bar; unsigned long long v_ = (unsigned long long)bar.bar; asm volatile("" : "+s"(v_)); b2_.bar = (unsigned*)v_; xcd_barrier(b2_); } } while (0)
    const int lo = args.ph_lo, hi = args.ph_hi;
#pragma unroll 1
    for (int ph = lo; ph < hi; ++ph) {
        if (ph == 0) { p0_prologue(F);
#if PROBE_DUP == 4
            GRID_BAR(); p0_prologue(F);
#endif
        } else if (ph == NPHASE - 1) { p11_final(F);
        } else {
            const int layer = (ph - 1) / 5, k = (ph - 1) % 5;
            if (k == 0 || k == 4) {
                const int which = k ? 1 : 0, N = which ? DM : NP;
                pg8::Gemm g{which ? F_Y : F_XB, which ? F_Wout_t + (size_t)layer * DM * DM : F_Win_t + (size_t)layer * NP * DM, T, N, DM};
                pg8::StaticOrder S; S.init(T, N, F.G, (int)blockIdx.x);
                pg8::EpiBoth E{which, pg8::EpiZ{F_Z, LDZ, F_SSQ + layer * T, F_G32, ZC_SM},
                               pg8::EpiRes{layer == 0 ? F_x : (const float*)F_out, F_out, layer == 0 ? F_XB : (bf16*)nullptr, F_SSQ + (layer + 1) * T}};
                pg8::gemm_phase<pg8::EpiBoth, pg8::StaticOrder, true, true>(F.lds + RING_OFF, g, S, E);
            } else if (k == 1) { p2_local(F, layer);
#if PROBE_DUP == 2
                GRID_BAR(); p2_local(F, layer);
#endif
            } else if (k == 2) { p3_scan(F);
            } else { p4_outputs(F, layer);
#if PROBE_DUP == 3
                GRID_BAR(); p4_outputs(F, layer);
#endif
            }
        }
        if (ph + 1 < hi) GRID_BAR();
    }
}

extern "C" void kernel_launch(void* const* d_in, const int* in_sizes, int n_in, void* d_out, int out_size, void* d_ws, size_t ws_size, hipStream_t stream) {
    static int grid = 0;
    if (grid == 0) {
        if (n_in != 12 || in_sizes[0] != T * DM || out_size != T * DM || ws_size < WS_END) {
            fprintf(stderr, "kernel_launch: unexpected shapes (n_in %d, in0 %d, out %d, ws %zu, need %zu); nothing launched\n", n_in, n_in > 0 ? in_sizes[0] : -1, out_size, ws_size, (size_t)WS_END); grid = -1; return; }
        int dev = 0, cus = 0, per_cu = 0;
        if (hipGetDevice(&dev) != hipSuccess || hipDeviceGetAttribute(&cus, hipDeviceAttributeMultiprocessorCount, dev) != hipSuccess) { fprintf(stderr, "kernel_launch: device query failed\n"); grid = -1; return; }
        if (hipFuncSetAttribute((const void*)hymba_fwd, hipFuncAttributeMaxDynamicSharedMemorySize, LDS_BYTES) != hipSuccess) { fprintf(stderr, "kernel_launch: hipFuncSetAttribute failed\n"); grid = -1; return; }
        if (hipOccupancyMaxActiveBlocksPerMultiprocessor(&per_cu, (const void*)hymba_fwd, NTHR, LDS_BYTES) != hipSuccess || per_cu < 1) {
            fprintf(stderr, "kernel_launch: occupancy query reports %d workgroups per CU; nothing launched\n", per_cu); (void)hipGetLastError(); grid = -1; return; }
        grid = cus;
        fprintf(stderr, "kernel_launch: grid %d x %d threads, %d B LDS, occupancy query %d/CU\n", grid, NTHR, LDS_BYTES, per_cu);
    }
    if (grid < 0) return;
    if (hipMemsetAsync((char*)d_ws + WS_CTL, 0, CTL_ZERO_BYTES, stream) != hipSuccess) { fprintf(stderr, "kernel_launch: memset failed\n"); return; }
    Args a{};
    for (int i = 0; i < 12; ++i) a.in[i] = (const float*)d_in[i];
    a.out = (float*)d_out; a.ws = (unsigned char*)d_ws;
    if (N_LAUNCHES == 1) {
        a.ph_lo = 0; a.ph_hi = NPHASE; a.li = 0;
        void* kargs[] = {&a};
        hipError_t e = hipLaunchCooperativeKernel((const void*)hymba_fwd, dim3(grid), dim3(NTHR), kargs, LDS_BYTES, stream);
        if (e != hipSuccess) fprintf(stderr, "kernel_launch: cooperative launch failed: %s\n", hipGetErrorString(e));
    } else {
        for (int p = 0; p < NPHASE; ++p) { a.ph_lo = p; a.ph_hi = p + 1; a.li = p;
            hipLaunchKernelGGL(hymba_fwd, dim3(grid), dim3(NTHR), LDS_BYTES, stream, a);
            if (hipPeekAtLastError() != hipSuccess) { fprintf(stderr, "kernel_launch: launch %d failed\n", p); break; } }
    }
}
```

```cpp
#include <hip/hip_runtime.h>
#include <cstdio>
#include <cstdint>
#include <cmath>

#ifndef PROBE_DUP
#define PROBE_DUP 0
#endif
#ifndef MK_N_LAUNCHES
#define MK_N_LAUNCHES 1
#endif

namespace pg8 {
#define PG8_LAS __attribute__((address_space(3)))
typedef unsigned short bf16_t;
typedef short bf16x8 __attribute__((ext_vector_type(8)));
typedef float f32x4 __attribute__((ext_vector_type(4)));
typedef unsigned u32x4 __attribute__((ext_vector_type(4)));
constexpr int BM = 256, BK = 64, HALF = 128, HTB = HALF * BK * 2  , STAGE_BYTES = 8 * HTB, NXCD = 8, WGM = 8;

__host__ __device__ __forceinline__ int lds_byte(int r, int c) { const int st = (r >> 4) * 2 + (c >> 5), rr = r & 15, cc = c & 31, ob = rr * 64 + cc * 2; return st * 1024 + (ob ^ (((ob >> 9) & 1) << 5)); }
__host__ __device__ __forceinline__ void stage_rc(int b, int& R, int& C) { const int st = b / 1024, sb = b % 1024, swz = sb ^ (((sb >> 9) & 1) << 5); R = (st >> 1) * 16 + swz / 64; C = (st & 1) * 32 + (swz % 64) / 2; }
__host__ __device__ __forceinline__ int perm32(int rho) { const int n = rho >> 4, i = rho & 15; return 8 * (i >> 2) + 4 * n + (i & 3); }

struct Unit { int pm, pn; };
struct Gemm { const bf16_t* A; const bf16_t* Bt; int M, N, K; };

struct StaticOrder {
    int nM, nN, nwg, G, c;
    __host__ __device__ void init(int M, int N, int G_, int c_) { nM = M / BM; nN = N / BM; nwg = nM * nN; G = G_; c = c_; }
    __host__ __device__ bool next(int i, Unit& u) const {
        const long L = (long)i * G + c; if (L >= nwg) return false;
        int wgid = (int)L; { const int q = nwg / NXCD, r = nwg % NXCD, xcd = wgid % NXCD, off = wgid / NXCD; wgid = (xcd < r ? xcd * (q + 1) : r * (q + 1) + (xcd - r) * q) + off; }
        const int nig = WGM * nN, gid = wgid / nig, fm = gid * WGM, gsz = (nM - fm) < WGM ? (nM - fm) : WGM;
        u.pm = fm + ((wgid % nig) % gsz); u.pn = (wgid % nig) / gsz; return true;
    }
    __device__ __forceinline__ void a_ready(const Unit&) const {}
    __device__ __forceinline__ void done(const Unit&) const {}
};

__device__ __forceinline__ unsigned cvt_pk_bf16(float lo, float hi) { unsigned r; asm volatile("v_cvt_pk_bf16_f32 %0, %1, %2" : "=v"(r) : "v"(lo), "v"(hi)); return r; }

typedef unsigned u32x2 __attribute__((ext_vector_type(2)));
struct EpiZ {
    bf16_t* Z; int ldz; const float* ssq; float* G32; int gcol0;
    __device__ __forceinline__ void operator()(const f32x4 (&acc)[2][2][4][2], const Unit& u, int wr, int wc, int fr, int fq) const {
        const int row0 = u.pm * BM + wr * 64 + fr, col0 = u.pn * BM + wc * 32 + 8 * fq;
#pragma unroll
        for (int ai = 0; ai < 2; ++ai)
#pragma unroll
            for (int m = 0; m < 4; ++m) {
                const int row = row0 + ai * HALF + m * 16;
                const float rs = 1.0f / sqrtf(ssq[row] * (1.0f / 1024.0f) + 1e-6f);
#pragma unroll
                for (int bj = 0; bj < 2; ++bj) {
                    const int col = col0 + bj * HALF;
                    const f32x4 v0 = acc[ai][bj][m][0] * rs, v1 = acc[ai][bj][m][1] * rs;
                    if (col < ldz) {
                        u32x4 w; w.x = cvt_pk_bf16(v0[0], v0[1]); w.y = cvt_pk_bf16(v0[2], v0[3]); w.z = cvt_pk_bf16(v1[0], v1[1]); w.w = cvt_pk_bf16(v1[2], v1[3]);
                        *(u32x4*)(Z + (size_t)row * ldz + col) = w;
                    } else if (col < gcol0 + 32) {
                        float* gp = G32 + (size_t)row * 32 + (col - gcol0);
                        *(f32x4*)gp = v0; *(f32x4*)(gp + 4) = v1;
                    }
                }
            }
    }
};
struct EpiRes {
    const float* base; float* out; bf16_t* xb; float* ssq;
    __device__ __forceinline__ void operator()(const f32x4 (&acc)[2][2][4][2], const Unit& u, int wr, int wc, int fr, int fq) const {
        const int col0 = u.pn * BM + wc * 32 + 8 * fq;
        f32x4 pre[2][2];
        { const int row = u.pm * BM + wr * 64 + fr;
#pragma unroll
          for (int bj = 0; bj < 2; ++bj) { const size_t off = (size_t)row * 1024 + col0 + bj * HALF; pre[bj][0] = *(const f32x4*)(base + off); pre[bj][1] = *(const f32x4*)(base + off + 4); } }
#pragma unroll
        for (int g = 0; g < 8; ++g) {
            const int ai = g >> 2, m = g & 3;
            const int row = u.pm * BM + ai * HALF + wr * 64 + m * 16 + fr;
            f32x4 nxt[2][2];
            if (g < 7) { const int row2 = u.pm * BM + ((g + 1) >> 2) * HALF + wr * 64 + ((g + 1) & 3) * 16 + fr;
#pragma unroll
                for (int bj = 0; bj < 2; ++bj) { const size_t off = (size_t)row2 * 1024 + col0 + bj * HALF; nxt[bj][0] = *(const f32x4*)(base + off); nxt[bj][1] = *(const f32x4*)(base + off + 4); } }
            asm volatile("" ::: "memory");
            float s = 0.f;
#pragma unroll
            for (int bj = 0; bj < 2; ++bj) {
                const size_t off = (size_t)row * 1024 + col0 + bj * HALF;
                const f32x4 o0 = pre[bj][0] + acc[ai][bj][m][0], o1 = pre[bj][1] + acc[ai][bj][m][1];
                *(f32x4*)(out + off) = o0; *(f32x4*)(out + off + 4) = o1;
                s += (o0[0] * o0[0] + o0[1] * o0[1]) + (o0[2] * o0[2] + o0[3] * o0[3]) + (o1[0] * o1[0] + o1[1] * o1[1]) + (o1[2] * o1[2] + o1[3] * o1[3]);
                if (xb) { u32x4 w; w.x = cvt_pk_bf16(o0[0], o0[1]); w.y = cvt_pk_bf16(o0[2], o0[3]); w.z = cvt_pk_bf16(o1[0], o1[1]); w.w = cvt_pk_bf16(o1[2], o1[3]); *(u32x4*)(xb + off) = w; }
            }
            s += __shfl_xor(s, 16); s += __shfl_xor(s, 32);
            if (fq == 0) atomicAdd(ssq + row, s);
            asm volatile("" ::: "memory");
            if (g < 7) {
#pragma unroll
                for (int bj = 0; bj < 2; ++bj) { pre[bj][0] = nxt[bj][0]; pre[bj][1] = nxt[bj][1]; } }
        }
    }
};
struct EpiBoth {
    static constexpr bool PERM = true, AFTER_DRAIN = false;
    int mode; EpiZ z; EpiRes r;
    __device__ __forceinline__ void operator()(const f32x4 (&acc)[2][2][4][2], const Unit& u, int wr, int wc, int fr, int fq) const {
        if (mode == 0) z(acc, u, wr, wc, fr, fq); else r(acc, u, wr, wc, fr, fq);
    }
};

template <class Epi, class Sched, bool ALIGN_EPI = false, bool SP2 = false>
__device__ __forceinline__ void gemm_phase(PG8_LAS unsigned char* lds, const Gemm g, const Sched& S, const Epi& E) {
    int tid_ = threadIdx.x; asm volatile("" : "+v"(tid_));
    const int tid = tid_, wid = __builtin_amdgcn_readfirstlane(tid >> 6), lane = tid & 63, wr = wid >> 2, wc = wid & 3, fr = lane & 15, fq = lane >> 4;
    const int K = g.K, nt = K / BK;
    unsigned voffA[2], voffB[2];
#pragma unroll
    for (int i = 0; i < 2; ++i) { int R, C; stage_rc(tid * 16 + i * 8192, R, C); const int Rb = Epi::PERM ? ((R & ~31) + perm32(R & 31)) : R;
        voffA[i] = (unsigned)(R * K + C) * 2u; voffB[i] = (unsigned)(Rb * K + C) * 2u; }
    const size_t kstep = (size_t)(BK * 2);
    const size_t hstep = (size_t)HALF * K * 2;
    const size_t tstep = 2 * hstep;
    const unsigned ldsw = (unsigned)wid * 1024u;
    const int aoff = lds_byte(wr * 64 + fr, fq * 8), boff = lds_byte(wc * 32 + fr, fq * 8);
#define PG8_SA(b, h) (((b) * 2 + (h)) * HTB)
#define PG8_SB(b, h) ((4 + (b) * 2 + (h)) * HTB)
#define PG8_STAGE(bufoff, gbase, voff) do { _Pragma("unroll") for (int _i = 0; _i < 2; ++_i) \
        __builtin_amdgcn_global_load_lds((const unsigned*)((const char*)(gbase) + (voff)[_i]), (PG8_LAS unsigned*)(lds + (bufoff) + ldsw + _i * 8192), 16, 0, 0); } while (0)
#define PG8_LDA(dst, b, h) do { _Pragma("unroll") for (int m = 0; m < 4; ++m) _Pragma("unroll") for (int k = 0; k < 2; ++k) dst[m][k] = *(const PG8_LAS bf16x8*)(lds + PG8_SA(b, h) + aoff + m * 2048 + k * 1024); } while (0)
#define PG8_LDB(dst, b, h) do { _Pragma("unroll") for (int n = 0; n < 2; ++n) _Pragma("unroll") for (int k = 0; k < 2; ++k) dst[n][k] = *(const PG8_LAS bf16x8*)(lds + PG8_SB(b, h) + boff + n * 2048 + k * 1024); } while (0)
#define PG8_MMA(ai, bj, At, Bt) do { __builtin_amdgcn_s_setprio(1); _Pragma("unroll") for (int m = 0; m < 4; ++m) _Pragma("unroll") for (int n = 0; n < 2; ++n) _Pragma("unroll") for (int k = 0; k < 2; ++k) \
        acc[ai][bj][m][n] = __builtin_amdgcn_mfma_f32_16x16x32_bf16(Bt[n][k], At[m][k], acc[ai][bj][m][n], 0, 0, 0); __builtin_amdgcn_s_setprio(0); } while (0)
#define PG8_WAIT_V(n) asm volatile("s_waitcnt vmcnt(" #n ")" ::: "memory")
#define PG8_WAIT_L(n) asm volatile("s_waitcnt lgkmcnt(" #n ")" ::: "memory")
#define PG8_BAR __builtin_amdgcn_s_barrier()
#define PG8_SCHED __builtin_amdgcn_sched_barrier(0)
    Unit cur, nxt; int ui = 0;
    if (!S.next(0, cur)) return;
    f32x4 acc[2][2][4][2];
#pragma unroll
    for (int a = 0; a < 2; ++a)
#pragma unroll
        for (int b = 0; b < 2; ++b)
#pragma unroll
            for (int m = 0; m < 4; ++m)
#pragma unroll
                for (int n = 0; n < 2; ++n) acc[a][b][m][n] = (f32x4){0.f, 0.f, 0.f, 0.f};
    bf16x8 At[4][2], B0[2][2], B1[2][2];
    const char* cA = (const char*)g.A + (size_t)cur.pm * tstep; const char* cB = (const char*)g.Bt + (size_t)cur.pn * tstep;
    S.a_ready(cur);
    if constexpr (SP2) {
        PG8_STAGE(PG8_SB(0, 0), cB, voffB); PG8_STAGE(PG8_SB(0, 1), cB + hstep, voffB); PG8_STAGE(PG8_SA(0, 0), cA, voffA); PG8_STAGE(PG8_SA(0, 1), cA + hstep, voffA);
        if (wr == 1) PG8_BAR;
        PG8_WAIT_V(2); PG8_BAR;
        PG8_STAGE(PG8_SB(1, 0), cB + kstep, voffB); PG8_STAGE(PG8_SA(1, 0), cA + kstep, voffA); PG8_STAGE(PG8_SB(1, 1), cB + hstep + kstep, voffB);
        PG8_WAIT_V(6); PG8_BAR;
    } else {
        PG8_STAGE(PG8_SB(0, 0), cB, voffB); PG8_STAGE(PG8_SA(0, 0), cA, voffA); PG8_STAGE(PG8_SB(0, 1), cB + hstep, voffB); PG8_STAGE(PG8_SA(0, 1), cA + hstep, voffA);
        if (wr == 1) PG8_BAR;
        PG8_WAIT_V(4); PG8_BAR;
        PG8_STAGE(PG8_SB(1, 0), cB + kstep, voffB); PG8_STAGE(PG8_SA(1, 0), cA + kstep, voffA); PG8_STAGE(PG8_SB(1, 1), cB + hstep + kstep, voffB);
        PG8_WAIT_V(6); PG8_BAR;
    }
    for (;;) {
        const bool has_next = S.next(ui + 1, nxt);
        const char* nA = has_next ? (const char*)g.A + (size_t)nxt.pm * tstep : cA; const char* nB = has_next ? (const char*)g.Bt + (size_t)nxt.pn * tstep : cB;
        for (int t = 0; t < nt; t += 2) {
            const bool last = (t == nt - 2);
            const char* a1 = cA + (size_t)(t + 1) * kstep;
            const char* a2 = last ? nA : cA + (size_t)(t + 2) * kstep; const char* b2 = last ? nB : cB + (size_t)(t + 2) * kstep;
            const char* a3 = a2 + kstep; const char* b3 = b2 + kstep;
            if (last && has_next) S.a_ready(nxt);
            if constexpr (SP2) {
            PG8_LDB(B0, 0, 0); PG8_LDB(B1, 0, 1); PG8_SCHED; PG8_LDA(At, 0, 0); PG8_STAGE(PG8_SA(1, 1), a1 + hstep, voffA);
            PG8_WAIT_V(8); PG8_WAIT_L(0); PG8_BAR; PG8_MMA(0, 0, At, B0); PG8_MMA(0, 1, At, B1); PG8_BAR; PG8_SCHED;
            PG8_LDA(At, 0, 1); PG8_STAGE(PG8_SB(0, 0), b2, voffB); PG8_STAGE(PG8_SB(0, 1), b2 + hstep, voffB); PG8_STAGE(PG8_SA(0, 0), a2, voffA);
            PG8_WAIT_V(8); PG8_WAIT_L(0); PG8_BAR; PG8_MMA(1, 0, At, B0); PG8_MMA(1, 1, At, B1); PG8_BAR; PG8_SCHED;
            PG8_LDB(B0, 1, 0); PG8_LDB(B1, 1, 1); PG8_SCHED; PG8_LDA(At, 1, 0); PG8_STAGE(PG8_SA(0, 1), a2 + hstep, voffA);
            PG8_WAIT_V(8); PG8_WAIT_L(0); PG8_BAR; PG8_MMA(0, 0, At, B0); PG8_MMA(0, 1, At, B1); PG8_BAR; PG8_SCHED;
            PG8_LDA(At, 1, 1); PG8_STAGE(PG8_SB(1, 0), b3, voffB); PG8_STAGE(PG8_SB(1, 1), b3 + hstep, voffB); PG8_STAGE(PG8_SA(1, 0), a3, voffA);
            PG8_WAIT_V(8); PG8_WAIT_L(0); PG8_BAR; PG8_MMA(1, 0, At, B0); PG8_MMA(1, 1, At, B1); PG8_BAR; PG8_SCHED;
            } else {
            PG8_LDB(B0, 0, 0); PG8_SCHED; PG8_LDA(At, 0, 0); PG8_STAGE(PG8_SA(1, 1), a1 + hstep, voffA);
            PG8_WAIT_L(8); PG8_BAR; PG8_WAIT_L(0); PG8_MMA(0, 0, At, B0); PG8_BAR; PG8_SCHED;
            PG8_LDB(B1, 0, 1); PG8_STAGE(PG8_SB(0, 0), b2, voffB);
            PG8_BAR; PG8_WAIT_L(0); PG8_MMA(0, 1, At, B1); PG8_BAR;
            PG8_LDA(At, 0, 1); PG8_STAGE(PG8_SA(0, 0), a2, voffA);
            PG8_BAR; PG8_WAIT_L(0); PG8_MMA(1, 0, At, B0); PG8_BAR; PG8_SCHED;
            PG8_STAGE(PG8_SB(0, 1), b2 + hstep, voffB);
            PG8_WAIT_V(6); PG8_BAR; PG8_MMA(1, 1, At, B1); PG8_BAR;
            PG8_LDB(B0, 1, 0); PG8_SCHED; PG8_LDA(At, 1, 0); PG8_STAGE(PG8_SA(0, 1), a2 + hstep, voffA);
            PG8_WAIT_L(8); PG8_BAR; PG8_WAIT_L(0); PG8_MMA(0, 0, At, B0); PG8_BAR; PG8_SCHED;
            PG8_LDB(B1, 1, 1); PG8_STAGE(PG8_SB(1, 0), b3, voffB);
            PG8_BAR; PG8_WAIT_L(0); PG8_MMA(0, 1, At, B1); PG8_BAR;
            PG8_LDA(At, 1, 1); PG8_STAGE(PG8_SA(1, 0), a3, voffA);
            PG8_BAR; PG8_WAIT_L(0); PG8_MMA(1, 0, At, B0); PG8_BAR; PG8_SCHED;
            PG8_STAGE(PG8_SB(1, 1), b3 + hstep, voffB);
            PG8_WAIT_V(6); PG8_BAR; PG8_MMA(1, 1, At, B1); PG8_BAR;
            }
        }
        if constexpr (ALIGN_EPI) { if (wr == 0) PG8_BAR; }
        if constexpr (!Epi::AFTER_DRAIN) { E(acc, cur, wr, wc, fr, fq); S.done(cur); }
        if (!has_next) break;
#pragma unroll
        for (int a = 0; a < 2; ++a)
#pragma unroll
            for (int b = 0; b < 2; ++b)
#pragma unroll
                for (int m = 0; m < 4; ++m)
#pragma unroll
                    for (int n = 0; n < 2; ++n) acc[a][b][m][n] = (f32x4){0.f, 0.f, 0.f, 0.f};
        cur = nxt; cA = nA; cB = nB; ++ui;
        if constexpr (ALIGN_EPI) { if (wr == 1) PG8_BAR; }
    }
    PG8_WAIT_V(0);
    if constexpr (!ALIGN_EPI) { if (wr == 0) PG8_BAR; }
    PG8_BAR;
    if constexpr (Epi::AFTER_DRAIN) { E.fused(acc, cur, wr, wc, fr, fq, lds, wid, lane); S.done(cur); }
#undef PG8_SA
#undef PG8_SB
#undef PG8_STAGE
#undef PG8_LDA
#undef PG8_LDB
#undef PG8_MMA
#undef PG8_WAIT_V
#undef PG8_WAIT_L
#undef PG8_BAR
#undef PG8_SCHED
}
}

constexpr int NWAVES = 8, NTHR = 512;
constexpr int N_LAUNCHES = MK_N_LAUNCHES;
constexpr int NPHASE = 12;
constexpr int BATCH = 2, SEQ = 8192, DM = 1024, T = BATCH * SEQ, DEPTH = 2, CH = 64, NCHT = T / CH  , NCHS = SEQ / CH  ;
constexpr int DIN = 4252, NP = 4352, LDZ = 4224;
constexpr int ZC_AQ = 0, ZC_AK = 384, ZC_AV = 768, ZC_AG = 1152, ZC_MQ = 1536, ZC_MK = 1920, ZC_MV = 2304, ZC_MO = 2688, ZC_MG = 3072, ZC_GQ = 3456, ZC_GK = 3584, ZC_GV = 3712, ZC_GG = 3968, ZC_SM = 4224;
constexpr float EPS = 1e-6f;
__host__ __device__ __forceinline__ int src_col(int n) {
    if (n < 3072) return n;
    if (n < 3968) return n + 12;
    if (n < 4224) return n + 28;
    if (n < 4236) return n - 1152;
    if (n < 4252) return n - 256;
    return -1;
}

constexpr size_t MiB = 1u << 20;
constexpr size_t WS_CTL = 0, CTL_ZERO_BYTES = 1 * MiB;
constexpr size_t WS_SSQ = 512 * 1024;
constexpr size_t WS_WIN = 1 * MiB;
constexpr size_t WS_WOUT = WS_WIN + (size_t)2 * NP * DM * 2;
constexpr size_t WS_XB = WS_WOUT + (size_t)2 * DM * DM * 2;
constexpr size_t WS_Y = WS_XB + (size_t)T * DM * 2;
constexpr size_t WS_Z = WS_Y + (size_t)T * DM * 2;
constexpr size_t WS_G32 = WS_Z + (size_t)T * LDZ * 2;
constexpr size_t WS_CST = WS_G32 + (size_t)T * 32 * 4;
constexpr size_t WS_NST = WS_CST + (size_t)NCHT * 6 * 4096 * 4;
constexpr size_t WS_SST = WS_NST + (size_t)NCHT * 6 * 64 * 4;
constexpr size_t WS_ADEC = WS_SST + (size_t)NCHT * 4 * 2048 * 4;
constexpr size_t WS_GS = WS_ADEC + (size_t)NCHT * 4 * 32 * 4;
constexpr size_t WS_MS = WS_GS + 8192;
constexpr size_t WS_MP = WS_MS + 8192;
constexpr size_t WS_END = WS_MP + 8192;
static_assert(WS_END <= 268435456, "d_ws map exceeds 256 MiB");
constexpr int CW_BAR = 4096;

constexpr int RING_OFF = 0, RING_BYTES = 162816;
constexpr int WL_BYTES = 20352;
constexpr int LDSCTL_OFF = RING_BYTES, MISC_OFF = LDSCTL_OFF + 320;
constexpr int LDS_BYTES = 163840;
#define GAS __attribute__((address_space(1)))
#define LAS __attribute__((address_space(3)))
typedef unsigned short bf16;
typedef unsigned v4u __attribute__((ext_vector_type(4)));
typedef float f32x4 __attribute__((ext_vector_type(4)));
typedef short bf16x8 __attribute__((ext_vector_type(8)));
typedef GAS unsigned gu32;
typedef GAS unsigned long long gu64;
#define RLX_AGENT __ATOMIC_RELAXED, __HIP_MEMORY_SCOPE_AGENT
#define LDS_WAIT() asm volatile("s_waitcnt lgkmcnt(0)" ::: "memory")
#define VM_WAIT() asm volatile("s_waitcnt vmcnt(0)" ::: "memory")
__device__ __forceinline__ unsigned long long rt() { return __builtin_amdgcn_s_memrealtime(); }
__device__ __forceinline__ unsigned f2bf(float f) { unsigned u = __builtin_bit_cast(unsigned, f); return (u + 0x7fffu + ((u >> 16) & 1u)) >> 16; }
__device__ __forceinline__ unsigned pk2(float lo, float hi) { return f2bf(lo) | (f2bf(hi) << 16); }

#define XB_TMO      128
#define XB_XCNT(j)  (256  + 64 * (j))
#define XB_XSUB(j)  (1280 + 64 * (j))
#define XB_XGEN(j)  (2304 + 64 * (j))
#define XB_TOP      3328
#define XB_TOPGEN   3392
#define XCD_BAR_WORDS 3456
#define XB_SPIN_CAP (1u << 18)

__device__ __forceinline__ unsigned xb_ld(unsigned* p)              { return __hip_atomic_load(p, __ATOMIC_RELAXED, __HIP_MEMORY_SCOPE_AGENT); }
__device__ __forceinline__ unsigned xb_add(unsigned* p, unsigned v) { return __hip_atomic_fetch_add(p, v, __ATOMIC_RELAXED, __HIP_MEMORY_SCOPE_AGENT); }
__device__ __forceinline__ unsigned xb_xcc_id() { return (unsigned)__builtin_amdgcn_s_getreg((3 << 11) | 20) & 0xFu; }
#define XB_SPIN(cond, bar) do { unsigned _sp = 0; while (cond) { __builtin_amdgcn_s_sleep(1); \
    if ((++_sp & 255u) == 0u) { if (xb_ld(&(bar)[XB_TMO])) break; if (_sp > XB_SPIN_CAP) { atomicAdd(&(bar)[XB_TMO], 1u); break; } } } } while (0)

struct XcdBarrier {
    unsigned* bar; unsigned x;
    volatile LAS unsigned* st;
};

__device__ __forceinline__ XcdBarrier xcd_barrier_post(unsigned* bar, volatile LAS unsigned* st) {
    XcdBarrier b; b.bar = bar; b.x = xb_xcc_id(); b.st = st;
    if (threadIdx.x == 0) (void)xb_add(&bar[XB_XCNT(b.x)], 1u);
    return b;
}
__device__ __forceinline__ void xcd_barrier_complete(unsigned* bar, unsigned x, unsigned& nloc, unsigned& nx) {
    const unsigned G = gridDim.x * gridDim.y * gridDim.z;
    unsigned sum, cnt, mine, sp = 0u;
    for (;;) {
        sum = 0u; cnt = 0u; mine = 0u;
#pragma unroll 1
        for (unsigned j = 0; j < 16; ++j) { const unsigned c = xb_ld(&bar[XB_XCNT(j)]); sum += c; cnt += (c > 0u) ? 1u : 0u; mine = (j == x) ? c : mine; }
        if (sum == G) break;
        __builtin_amdgcn_s_sleep(1);
        if ((++sp & 255u) == 0u) { if (xb_ld(&bar[XB_TMO])) break; if (sp > XB_SPIN_CAP) { atomicAdd(&bar[XB_TMO], 1u); break; } }
    }
    nloc = mine > 0u ? mine : 1u; nx = cnt > 0u ? cnt : 1u;
}

__device__ __forceinline__ void xcd_barrier(const XcdBarrier& b) {
    asm volatile("s_waitcnt vmcnt(0)" ::: "memory");
    __syncthreads();
    if (threadIdx.x == 0) {
        unsigned* bar = b.bar;
        __builtin_amdgcn_s_waitcnt(0);
        unsigned nloc = b.st[0], nx = b.st[1];
        if (nloc == 0u) { xcd_barrier_complete(bar, b.x, nloc, nx); b.st[0] = nloc; b.st[1] = nx; }
        const unsigned old = xb_add(&bar[XB_XSUB(b.x)], 1u);
        const unsigned gen = old / nloc;
        if (old + 1u == (gen + 1u) * nloc) {
            __builtin_amdgcn_fence(__ATOMIC_RELEASE, "agent");
            asm volatile("s_waitcnt vmcnt(0)" ::: "memory");
            const unsigned og = xb_add(&bar[XB_TOP], 1u);
            const unsigned tg = og / nx;
            if (og + 1u == (tg + 1u) * nx) xb_add(&bar[XB_TOPGEN], 1u);
            else XB_SPIN(xb_ld(&bar[XB_TOPGEN]) == tg, bar);
            __builtin_amdgcn_fence(__ATOMIC_ACQUIRE, "agent");
            xb_add(&bar[XB_XGEN(b.x)], 1u);
            asm volatile("s_waitcnt vmcnt(0)" ::: "memory");
        } else {
            XB_SPIN(xb_ld(&bar[XB_XGEN(b.x)]) == gen, bar);
            __builtin_amdgcn_fence(__ATOMIC_ACQUIRE, "agent");
            asm volatile("s_waitcnt vmcnt(0)" ::: "memory");
        }
    }
    __syncthreads();
}


struct Args { const float* in[12]; float* out; unsigned char* ws; int ph_lo, ph_hi, li, pad; };
struct Frame {
    LAS unsigned char* lds;
    volatile LAS unsigned* MISC;
    const Args* A;
    int wave, vcu, G;
};
__device__ __forceinline__ int opaque_tid() { int t = threadIdx.x; asm volatile("" : "+v"(t)); return t; }
#define F_tid (opaque_tid())
#define F_lane (opaque_tid() & 63)
__device__ __forceinline__ const Args* opaque_args(const Args* a) { unsigned long long v = (unsigned long long)a; asm volatile("" : "+s"(v)); return (const Args*)v; }
#define F_A (F.A)
#define F_x          (F_A->in[0])
#define F_norm_g     (F_A->in[1])
#define F_w_in       (F_A->in[2])
#define F_b_gates    (F_A->in[3])
#define F_conv_w     (F_A->in[4])
#define F_w_alpha    (F_A->in[5])
#define F_b_alpha    (F_A->in[6])
#define F_rel_bias   (F_A->in[7])
#define F_ml_norm_g  (F_A->in[8])
#define F_gla_norm_g (F_A->in[9])
#define F_w_out      (F_A->in[10])
#define F_final_g    (F_A->in[11])
#define F_out        (F_A->out)
#define F_ws         (F_A->ws)
#define F_ctl        ((gu32*)(F_ws + WS_CTL))
#define F_Win_t      ((bf16*)(F_ws + WS_WIN))
#define F_Wout_t     ((bf16*)(F_ws + WS_WOUT))
#define F_XB         ((bf16*)(F_ws + WS_XB))
#define F_Y          ((bf16*)(F_ws + WS_Y))
#define F_Z          ((bf16*)(F_ws + WS_Z))
#define F_G32        ((float*)(F_ws + WS_G32))
#define F_SSQ        ((float*)(F_ws + WS_SSQ))
#define F_CST        ((float*)(F_ws + WS_CST))
#define F_NST        ((float*)(F_ws + WS_NST))
#define F_SST        ((float*)(F_ws + WS_SST))
#define F_ADEC       ((float*)(F_ws + WS_ADEC))
#define F_GS         ((float*)(F_ws + WS_GS))
#define F_MS         ((float*)(F_ws + WS_MS))
#define F_MP         ((float*)(F_ws + WS_MP))
#define F_CPB        ((bf16*)(F_ws + WS_XB + (size_t)T * 128 * 4))
#define F_BC         ((float*)(F_ws + WS_XB))
__device__ __forceinline__ float bf2f(unsigned short u) { return __uint_as_float((unsigned)u << 16); }
__device__ __forceinline__ float wave_sum(float v) {
#pragma unroll
    for (int o = 1; o < 64; o <<= 1) v += __shfl_xor(v, o);
    return v;
}
__device__ __forceinline__ float siluf(float x) { return x / (1.0f + expf(-x)); }
__device__ __forceinline__ float sigmf(float x) { return 1.0f / (1.0f + expf(-x)); }
__device__ __forceinline__ float logsigf(float x) { return fminf(x, 0.f) - log1pf(expf(-fabsf(x))); }
__device__ __forceinline__ void ld8(const bf16* p, float* o) {
    const v4u w = *(const v4u*)p;
    o[0] = __uint_as_float(w.x << 16); o[1] = __uint_as_float(w.x & 0xffff0000u); o[2] = __uint_as_float(w.y << 16); o[3] = __uint_as_float(w.y & 0xffff0000u);
    o[4] = __uint_as_float(w.z << 16); o[5] = __uint_as_float(w.z & 0xffff0000u); o[6] = __uint_as_float(w.w << 16); o[7] = __uint_as_float(w.w & 0xffff0000u);
}

template <bool PERMUTE>
__device__ __forceinline__ void p0_transpose_item(const float* W, int Nsrc, int Ndst, const float* gk, bf16* WT, LAS float* scr, int item, int lane) {
    const int nblk = Ndst / 32, kb = item / nblk, nb = item % nblk, k0 = 64 * kb, n0 = 32 * nb;
    const int nd = n0 + (lane & 31), ns = PERMUTE ? src_col(nd) : nd;
#pragma unroll 8
    for (int i = 0; i < 32; ++i) { const int kk = 2 * i + (lane >> 5);
        float v = 0.f; if (ns >= 0) { v = W[(size_t)(k0 + kk) * Nsrc + ns]; if (gk) v *= gk[k0 + kk]; }
        scr[kk * 33 + (lane & 31)] = v; }
    LDS_WAIT(); asm volatile("" ::: "memory");
    const int c = lane & 7;
#pragma unroll
    for (int j = 0; j < 4; ++j) { const int n = (lane >> 3) + 8 * j; const LAS float* s = scr + (8 * c) * 33 + n;
        v4u o; o.x = pk2(s[0 * 33], s[1 * 33]); o.y = pk2(s[2 * 33], s[3 * 33]); o.z = pk2(s[4 * 33], s[5 * 33]); o.w = pk2(s[6 * 33], s[7 * 33]);
        *(GAS v4u*)(WT + (size_t)(n0 + n) * 1024 + k0 + 8 * c) = o; }
    LDS_WAIT(); asm volatile("" ::: "memory");
}
__device__ __forceinline__ void p0_weights(Frame& F, int l, int wi, int nw) {
    LAS float* scr = (LAS float*)(F.lds + RING_OFF + F.wave * 16384);
    constexpr int I_IN = 16 * (NP / 32), I_OUT = 16 * (DM / 32);
    for (int it = wi; it < I_IN + I_OUT; it += nw) {
        if (it < I_IN) p0_transpose_item<true>(F_w_in + (size_t)l * DM * DIN, DIN, NP, F_norm_g + l * DM, F_Win_t + (size_t)l * NP * DM, scr, it, F_lane);
        else p0_transpose_item<false>(F_w_out + (size_t)l * DM * DM, DM, DM, nullptr, F_Wout_t + (size_t)l * DM * DM, scr, it - I_IN, F_lane);
    }
}
__device__ __forceinline__ void p0_prologue(Frame& F) {
    int gw_ = F.vcu * NWAVES + F.wave; asm volatile("" : "+s"(gw_));
    const int gw = gw_, NGW = F.G * NWAVES;
    p0_weights(F, 0, gw, NGW);
    if (F.G != 256) p0_weights(F, 1, gw, NGW);
    for (int m = gw; m < T; m += NGW) {
        const GAS f32x4* xr = (const GAS f32x4*)(F_x + (size_t)m * DM) + F_lane;
        GAS unsigned long long* o8 = (GAS unsigned long long*)(F_XB + (size_t)m * DM) + F_lane;
        float s = 0.f;
#pragma unroll
        for (int j = 0; j < 4; ++j) { const f32x4 v = xr[64 * j]; s += (v.x * v.x + v.y * v.y) + (v.z * v.z + v.w * v.w);
            o8[64 * j] = (unsigned long long)pk2(v.x, v.y) | ((unsigned long long)pk2(v.z, v.w) << 32); }
        s = wave_sum(s);
        if (F_lane == 0) F_SSQ[m] = s;
    }
}

constexpr int LP = 65;
__device__ __forceinline__ void stage_conv(Frame& F, int layer, int b, int n, int zcol, int wch, float scale, LAS float* dst) {
    const float* cw = F_conv_w + (size_t)layer * 4 * 768;
    const int r0 = b * SEQ + n * CH;
    for (int idx = F_tid; idx < 4096; idx += NTHR) {
        const int t = idx >> 6, c = idx & 63;
        float a = 0.f;
#pragma unroll
        for (int j = 0; j < 4; ++j) { const int tt = t + j - 3;
            if (n * CH + tt >= 0) a += bf2f(F_Z[(size_t)(r0 + tt) * LDZ + zcol + c]) * cw[j * 768 + wch + c]; }
        dst[t * LP + c] = siluf(a) * scale;
    }
}
__device__ __forceinline__ void stage_tile(Frame& F, int b, int n, int zcol, int W, float scale, LAS float* dst, int pitch) {
    const int r0 = b * SEQ + n * CH;
    for (int idx = F_tid; idx < 64 * W; idx += NTHR) { const int t = idx / W, c = idx % W; dst[t * pitch + c] = bf2f(F_Z[(size_t)(r0 + t) * LDZ + zcol + c]) * scale; }
}
__device__ __forceinline__ void stage_mgates(Frame& F, int layer, int b, int n, int h, LAS float* ig, LAS float* bc, LAS float* lf) {
    const int r0 = b * SEQ + n * CH;
    if (F_tid < 64) { const float* g = F_G32 + (size_t)(r0 + F_tid) * 32;
        ig[F_tid] = g[h] + F_b_gates[layer * 12 + h]; lf[F_tid] = logsigf(g[6 + h] + F_b_gates[layer * 12 + 6 + h]); }
    __syncthreads();
    if (F_tid < 64) { float s = 0.f; for (int j = 0; j <= F_tid; ++j) s += lf[j]; bc[F_tid] = s; }
}
__device__ __forceinline__ void stage_gla_decay(Frame& F, int layer, int b, int n, int hh, LAS float* bcum) {
    const int r0 = b * SEQ + n * CH;
    const float* wa = F_w_alpha + (size_t)layer * 16 * 128; const float* ba = F_b_alpha + layer * 128;
    for (int idx = F_tid; idx < 2048; idx += NTHR) { const int t = idx >> 5, d = idx & 31;
        const float* g = F_G32 + (size_t)(r0 + t) * 32 + 12; float a = ba[hh * 32 + d];
#pragma unroll
        for (int r = 0; r < 16; ++r) a += g[r] * wa[r * 128 + hh * 32 + d];
        bcum[t * 33 + d] = logsigf(a) * (1.0f / 16.0f); }
    __syncthreads();
    if (F_tid < 32) { float s = 0.f; for (int t = 0; t < 64; ++t) { s += bcum[t * 33 + F_tid]; bcum[t * 33 + F_tid] = s; } }
    __syncthreads();
}

__device__ __forceinline__ void p3_scan(Frame& F) {
    LAS float* L = (LAS float*)(F.lds + RING_OFF);
    LAS float* so = L; LAS float* sn = L + 128; LAS float* gl = L + 256; LAS float* ml = L + 384; LAS float* ex = L + 512;
    const int tid = F_tid, w = tid >> 6, l = tid & 63;
    constexpr int NU_M = 12 * 65, NU = NU_M + 8 * 32;
    const int u0 = (int)(((long)F.vcu * NU) / F.G), u1 = (int)(((long)(F.vcu + 1) * NU) / F.G);
    int cur_bh = -1, par = 0;
    for (int u = u0; u < u1; ++u, par ^= 1) {
        LAS float* exu = ex + par * 1024;
        float c[16], dcy[16];
        float* p; size_t stride;
        if (u < NU_M) {
            const int bh = u / 65, eu = u % 65, b = bh / 6, h = bh % 6;
            if (bh != cur_bh) {
                __syncthreads();
                if (tid < 128) { const int ci = (b * NCHS + tid) * 6 + h; gl[tid] = F_GS[ci]; ml[tid] = F_MS[ci]; }
                __syncthreads();
                if (tid == 0) { float m = 0.f;
                    for (int n = 0; n < NCHS; ++n) { const float g = gl[n], mloc = ml[n], mn = fmaxf(g + m, mloc);
                        so[n] = expf(g + m - mn); sn[n] = expf(mloc - mn); gl[n] = m; m = mn; } }
                __syncthreads();
                if (eu == 0 && tid < 128) F_MP[(b * NCHS + tid) * 6 + h] = gl[tid];
                cur_bh = bh;
            }
            if (eu < 64) { p = F_CST + ((size_t)(b * NCHS + 16 * w) * 6 + h) * 4096 + eu * 64 + l; stride = (size_t)6 * 4096; }
            else { p = F_NST + ((size_t)(b * NCHS + 16 * w) * 6 + h) * 64 + l; stride = (size_t)6 * 64; }
#pragma unroll
            for (int i = 0; i < 16; ++i) { c[i] = p[i * stride] * sn[16 * w + i]; dcy[i] = so[16 * w + i]; }
        } else {
            const int v = u - NU_M, bh = v >> 5, eu = v & 31, b = bh >> 2, hh = bh & 3;
            p = F_SST + ((size_t)(b * NCHS + 16 * w) * 4 + hh) * 2048 + eu * 64 + l; stride = (size_t)4 * 2048;
            const float* ad = F_ADEC + ((size_t)(b * NCHS + 16 * w) * 4 + hh) * 32 + (l & 31);
#pragma unroll
            for (int i = 0; i < 16; ++i) { c[i] = p[i * stride]; dcy[i] = ad[(size_t)i * 4 * 32]; }
        }
        float st = 0.f, P = 1.f;
#pragma unroll
        for (int i = 0; i < 16; ++i) { const float ci = c[i]; c[i] = st; st = dcy[i] * st + ci; P *= dcy[i]; }
        exu[(w * 64 + l) * 2] = P; exu[(w * 64 + l) * 2 + 1] = st;
        __syncthreads();
        float sin = 0.f;
        for (int w2 = 0; w2 < w; ++w2) sin = exu[(w2 * 64 + l) * 2] * sin + exu[(w2 * 64 + l) * 2 + 1];
        float q = sin;
        if (u < NU_M && (u % 65) < 64) {
            const int bh = u / 65, eu = u % 65, b = bh / 6, h = bh % 6;
            bf16* pb = F_CPB + ((size_t)(b * NCHS + 16 * w) * 6 + h) * 4096 + eu * 64 + l;
#pragma unroll
            for (int i = 0; i < 16; ++i) { pb[(size_t)i * 6 * 4096] = (bf16)f2bf(c[i] + q); q *= dcy[i]; }
        } else {
#pragma unroll
            for (int i = 0; i < 16; ++i) { p[i * stride] = c[i] + q; q *= dcy[i]; }
        }
    }
    __syncthreads();
}

#define P4_STORE8(o, kg, yrow, GATE_EXPR) do { _Pragma("unroll") for (int c8 = 0; c8 < 8; ++c8) if ((kg) == c8) { float yv[8]; \
    _Pragma("unroll") for (int i = 0; i < 8; ++i) { const int v = c8 * 8 + i; yv[i] = (o)[v] * (GATE_EXPR); } \
    v4u w; w.x = pk2(yv[0], yv[1]); w.y = pk2(yv[2], yv[3]); w.z = pk2(yv[4], yv[5]); w.w = pk2(yv[6], yv[7]); *(GAS v4u*)((yrow) + c8 * 8) = w; } } while (0)

__device__ __forceinline__ void p4_attn(Frame& F, int layer, int b, int n, int h) {
    const int t = F_tid >> 3, kg = F_tid & 7;
    const int r0 = b * SEQ + n * CH, row = r0 + t;
    LAS float* qL = (LAS float*)(F.lds + RING_OFF);
    stage_tile(F, b, n, ZC_AQ + h * 64, 64, 1.f, qL, LP);
    __syncthreads();
    float o[64];
#pragma unroll
    for (int c = 0; c < 64; ++c) o[c] = 0.f;
    float m = -1e30f, l = 0.f;
    const float* rb = F_rel_bias + (size_t)(layer * 6 + h) * 257;
    for (int i = 0; i < 72; ++i) {
        const int jb = kg + 8 * i, kpos = n * CH - 512 + jb;
        if (kpos < 0) continue;
        const bf16* kr = F_Z + (size_t)(b * SEQ + kpos) * LDZ + ZC_AK + h * 64;
        float s = 0.f;
#pragma unroll
        for (int c = 0; c < 8; ++c) { float kf[8]; ld8(kr + c * 8, kf);
#pragma unroll
            for (int e = 0; e < 8; ++e) s += qL[t * LP + c * 8 + e] * kf[e]; }
        int rel = t + 512 - jb; rel = rel < -128 ? -128 : (rel > 128 ? 128 : rel);
        s = s * 0.125f + rb[rel + 128];
        const float mn = fmaxf(m, s), a = expf(m - mn), p = expf(s - mn);
        l = l * a + p; m = mn;
        const bf16* vr = F_Z + (size_t)(b * SEQ + kpos) * LDZ + ZC_AV + h * 64;
#pragma unroll
        for (int c = 0; c < 8; ++c) { float vf[8]; ld8(vr + c * 8, vf);
#pragma unroll
            for (int e = 0; e < 8; ++e) o[c * 8 + e] = o[c * 8 + e] * a + p * vf[e]; }
    }
#pragma unroll
    for (int off = 1; off < 8; off <<= 1) {
        const float m2 = __shfl_xor(m, off), l2 = __shfl_xor(l, off);
        const float mn = fmaxf(m, m2), a = expf(m - mn), bb = expf(m2 - mn);
        l = l * a + l2 * bb; m = mn;
#pragma unroll
        for (int c = 0; c < 64; ++c) { const float o2 = __shfl_xor(o[c], off); o[c] = o[c] * a + o2 * bb; }
    }
    const float inv = 1.0f / l;
    const bf16* gr = F_Z + (size_t)row * LDZ + ZC_AG + h * 64;
    bf16* yrow = F_Y + (size_t)row * DM + h * 64;
    P4_STORE8(o, kg, yrow, inv * siluf(bf2f(gr[v])));
}

__device__ __forceinline__ void p4_mlstm(Frame& F, int layer, int b, int n, int h) {
    LAS float* L = (LAS float*)(F.lds + RING_OFF);
    LAS float* qc = L; LAS float* kc = qc + 64 * LP; LAS float* vv = kc + 64 * LP; LAS float* Cp = vv + 64 * LP;
    LAS float* np = Cp + 64 * LP; LAS float* ig = np + 64; LAS float* bc = ig + 64; LAS float* lf = bc + 64;
    const int cn = b * NCHS + n, r0 = b * SEQ + n * CH;
    stage_conv(F, layer, b, n, ZC_MQ + h * 64, h * 64, 1.f, qc);
    stage_conv(F, layer, b, n, ZC_MK + h * 64, 384 + h * 64, 0.125f, kc);
    stage_tile(F, b, n, ZC_MV + h * 64, 64, 1.f, vv, LP);
    { const float* cs = F_CST + ((size_t)cn * 6 + h) * 4096; for (int idx = F_tid; idx < 4096; idx += NTHR) Cp[(idx >> 6) * LP + (idx & 63)] = cs[idx]; }
    if (F_tid < 64) np[F_tid] = F_NST[((size_t)cn * 6 + h) * 64 + F_tid];
    stage_mgates(F, layer, b, n, h, ig, bc, lf);
    __syncthreads();
    const float mprev = F_MP[cn * 6 + h];
    const int t = F_tid >> 3, jg = F_tid & 7, row = r0 + t;
    const float bt = bc[t], il = bt + mprev;
    float mx = il;
    for (int i = 0; i < 8; ++i) { const int j = jg + 8 * i; if (j <= t) mx = fmaxf(mx, bt - bc[j] + ig[j]); }
    mx = fmaxf(mx, __shfl_xor(mx, 1)); mx = fmaxf(mx, __shfl_xor(mx, 2)); mx = fmaxf(mx, __shfl_xor(mx, 4));
    float num[64]; float den = 0.f;
#pragma unroll
    for (int c = 0; c < 64; ++c) num[c] = 0.f;
    for (int i = 0; i < 8; ++i) { const int j = jg + 8 * i;
        if (j <= t) { float dot = 0.f;
#pragma unroll 8
            for (int k = 0; k < 64; ++k) dot += qc[t * LP + k] * kc[j * LP + k];
            const float sc = dot * expf(bt - bc[j] + ig[j] - mx); den += sc;
#pragma unroll
            for (int c = 0; c < 64; ++c) num[c] += sc * vv[j * LP + c]; } }
    const float iw = expf(il - mx);
#pragma unroll 2
    for (int kk = 0; kk < 8; ++kk) { const int k = jg * 8 + kk; const float qk = qc[t * LP + k] * iw; den += qk * np[k];
#pragma unroll
        for (int c = 0; c < 64; ++c) num[c] += qk * Cp[c * LP + k]; }
#pragma unroll
    for (int off = 1; off < 8; off <<= 1) { den += __shfl_xor(den, off);
#pragma unroll
        for (int c = 0; c < 64; ++c) num[c] += __shfl_xor(num[c], off); }
    den = fmaxf(fabsf(den), expf(-mx));
    const float rden = 1.0f / den; float ss = 0.f;
#pragma unroll
    for (int c = 0; c < 64; ++c) { num[c] *= rden; ss += num[c] * num[c]; }
    const float rn = 1.0f / sqrtf(ss * (1.0f / 64.0f) + EPS);
    const bf16* mo = F_Z + (size_t)row * LDZ + ZC_MO + h * 64; const bf16* mg = F_Z + (size_t)row * LDZ + ZC_MG + h * 64;
    const float* gn = F_ml_norm_g + layer * 384 + h * 64;
    bf16* yrow = F_Y + (size_t)row * DM + 384 + h * 64;
    P4_STORE8(num, jg, yrow, rn * gn[v] * sigmf(bf2f(mo[v])) * siluf(bf2f(mg[v])));
}

__device__ __forceinline__ void p4_gla(Frame& F, int layer, int b, int n, int hh) {
    LAS float* L = (LAS float*)(F.lds + RING_OFF);
    LAS float* qx = L; LAS float* kk = qx + 64 * 33; LAS float* vv = kk + 64 * 33; LAS float* bcum = vv + 64 * LP; LAS float* Sp = bcum + 64 * 33;
    const int cn = b * NCHS + n, r0 = b * SEQ + n * CH;
    stage_tile(F, b, n, ZC_GQ + hh * 32, 32, 0.17677669529663687f, qx, 33);
    stage_tile(F, b, n, ZC_GK + hh * 32, 32, 1.f, kk, 33);
    stage_tile(F, b, n, ZC_GV + hh * 64, 64, 1.f, vv, LP);
    { const float* ss = F_SST + ((size_t)cn * 4 + hh) * 2048; for (int idx = F_tid; idx < 2048; idx += NTHR) Sp[(idx >> 6) * LP + (idx & 63)] = ss[idx]; }
    stage_gla_decay(F, layer, b, n, hh, bcum);
    const int t = F_tid >> 3, jg = F_tid & 7, row = r0 + t;
    float num[64];
#pragma unroll
    for (int c = 0; c < 64; ++c) num[c] = 0.f;
    for (int i = 0; i < 8; ++i) { const int j = jg + 8 * i;
        if (j <= t) { float att = 0.f;
#pragma unroll 4
            for (int d = 0; d < 32; ++d) att += qx[t * 33 + d] * kk[j * 33 + d] * expf(bcum[t * 33 + d] - bcum[j * 33 + d]);
#pragma unroll
            for (int c = 0; c < 64; ++c) num[c] += att * vv[j * LP + c]; } }
#pragma unroll 2
    for (int dd = 0; dd < 4; ++dd) { const int d = jg * 4 + dd; const float w = qx[t * 33 + d] * expf(bcum[t * 33 + d]);
#pragma unroll
        for (int c = 0; c < 64; ++c) num[c] += w * Sp[d * LP + c]; }
    float ss = 0.f;
#pragma unroll
    for (int off = 1; off < 8; off <<= 1) {
#pragma unroll
        for (int c = 0; c < 64; ++c) num[c] += __shfl_xor(num[c], off); }
#pragma unroll
    for (int c = 0; c < 64; ++c) ss += num[c] * num[c];
    const float rn = 1.0f / sqrtf(ss * (1.0f / 64.0f) + EPS);
    const bf16* gg = F_Z + (size_t)row * LDZ + ZC_GG + hh * 64;
    const float* gn = F_gla_norm_g + layer * 256 + hh * 64;
    bf16* yrow = F_Y + (size_t)row * DM + 768 + hh * 64;
    P4_STORE8(num, jg, yrow, rn * gn[v] * siluf(bf2f(gg[v])));
}

typedef float f32x16 __attribute__((ext_vector_type(16)));
typedef short s16x4 __attribute__((ext_vector_type(4)));
typedef short v4i16_t __attribute__((ext_vector_type(4)));
typedef float f32x2_t __attribute__((ext_vector_type(2))); typedef __bf16 bf16x2_t __attribute__((ext_vector_type(2)));
__device__ __forceinline__ unsigned cvtpk(float lo, float hi) { f32x2_t v = {lo, hi}; bf16x2_t b = __builtin_convertvector(v, bf16x2_t); return __builtin_bit_cast(unsigned, b); }
__device__ __forceinline__ s16x4 lds_tr(LAS const unsigned char* p) { return __builtin_bit_cast(s16x4, __builtin_amdgcn_ds_read_tr16_b64_v4i16((LAS v4i16_t*)p)); }
__device__ __forceinline__ bf16x8 pack8(float a0, float a1, float a2, float a3, float a4, float a5, float a6, float a7) {
    v4u w; w.x = cvtpk(a0, a1); w.y = cvtpk(a2, a3); w.z = cvtpk(a4, a5); w.w = cvtpk(a6, a7); return __builtin_bit_cast(bf16x8, w); }
#define MFMA32(a, b, c) __builtin_amdgcn_mfma_f32_32x32x16_bf16((a), (b), (c), 0, 0, 0)
constexpr float LOG2E = 1.4426950408889634f;
__device__ __forceinline__ float fexp(float x) { return __builtin_amdgcn_exp2f(x * LOG2E); }
__device__ __forceinline__ float fsigm(float x) { return __builtin_amdgcn_rcpf(1.0f + fexp(-x)); }
__device__ __forceinline__ float fsilu(float x) { return x * fsigm(x); }
__device__ __forceinline__ int tile_off(int row, int bytecol) { return row * 128 + ((((bytecol >> 4) ^ (((row >> 1) & 1) << 2)) << 4) | (bytecol & 15)); }
__device__ __forceinline__ void dma_tile(const bf16* g, LAS unsigned char* tile, int lane) {
    const int rr = lane >> 3, cpos = lane & 7;
#pragma unroll
    for (int it = 0; it < 8; ++it) { const int row = 8 * it + rr, ch = cpos ^ (((row >> 1) & 1) << 2);
        __builtin_amdgcn_global_load_lds((const unsigned*)(g + (size_t)row * LDZ + ch * 8), (LAS unsigned*)(tile + it * 1024), 16, 0, 0); }
}
__device__ __forceinline__ bf16x8 tr_frag(LAS const unsigned char* tile, int lane, int c0, int ks) {
    const int g = lane >> 4, i = lane & 15, hf = g >> 1;
    const int row = 16 * ks + 4 * hf + (i >> 2), bc = (c0 + 16 * (g & 1) + 4 * (i & 3)) * 2;
    const s16x4 lo = lds_tr(tile + tile_off(row, bc)), hi = lds_tr(tile + tile_off(row + 8, bc));
    return (bf16x8){lo[0], lo[1], lo[2], lo[3], hi[0], hi[1], hi[2], hi[3]};
}

typedef const GAS char* gcp;
__device__ __forceinline__ gcp uptr(const void* p) { const unsigned long long v = (unsigned long long)p;
    const unsigned lo = __builtin_amdgcn_readfirstlane((unsigned)v), hi = __builtin_amdgcn_readfirstlane((unsigned)(v >> 32)); return (gcp)(((unsigned long long)hi << 32) | lo); }
__device__ __forceinline__ bf16x8 ldfrag(gcp ub, unsigned voff) { return *(const GAS bf16x8*)(ub + voff); }
__device__ __forceinline__ unsigned dma_voff(int lane) { const int rr = lane >> 3; return (unsigned)(rr * LDZ + (((lane & 7) ^ (((rr >> 1) & 1) << 2)) * 8)) * 2u; }
__device__ __forceinline__ void dma_tile_u(gcp ub, unsigned voff, LAS unsigned char* tile) {
#pragma unroll
    for (int it = 0; it < 8; ++it) __builtin_amdgcn_global_load_lds((const GAS unsigned*)(ub + (size_t)it * 8 * LDZ * 2 + voff), (LAS unsigned*)(tile + it * 1024), 16, 0, 0);
}
__device__ __forceinline__ void tr_bases(int lane, unsigned& b0, unsigned& b1) {
    const int g = lane >> 4, i = lane & 15, hf = g >> 1, row = 4 * hf + (i >> 2), bc = (16 * (g & 1) + 4 * (i & 3)) * 2;
    b0 = (unsigned)tile_off(row, bc); b1 = (unsigned)tile_off(row, bc + 64);
}
__device__ __forceinline__ bf16x8 tr_frag_b(LAS const unsigned char* tile, unsigned base, int ks) {
    const s16x4 lo = lds_tr(tile + base + ks * 2048), hi = lds_tr(tile + base + ks * 2048 + 1024);
    return (bf16x8){lo[0], lo[1], lo[2], lo[3], hi[0], hi[1], hi[2], hi[3]};
}

__device__ __forceinline__ void unpack8(v4u w, float* o) {
    o[0] = __uint_as_float(w.x << 16); o[1] = __uint_as_float(w.x & 0xffff0000u); o[2] = __uint_as_float(w.y << 16); o[3] = __uint_as_float(w.y & 0xffff0000u);
    o[4] = __uint_as_float(w.z << 16); o[5] = __uint_as_float(w.z & 0xffff0000u); o[6] = __uint_as_float(w.w << 16); o[7] = __uint_as_float(w.w & 0xffff0000u);
}
__device__ __forceinline__ float max3f(float a, float b, float c) { float r; asm("v_max3_f32 %0, %1, %2, %3" : "=v"(r) : "v"(a), "v"(b), "v"(c)); return r; }
__device__ __forceinline__ float xh_max(float x) { const auto rr = __builtin_amdgcn_permlane32_swap(__float_as_uint(x), __float_as_uint(x), false, false); return fmaxf(__uint_as_float(rr[0]), __uint_as_float(rr[1])); }
__device__ __forceinline__ float xh_sum(float x) { const auto rr = __builtin_amdgcn_permlane32_swap(__float_as_uint(x), __float_as_uint(x), false, false); return __uint_as_float(rr[0]) + __uint_as_float(rr[1]); }
constexpr int TLP = 68;
__device__ __forceinline__ void tl_put4(LAS unsigned char* wl, int t, int v, float a, float b, float c, float e) { *(LAS f32x4*)(wl + ((t * TLP + v) << 2)) = (f32x4){a, b, c, e}; }
template <int GATE>
__device__ __forceinline__ void tl_emit(LAS const unsigned char* wl, int lane, gcp g0, gcp g1, const float* gn, GAS char* yb) {
    const int rr = lane >> 3, c = lane & 7;
    float gnv[8];
    if (GATE != 0) { const f32x4 a = *(const f32x4*)(gn + 8 * c), b = *(const f32x4*)(gn + 8 * c + 4); gnv[0] = a[0]; gnv[1] = a[1]; gnv[2] = a[2]; gnv[3] = a[3]; gnv[4] = b[0]; gnv[5] = b[1]; gnv[6] = b[2]; gnv[7] = b[3]; }
    const unsigned voff = (unsigned)(rr * LDZ + 8 * c) * 2u, yoff = (unsigned)(rr * DM + 8 * c) * 2u;
    v4u ga[8], gb[8];
#pragma unroll
    for (int it = 0; it < 8; ++it) { ga[it] = *(const GAS v4u*)(g0 + (size_t)it * 8 * LDZ * 2 + voff); if (GATE == 1) gb[it] = *(const GAS v4u*)(g1 + (size_t)it * 8 * LDZ * 2 + voff); }
#pragma unroll
    for (int it = 0; it < 8; ++it) {
        const int row = 8 * it + rr;
        const f32x4 x0 = *(LAS const f32x4*)(wl + ((row * TLP + 8 * c) << 2)), x1 = *(LAS const f32x4*)(wl + ((row * TLP + 8 * c + 4) << 2));
        float x[8] = {x0[0], x0[1], x0[2], x0[3], x1[0], x1[1], x1[2], x1[3]}, p[8], q[8];
        unpack8(ga[it], p); if (GATE == 1) unpack8(gb[it], q);
#pragma unroll
        for (int e = 0; e < 8; ++e) {
            if (GATE == 0) x[e] *= fsilu(p[e]);
            else if (GATE == 1) x[e] *= gnv[e] * fsigm(p[e]) * fsilu(q[e]);
            else x[e] *= gnv[e] * fsilu(p[e]);
        }
        *(GAS v4u*)(yb + (size_t)it * 8 * DM * 2 + yoff) = __builtin_bit_cast(v4u, pack8(x[0], x[1], x[2], x[3], x[4], x[5], x[6], x[7]));
    }
}

__device__ __forceinline__ void attn_wave(Frame& F, int layer, int cn, int h, LAS unsigned char* wl) {
    const int lane = F_lane, r = lane & 31, hf = lane >> 5;
    const int b = cn / NCHS, n = cn % NCHS;
    const size_t row0 = (size_t)b * SEQ + (size_t)n * CH;
    const bf16* Z = F_Z;
    LAS float* rbl = (LAS float*)(wl + 16384);
    const float* rb = F_rel_bias + (size_t)(layer * 6 + h) * 257;
    for (int i = lane; i < 257; i += 64) rbl[i] = rb[i] * LOG2E;
    const float bfar = rb[256] * LOG2E;
    constexpr float C1 = 0.125f * LOG2E;
    const unsigned voffK = (unsigned)(r * LDZ + 8 * hf) * 2u, voffV = dma_voff(lane);
    unsigned trb0, trb1; tr_bases(lane, trb0, trb1);
    bf16x8 qf[2][4];
    { gcp qb_ = uptr(Z + row0 * LDZ + ZC_AQ + h * 64);
#pragma unroll
    for (int qb = 0; qb < 2; ++qb)
#pragma unroll
        for (int s = 0; s < 4; ++s) qf[qb][s] = ldfrag(qb_ + ((size_t)32 * qb * LDZ + 16 * s) * 2, voffK); }
    f32x16 o[2][2];
#pragma unroll
    for (int a = 0; a < 2; ++a)
#pragma unroll
        for (int c = 0; c < 2; ++c)
#pragma unroll
            for (int i = 0; i < 16; ++i) o[a][c][i] = 0.f;
    float m[2] = {-1e30f, -1e30f}, lsum[2] = {0.f, 0.f};
    const int i0 = (n >= 8) ? 0 : 8 - n;
    dma_tile_u(uptr(Z + (row0 - 512 + 64 * i0) * LDZ + ZC_AV + h * 64), voffV, wl + (i0 & 1) * 8192);
#define ATTN_STEP(KF, KB) do { \
        f32x16 st[2]; \
        _Pragma("unroll") for (int qb = 0; qb < 2; ++qb) { _Pragma("unroll") for (int i = 0; i < 16; ++i) st[qb][i] = 0.f; \
            _Pragma("unroll") for (int s = 0; s < 4; ++s) st[qb] = MFMA32(KF[s], qf[qb][s], st[qb]); } \
        const bool far_ = (ti <= 5); \
        if (!far_) { _Pragma("unroll") for (int qb = 0; qb < 2; ++qb) _Pragma("unroll") for (int i = 0; i < 16; ++i) { \
            const int kk = 32 * (KB) + (i & 3) + 8 * (i >> 2) + 4 * hf, t = 32 * qb + r; \
            int rel = t + 512 - 64 * ti - kk; rel = rel < -128 ? -128 : (rel > 128 ? 128 : rel); \
            st[qb][i] = st[qb][i] * C1 + rbl[rel + 128]; } } \
        bf16x8 pf[2][2]; \
        _Pragma("unroll") for (int qb = 0; qb < 2; ++qb) { \
            float ma = max3f(st[qb][0], st[qb][1], st[qb][2]), mb = max3f(st[qb][3], st[qb][4], st[qb][5]); \
            ma = max3f(ma, st[qb][6], st[qb][7]); mb = max3f(mb, st[qb][8], st[qb][9]); ma = max3f(ma, st[qb][10], st[qb][11]); mb = max3f(mb, st[qb][12], st[qb][13]); \
            float mx = max3f(ma, mb, fmaxf(st[qb][14], st[qb][15])); \
            if (far_) mx = mx * C1 + bfar;              \
            mx = xh_max(mx); \
            if (__any(mx > m[qb] + 8.0f)) { const float mn = fmaxf(m[qb], mx), alpha = __builtin_amdgcn_exp2f(m[qb] - mn); m[qb] = mn; lsum[qb] *= alpha; \
                _Pragma("unroll") for (int i = 0; i < 16; ++i) { o[0][qb][i] *= alpha; o[1][qb][i] *= alpha; } } \
            const float sc_ = far_ ? C1 : 1.0f, of_ = far_ ? bfar - m[qb] : -m[qb]; \
            float ps0 = 0.f, ps1 = 0.f, ps2 = 0.f, ps3 = 0.f; \
            _Pragma("unroll") for (int i = 0; i < 16; i += 4) { \
                const float p0 = __builtin_amdgcn_exp2f(st[qb][i] * sc_ + of_), p1 = __builtin_amdgcn_exp2f(st[qb][i + 1] * sc_ + of_), p2 = __builtin_amdgcn_exp2f(st[qb][i + 2] * sc_ + of_), p3 = __builtin_amdgcn_exp2f(st[qb][i + 3] * sc_ + of_); \
                st[qb][i] = p0; st[qb][i + 1] = p1; st[qb][i + 2] = p2; st[qb][i + 3] = p3; ps0 += p0; ps1 += p1; ps2 += p2; ps3 += p3; } \
            lsum[qb] += (ps0 + ps1) + (ps2 + ps3); \
            pf[qb][0] = pack8(st[qb][0], st[qb][1], st[qb][2], st[qb][3], st[qb][4], st[qb][5], st[qb][6], st[qb][7]); \
            pf[qb][1] = pack8(st[qb][8], st[qb][9], st[qb][10], st[qb][11], st[qb][12], st[qb][13], st[qb][14], st[qb][15]); } \
        if ((KB) == 0) { if (ti < 8) asm volatile("s_waitcnt vmcnt(8)" ::: "memory"); else asm volatile("s_waitcnt vmcnt(0)" ::: "memory"); }     \
        _Pragma("unroll") for (int k2 = 0; k2 < 2; ++k2) _Pragma("unroll") for (int dvb = 0; dvb < 2; ++dvb) { \
            const bf16x8 vf = tr_frag_b(vt, dvb ? trb1 : trb0, 2 * (KB) + k2); \
            o[dvb][0] = MFMA32(vf, pf[0][k2], o[dvb][0]); o[dvb][1] = MFMA32(vf, pf[1][k2], o[dvb][1]); } \
    } while (0)
    bf16x8 kfa[4], kfb[4];
    { gcp kb_ = uptr(Z + (row0 - 512 + 64 * i0) * LDZ + ZC_AK + h * 64);
#pragma unroll
      for (int s = 0; s < 4; ++s) kfa[s] = ldfrag(kb_ + (size_t)16 * s * 2, voffK); }
#pragma unroll 1
    for (int ti = i0; ti < 9; ++ti) {
        const size_t kr0 = row0 - 512 + 64 * ti;
        LAS const unsigned char* vt = wl + (ti & 1) * 8192;
        gcp kb_ = uptr(Z + kr0 * LDZ + ZC_AK + h * 64);
#pragma unroll
        for (int s = 0; s < 4; ++s) kfb[s] = ldfrag(kb_ + ((size_t)32 * LDZ + 16 * s) * 2, voffK);
        if (ti < 8) dma_tile_u(uptr(Z + (kr0 + 64) * LDZ + ZC_AV + h * 64), voffV, wl + ((ti + 1) & 1) * 8192);
        ATTN_STEP(kfa, 0);
#pragma unroll
        for (int s = 0; s < 4; ++s) kfa[s] = ldfrag(kb_ + ((size_t)64 * LDZ + 16 * s) * 2, voffK);
        ATTN_STEP(kfb, 1);
    }
#undef ATTN_STEP
#pragma unroll
    for (int qb = 0; qb < 2; ++qb) {
        const float l = xh_sum(lsum[qb]), inv = 1.0f / l;
#pragma unroll
        for (int dvb = 0; dvb < 2; ++dvb)
#pragma unroll
            for (int i4 = 0; i4 < 4; ++i4) tl_put4(wl, 32 * qb + r, 32 * dvb + 8 * i4 + 4 * hf, o[dvb][qb][4 * i4] * inv, o[dvb][qb][4 * i4 + 1] * inv, o[dvb][qb][4 * i4 + 2] * inv, o[dvb][qb][4 * i4 + 3] * inv);
    }
    tl_emit<0>(wl, lane, uptr(Z + row0 * LDZ + ZC_AG + h * 64), (gcp)nullptr, nullptr, (GAS char*)uptr(F_Y + row0 * DM + h * 64));
}

#define DPPF(old, x, ctrl, rmask) __uint_as_float(__builtin_amdgcn_update_dpp(__float_as_uint(old), __float_as_uint(x), (ctrl), (rmask), 0xf, false))
__device__ __forceinline__ float wave_scan_add(float x, int) {
    x += DPPF(0.f, x, 0x111, 0xf);
    x += DPPF(0.f, x, 0x112, 0xf);
    x += DPPF(0.f, x, 0x114, 0xf);
    x += DPPF(0.f, x, 0x118, 0xf);
    x += DPPF(0.f, x, 0x142, 0xa);
    x += DPPF(0.f, x, 0x143, 0xc);
    return x;
}
__device__ __forceinline__ float wave_scan_max(float x, int) {
    const float ninf = -3.0e38f;
    x = fmaxf(x, DPPF(ninf, x, 0x111, 0xf));
    x = fmaxf(x, DPPF(ninf, x, 0x112, 0xf));
    x = fmaxf(x, DPPF(ninf, x, 0x114, 0xf));
    x = fmaxf(x, DPPF(ninf, x, 0x118, 0xf));
    x = fmaxf(x, DPPF(ninf, x, 0x142, 0xa));
    x = fmaxf(x, DPPF(ninf, x, 0x143, 0xc));
    return x;
}
__device__ __forceinline__ float wave_max(float x) {
#pragma unroll
    for (int o = 1; o < 64; o <<= 1) x = fmaxf(x, __shfl_xor(x, o));
    return x;
}
__device__ __forceinline__ void conv8(const char* zub, unsigned voff, int blk, int s, int tt, int n, LAS const float* w, int c0, float scale, float* out) {
    float acc[8];
#pragma unroll
    for (int e = 0; e < 8; ++e) acc[e] = 0.f;
#pragma unroll
    for (int j = 0; j < 4; ++j) {
        v4u raw = *(const v4u*)(zub + ((long)(32 * blk + j - 3) * LDZ + 16 * s) * 2 + voff);
        if (!(n > 0 || tt + j - 3 >= 0)) raw = (v4u){0u, 0u, 0u, 0u};
        float z[8]; unpack8(raw, z);
        const f32x4 w0 = *(LAS const f32x4*)(w + j * 64 + c0), w1 = *(LAS const f32x4*)(w + j * 64 + c0 + 4);
        acc[0] += z[0] * w0[0]; acc[1] += z[1] * w0[1]; acc[2] += z[2] * w0[2]; acc[3] += z[3] * w0[3];
        acc[4] += z[4] * w1[0]; acc[5] += z[5] * w1[1]; acc[6] += z[6] * w1[2]; acc[7] += z[7] * w1[3];
    }
#pragma unroll
    for (int e = 0; e < 8; ++e) out[e] = fsilu(acc[e]) * scale;
}
__device__ __forceinline__ bf16x8 ld_f32_frag(gcp ub, unsigned voff) {
    const f32x4 a = *(const GAS f32x4*)(ub + voff), b = *(const GAS f32x4*)(ub + voff + 16);
    return pack8(a[0], a[1], a[2], a[3], b[0], b[1], b[2], b[3]);
}

__device__ __forceinline__ void dma_rows67(gcp ub, unsigned voff, LAS unsigned char* img, int lane) {
#pragma unroll
    for (int it = 0; it < 8; ++it) __builtin_amdgcn_global_load_lds((const GAS unsigned*)(ub + (size_t)it * 8 * LDZ * 2 + voff), (LAS unsigned*)(img + it * 1024), 16, 0, 0);
    if (lane < 24) __builtin_amdgcn_global_load_lds((const GAS unsigned*)(ub + (size_t)64 * LDZ * 2 + voff), (LAS unsigned*)(img + 8192), 16, 0, 0);
}
constexpr int IMG1 = 8704;
__device__ __forceinline__ void ml_out_wave(Frame& F, int layer, int cn, int h, LAS unsigned char* wl) {
    const int lane = F_lane, r = lane & 31, hf = lane >> 5;
    const int b = cn / NCHS, n = cn % NCHS;
    const size_t row0 = (size_t)b * SEQ + (size_t)n * CH;
    const bf16* Z = F_Z;
    LAS unsigned char* img0 = wl; LAS unsigned char* img1 = wl + IMG1;
    LAS float* wq = (LAS float*)(wl + 17408); LAS float* wk = wq + 256; LAS float* npl = wq + 512;
    const unsigned dvo = dma_voff(lane);
    dma_rows67(uptr(Z + (row0 - 3) * LDZ + ZC_MQ + h * 64), dvo, img0, lane);
    dma_rows67(uptr(Z + (row0 - 3) * LDZ + ZC_MK + h * 64), dvo, img1, lane);
    { const float* cw = F_conv_w + (size_t)layer * 4 * 768 + h * 64 + lane;
#pragma unroll
      for (int j = 0; j < 4; ++j) { wq[j * 64 + lane] = cw[j * 768]; wk[j * 64 + lane] = cw[j * 768 + 384]; } }
    npl[lane] = F_NST[((size_t)cn * 6 + h) * 64 + lane];
    const float* g32 = F_G32 + (row0 + lane) * 32;
    const float ig = g32[h] + F_b_gates[layer * 12 + h];
    const float lf = logsigf(g32[6 + h] + F_b_gates[layer * 12 + 6 + h]);
    const float bc = wave_scan_add(lf, lane);
    const float av = ig - bc;
    const float amax = wave_scan_max(av, lane);
    const float mprev = F_MP[cn * 6 + h];
    float bct[2], mt[2], iw[2];
#pragma unroll
    for (int tb = 0; tb < 2; ++tb) { bct[tb] = __shfl(bc, 32 * tb + r); mt[tb] = fmaxf(mprev, __shfl(amax, 32 * tb + r)); iw[tb] = fexp(mprev - mt[tb]); }
    asm volatile("s_waitcnt vmcnt(0)" ::: "memory");
    bf16x8 qcf[2][4], kcf[2][4];
    float nq[2] = {0.f, 0.f};
#pragma unroll
    for (int s = 0; s < 4; ++s) {
        const int c0 = 16 * s + 8 * hf;
        const f32x4 n0 = *(LAS const f32x4*)(npl + c0), n1 = *(LAS const f32x4*)(npl + c0 + 4);
#pragma unroll
        for (int blk = 0; blk < 2; ++blk) {
            float aq[8], ak[8];
#pragma unroll
            for (int e = 0; e < 8; ++e) { aq[e] = 0.f; ak[e] = 0.f; }
#pragma unroll
            for (int j = 0; j < 4; ++j) {
                const int rho = 32 * blk + r + j, off = tile_off(rho, c0 * 2);
                v4u rq = *(LAS const v4u*)(img0 + off), rk = *(LAS const v4u*)(img1 + off);
                if (n == 0 && rho < 3) { rq = (v4u){0u, 0u, 0u, 0u}; rk = (v4u){0u, 0u, 0u, 0u}; }
                float zq[8], zk[8]; unpack8(rq, zq); unpack8(rk, zk);
                const f32x4 a0 = *(LAS const f32x4*)(wq + j * 64 + c0), a1 = *(LAS const f32x4*)(wq + j * 64 + c0 + 4), b0 = *(LAS const f32x4*)(wk + j * 64 + c0), b1 = *(LAS const f32x4*)(wk + j * 64 + c0 + 4);
                aq[0] += zq[0] * a0[0]; aq[1] += zq[1] * a0[1]; aq[2] += zq[2] * a0[2]; aq[3] += zq[3] * a0[3]; aq[4] += zq[4] * a1[0]; aq[5] += zq[5] * a1[1]; aq[6] += zq[6] * a1[2]; aq[7] += zq[7] * a1[3];
                ak[0] += zk[0] * b0[0]; ak[1] += zk[1] * b0[1]; ak[2] += zk[2] * b0[2]; ak[3] += zk[3] * b0[3]; ak[4] += zk[4] * b1[0]; ak[5] += zk[5] * b1[1]; ak[6] += zk[6] * b1[2]; ak[7] += zk[7] * b1[3];
            }
#pragma unroll
            for (int e = 0; e < 8; ++e) { aq[e] = fsilu(aq[e]); ak[e] = fsilu(ak[e]) * 0.125f; }
            nq[blk] += aq[0] * n0[0] + aq[1] * n0[1] + aq[2] * n0[2] + aq[3] * n0[3] + aq[4] * n1[0] + aq[5] * n1[1] + aq[6] * n1[2] + aq[7] * n1[3];
            qcf[blk][s] = pack8(aq[0], aq[1], aq[2], aq[3], aq[4], aq[5], aq[6], aq[7]);
            kcf[blk][s] = pack8(ak[0], ak[1], ak[2], ak[3], ak[4], ak[5], ak[6], ak[7]);
        }
    }
    dma_tile_u(uptr(Z + row0 * LDZ + ZC_MV + h * 64), dvo, img0);
    bf16x8 pf0[2], pf1[4];
    float den[2] = {0.f, 0.f};
    {
        f32x16 s00, s01, s11;
#pragma unroll
        for (int i = 0; i < 16; ++i) { s00[i] = 0.f; s01[i] = 0.f; s11[i] = 0.f; }
#pragma unroll
        for (int s = 0; s < 4; ++s) { s00 = MFMA32(kcf[0][s], qcf[0][s], s00); s01 = MFMA32(kcf[0][s], qcf[1][s], s01); s11 = MFMA32(kcf[1][s], qcf[1][s], s11); }
#pragma unroll
        for (int i = 0; i < 16; ++i) {
            const int jr = (i & 3) + 8 * (i >> 2) + 4 * hf;
            const float a0 = __shfl(av, jr), a1 = __shfl(av, 32 + jr);
            const float d00 = (jr <= r) ? fexp(a0 - mt[0]) : 0.f, d01 = fexp(a0 - mt[1]), d11 = (jr <= r) ? fexp(a1 - mt[1]) : 0.f;
            s00[i] *= d00; s01[i] *= d01; s11[i] *= d11;
            den[0] += s00[i]; den[1] += s01[i] + s11[i];
        }
        pf0[0] = pack8(s00[0], s00[1], s00[2], s00[3], s00[4], s00[5], s00[6], s00[7]); pf0[1] = pack8(s00[8], s00[9], s00[10], s00[11], s00[12], s00[13], s00[14], s00[15]);
        pf1[0] = pack8(s01[0], s01[1], s01[2], s01[3], s01[4], s01[5], s01[6], s01[7]); pf1[1] = pack8(s01[8], s01[9], s01[10], s01[11], s01[12], s01[13], s01[14], s01[15]);
        pf1[2] = pack8(s11[0], s11[1], s11[2], s11[3], s11[4], s11[5], s11[6], s11[7]); pf1[3] = pack8(s11[8], s11[9], s11[10], s11[11], s11[12], s11[13], s11[14], s11[15]);
    }
#pragma unroll
    for (int tb = 0; tb < 2; ++tb) {
        den[tb] = xh_sum(den[tb]); nq[tb] = xh_sum(nq[tb]);
        den[tb] = fmaxf(fabsf(den[tb] + iw[tb] * nq[tb]), fexp(-(bct[tb] + mt[tb])));
    }
    unsigned trb0, trb1; tr_bases(lane, trb0, trb1);
    gcp cpb = uptr(F_CPB + ((size_t)cn * 6 + h) * 4096);
    f32x16 num[2][2];
#pragma unroll
    for (int vb = 0; vb < 2; ++vb) {
        bf16x8 cf[4];
#pragma unroll
        for (int s = 0; s < 4; ++s) cf[s] = ldfrag(cpb + ((size_t)32 * vb * 64 + 16 * s) * 2, (unsigned)(r * 64 + 8 * hf) * 2u);
#pragma unroll
        for (int tb = 0; tb < 2; ++tb) {
#pragma unroll
            for (int i = 0; i < 16; ++i) num[vb][tb][i] = 0.f;
#pragma unroll
            for (int s = 0; s < 4; ++s) num[vb][tb] = MFMA32(cf[s], qcf[tb][s], num[vb][tb]);
#pragma unroll
            for (int i = 0; i < 16; ++i) num[vb][tb][i] *= iw[tb];
        }
    }
    asm volatile("s_waitcnt vmcnt(0)" ::: "memory");
#pragma unroll
    for (int vb = 0; vb < 2; ++vb)
#pragma unroll
        for (int ks = 0; ks < 4; ++ks) {
            const bf16x8 vf = tr_frag_b(img0, vb ? trb1 : trb0, ks);
            if (ks < 2) num[vb][0] = MFMA32(vf, pf0[ks], num[vb][0]);
            num[vb][1] = MFMA32(vf, pf1[ks], num[vb][1]);
        }
#pragma unroll
    for (int tb = 0; tb < 2; ++tb) {
        const float rden = 1.0f / den[tb]; float ss = 0.f;
#pragma unroll
        for (int vb = 0; vb < 2; ++vb)
#pragma unroll
            for (int i = 0; i < 16; ++i) { num[vb][tb][i] *= rden; ss += num[vb][tb][i] * num[vb][tb][i]; }
        ss = xh_sum(ss);
        const float rn = 1.0f / sqrtf(ss * (1.0f / 64.0f) + EPS);
#pragma unroll
        for (int vb = 0; vb < 2; ++vb)
#pragma unroll
            for (int i4 = 0; i4 < 4; ++i4) tl_put4(wl, 32 * tb + r, 32 * vb + 8 * i4 + 4 * hf, num[vb][tb][4 * i4] * rn, num[vb][tb][4 * i4 + 1] * rn, num[vb][tb][4 * i4 + 2] * rn, num[vb][tb][4 * i4 + 3] * rn);
    }
    tl_emit<1>(wl, lane, uptr(Z + row0 * LDZ + ZC_MO + h * 64), uptr(Z + row0 * LDZ + ZC_MG + h * 64), F_ml_norm_g + layer * 384 + h * 64, (GAS char*)uptr(F_Y + row0 * DM + 384 + h * 64));
}

__device__ __forceinline__ void ml_loc_wave(Frame& F, int layer, int cn, int h, LAS unsigned char* wl) {
    const int lane = F_lane, r = lane & 31, hf = lane >> 5;
    const int b = cn / NCHS, n = cn % NCHS;
    const size_t row0 = (size_t)b * SEQ + (size_t)n * CH;
    const bf16* Z = F_Z;
    LAS unsigned char* img0 = wl; LAS unsigned char* img1 = wl + IMG1;
    const unsigned dvo = dma_voff(lane);
    dma_rows67(uptr(Z + (row0 - 3) * LDZ + ZC_MK + h * 64), dvo, img0, lane);
    dma_tile_u(uptr(Z + row0 * LDZ + ZC_MV + h * 64), dvo, img1);
    const int rr = lane >> 3, ch = lane & 7;
    float wk[4][8];
    { const float* cw = F_conv_w + (size_t)layer * 4 * 768 + 384 + h * 64 + ch * 8;
#pragma unroll
      for (int j = 0; j < 4; ++j) { const f32x4 a = *(const f32x4*)(cw + j * 768), c = *(const f32x4*)(cw + j * 768 + 4);
          wk[j][0] = a[0]; wk[j][1] = a[1]; wk[j][2] = a[2]; wk[j][3] = a[3]; wk[j][4] = c[0]; wk[j][5] = c[1]; wk[j][6] = c[2]; wk[j][7] = c[3]; } }
    const float* g32 = F_G32 + (row0 + lane) * 32;
    const float ig = g32[h] + F_b_gates[layer * 12 + h];
    const float lf = logsigf(g32[6 + h] + F_b_gates[layer * 12 + 6 + h]);
    const float bc = wave_scan_add(lf, lane);
    const float g = __shfl(bc, 63);
    const float av = g - bc + ig;
    const float mloc = wave_max(av);
    const float w = fexp(av - mloc);
    asm volatile("s_waitcnt vmcnt(0)" ::: "memory");
#pragma unroll 2
    for (int it = 0; it < 8; ++it) {
        const int row = 8 * it + rr;
        float acc[8];
#pragma unroll
        for (int e = 0; e < 8; ++e) acc[e] = 0.f;
#pragma unroll
        for (int j = 0; j < 4; ++j) {
            v4u raw = *(LAS const v4u*)(img0 + tile_off(row + j, ch * 16));
            if (n == 0 && row + j < 3) raw = (v4u){0u, 0u, 0u, 0u};
            float z[8]; unpack8(raw, z);
#pragma unroll
            for (int e = 0; e < 8; ++e) acc[e] += z[e] * wk[j][e];
        }
        const int lo = tile_off(row, ch * 16);
        float v8[8]; unpack8(*(LAS const v4u*)(img1 + lo), v8);
        const float wr = __shfl(w, row);
        *(LAS v4u*)(img0 + lo) = __builtin_bit_cast(v4u, pack8(fsilu(acc[0]) * 0.125f, fsilu(acc[1]) * 0.125f, fsilu(acc[2]) * 0.125f, fsilu(acc[3]) * 0.125f,
                                                                fsilu(acc[4]) * 0.125f, fsilu(acc[5]) * 0.125f, fsilu(acc[6]) * 0.125f, fsilu(acc[7]) * 0.125f));
        *(LAS v4u*)(img1 + lo) = __builtin_bit_cast(v4u, pack8(v8[0] * wr, v8[1] * wr, v8[2] * wr, v8[3] * wr, v8[4] * wr, v8[5] * wr, v8[6] * wr, v8[7] * wr));
    }
    unsigned trb0, trb1; tr_bases(lane, trb0, trb1);
    f32x16 acc[2][2];
#pragma unroll
    for (int a = 0; a < 2; ++a)
#pragma unroll
        for (int c = 0; c < 2; ++c)
#pragma unroll
            for (int i = 0; i < 16; ++i) acc[a][c][i] = 0.f;
#pragma unroll
    for (int ks = 0; ks < 4; ++ks) {
        const bf16x8 a0 = tr_frag_b(img1, trb0, ks), a1 = tr_frag_b(img1, trb1, ks), b0 = tr_frag_b(img0, trb0, ks), b1 = tr_frag_b(img0, trb1, ks);
        acc[0][0] = MFMA32(a0, b0, acc[0][0]); acc[0][1] = MFMA32(a0, b1, acc[0][1]); acc[1][0] = MFMA32(a1, b0, acc[1][0]); acc[1][1] = MFMA32(a1, b1, acc[1][1]);
    }
    float* cst = F_CST + ((size_t)cn * 6 + h) * 4096;
#pragma unroll
    for (int vb = 0; vb < 2; ++vb)
#pragma unroll
        for (int kb = 0; kb < 2; ++kb)
#pragma unroll
            for (int i = 0; i < 16; ++i) cst[(32 * vb + (i & 3) + 8 * (i >> 2) + 4 * hf) * 64 + 32 * kb + r] = acc[vb][kb][i];
    float s = 0.f;
#pragma unroll 8
    for (int j = 0; j < 64; ++j) s += __shfl(w, j) * bf2f(*(LAS const unsigned short*)(img0 + tile_off(j, 2 * lane)));
    F_NST[((size_t)cn * 6 + h) * 64 + lane] = s;
    if (lane == 0) { F_GS[cn * 6 + h] = g; F_MS[cn * 6 + h] = mloc; }
}

__device__ __forceinline__ float flogsig(float x) { return fminf(x, 0.f) - 0.6931471805599453f * __builtin_amdgcn_logf(1.0f + fexp(-fabsf(x))); }
__device__ __forceinline__ void gla_loc_wave(Frame& F, int layer, int cn, int hh, LAS unsigned char* wl) {
    const int lane = F_lane, hf = lane >> 5;
    const int b = cn / NCHS, n = cn % NCHS;
    const size_t row0 = (size_t)b * SEQ + (size_t)n * CH, row = row0 + lane;
    const bf16* Z = F_Z;
    dma_tile_u(uptr(Z + row0 * LDZ + ZC_GV + hh * 64), dma_voff(lane), wl + 8192);
    float ga[16];
    { const f32x4* gp = (const f32x4*)(F_G32 + row * 32 + 12);
#pragma unroll
      for (int q = 0; q < 4; ++q) { const f32x4 v = gp[q]; ga[4 * q] = v[0]; ga[4 * q + 1] = v[1]; ga[4 * q + 2] = v[2]; ga[4 * q + 3] = v[3]; } }
    const float* wa = F_w_alpha + (size_t)layer * 16 * 128 + hh * 32; const float* ba = F_b_alpha + layer * 128 + hh * 32;
    LAS float* wsl = (LAS float*)(wl + 16384);
#pragma unroll
    for (int i = lane; i < 512; i += 64) wsl[i] = wa[(i >> 5) * 128 + (i & 31)];
    float bcv[32];
#pragma unroll
    for (int d4 = 0; d4 < 8; ++d4) {
        f32x4 a = *(const f32x4*)(ba + 4 * d4);
#pragma unroll
        for (int q = 0; q < 16; ++q) a += *(LAS const f32x4*)(wsl + q * 32 + 4 * d4) * ga[q];
#pragma unroll
        for (int e = 0; e < 4; ++e) bcv[4 * d4 + e] = wave_scan_add(flogsig(a[e]) * (1.0f / 16.0f), lane);
    }
    { f32x4* bp = (f32x4*)(F_BC + row * 128 + hh * 32);
#pragma unroll
      for (int q = 0; q < 8; ++q) bp[q] = (f32x4){bcv[4 * q], bcv[4 * q + 1], bcv[4 * q + 2], bcv[4 * q + 3]}; }
#pragma unroll
    for (int c = 0; c < 4; ++c) {
        float k8[8]; unpack8(*(const v4u*)(Z + row * LDZ + ZC_GK + hh * 32 + 8 * c), k8);
#pragma unroll
        for (int e = 0; e < 8; ++e) k8[e] *= fexp(__shfl(bcv[8 * c + e], 63) - bcv[8 * c + e]);
        *(LAS v4u*)(wl + tile_off(lane, c * 16)) = __builtin_bit_cast(v4u, pack8(k8[0], k8[1], k8[2], k8[3], k8[4], k8[5], k8[6], k8[7]));
    }
    if (lane == 63) { f32x4* ap = (f32x4*)(F_ADEC + ((size_t)cn * 4 + hh) * 32);
#pragma unroll
        for (int q = 0; q < 8; ++q) ap[q] = (f32x4){fexp(bcv[4 * q]), fexp(bcv[4 * q + 1]), fexp(bcv[4 * q + 2]), fexp(bcv[4 * q + 3])}; }
    unsigned trb0, trb1; tr_bases(lane, trb0, trb1);
    f32x16 u0, u1;
#pragma unroll
    for (int i = 0; i < 16; ++i) { u0[i] = 0.f; u1[i] = 0.f; }
    asm volatile("s_waitcnt vmcnt(0)" ::: "memory");
#pragma unroll
    for (int ks = 0; ks < 4; ++ks) { const bf16x8 kd = tr_frag_b(wl, trb0, ks);
        u0 = MFMA32(tr_frag_b(wl + 8192, trb0, ks), kd, u0); u1 = MFMA32(tr_frag_b(wl + 8192, trb1, ks), kd, u1); }
    float* sst = F_SST + ((size_t)cn * 4 + hh) * 2048;
#pragma unroll
    for (int i = 0; i < 16; ++i) { const int v = (i & 3) + 8 * (i >> 2) + 4 * hf; sst[v * 32 + (lane & 31)] = u0[i]; sst[(32 + v) * 32 + (lane & 31)] = u1[i]; }
}

__device__ __forceinline__ void gla_out_wave(Frame& F, int layer, int cn, int hh, LAS unsigned char* wl) {
    const int lane = F_lane, r = lane & 31, hf = lane >> 5;
    const int b = cn / NCHS, n = cn % NCHS;
    const size_t row0 = (size_t)b * SEQ + (size_t)n * CH;
    const bf16* Z = F_Z;
    dma_tile_u(uptr(Z + row0 * LDZ + ZC_GV + hh * 64), dma_voff(lane), wl);
    const unsigned voffK = (unsigned)(r * LDZ + 8 * hf) * 2u, voffB = (unsigned)(r * 128 + 8 * hf) * 4u;
    gcp zq = uptr(Z + row0 * LDZ + ZC_GQ + hh * 32); gcp zk = uptr(Z + row0 * LDZ + ZC_GK + hh * 32); gcp bcb = uptr(F_BC + row0 * 128 + hh * 32);
    bf16x8 qf[2][2], kf[2][2];
#pragma unroll
    for (int blk = 0; blk < 2; ++blk)
#pragma unroll
        for (int s = 0; s < 2; ++s) {
            float q8[8], k8[8];
            unpack8(*(const GAS v4u*)(zq + ((size_t)32 * blk * LDZ + 16 * s) * 2 + voffK), q8); unpack8(*(const GAS v4u*)(zk + ((size_t)32 * blk * LDZ + 16 * s) * 2 + voffK), k8);
            const f32x4 c0 = *(const GAS f32x4*)(bcb + ((size_t)32 * blk * 128 + 16 * s) * 4 + voffB), c1 = *(const GAS f32x4*)(bcb + ((size_t)32 * blk * 128 + 16 * s) * 4 + voffB + 16);
            const float bc8[8] = {c0[0], c0[1], c0[2], c0[3], c1[0], c1[1], c1[2], c1[3]};
#pragma unroll
            for (int e = 0; e < 8; ++e) { q8[e] *= 0.17677669529663687f * fexp(bc8[e]); k8[e] *= fexp(-bc8[e]); }
            qf[blk][s] = pack8(q8[0], q8[1], q8[2], q8[3], q8[4], q8[5], q8[6], q8[7]);
            kf[blk][s] = pack8(k8[0], k8[1], k8[2], k8[3], k8[4], k8[5], k8[6], k8[7]);
        }
    bf16x8 pf0[2], pf1[4];
    {
        f32x16 s00, s01, s11;
#pragma unroll
        for (int i = 0; i < 16; ++i) { s00[i] = 0.f; s01[i] = 0.f; s11[i] = 0.f; }
#pragma unroll
        for (int s = 0; s < 2; ++s) { s00 = MFMA32(kf[0][s], qf[0][s], s00); s01 = MFMA32(kf[0][s], qf[1][s], s01); s11 = MFMA32(kf[1][s], qf[1][s], s11); }
#pragma unroll
        for (int i = 0; i < 16; ++i) { const int jr = (i & 3) + 8 * (i >> 2) + 4 * hf; if (jr > r) { s00[i] = 0.f; s11[i] = 0.f; } }
        pf0[0] = pack8(s00[0], s00[1], s00[2], s00[3], s00[4], s00[5], s00[6], s00[7]); pf0[1] = pack8(s00[8], s00[9], s00[10], s00[11], s00[12], s00[13], s00[14], s00[15]);
        pf1[0] = pack8(s01[0], s01[1], s01[2], s01[3], s01[4], s01[5], s01[6], s01[7]); pf1[1] = pack8(s01[8], s01[9], s01[10], s01[11], s01[12], s01[13], s01[14], s01[15]);
        pf1[2] = pack8(s11[0], s11[1], s11[2], s11[3], s11[4], s11[5], s11[6], s11[7]); pf1[3] = pack8(s11[8], s11[9], s11[10], s11[11], s11[12], s11[13], s11[14], s11[15]);
    }
    unsigned trb0, trb1; tr_bases(lane, trb0, trb1);
    gcp spb = uptr(F_SST + ((size_t)cn * 4 + hh) * 2048);
    f32x16 num[2][2];
#pragma unroll
    for (int vb = 0; vb < 2; ++vb) {
        bf16x8 sf[2];
#pragma unroll
        for (int s = 0; s < 2; ++s) sf[s] = ld_f32_frag(spb + ((size_t)32 * vb * 32 + 16 * s) * 4, (unsigned)(r * 32 + 8 * hf) * 4u);
#pragma unroll
        for (int tb = 0; tb < 2; ++tb) {
#pragma unroll
            for (int i = 0; i < 16; ++i) num[vb][tb][i] = 0.f;
#pragma unroll
            for (int s = 0; s < 2; ++s) num[vb][tb] = MFMA32(sf[s], qf[tb][s], num[vb][tb]);
        }
    }
    asm volatile("s_waitcnt vmcnt(0)" ::: "memory");
#pragma unroll
    for (int vb = 0; vb < 2; ++vb)
#pragma unroll
        for (int ks = 0; ks < 4; ++ks) {
            const bf16x8 vf = tr_frag_b(wl, vb ? trb1 : trb0, ks);
            if (ks < 2) num[vb][0] = MFMA32(vf, pf0[ks], num[vb][0]);
            num[vb][1] = MFMA32(vf, pf1[ks], num[vb][1]);
        }
#pragma unroll
    for (int tb = 0; tb < 2; ++tb) {
        float ss = 0.f;
#pragma unroll
        for (int vb = 0; vb < 2; ++vb)
#pragma unroll
            for (int i = 0; i < 16; ++i) ss += num[vb][tb][i] * num[vb][tb][i];
        ss = xh_sum(ss);
        const float rn = 1.0f / sqrtf(ss * (1.0f / 64.0f) + EPS);
#pragma unroll
        for (int vb = 0; vb < 2; ++vb)
#pragma unroll
            for (int i4 = 0; i4 < 4; ++i4) tl_put4(wl, 32 * tb + r, 32 * vb + 8 * i4 + 4 * hf, num[vb][tb][4 * i4] * rn, num[vb][tb][4 * i4 + 1] * rn, num[vb][tb][4 * i4 + 2] * rn, num[vb][tb][4 * i4 + 3] * rn);
    }
    tl_emit<2>(wl, lane, uptr(Z + row0 * LDZ + ZC_GG + hh * 64), (gcp)nullptr, F_gla_norm_g + layer * 256 + hh * 64, (GAS char*)uptr(F_Y + row0 * DM + 768 + hh * 64));
}

__device__ __forceinline__ void p2_local(Frame& F, int layer) {
    int gw_ = F.vcu * NWAVES + F.wave; asm volatile("" : "+s"(gw_));
    const int gw = gw_, NGW = F.G * NWAVES;
    LAS unsigned char* wl = F.lds + RING_OFF + F.wave * WL_BYTES;
    constexpr int NA = NCHT * 6, NL = NCHT * 10;
    if (NGW == 2048) {
#define LOCAL_TASK(q) do { const int q_ = (q); if (q_ < NA) ml_loc_wave(F, layer, q_ / 6, q_ % 6, wl); else gla_loc_wave(F, layer, (q_ - NA) >> 2, (q_ - NA) & 3, wl); } while (0)
        if (gw < NA) { LOCAL_TASK(gw); attn_wave(F, layer, gw / 6, gw % 6, wl); }
        else { const int q0 = NA + 2 * (gw - NA); for (int q = q0; q < q0 + 2; ++q) LOCAL_TASK(q); }
#undef LOCAL_TASK
    } else {
        for (int a = gw; a < NA; a += NGW) attn_wave(F, layer, a / 6, a % 6, wl);
        for (int q = gw; q < NL; q += NGW) { if (q < NA) ml_loc_wave(F, layer, q / 6, q % 6, wl); else gla_loc_wave(F, layer, (q - NA) >> 2, (q - NA) & 3, wl); }
    }
}
__device__ __forceinline__ void p4_outputs(Frame& F, int layer) {
    int gw_ = F.vcu * NWAVES + F.wave; asm volatile("" : "+s"(gw_));
    const int gw = gw_, NGW = F.G * NWAVES;
    LAS unsigned char* wl = F.lds + RING_OFF + F.wave * WL_BYTES;
    constexpr int NA = NCHT * 6, NG = NCHT * 4;
    if (NGW == 2048) {
        if (gw < NA) { ml_out_wave(F, layer, gw / 6, gw % 6, wl);
#if PROBE_DUP == 8
            ml_out_wave(F, layer, gw / 6, gw % 6, wl);
#endif
        }
        else { for (int q = gw - NA; q < NG; q += 512) gla_out_wave(F, layer, q >> 2, q & 3, wl);
#if PROBE_DUP == 9
            for (int q = gw - NA; q < NG; q += 512) gla_out_wave(F, layer, q >> 2, q & 3, wl);
#endif
        }
    } else {
        for (int a = gw; a < NA; a += NGW) ml_out_wave(F, layer, a / 6, a % 6, wl);
        for (int q = gw; q < NG; q += NGW) gla_out_wave(F, layer, q >> 2, q & 3, wl);
    }
}

__device__ __forceinline__ void p11_final(Frame& F) {
    int gw_ = F.vcu * NWAVES + F.wave; asm volatile("" : "+s"(gw_));
    const int gw = gw_, NGW = F.G * NWAVES;
    const float* ssq = F_SSQ + 2 * T;
    for (int m = gw; m < T; m += NGW) {
        const float rs = 1.0f / sqrtf(ssq[m] * (1.0f / 1024.0f) + EPS);
        GAS f32x4* xr = (GAS f32x4*)(F_out + (size_t)m * DM) + F_lane; const GAS f32x4* gr = (const GAS f32x4*)F_final_g + F_lane;
#pragma unroll
        for (int j = 0; j < 4; ++j) { const f32x4 v = xr[64 * j], g = gr[64 * j]; xr[64 * j] = v * rs * g; }
    }
}

__global__ void __launch_bounds__(NTHR, 2) hymba_fwd(Args args) {
    extern __shared__ __attribute__((aligned(16))) unsigned char lds[];
    Frame F;
    F.lds = (LAS unsigned char*)lds;
    F.MISC = (volatile LAS unsigned*)(F.lds + MISC_OFF);
    F.wave = __builtin_amdgcn_readfirstlane(F_tid >> 6);
    F.G = gridDim.x; { const int bx = blockIdx.x; F.vcu = (F.G % 8 == 0) ? (bx % 8) * (F.G / 8) + bx / 8 : bx; }
    F.A = &args;
    for (int u = F_tid; u < (LDS_BYTES - LDSCTL_OFF) / 4; u += NTHR) ((LAS unsigned*)(F.lds + LDSCTL_OFF))[u] = 0u;
    __syncthreads();
    XcdBarrier bar; bar.bar = (unsigned*)(F_ctl + CW_BAR); bar.x = 0; bar.st = nullptr;
    if (N_LAUNCHES == 1) bar = xcd_barrier_post((unsigned*)(F_ctl + CW_BAR), F.MISC + 8);
#define GRID_BAR() do { if (N_LAUNCHES == 1) { XcdBarrier b2_ = bar; unsigned long long v_ = (unsigned long long)bar.bar; asm volatile("" : "+s"(v_)); b2_.bar = (unsigned*)v_; xcd_barrier(b2_); } } while (0)
    const int lo = args.ph_lo, hi = args.ph_hi;
#pragma unroll 1
    for (int ph = lo; ph < hi; ++ph) {
        if (ph == 0) { p0_prologue(F);
#if PROBE_DUP == 4
            GRID_BAR(); p0_prologue(F);
#endif
        } else if (ph == NPHASE - 1) { p11_final(F);
        } else {
            const int layer = (ph - 1) / 5, k = (ph - 1) % 5;
            if (k == 0 || k == 4) {
                const int which = k ? 1 : 0, N = which ? DM : NP;
                pg8::Gemm g{which ? F_Y : F_XB, which ? F_Wout_t + (size_t)layer * DM * DM : F_Win_t + (size_t)layer * NP * DM, T, N, DM};
                pg8::StaticOrder S; S.init(T, N, F.G, (int)blockIdx.x);
                pg8::EpiBoth E{which, pg8::EpiZ{F_Z, LDZ, F_SSQ + layer * T, F_G32, ZC_SM},
                               pg8::EpiRes{layer == 0 ? F_x : (const float*)F_out, F_out, layer == 0 ? F_XB : (bf16*)nullptr, F_SSQ + (layer + 1) * T}};
                pg8::gemm_phase<pg8::EpiBoth, pg8::StaticOrder, true, true>(F.lds + RING_OFF, g, S, E);
                if (ph == 1 && F.G == 256 && (int)blockIdx.x >= 64) { int wi_ = ((int)blockIdx.x - 64) * NWAVES + F.wave; asm volatile("" : "+s"(wi_)); p0_weights(F, 1, wi_, 192 * NWAVES); }
            } else if (k == 1) { p2_local(F, layer);
#if PROBE_DUP == 2
                GRID_BAR(); p2_local(F, layer);
#endif
            } else if (k == 2) { p3_scan(F);
            } else { p4_outputs(F, layer);
#if PROBE_DUP == 3
                GRID_BAR(); p4_outputs(F, layer);
#endif
            }
        }
        if (ph + 1 < hi) GRID_BAR();
    }
}

extern "C" void kernel_launch(void* const* d_in, const int* in_sizes, int n_in, void* d_out, int out_size, void* d_ws, size_t ws_size, hipStream_t stream) {
    static int grid = 0;
    if (grid == 0) {
        if (n_in != 12 || in_sizes[0] != T * DM || out_size != T * DM || ws_size < WS_END) {
            fprintf(stderr, "kernel_launch: unexpected shapes (n_in %d, in0 %d, out %d, ws %zu, need %zu); nothing launched\n", n_in, n_in > 0 ? in_sizes[0] : -1, out_size, ws_size, (size_t)WS_END); grid = -1; return; }
        int dev = 0, cus = 0, per_cu = 0;
        if (hipGetDevice(&dev) != hipSuccess || hipDeviceGetAttribute(&cus, hipDeviceAttributeMultiprocessorCount, dev) != hipSuccess) { fprintf(stderr, "kernel_launch: device query failed\n"); grid = -1; return; }
        if (hipFuncSetAttribute((const void*)hymba_fwd, hipFuncAttributeMaxDynamicSharedMemorySize, LDS_BYTES) != hipSuccess) { fprintf(stderr, "kernel_launch: hipFuncSetAttribute failed\n"); grid = -1; return; }
        if (hipOccupancyMaxActiveBlocksPerMultiprocessor(&per_cu, (const void*)hymba_fwd, NTHR, LDS_BYTES) != hipSuccess || per_cu < 1) {
            fprintf(stderr, "kernel_launch: occupancy query reports %d workgroups per CU; nothing launched\n", per_cu); (void)hipGetLastError(); grid = -1; return; }
        grid = cus;
        fprintf(stderr, "kernel_launch: grid %d x %d threads, %d B LDS, occupancy query %d/CU\n", grid, NTHR, LDS_BYTES, per_cu);
    }
    if (grid < 0) return;
    if (hipMemsetAsync((char*)d_ws + WS_CTL, 0, CTL_ZERO_BYTES, stream) != hipSuccess) { fprintf(stderr, "kernel_launch: memset failed\n"); return; }
    Args a{};
    for (int i = 0; i < 12; ++i) a.in[i] = (const float*)d_in[i];
    a.out = (float*)d_out; a.ws = (unsigned char*)d_ws;
    if (N_LAUNCHES == 1) {
        a.ph_lo = 0; a.ph_hi = NPHASE; a.li = 0;
        void* kargs[] = {&a};
        hipError_t e = hipLaunchCooperativeKernel((const void*)hymba_fwd, dim3(grid), dim3(NTHR), kargs, LDS_BYTES, stream);
        if (e != hipSuccess) fprintf(stderr, "kernel_launch: cooperative launch failed: %s\n", hipGetErrorString(e));
    } else {
        for (int p = 0; p < NPHASE; ++p) { a.ph_lo = p; a.ph_hi = p + 1; a.li = p;
            hipLaunchKernelGGL(hymba_fwd, dim3(grid), dim3(NTHR), LDS_BYTES, stream, a);
            if (hipPeekAtLastError() != hipSuccess) { fprintf(stderr, "kernel_launch: launch %d failed\n", p); break; } }
    }
}
```

```cpp
#include <hip/hip_runtime.h>
#include <cstdio>
#include <cstdint>
#include <cmath>

#ifndef PROBE_DUP
#define PROBE_DUP 0
#endif
#ifndef MK_N_LAUNCHES
#define MK_N_LAUNCHES 1
#endif

namespace pg8 {
#define PG8_LAS __attribute__((address_space(3)))
typedef unsigned short bf16_t;
typedef short bf16x8 __attribute__((ext_vector_type(8)));
typedef float f32x4 __attribute__((ext_vector_type(4)));
typedef unsigned u32x4 __attribute__((ext_vector_type(4)));
constexpr int BM = 256, BK = 64, HALF = 128, HTB = HALF * BK * 2  , STAGE_BYTES = 8 * HTB, NXCD = 8, WGM = 8;

__host__ __device__ __forceinline__ int lds_byte(int r, int c) { const int st = (r >> 4) * 2 + (c >> 5), rr = r & 15, cc = c & 31, ob = rr * 64 + cc * 2; return st * 1024 + (ob ^ (((ob >> 9) & 1) << 5)); }
__host__ __device__ __forceinline__ void stage_rc(int b, int& R, int& C) { const int st = b / 1024, sb = b % 1024, swz = sb ^ (((sb >> 9) & 1) << 5); R = (st >> 1) * 16 + swz / 64; C = (st & 1) * 32 + (swz % 64) / 2; }
__host__ __device__ __forceinline__ int perm32(int rho) { const int n = rho >> 4, i = rho & 15; return 8 * (i >> 2) + 4 * n + (i & 3); }

struct Unit { int pm, pn; };
struct Gemm { const bf16_t* A; const bf16_t* Bt; int M, N, K; };

struct StaticOrder {
    int nM, nN, nwg, G, c;
    __host__ __device__ void init(int M, int N, int G_, int c_) { nM = M / BM; nN = N / BM; nwg = nM * nN; G = G_; c = c_; }
    __host__ __device__ bool next(int i, Unit& u) const {
        const long L = (long)i * G + c; if (L >= nwg) return false;
        int wgid = (int)L; { const int q = nwg / NXCD, r = nwg % NXCD, xcd = wgid % NXCD, off = wgid / NXCD; wgid = (xcd < r ? xcd * (q + 1) : r * (q + 1) + (xcd - r) * q) + off; }
        const int nig = WGM * nN, gid = wgid / nig, fm = gid * WGM, gsz = (nM - fm) < WGM ? (nM - fm) : WGM;
        u.pm = fm + ((wgid % nig) % gsz); u.pn = (wgid % nig) / gsz; return true;
    }
    __device__ __forceinline__ void a_ready(const Unit&) const {}
    __device__ __forceinline__ void done(const Unit&) const {}
};

__device__ __forceinline__ unsigned cvt_pk_bf16(float lo, float hi) { unsigned r; asm volatile("v_cvt_pk_bf16_f32 %0, %1, %2" : "=v"(r) : "v"(lo), "v"(hi)); return r; }

typedef unsigned u32x2 __attribute__((ext_vector_type(2)));
struct EpiZ {
    bf16_t* Z; int ldz; const float* ssq; float* G32; int gcol0;
    __device__ __forceinline__ void operator()(const f32x4 (&acc)[2][2][4][2], const Unit& u, int wr, int wc, int fr, int fq) const {
        const int row0 = u.pm * BM + wr * 64 + fr, col0 = u.pn * BM + wc * 32 + 8 * fq;
#pragma unroll
        for (int ai = 0; ai < 2; ++ai)
#pragma unroll
            for (int m = 0; m < 4; ++m) {
                const int row = row0 + ai * HALF + m * 16;
                const float rs = 1.0f / sqrtf(ssq[row] * (1.0f / 1024.0f) + 1e-6f);
#pragma unroll
                for (int bj = 0; bj < 2; ++bj) {
                    const int col = col0 + bj * HALF;
                    const f32x4 v0 = acc[ai][bj][m][0] * rs, v1 = acc[ai][bj][m][1] * rs;
                    if (col < ldz) {
                        u32x4 w; w.x = cvt_pk_bf16(v0[0], v0[1]); w.y = cvt_pk_bf16(v0[2], v0[3]); w.z = cvt_pk_bf16(v1[0], v1[1]); w.w = cvt_pk_bf16(v1[2], v1[3]);
                        *(u32x4*)(Z + (size_t)(col >> 6) * ((size_t)16384 * 64) + (size_t)row * 64 + (col & 63)) = w;
                    } else if (col < gcol0 + 32) {
                        float* gp = G32 + (size_t)row * 32 + (col - gcol0);
                        *(f32x4*)gp = v0; *(f32x4*)(gp + 4) = v1;
                    }
                }
            }
    }
};
struct EpiRes {
    const float* base; const bf16_t* baseb; float* out; bf16_t* xb; float* ssq;
    __device__ __forceinline__ void ldres(int row, int col0, int bj, f32x4& r0, f32x4& r1) const {
        const size_t off = (size_t)row * 1024 + col0 + bj * HALF;
        if (base) { r0 = *(const f32x4*)(base + off); r1 = *(const f32x4*)(base + off + 4); }
        else { const u32x4 w = *(const u32x4*)(baseb + off);
            r0 = (f32x4){__uint_as_float(w.x << 16), __uint_as_float(w.x & 0xffff0000u), __uint_as_float(w.y << 16), __uint_as_float(w.y & 0xffff0000u)};
            r1 = (f32x4){__uint_as_float(w.z << 16), __uint_as_float(w.z & 0xffff0000u), __uint_as_float(w.w << 16), __uint_as_float(w.w & 0xffff0000u)}; }
    }
    __device__ __forceinline__ void operator()(const f32x4 (&acc)[2][2][4][2], const Unit& u, int wr, int wc, int fr, int fq) const {
        const int col0 = u.pn * BM + wc * 32 + 8 * fq;
        f32x4 pre[2][2];
        { const int row = u.pm * BM + wr * 64 + fr;
#pragma unroll
          for (int bj = 0; bj < 2; ++bj) ldres(row, col0, bj, pre[bj][0], pre[bj][1]); }
#pragma unroll
        for (int g = 0; g < 8; ++g) {
            const int ai = g >> 2, m = g & 3;
            const int row = u.pm * BM + ai * HALF + wr * 64 + m * 16 + fr;
            f32x4 nxt[2][2];
            if (g < 7) { const int row2 = u.pm * BM + ((g + 1) >> 2) * HALF + wr * 64 + ((g + 1) & 3) * 16 + fr;
#pragma unroll
                for (int bj = 0; bj < 2; ++bj) ldres(row2, col0, bj, nxt[bj][0], nxt[bj][1]); }
            asm volatile("" ::: "memory");
            float s = 0.f;
#pragma unroll
            for (int bj = 0; bj < 2; ++bj) {
                const size_t off = (size_t)row * 1024 + col0 + bj * HALF;
                const f32x4 o0 = pre[bj][0] + acc[ai][bj][m][0], o1 = pre[bj][1] + acc[ai][bj][m][1];
                if (out) { *(f32x4*)(out + off) = o0; *(f32x4*)(out + off + 4) = o1; }
                s += (o0[0] * o0[0] + o0[1] * o0[1]) + (o0[2] * o0[2] + o0[3] * o0[3]) + (o1[0] * o1[0] + o1[1] * o1[1]) + (o1[2] * o1[2] + o1[3] * o1[3]);
                if (xb) { u32x4 w; w.x = cvt_pk_bf16(o0[0], o0[1]); w.y = cvt_pk_bf16(o0[2], o0[3]); w.z = cvt_pk_bf16(o1[0], o1[1]); w.w = cvt_pk_bf16(o1[2], o1[3]); *(u32x4*)(xb + off) = w; }
            }
            s += __shfl_xor(s, 16); s += __shfl_xor(s, 32);
            if (fq == 0) atomicAdd(ssq + row, s);
            asm volatile("" ::: "memory");
            if (g < 7) {
#pragma unroll
                for (int bj = 0; bj < 2; ++bj) { pre[bj][0] = nxt[bj][0]; pre[bj][1] = nxt[bj][1]; } }
        }
    }
};
struct EpiBoth {
    static constexpr bool PERM = true, AFTER_DRAIN = false;
    int mode; EpiZ z; EpiRes r;
    __device__ __forceinline__ void operator()(const f32x4 (&acc)[2][2][4][2], const Unit& u, int wr, int wc, int fr, int fq) const {
        if (mode == 0) z(acc, u, wr, wc, fr, fq); else r(acc, u, wr, wc, fr, fq);
    }
};

template <class Epi, class Sched, bool ALIGN_EPI = false, bool SP2 = false>
__device__ __forceinline__ void gemm_phase(PG8_LAS unsigned char* lds, const Gemm g, const Sched& S, const Epi& E) {
    int tid_ = threadIdx.x; asm volatile("" : "+v"(tid_));
    const int tid = tid_, wid = __builtin_amdgcn_readfirstlane(tid >> 6), lane = tid & 63, wr = wid >> 2, wc = wid & 3, fr = lane & 15, fq = lane >> 4;
    const int K = g.K, nt = K / BK;
    unsigned voffA[2], voffB[2];
#pragma unroll
    for (int i = 0; i < 2; ++i) { int R, C; stage_rc(tid * 16 + i * 8192, R, C); const int Rb = Epi::PERM ? ((R & ~31) + perm32(R & 31)) : R;
        voffA[i] = (unsigned)(R * K + C) * 2u; voffB[i] = (unsigned)(Rb * K + C) * 2u; }
    const size_t kstep = (size_t)(BK * 2);
    const size_t hstep = (size_t)HALF * K * 2;
    const size_t tstep = 2 * hstep;
    const unsigned ldsw = (unsigned)wid * 1024u;
    const int aoff = lds_byte(wr * 64 + fr, fq * 8), boff = lds_byte(wc * 32 + fr, fq * 8);
#define PG8_SA(b, h) (((b) * 2 + (h)) * HTB)
#define PG8_SB(b, h) ((4 + (b) * 2 + (h)) * HTB)
#define PG8_STAGE(bufoff, gbase, voff) do { _Pragma("unroll") for (int _i = 0; _i < 2; ++_i) \
        __builtin_amdgcn_global_load_lds((const unsigned*)((const char*)(gbase) + (voff)[_i]), (PG8_LAS unsigned*)(lds + (bufoff) + ldsw + _i * 8192), 16, 0, 0); } while (0)
#define PG8_LDA(dst, b, h) do { _Pragma("unroll") for (int m = 0; m < 4; ++m) _Pragma("unroll") for (int k = 0; k < 2; ++k) dst[m][k] = *(const PG8_LAS bf16x8*)(lds + PG8_SA(b, h) + aoff + m * 2048 + k * 1024); } while (0)
#define PG8_LDB(dst, b, h) do { _Pragma("unroll") for (int n = 0; n < 2; ++n) _Pragma("unroll") for (int k = 0; k < 2; ++k) dst[n][k] = *(const PG8_LAS bf16x8*)(lds + PG8_SB(b, h) + boff + n * 2048 + k * 1024); } while (0)
#define PG8_MMA(ai, bj, At, Bt) do { __builtin_amdgcn_s_setprio(1); _Pragma("unroll") for (int m = 0; m < 4; ++m) _Pragma("unroll") for (int n = 0; n < 2; ++n) _Pragma("unroll") for (int k = 0; k < 2; ++k) \
        acc[ai][bj][m][n] = __builtin_amdgcn_mfma_f32_16x16x32_bf16(Bt[n][k], At[m][k], acc[ai][bj][m][n], 0, 0, 0); __builtin_amdgcn_s_setprio(0); } while (0)
#define PG8_WAIT_V(n) asm volatile("s_waitcnt vmcnt(" #n ")" ::: "memory")
#define PG8_WAIT_L(n) asm volatile("s_waitcnt lgkmcnt(" #n ")" ::: "memory")
#define PG8_BAR __builtin_amdgcn_s_barrier()
#define PG8_SCHED __builtin_amdgcn_sched_barrier(0)
    Unit cur, nxt; int ui = 0;
    if (!S.next(0, cur)) return;
    f32x4 acc[2][2][4][2];
#pragma unroll
    for (int a = 0; a < 2; ++a)
#pragma unroll
        for (int b = 0; b < 2; ++b)
#pragma unroll
            for (int m = 0; m < 4; ++m)
#pragma unroll
                for (int n = 0; n < 2; ++n) acc[a][b][m][n] = (f32x4){0.f, 0.f, 0.f, 0.f};
    bf16x8 At[4][2], B0[2][2], B1[2][2];
    const char* cA = (const char*)g.A + (size_t)cur.pm * tstep; const char* cB = (const char*)g.Bt + (size_t)cur.pn * tstep;
    S.a_ready(cur);
    if constexpr (SP2) {
        PG8_STAGE(PG8_SB(0, 0), cB, voffB); PG8_STAGE(PG8_SB(0, 1), cB + hstep, voffB); PG8_STAGE(PG8_SA(0, 0), cA, voffA); PG8_STAGE(PG8_SA(0, 1), cA + hstep, voffA);
        if (wr == 1) PG8_BAR;
        PG8_WAIT_V(2); PG8_BAR;
        PG8_STAGE(PG8_SB(1, 0), cB + kstep, voffB); PG8_STAGE(PG8_SA(1, 0), cA + kstep, voffA); PG8_STAGE(PG8_SB(1, 1), cB + hstep + kstep, voffB);
        PG8_WAIT_V(6); PG8_BAR;
    } else {
        PG8_STAGE(PG8_SB(0, 0), cB, voffB); PG8_STAGE(PG8_SA(0, 0), cA, voffA); PG8_STAGE(PG8_SB(0, 1), cB + hstep, voffB); PG8_STAGE(PG8_SA(0, 1), cA + hstep, voffA);
        if (wr == 1) PG8_BAR;
        PG8_WAIT_V(4); PG8_BAR;
        PG8_STAGE(PG8_SB(1, 0), cB + kstep, voffB); PG8_STAGE(PG8_SA(1, 0), cA + kstep, voffA); PG8_STAGE(PG8_SB(1, 1), cB + hstep + kstep, voffB);
        PG8_WAIT_V(6); PG8_BAR;
    }
    for (;;) {
        const bool has_next = S.next(ui + 1, nxt);
        const char* nA = has_next ? (const char*)g.A + (size_t)nxt.pm * tstep : cA; const char* nB = has_next ? (const char*)g.Bt + (size_t)nxt.pn * tstep : cB;
        for (int t = 0; t < nt; t += 2) {
            const bool last = (t == nt - 2);
            const char* a1 = cA + (size_t)(t + 1) * kstep;
            const char* a2 = last ? nA : cA + (size_t)(t + 2) * kstep; const char* b2 = last ? nB : cB + (size_t)(t + 2) * kstep;
            const char* a3 = a2 + kstep; const char* b3 = b2 + kstep;
            if (last && has_next) S.a_ready(nxt);
            if constexpr (SP2) {
            PG8_LDB(B0, 0, 0); PG8_LDB(B1, 0, 1); PG8_SCHED; PG8_LDA(At, 0, 0); PG8_STAGE(PG8_SA(1, 1), a1 + hstep, voffA);
            PG8_WAIT_V(8); PG8_WAIT_L(0); PG8_BAR; PG8_MMA(0, 0, At, B0); PG8_MMA(0, 1, At, B1); PG8_BAR; PG8_SCHED;
            PG8_LDA(At, 0, 1); PG8_STAGE(PG8_SB(0, 0), b2, voffB); PG8_STAGE(PG8_SB(0, 1), b2 + hstep, voffB); PG8_STAGE(PG8_SA(0, 0), a2, voffA);
            PG8_WAIT_V(8); PG8_WAIT_L(0); PG8_BAR; PG8_MMA(1, 0, At, B0); PG8_MMA(1, 1, At, B1); PG8_BAR; PG8_SCHED;
            PG8_LDB(B0, 1, 0); PG8_LDB(B1, 1, 1); PG8_SCHED; PG8_LDA(At, 1, 0); PG8_STAGE(PG8_SA(0, 1), a2 + hstep, voffA);
            PG8_WAIT_V(8); PG8_WAIT_L(0); PG8_BAR; PG8_MMA(0, 0, At, B0); PG8_MMA(0, 1, At, B1); PG8_BAR; PG8_SCHED;
            PG8_LDA(At, 1, 1); PG8_STAGE(PG8_SB(1, 0), b3, voffB); PG8_STAGE(PG8_SB(1, 1), b3 + hstep, voffB); PG8_STAGE(PG8_SA(1, 0), a3, voffA);
            PG8_WAIT_V(8); PG8_WAIT_L(0); PG8_BAR; PG8_MMA(1, 0, At, B0); PG8_MMA(1, 1, At, B1); PG8_BAR; PG8_SCHED;
            } else {
            PG8_LDB(B0, 0, 0); PG8_SCHED; PG8_LDA(At, 0, 0); PG8_STAGE(PG8_SA(1, 1), a1 + hstep, voffA);
            PG8_WAIT_L(8); PG8_BAR; PG8_WAIT_L(0); PG8_MMA(0, 0, At, B0); PG8_BAR; PG8_SCHED;
            PG8_LDB(B1, 0, 1); PG8_STAGE(PG8_SB(0, 0), b2, voffB);
            PG8_BAR; PG8_WAIT_L(0); PG8_MMA(0, 1, At, B1); PG8_BAR;
            PG8_LDA(At, 0, 1); PG8_STAGE(PG8_SA(0, 0), a2, voffA);
            PG8_BAR; PG8_WAIT_L(0); PG8_MMA(1, 0, At, B0); PG8_BAR; PG8_SCHED;
            PG8_STAGE(PG8_SB(0, 1), b2 + hstep, voffB);
            PG8_WAIT_V(6); PG8_BAR; PG8_MMA(1, 1, At, B1); PG8_BAR;
            PG8_LDB(B0, 1, 0); PG8_SCHED; PG8_LDA(At, 1, 0); PG8_STAGE(PG8_SA(0, 1), a2 + hstep, voffA);
            PG8_WAIT_L(8); PG8_BAR; PG8_WAIT_L(0); PG8_MMA(0, 0, At, B0); PG8_BAR; PG8_SCHED;
            PG8_LDB(B1, 1, 1); PG8_STAGE(PG8_SB(1, 0), b3, voffB);
            PG8_BAR; PG8_WAIT_L(0); PG8_MMA(0, 1, At, B1); PG8_BAR;
            PG8_LDA(At, 1, 1); PG8_STAGE(PG8_SA(1, 0), a3, voffA);
            PG8_BAR; PG8_WAIT_L(0); PG8_MMA(1, 0, At, B0); PG8_BAR; PG8_SCHED;
            PG8_STAGE(PG8_SB(1, 1), b3 + hstep, voffB);
            PG8_WAIT_V(6); PG8_BAR; PG8_MMA(1, 1, At, B1); PG8_BAR;
            }
        }
        if constexpr (ALIGN_EPI) { if (wr == 0) PG8_BAR; }
        if constexpr (!Epi::AFTER_DRAIN) { E(acc, cur, wr, wc, fr, fq); S.done(cur); }
        if (!has_next) break;
#pragma unroll
        for (int a = 0; a < 2; ++a)
#pragma unroll
            for (int b = 0; b < 2; ++b)
#pragma unroll
                for (int m = 0; m < 4; ++m)
#pragma unroll
                    for (int n = 0; n < 2; ++n) acc[a][b][m][n] = (f32x4){0.f, 0.f, 0.f, 0.f};
        cur = nxt; cA = nA; cB = nB; ++ui;
        if constexpr (ALIGN_EPI) { if (wr == 1) PG8_BAR; }
    }
    PG8_WAIT_V(0);
    if constexpr (!ALIGN_EPI) { if (wr == 0) PG8_BAR; }
    PG8_BAR;
    if constexpr (Epi::AFTER_DRAIN) { E.fused(acc, cur, wr, wc, fr, fq, lds, wid, lane); S.done(cur); }
#undef PG8_SA
#undef PG8_SB
#undef PG8_STAGE
#undef PG8_LDA
#undef PG8_LDB
#undef PG8_MMA
#undef PG8_WAIT_V
#undef PG8_WAIT_L
#undef PG8_BAR
#undef PG8_SCHED
}
}

constexpr int NWAVES = 8, NTHR = 512;
constexpr int N_LAUNCHES = MK_N_LAUNCHES;
constexpr int NPHASE = 12;
constexpr int BATCH = 2, SEQ = 8192, DM = 1024, T = BATCH * SEQ, DEPTH = 2, CH = 64, NCHT = T / CH  , NCHS = SEQ / CH  ;
constexpr int DIN = 4252, NP = 4352, LDZ = 4224;
constexpr int ZC_AQ = 0, ZC_AK = 384, ZC_AV = 768, ZC_AG = 1152, ZC_MQ = 1536, ZC_MK = 1920, ZC_MV = 2304, ZC_MO = 2688, ZC_MG = 3072, ZC_GQ = 3456, ZC_GK = 3584, ZC_GV = 3712, ZC_GG = 3968, ZC_SM = 4224;
constexpr float EPS = 1e-6f;
__host__ __device__ __forceinline__ int src_col(int n) {
    if (n < 3072) return n;
    if (n < 3968) return n + 12;
    if (n < 4224) return n + 28;
    if (n < 4236) return n - 1152;
    if (n < 4252) return n - 256;
    return -1;
}

constexpr size_t MiB = 1u << 20;
constexpr size_t WS_CTL = 0, CTL_ZERO_BYTES = 1 * MiB;
constexpr size_t WS_SSQ = 512 * 1024;
constexpr size_t WS_WIN = 1 * MiB;
constexpr size_t WS_WOUT = WS_WIN + (size_t)2 * NP * DM * 2;
constexpr size_t WS_XB = WS_WOUT + (size_t)2 * DM * DM * 2;
constexpr size_t WS_Y = WS_XB + (size_t)T * DM * 2;
constexpr size_t WS_Z = WS_Y + (size_t)T * DM * 2;
constexpr size_t WS_G32 = WS_Z + (size_t)T * LDZ * 2;
constexpr size_t WS_CST = WS_G32 + (size_t)T * 32 * 4;
constexpr size_t WS_NST = WS_CST + (size_t)NCHT * 6 * 4096 * 4;
constexpr size_t WS_SST = WS_NST + (size_t)NCHT * 6 * 64 * 4;
constexpr size_t WS_ADEC = WS_SST + (size_t)NCHT * 4 * 2048 * 4;
constexpr size_t WS_GS = WS_ADEC + (size_t)NCHT * 4 * 32 * 4;
constexpr size_t WS_MS = WS_GS + 8192;
constexpr size_t WS_MP = WS_MS + 8192;
constexpr size_t WS_END = WS_MP + 8192;
static_assert(WS_END <= 268435456, "d_ws map exceeds 256 MiB");
constexpr int CW_BAR = 4096;

constexpr int RING_OFF = 0, RING_BYTES = 162816;
constexpr int WL_BYTES = 20352;
constexpr int LDSCTL_OFF = RING_BYTES, MISC_OFF = LDSCTL_OFF + 320;
constexpr int LDS_BYTES = 163840;
#define GAS __attribute__((address_space(1)))
#define LAS __attribute__((address_space(3)))
typedef unsigned short bf16;
typedef unsigned v4u __attribute__((ext_vector_type(4)));
typedef float f32x4 __attribute__((ext_vector_type(4)));
typedef short bf16x8 __attribute__((ext_vector_type(8)));
typedef GAS unsigned gu32;
typedef GAS unsigned long long gu64;
#define RLX_AGENT __ATOMIC_RELAXED, __HIP_MEMORY_SCOPE_AGENT
#define LDS_WAIT() asm volatile("s_waitcnt lgkmcnt(0)" ::: "memory")
#define VM_WAIT() asm volatile("s_waitcnt vmcnt(0)" ::: "memory")
__device__ __forceinline__ unsigned long long rt() { return __builtin_amdgcn_s_memrealtime(); }
__device__ __forceinline__ unsigned f2bf(float f) { unsigned u = __builtin_bit_cast(unsigned, f); return (u + 0x7fffu + ((u >> 16) & 1u)) >> 16; }
__device__ __forceinline__ unsigned pk2(float lo, float hi) { return f2bf(lo) | (f2bf(hi) << 16); }

#define XB_TMO      128
#define XB_XCNT(j)  (256  + 64 * (j))
#define XB_XSUB(j)  (1280 + 64 * (j))
#define XB_XGEN(j)  (2304 + 64 * (j))
#define XB_TOP      3328
#define XB_TOPGEN   3392
#define XCD_BAR_WORDS 3456
#define XB_SPIN_CAP (1u << 18)

__device__ __forceinline__ unsigned xb_ld(unsigned* p)              { return __hip_atomic_load(p, __ATOMIC_RELAXED, __HIP_MEMORY_SCOPE_AGENT); }
__device__ __forceinline__ unsigned xb_add(unsigned* p, unsigned v) { return __hip_atomic_fetch_add(p, v, __ATOMIC_RELAXED, __HIP_MEMORY_SCOPE_AGENT); }
__device__ __forceinline__ unsigned xb_xcc_id() { return (unsigned)__builtin_amdgcn_s_getreg((3 << 11) | 20) & 0xFu; }
#define XB_SPIN(cond, bar) do { unsigned _sp = 0; while (cond) { __builtin_amdgcn_s_sleep(1); \
    if ((++_sp & 255u) == 0u) { if (xb_ld(&(bar)[XB_TMO])) break; if (_sp > XB_SPIN_CAP) { atomicAdd(&(bar)[XB_TMO], 1u); break; } } } } while (0)

struct XcdBarrier {
    unsigned* bar; unsigned x;
    volatile LAS unsigned* st;
};

__device__ __forceinline__ XcdBarrier xcd_barrier_post(unsigned* bar, volatile LAS unsigned* st) {
    XcdBarrier b; b.bar = bar; b.x = xb_xcc_id(); b.st = st;
    if (threadIdx.x == 0) (void)xb_add(&bar[XB_XCNT(b.x)], 1u);
    return b;
}
__device__ __forceinline__ void xcd_barrier_complete(unsigned* bar, unsigned x, unsigned& nloc, unsigned& nx) {
    const unsigned G = gridDim.x * gridDim.y * gridDim.z;
    unsigned sum, cnt, mine, sp = 0u;
    for (;;) {
        sum = 0u; cnt = 0u; mine = 0u;
#pragma unroll 1
        for (unsigned j = 0; j < 16; ++j) { const unsigned c = xb_ld(&bar[XB_XCNT(j)]); sum += c; cnt += (c > 0u) ? 1u : 0u; mine = (j == x) ? c : mine; }
        if (sum == G) break;
        __builtin_amdgcn_s_sleep(1);
        if ((++sp & 255u) == 0u) { if (xb_ld(&bar[XB_TMO])) break; if (sp > XB_SPIN_CAP) { atomicAdd(&bar[XB_TMO], 1u); break; } }
    }
    nloc = mine > 0u ? mine : 1u; nx = cnt > 0u ? cnt : 1u;
}

__device__ __forceinline__ void xcd_barrier(const XcdBarrier& b) {
    asm volatile("s_waitcnt vmcnt(0)" ::: "memory");
    __syncthreads();
    if (threadIdx.x == 0) {
        unsigned* bar = b.bar;
        __builtin_amdgcn_s_waitcnt(0);
        unsigned nloc = b.st[0], nx = b.st[1];
        if (nloc == 0u) { xcd_barrier_complete(bar, b.x, nloc, nx); b.st[0] = nloc; b.st[1] = nx; }
        const unsigned old = xb_add(&bar[XB_XSUB(b.x)], 1u);
        const unsigned gen = old / nloc;
        if (old + 1u == (gen + 1u) * nloc) {
            __builtin_amdgcn_fence(__ATOMIC_RELEASE, "agent");
            asm volatile("s_waitcnt vmcnt(0)" ::: "memory");
            const unsigned og = xb_add(&bar[XB_TOP], 1u);
            const unsigned tg = og / nx;
            if (og + 1u == (tg + 1u) * nx) xb_add(&bar[XB_TOPGEN], 1u);
            else XB_SPIN(xb_ld(&bar[XB_TOPGEN]) == tg, bar);
            __builtin_amdgcn_fence(__ATOMIC_ACQUIRE, "agent");
            xb_add(&bar[XB_XGEN(b.x)], 1u);
            asm volatile("s_waitcnt vmcnt(0)" ::: "memory");
        } else {
            XB_SPIN(xb_ld(&bar[XB_XGEN(b.x)]) == gen, bar);
            __builtin_amdgcn_fence(__ATOMIC_ACQUIRE, "agent");
            asm volatile("s_waitcnt vmcnt(0)" ::: "memory");
        }
    }
    __syncthreads();
}


struct Args { const float* in[12]; float* out; unsigned char* ws; int ph_lo, ph_hi, li, pad; };
struct Frame {
    LAS unsigned char* lds;
    volatile LAS unsigned* MISC;
    const Args* A;
    int wave, vcu, G;
};
__device__ __forceinline__ int opaque_tid() { int t = threadIdx.x; asm volatile("" : "+v"(t)); return t; }
#define F_tid (opaque_tid())
#define F_lane (opaque_tid() & 63)
__device__ __forceinline__ const Args* opaque_args(const Args* a) { unsigned long long v = (unsigned long long)a; asm volatile("" : "+s"(v)); return (const Args*)v; }
#define F_A (F.A)
#define F_x          (F_A->in[0])
#define F_norm_g     (F_A->in[1])
#define F_w_in       (F_A->in[2])
#define F_b_gates    (F_A->in[3])
#define F_conv_w     (F_A->in[4])
#define F_w_alpha    (F_A->in[5])
#define F_b_alpha    (F_A->in[6])
#define F_rel_bias   (F_A->in[7])
#define F_ml_norm_g  (F_A->in[8])
#define F_gla_norm_g (F_A->in[9])
#define F_w_out      (F_A->in[10])
#define F_final_g    (F_A->in[11])
#define F_out        (F_A->out)
#define F_ws         (F_A->ws)
#define F_ctl        ((gu32*)(F_ws + WS_CTL))
#define F_Win_t      ((bf16*)(F_ws + WS_WIN))
#define F_Wout_t     ((bf16*)(F_ws + WS_WOUT))
#define F_XB         ((bf16*)(F_ws + WS_XB))
#define F_Y          ((bf16*)(F_ws + WS_Y))
#define F_Z          ((bf16*)(F_ws + WS_Z))
#define F_G32        ((float*)(F_ws + WS_G32))
#define F_SSQ        ((float*)(F_ws + WS_SSQ))
#define F_CST        ((float*)(F_ws + WS_CST))
#define F_NST        ((float*)(F_ws + WS_NST))
#define F_SST        ((float*)(F_ws + WS_SST))
#define F_ADEC       ((float*)(F_ws + WS_ADEC))
#define F_GS         ((float*)(F_ws + WS_GS))
#define F_MS         ((float*)(F_ws + WS_MS))
#define F_MP         ((float*)(F_ws + WS_MP))
#define F_BC         (F_out)
#define F_CPB        ((bf16*)(F_out + (size_t)T * 128))
__device__ __forceinline__ float bf2f(unsigned short u) { return __uint_as_float((unsigned)u << 16); }
__device__ __forceinline__ float wave_sum(float v) {
#pragma unroll
    for (int o = 1; o < 64; o <<= 1) v += __shfl_xor(v, o);
    return v;
}
__device__ __forceinline__ float siluf(float x) { return x / (1.0f + expf(-x)); }
__device__ __forceinline__ float sigmf(float x) { return 1.0f / (1.0f + expf(-x)); }
__device__ __forceinline__ float logsigf(float x) { return fminf(x, 0.f) - log1pf(expf(-fabsf(x))); }
__device__ __forceinline__ void ld8(const bf16* p, float* o) {
    const v4u w = *(const v4u*)p;
    o[0] = __uint_as_float(w.x << 16); o[1] = __uint_as_float(w.x & 0xffff0000u); o[2] = __uint_as_float(w.y << 16); o[3] = __uint_as_float(w.y & 0xffff0000u);
    o[4] = __uint_as_float(w.z << 16); o[5] = __uint_as_float(w.z & 0xffff0000u); o[6] = __uint_as_float(w.w << 16); o[7] = __uint_as_float(w.w & 0xffff0000u);
}

template <bool PERMUTE>
__device__ __forceinline__ void p0_transpose_item(const float* W, int Nsrc, int Ndst, const float* gk, bf16* WT, LAS float* scr, int item, int lane) {
    const int nblk = Ndst / 32, kb = item / nblk, nb = item % nblk, k0 = 64 * kb, n0 = 32 * nb;
    const int nd = n0 + (lane & 31), ns = PERMUTE ? src_col(nd) : nd;
#pragma unroll 8
    for (int i = 0; i < 32; ++i) { const int kk = 2 * i + (lane >> 5);
        float v = 0.f; if (ns >= 0) { v = W[(size_t)(k0 + kk) * Nsrc + ns]; if (gk) v *= gk[k0 + kk]; }
        scr[kk * 33 + (lane & 31)] = v; }
    LDS_WAIT(); asm volatile("" ::: "memory");
    const int c = lane & 7;
#pragma unroll
    for (int j = 0; j < 4; ++j) { const int n = (lane >> 3) + 8 * j; const LAS float* s = scr + (8 * c) * 33 + n;
        v4u o; o.x = pk2(s[0 * 33], s[1 * 33]); o.y = pk2(s[2 * 33], s[3 * 33]); o.z = pk2(s[4 * 33], s[5 * 33]); o.w = pk2(s[6 * 33], s[7 * 33]);
        *(GAS v4u*)(WT + (size_t)(n0 + n) * 1024 + k0 + 8 * c) = o; }
    LDS_WAIT(); asm volatile("" ::: "memory");
}
__device__ __forceinline__ void p0_weights(Frame& F, int l, int wi, int nw) {
    LAS float* scr = (LAS float*)(F.lds + RING_OFF + F.wave * 16384);
    constexpr int I_IN = 16 * (NP / 32), I_OUT = 16 * (DM / 32);
    for (int it = wi; it < I_IN + I_OUT; it += nw) {
        if (it < I_IN) p0_transpose_item<true>(F_w_in + (size_t)l * DM * DIN, DIN, NP, F_norm_g + l * DM, F_Win_t + (size_t)l * NP * DM, scr, it, F_lane);
        else p0_transpose_item<false>(F_w_out + (size_t)l * DM * DM, DM, DM, nullptr, F_Wout_t + (size_t)l * DM * DM, scr, it - I_IN, F_lane);
    }
}
__device__ __forceinline__ void p0_prologue(Frame& F) {
    int gw_ = F.vcu * NWAVES + F.wave; asm volatile("" : "+s"(gw_));
    const int gw = gw_, NGW = F.G * NWAVES;
    p0_weights(F, 0, gw, NGW);
    if (F.G != 256) p0_weights(F, 1, gw, NGW);
    for (int m = gw; m < T; m += NGW) {
        const GAS f32x4* xr = (const GAS f32x4*)(F_x + (size_t)m * DM) + F_lane;
        GAS unsigned long long* o8 = (GAS unsigned long long*)(F_XB + (size_t)m * DM) + F_lane;
        float s = 0.f;
#pragma unroll
        for (int j = 0; j < 4; ++j) { const f32x4 v = xr[64 * j]; s += (v.x * v.x + v.y * v.y) + (v.z * v.z + v.w * v.w);
            o8[64 * j] = (unsigned long long)pk2(v.x, v.y) | ((unsigned long long)pk2(v.z, v.w) << 32); }
        s = wave_sum(s);
        if (F_lane == 0) F_SSQ[m] = s;
    }
}

constexpr int LP = 65;
__device__ __forceinline__ void stage_conv(Frame& F, int layer, int b, int n, int zcol, int wch, float scale, LAS float* dst) {
    const float* cw = F_conv_w + (size_t)layer * 4 * 768;
    const int r0 = b * SEQ + n * CH;
    for (int idx = F_tid; idx < 4096; idx += NTHR) {
        const int t = idx >> 6, c = idx & 63;
        float a = 0.f;
#pragma unroll
        for (int j = 0; j < 4; ++j) { const int tt = t + j - 3;
            if (n * CH + tt >= 0) a += bf2f(F_Z[(size_t)(r0 + tt) * LDZ + zcol + c]) * cw[j * 768 + wch + c]; }
        dst[t * LP + c] = siluf(a) * scale;
    }
}
__device__ __forceinline__ void stage_tile(Frame& F, int b, int n, int zcol, int W, float scale, LAS float* dst, int pitch) {
    const int r0 = b * SEQ + n * CH;
    for (int idx = F_tid; idx < 64 * W; idx += NTHR) { const int t = idx / W, c = idx % W; dst[t * pitch + c] = bf2f(F_Z[(size_t)(r0 + t) * LDZ + zcol + c]) * scale; }
}
__device__ __forceinline__ void stage_mgates(Frame& F, int layer, int b, int n, int h, LAS float* ig, LAS float* bc, LAS float* lf) {
    const int r0 = b * SEQ + n * CH;
    if (F_tid < 64) { const float* g = F_G32 + (size_t)(r0 + F_tid) * 32;
        ig[F_tid] = g[h] + F_b_gates[layer * 12 + h]; lf[F_tid] = logsigf(g[6 + h] + F_b_gates[layer * 12 + 6 + h]); }
    __syncthreads();
    if (F_tid < 64) { float s = 0.f; for (int j = 0; j <= F_tid; ++j) s += lf[j]; bc[F_tid] = s; }
}
__device__ __forceinline__ void stage_gla_decay(Frame& F, int layer, int b, int n, int hh, LAS float* bcum) {
    const int r0 = b * SEQ + n * CH;
    const float* wa = F_w_alpha + (size_t)layer * 16 * 128; const float* ba = F_b_alpha + layer * 128;
    for (int idx = F_tid; idx < 2048; idx += NTHR) { const int t = idx >> 5, d = idx & 31;
        const float* g = F_G32 + (size_t)(r0 + t) * 32 + 12; float a = ba[hh * 32 + d];
#pragma unroll
        for (int r = 0; r < 16; ++r) a += g[r] * wa[r * 128 + hh * 32 + d];
        bcum[t * 33 + d] = logsigf(a) * (1.0f / 16.0f); }
    __syncthreads();
    if (F_tid < 32) { float s = 0.f; for (int t = 0; t < 64; ++t) { s += bcum[t * 33 + F_tid]; bcum[t * 33 + F_tid] = s; } }
    __syncthreads();
}

__device__ __forceinline__ void p3_scan(Frame& F) {
    LAS float* L = (LAS float*)(F.lds + RING_OFF);
    LAS float* so = L; LAS float* sn = L + 128; LAS float* gl = L + 256; LAS float* ml = L + 384; LAS float* ex = L + 512;
    const int tid = F_tid, w = tid >> 6, l = tid & 63;
    constexpr int NU_M = 12 * 65, NU = NU_M + 8 * 32;
    const int u0 = (int)(((long)F.vcu * NU) / F.G), u1 = (int)(((long)(F.vcu + 1) * NU) / F.G);
    int cur_bh = -1, par = 0;
    for (int u = u0; u < u1; ++u, par ^= 1) {
        LAS float* exu = ex + par * 1024;
        float c[16], dcy[16];
        float* p; size_t stride;
        if (u < NU_M) {
            const int bh = u / 65, eu = u % 65, b = bh / 6, h = bh % 6;
            if (bh != cur_bh) {
                __syncthreads();
                if (tid < 128) { const int ci = (b * NCHS + tid) * 6 + h; gl[tid] = F_GS[ci]; ml[tid] = F_MS[ci]; }
                __syncthreads();
                if (tid == 0) { float m = 0.f;
                    for (int n = 0; n < NCHS; ++n) { const float g = gl[n], mloc = ml[n], mn = fmaxf(g + m, mloc);
                        so[n] = expf(g + m - mn); sn[n] = expf(mloc - mn); gl[n] = m; m = mn; } }
                __syncthreads();
                if (eu == 0 && tid < 128) F_MP[(b * NCHS + tid) * 6 + h] = gl[tid];
                cur_bh = bh;
            }
            if (eu < 64) { const bf16* p16 = (const bf16*)F_CST + ((size_t)(b * NCHS + 16 * w) * 6 + h) * 4096 + eu * 64 + l; p = nullptr; stride = 0;
#pragma unroll
                for (int i = 0; i < 16; ++i) { c[i] = bf2f(p16[(size_t)i * 6 * 4096]) * sn[16 * w + i]; dcy[i] = so[16 * w + i]; } }
            else { p = F_NST + ((size_t)(b * NCHS + 16 * w) * 6 + h) * 64 + l; stride = (size_t)6 * 64;
#pragma unroll
                for (int i = 0; i < 16; ++i) { c[i] = p[i * stride] * sn[16 * w + i]; dcy[i] = so[16 * w + i]; } }
        } else {
            const int v = u - NU_M, bh = v >> 5, eu = v & 31, b = bh >> 2, hh = bh & 3;
            p = F_SST + ((size_t)(b * NCHS + 16 * w) * 4 + hh) * 2048 + eu * 64 + l; stride = (size_t)4 * 2048;
            const float* ad = F_ADEC + ((size_t)(b * NCHS + 16 * w) * 4 + hh) * 32 + (l & 31);
#pragma unroll
            for (int i = 0; i < 16; ++i) { c[i] = p[i * stride]; dcy[i] = ad[(size_t)i * 4 * 32]; }
        }
        float st = 0.f, P = 1.f;
#pragma unroll
        for (int i = 0; i < 16; ++i) { const float ci = c[i]; c[i] = st; st = dcy[i] * st + ci; P *= dcy[i]; }
        exu[(w * 64 + l) * 2] = P; exu[(w * 64 + l) * 2 + 1] = st;
        __syncthreads();
        float sin = 0.f;
        for (int w2 = 0; w2 < w; ++w2) sin = exu[(w2 * 64 + l) * 2] * sin + exu[(w2 * 64 + l) * 2 + 1];
        float q = sin;
        if (u < NU_M && (u % 65) < 64) {
            const int bh = u / 65, eu = u % 65, b = bh / 6, h = bh % 6;
            bf16* pb = F_CPB + ((size_t)(b * NCHS + 16 * w) * 6 + h) * 4096 + eu * 64 + l;
#pragma unroll
            for (int i = 0; i < 16; ++i) { pb[(size_t)i * 6 * 4096] = (bf16)f2bf(c[i] + q); q *= dcy[i]; }
        } else {
#pragma unroll
            for (int i = 0; i < 16; ++i) { p[i * stride] = c[i] + q; q *= dcy[i]; }
        }
    }
    __syncthreads();
}

#define P4_STORE8(o, kg, yrow, GATE_EXPR) do { _Pragma("unroll") for (int c8 = 0; c8 < 8; ++c8) if ((kg) == c8) { float yv[8]; \
    _Pragma("unroll") for (int i = 0; i < 8; ++i) { const int v = c8 * 8 + i; yv[i] = (o)[v] * (GATE_EXPR); } \
    v4u w; w.x = pk2(yv[0], yv[1]); w.y = pk2(yv[2], yv[3]); w.z = pk2(yv[4], yv[5]); w.w = pk2(yv[6], yv[7]); *(GAS v4u*)((yrow) + c8 * 8) = w; } } while (0)

__device__ __forceinline__ void p4_attn(Frame& F, int layer, int b, int n, int h) {
    const int t = F_tid >> 3, kg = F_tid & 7;
    const int r0 = b * SEQ + n * CH, row = r0 + t;
    LAS float* qL = (LAS float*)(F.lds + RING_OFF);
    stage_tile(F, b, n, ZC_AQ + h * 64, 64, 1.f, qL, LP);
    __syncthreads();
    float o[64];
#pragma unroll
    for (int c = 0; c < 64; ++c) o[c] = 0.f;
    float m = -1e30f, l = 0.f;
    const float* rb = F_rel_bias + (size_t)(layer * 6 + h) * 257;
    for (int i = 0; i < 72; ++i) {
        const int jb = kg + 8 * i, kpos = n * CH - 512 + jb;
        if (kpos < 0) continue;
        const bf16* kr = F_Z + (size_t)(b * SEQ + kpos) * LDZ + ZC_AK + h * 64;
        float s = 0.f;
#pragma unroll
        for (int c = 0; c < 8; ++c) { float kf[8]; ld8(kr + c * 8, kf);
#pragma unroll
            for (int e = 0; e < 8; ++e) s += qL[t * LP + c * 8 + e] * kf[e]; }
        int rel = t + 512 - jb; rel = rel < -128 ? -128 : (rel > 128 ? 128 : rel);
        s = s * 0.125f + rb[rel + 128];
        const float mn = fmaxf(m, s), a = expf(m - mn), p = expf(s - mn);
        l = l * a + p; m = mn;
        const bf16* vr = F_Z + (size_t)(b * SEQ + kpos) * LDZ + ZC_AV + h * 64;
#pragma unroll
        for (int c = 0; c < 8; ++c) { float vf[8]; ld8(vr + c * 8, vf);
#pragma unroll
            for (int e = 0; e < 8; ++e) o[c * 8 + e] = o[c * 8 + e] * a + p * vf[e]; }
    }
#pragma unroll
    for (int off = 1; off < 8; off <<= 1) {
        const float m2 = __shfl_xor(m, off), l2 = __shfl_xor(l, off);
        const float mn = fmaxf(m, m2), a = expf(m - mn), bb = expf(m2 - mn);
        l = l * a + l2 * bb; m = mn;
#pragma unroll
        for (int c = 0; c < 64; ++c) { const float o2 = __shfl_xor(o[c], off); o[c] = o[c] * a + o2 * bb; }
    }
    const float inv = 1.0f / l;
    const bf16* gr = F_Z + (size_t)row * LDZ + ZC_AG + h * 64;
    bf16* yrow = F_Y + (size_t)row * DM + h * 64;
    P4_STORE8(o, kg, yrow, inv * siluf(bf2f(gr[v])));
}

__device__ __forceinline__ void p4_mlstm(Frame& F, int layer, int b, int n, int h) {
    LAS float* L = (LAS float*)(F.lds + RING_OFF);
    LAS float* qc = L; LAS float* kc = qc + 64 * LP; LAS float* vv = kc + 64 * LP; LAS float* Cp = vv + 64 * LP;
    LAS float* np = Cp + 64 * LP; LAS float* ig = np + 64; LAS float* bc = ig + 64; LAS float* lf = bc + 64;
    const int cn = b * NCHS + n, r0 = b * SEQ + n * CH;
    stage_conv(F, layer, b, n, ZC_MQ + h * 64, h * 64, 1.f, qc);
    stage_conv(F, layer, b, n, ZC_MK + h * 64, 384 + h * 64, 0.125f, kc);
    stage_tile(F, b, n, ZC_MV + h * 64, 64, 1.f, vv, LP);
    { const float* cs = F_CST + ((size_t)cn * 6 + h) * 4096; for (int idx = F_tid; idx < 4096; idx += NTHR) Cp[(idx >> 6) * LP + (idx & 63)] = cs[idx]; }
    if (F_tid < 64) np[F_tid] = F_NST[((size_t)cn * 6 + h) * 64 + F_tid];
    stage_mgates(F, layer, b, n, h, ig, bc, lf);
    __syncthreads();
    const float mprev = F_MP[cn * 6 + h];
    const int t = F_tid >> 3, jg = F_tid & 7, row = r0 + t;
    const float bt = bc[t], il = bt + mprev;
    float mx = il;
    for (int i = 0; i < 8; ++i) { const int j = jg + 8 * i; if (j <= t) mx = fmaxf(mx, bt - bc[j] + ig[j]); }
    mx = fmaxf(mx, __shfl_xor(mx, 1)); mx = fmaxf(mx, __shfl_xor(mx, 2)); mx = fmaxf(mx, __shfl_xor(mx, 4));
    float num[64]; float den = 0.f;
#pragma unroll
    for (int c = 0; c < 64; ++c) num[c] = 0.f;
    for (int i = 0; i < 8; ++i) { const int j = jg + 8 * i;
        if (j <= t) { float dot = 0.f;
#pragma unroll 8
            for (int k = 0; k < 64; ++k) dot += qc[t * LP + k] * kc[j * LP + k];
            const float sc = dot * expf(bt - bc[j] + ig[j] - mx); den += sc;
#pragma unroll
            for (int c = 0; c < 64; ++c) num[c] += sc * vv[j * LP + c]; } }
    const float iw = expf(il - mx);
#pragma unroll 2
    for (int kk = 0; kk < 8; ++kk) { const int k = jg * 8 + kk; const float qk = qc[t * LP + k] * iw; den += qk * np[k];
#pragma unroll
        for (int c = 0; c < 64; ++c) num[c] += qk * Cp[c * LP + k]; }
#pragma unroll
    for (int off = 1; off < 8; off <<= 1) { den += __shfl_xor(den, off);
#pragma unroll
        for (int c = 0; c < 64; ++c) num[c] += __shfl_xor(num[c], off); }
    den = fmaxf(fabsf(den), expf(-mx));
    const float rden = 1.0f / den; float ss = 0.f;
#pragma unroll
    for (int c = 0; c < 64; ++c) { num[c] *= rden; ss += num[c] * num[c]; }
    const float rn = 1.0f / sqrtf(ss * (1.0f / 64.0f) + EPS);
    const bf16* mo = F_Z + (size_t)row * LDZ + ZC_MO + h * 64; const bf16* mg = F_Z + (size_t)row * LDZ + ZC_MG + h * 64;
    const float* gn = F_ml_norm_g + layer * 384 + h * 64;
    bf16* yrow = F_Y + (size_t)row * DM + 384 + h * 64;
    P4_STORE8(num, jg, yrow, rn * gn[v] * sigmf(bf2f(mo[v])) * siluf(bf2f(mg[v])));
}

__device__ __forceinline__ void p4_gla(Frame& F, int layer, int b, int n, int hh) {
    LAS float* L = (LAS float*)(F.lds + RING_OFF);
    LAS float* qx = L; LAS float* kk = qx + 64 * 33; LAS float* vv = kk + 64 * 33; LAS float* bcum = vv + 64 * LP; LAS float* Sp = bcum + 64 * 33;
    const int cn = b * NCHS + n, r0 = b * SEQ + n * CH;
    stage_tile(F, b, n, ZC_GQ + hh * 32, 32, 0.17677669529663687f, qx, 33);
    stage_tile(F, b, n, ZC_GK + hh * 32, 32, 1.f, kk, 33);
    stage_tile(F, b, n, ZC_GV + hh * 64, 64, 1.f, vv, LP);
    { const float* ss = F_SST + ((size_t)cn * 4 + hh) * 2048; for (int idx = F_tid; idx < 2048; idx += NTHR) Sp[(idx >> 6) * LP + (idx & 63)] = ss[idx]; }
    stage_gla_decay(F, layer, b, n, hh, bcum);
    const int t = F_tid >> 3, jg = F_tid & 7, row = r0 + t;
    float num[64];
#pragma unroll
    for (int c = 0; c < 64; ++c) num[c] = 0.f;
    for (int i = 0; i < 8; ++i) { const int j = jg + 8 * i;
        if (j <= t) { float att = 0.f;
#pragma unroll 4
            for (int d = 0; d < 32; ++d) att += qx[t * 33 + d] * kk[j * 33 + d] * expf(bcum[t * 33 + d] - bcum[j * 33 + d]);
#pragma unroll
            for (int c = 0; c < 64; ++c) num[c] += att * vv[j * LP + c]; } }
#pragma unroll 2
    for (int dd = 0; dd < 4; ++dd) { const int d = jg * 4 + dd; const float w = qx[t * 33 + d] * expf(bcum[t * 33 + d]);
#pragma unroll
        for (int c = 0; c < 64; ++c) num[c] += w * Sp[d * LP + c]; }
    float ss = 0.f;
#pragma unroll
    for (int off = 1; off < 8; off <<= 1) {
#pragma unroll
        for (int c = 0; c < 64; ++c) num[c] += __shfl_xor(num[c], off); }
#pragma unroll
    for (int c = 0; c < 64; ++c) ss += num[c] * num[c];
    const float rn = 1.0f / sqrtf(ss * (1.0f / 64.0f) + EPS);
    const bf16* gg = F_Z + (size_t)row * LDZ + ZC_GG + hh * 64;
    const float* gn = F_gla_norm_g + layer * 256 + hh * 64;
    bf16* yrow = F_Y + (size_t)row * DM + 768 + hh * 64;
    P4_STORE8(num, jg, yrow, rn * gn[v] * siluf(bf2f(gg[v])));
}

constexpr int ZRS = 64;
__host__ __device__ constexpr size_t zc(int col) { return (size_t)(col >> 6) * ((size_t)T * 64) + (size_t)(col & 63); }
typedef float f32x16 __attribute__((ext_vector_type(16)));
typedef short s16x4 __attribute__((ext_vector_type(4)));
typedef short v4i16_t __attribute__((ext_vector_type(4)));
typedef float f32x2_t __attribute__((ext_vector_type(2))); typedef __bf16 bf16x2_t __attribute__((ext_vector_type(2)));
__device__ __forceinline__ unsigned cvtpk(float lo, float hi) { f32x2_t v = {lo, hi}; bf16x2_t b = __builtin_convertvector(v, bf16x2_t); return __builtin_bit_cast(unsigned, b); }
__device__ __forceinline__ s16x4 lds_tr(LAS const unsigned char* p) { return __builtin_bit_cast(s16x4, __builtin_amdgcn_ds_read_tr16_b64_v4i16((LAS v4i16_t*)p)); }
__device__ __forceinline__ bf16x8 pack8(float a0, float a1, float a2, float a3, float a4, float a5, float a6, float a7) {
    v4u w; w.x = cvtpk(a0, a1); w.y = cvtpk(a2, a3); w.z = cvtpk(a4, a5); w.w = cvtpk(a6, a7); return __builtin_bit_cast(bf16x8, w); }
#define MFMA32(a, b, c) __builtin_amdgcn_mfma_f32_32x32x16_bf16((a), (b), (c), 0, 0, 0)
constexpr float LOG2E = 1.4426950408889634f;
__device__ __forceinline__ float fexp(float x) { return __builtin_amdgcn_exp2f(x * LOG2E); }
__device__ __forceinline__ float fsigm(float x) { return __builtin_amdgcn_rcpf(1.0f + fexp(-x)); }
__device__ __forceinline__ float fsilu(float x) { return x * fsigm(x); }
__device__ __forceinline__ int tile_off(int row, int bytecol) { return row * 128 + ((((bytecol >> 4) ^ (((row >> 1) & 1) << 2)) << 4) | (bytecol & 15)); }
__device__ __forceinline__ void dma_tile(const bf16* g, LAS unsigned char* tile, int lane) {
    const int rr = lane >> 3, cpos = lane & 7;
#pragma unroll
    for (int it = 0; it < 8; ++it) { const int row = 8 * it + rr, ch = cpos ^ (((row >> 1) & 1) << 2);
        __builtin_amdgcn_global_load_lds((const unsigned*)(g + (size_t)row * ZRS + ch * 8), (LAS unsigned*)(tile + it * 1024), 16, 0, 0); }
}
__device__ __forceinline__ bf16x8 tr_frag(LAS const unsigned char* tile, int lane, int c0, int ks) {
    const int g = lane >> 4, i = lane & 15, hf = g >> 1;
    const int row = 16 * ks + 4 * hf + (i >> 2), bc = (c0 + 16 * (g & 1) + 4 * (i & 3)) * 2;
    const s16x4 lo = lds_tr(tile + tile_off(row, bc)), hi = lds_tr(tile + tile_off(row + 8, bc));
    return (bf16x8){lo[0], lo[1], lo[2], lo[3], hi[0], hi[1], hi[2], hi[3]};
}

typedef const GAS char* gcp;
__device__ __forceinline__ gcp uptr(const void* p) { const unsigned long long v = (unsigned long long)p;
    const unsigned lo = __builtin_amdgcn_readfirstlane((unsigned)v), hi = __builtin_amdgcn_readfirstlane((unsigned)(v >> 32)); return (gcp)(((unsigned long long)hi << 32) | lo); }
__device__ __forceinline__ bf16x8 ldfrag(gcp ub, unsigned voff) { return *(const GAS bf16x8*)(ub + voff); }
__device__ __forceinline__ unsigned dma_voff(int lane) { const int rr = lane >> 3; return (unsigned)(rr * ZRS + (((lane & 7) ^ (((rr >> 1) & 1) << 2)) * 8)) * 2u; }
__device__ __forceinline__ void dma_tile_u(gcp ub, unsigned voff, LAS unsigned char* tile) {
#pragma unroll
    for (int it = 0; it < 8; ++it) __builtin_amdgcn_global_load_lds((const GAS unsigned*)(ub + (size_t)it * 8 * ZRS * 2 + voff), (LAS unsigned*)(tile + it * 1024), 16, 0, 0);
}
__device__ __forceinline__ void tr_bases(int lane, unsigned& b0, unsigned& b1) {
    const int g = lane >> 4, i = lane & 15, hf = g >> 1, row = 4 * hf + (i >> 2), bc = (16 * (g & 1) + 4 * (i & 3)) * 2;
    b0 = (unsigned)tile_off(row, bc); b1 = (unsigned)tile_off(row, bc + 64);
}
__device__ __forceinline__ bf16x8 tr_frag_b(LAS const unsigned char* tile, unsigned base, int ks) {
    const s16x4 lo = lds_tr(tile + base + ks * 2048), hi = lds_tr(tile + base + ks * 2048 + 1024);
    return (bf16x8){lo[0], lo[1], lo[2], lo[3], hi[0], hi[1], hi[2], hi[3]};
}

__device__ __forceinline__ void unpack8(v4u w, float* o) {
    o[0] = __uint_as_float(w.x << 16); o[1] = __uint_as_float(w.x & 0xffff0000u); o[2] = __uint_as_float(w.y << 16); o[3] = __uint_as_float(w.y & 0xffff0000u);
    o[4] = __uint_as_float(w.z << 16); o[5] = __uint_as_float(w.z & 0xffff0000u); o[6] = __uint_as_float(w.w << 16); o[7] = __uint_as_float(w.w & 0xffff0000u);
}
__device__ __forceinline__ float max3f(float a, float b, float c) { float r; asm("v_max3_f32 %0, %1, %2, %3" : "=v"(r) : "v"(a), "v"(b), "v"(c)); return r; }
__device__ __forceinline__ float xh_max(float x) { const auto rr = __builtin_amdgcn_permlane32_swap(__float_as_uint(x), __float_as_uint(x), false, false); return fmaxf(__uint_as_float(rr[0]), __uint_as_float(rr[1])); }
__device__ __forceinline__ float xh_sum(float x) { const auto rr = __builtin_amdgcn_permlane32_swap(__float_as_uint(x), __float_as_uint(x), false, false); return __uint_as_float(rr[0]) + __uint_as_float(rr[1]); }
constexpr int TLP = 68;
__device__ __forceinline__ void tl_put4(LAS unsigned char* wl, int t, int v, float a, float b, float c, float e) { *(LAS f32x4*)(wl + ((t * TLP + v) << 2)) = (f32x4){a, b, c, e}; }
template <int GATE>
__device__ __forceinline__ void tl_emit(LAS const unsigned char* wl, int lane, gcp g0, gcp g1, const float* gn, GAS char* yb) {
    const int rr = lane >> 3, c = lane & 7;
    float gnv[8];
    if (GATE != 0) { const f32x4 a = *(const f32x4*)(gn + 8 * c), b = *(const f32x4*)(gn + 8 * c + 4); gnv[0] = a[0]; gnv[1] = a[1]; gnv[2] = a[2]; gnv[3] = a[3]; gnv[4] = b[0]; gnv[5] = b[1]; gnv[6] = b[2]; gnv[7] = b[3]; }
    const unsigned voff = (unsigned)(rr * ZRS + 8 * c) * 2u, yoff = (unsigned)(rr * DM + 8 * c) * 2u;
    v4u ga[8], gb[8];
#pragma unroll
    for (int it = 0; it < 8; ++it) { ga[it] = *(const GAS v4u*)(g0 + (size_t)it * 8 * ZRS * 2 + voff); if (GATE == 1) gb[it] = *(const GAS v4u*)(g1 + (size_t)it * 8 * ZRS * 2 + voff); }
#pragma unroll
    for (int it = 0; it < 8; ++it) {
        const int row = 8 * it + rr;
        const f32x4 x0 = *(LAS const f32x4*)(wl + ((row * TLP + 8 * c) << 2)), x1 = *(LAS const f32x4*)(wl + ((row * TLP + 8 * c + 4) << 2));
        float x[8] = {x0[0], x0[1], x0[2], x0[3], x1[0], x1[1], x1[2], x1[3]}, p[8], q[8];
        unpack8(ga[it], p); if (GATE == 1) unpack8(gb[it], q);
#pragma unroll
        for (int e = 0; e < 8; ++e) {
            if (GATE == 0) x[e] *= fsilu(p[e]);
            else if (GATE == 1) x[e] *= gnv[e] * fsigm(p[e]) * fsilu(q[e]);
            else x[e] *= gnv[e] * fsilu(p[e]);
        }
        *(GAS v4u*)(yb + (size_t)it * 8 * DM * 2 + yoff) = __builtin_bit_cast(v4u, pack8(x[0], x[1], x[2], x[3], x[4], x[5], x[6], x[7]));
    }
}

__device__ __forceinline__ void attn_wave(Frame& F, int layer, int cn, int h, LAS unsigned char* wl) {
    const int lane = F_lane, r = lane & 31, hf = lane >> 5;
    const int b = cn / NCHS, n = cn % NCHS;
    const size_t row0 = (size_t)b * SEQ + (size_t)n * CH;
    const bf16* Z = F_Z;
    LAS float* rbl = (LAS float*)(wl + 16384);
    const float* rb = F_rel_bias + (size_t)(layer * 6 + h) * 257;
    for (int i = lane; i < 257; i += 64) rbl[i] = rb[i] * LOG2E;
    const float bfar = rb[256] * LOG2E;
    constexpr float C1 = 0.125f * LOG2E;
    const unsigned voffK = (unsigned)(r * ZRS + 8 * hf) * 2u, voffV = dma_voff(lane);
    unsigned trb0, trb1; tr_bases(lane, trb0, trb1);
    bf16x8 qf[2][4];
    { gcp qb_ = uptr(Z + zc(ZC_AQ + h * 64) + row0 * ZRS);
#pragma unroll
    for (int qb = 0; qb < 2; ++qb)
#pragma unroll
        for (int s = 0; s < 4; ++s) qf[qb][s] = ldfrag(qb_ + ((size_t)32 * qb * ZRS + 16 * s) * 2, voffK); }
    f32x16 o[2][2];
#pragma unroll
    for (int a = 0; a < 2; ++a)
#pragma unroll
        for (int c = 0; c < 2; ++c)
#pragma unroll
            for (int i = 0; i < 16; ++i) o[a][c][i] = 0.f;
    float m[2] = {-1e30f, -1e30f}, lsum[2] = {0.f, 0.f};
    const int i0 = (n >= 8) ? 0 : 8 - n;
    dma_tile_u(uptr(Z + zc(ZC_AV + h * 64) + (row0 - 512 + 64 * i0) * ZRS), voffV, wl + (i0 & 1) * 8192);
#define ATTN_STEP(KF, KB) do { \
        f32x16 st[2]; \
        _Pragma("unroll") for (int qb = 0; qb < 2; ++qb) { _Pragma("unroll") for (int i = 0; i < 16; ++i) st[qb][i] = 0.f; \
            _Pragma("unroll") for (int s = 0; s < 4; ++s) st[qb] = MFMA32(KF[s], qf[qb][s], st[qb]); } \
        const bool far_ = (ti <= 5); \
        if (!far_) { _Pragma("unroll") for (int qb = 0; qb < 2; ++qb) _Pragma("unroll") for (int i = 0; i < 16; ++i) { \
            const int kk = 32 * (KB) + (i & 3) + 8 * (i >> 2) + 4 * hf, t = 32 * qb + r; \
            int rel = t + 512 - 64 * ti - kk; rel = rel < -128 ? -128 : (rel > 128 ? 128 : rel); \
            st[qb][i] = st[qb][i] * C1 + rbl[rel + 128]; } } \
        bf16x8 pf[2][2]; \
        _Pragma("unroll") for (int qb = 0; qb < 2; ++qb) { \
            float ma = max3f(st[qb][0], st[qb][1], st[qb][2]), mb = max3f(st[qb][3], st[qb][4], st[qb][5]); \
            ma = max3f(ma, st[qb][6], st[qb][7]); mb = max3f(mb, st[qb][8], st[qb][9]); ma = max3f(ma, st[qb][10], st[qb][11]); mb = max3f(mb, st[qb][12], st[qb][13]); \
            float mx = max3f(ma, mb, fmaxf(st[qb][14], st[qb][15])); \
            if (far_) mx = mx * C1 + bfar;              \
            mx = xh_max(mx); \
            if (__any(mx > m[qb] + 8.0f)) { const float mn = fmaxf(m[qb], mx), alpha = __builtin_amdgcn_exp2f(m[qb] - mn); m[qb] = mn; lsum[qb] *= alpha; \
                _Pragma("unroll") for (int i = 0; i < 16; ++i) { o[0][qb][i] *= alpha; o[1][qb][i] *= alpha; } } \
            const float sc_ = far_ ? C1 : 1.0f, of_ = far_ ? bfar - m[qb] : -m[qb]; \
            float ps0 = 0.f, ps1 = 0.f, ps2 = 0.f, ps3 = 0.f; \
            _Pragma("unroll") for (int i = 0; i < 16; i += 4) { \
                const float p0 = __builtin_amdgcn_exp2f(st[qb][i] * sc_ + of_), p1 = __builtin_amdgcn_exp2f(st[qb][i + 1] * sc_ + of_), p2 = __builtin_amdgcn_exp2f(st[qb][i + 2] * sc_ + of_), p3 = __builtin_amdgcn_exp2f(st[qb][i + 3] * sc_ + of_); \
                st[qb][i] = p0; st[qb][i + 1] = p1; st[qb][i + 2] = p2; st[qb][i + 3] = p3; ps0 += p0; ps1 += p1; ps2 += p2; ps3 += p3; } \
            lsum[qb] += (ps0 + ps1) + (ps2 + ps3); \
            pf[qb][0] = pack8(st[qb][0], st[qb][1], st[qb][2], st[qb][3], st[qb][4], st[qb][5], st[qb][6], st[qb][7]); \
            pf[qb][1] = pack8(st[qb][8], st[qb][9], st[qb][10], st[qb][11], st[qb][12], st[qb][13], st[qb][14], st[qb][15]); } \
        if ((KB) == 0) { if (ti < 8) asm volatile("s_waitcnt vmcnt(8)" ::: "memory"); else asm volatile("s_waitcnt vmcnt(0)" ::: "memory"); }     \
        _Pragma("unroll") for (int k2 = 0; k2 < 2; ++k2) _Pragma("unroll") for (int dvb = 0; dvb < 2; ++dvb) { \
            const bf16x8 vf = tr_frag_b(vt, dvb ? trb1 : trb0, 2 * (KB) + k2); \
            o[dvb][0] = MFMA32(vf, pf[0][k2], o[dvb][0]); o[dvb][1] = MFMA32(vf, pf[1][k2], o[dvb][1]); } \
    } while (0)
    bf16x8 kfa[4], kfb[4];
    { gcp kb_ = uptr(Z + zc(ZC_AK + h * 64) + (row0 - 512 + 64 * i0) * ZRS);
#pragma unroll
      for (int s = 0; s < 4; ++s) kfa[s] = ldfrag(kb_ + (size_t)16 * s * 2, voffK); }
#pragma unroll 1
    for (int ti = i0; ti < 9; ++ti) {
        const size_t kr0 = row0 - 512 + 64 * ti;
        LAS const unsigned char* vt = wl + (ti & 1) * 8192;
        gcp kb_ = uptr(Z + zc(ZC_AK + h * 64) + kr0 * ZRS);
#pragma unroll
        for (int s = 0; s < 4; ++s) kfb[s] = ldfrag(kb_ + ((size_t)32 * ZRS + 16 * s) * 2, voffK);
        if (ti < 8) dma_tile_u(uptr(Z + zc(ZC_AV + h * 64) + (kr0 + 64) * ZRS), voffV, wl + ((ti + 1) & 1) * 8192);
        ATTN_STEP(kfa, 0);
#pragma unroll
        for (int s = 0; s < 4; ++s) kfa[s] = ldfrag(kb_ + ((size_t)64 * ZRS + 16 * s) * 2, voffK);
        ATTN_STEP(kfb, 1);
    }
#undef ATTN_STEP
#pragma unroll
    for (int qb = 0; qb < 2; ++qb) {
        const float l = xh_sum(lsum[qb]), inv = 1.0f / l;
#pragma unroll
        for (int dvb = 0; dvb < 2; ++dvb)
#pragma unroll
            for (int i4 = 0; i4 < 4; ++i4) tl_put4(wl, 32 * qb + r, 32 * dvb + 8 * i4 + 4 * hf, o[dvb][qb][4 * i4] * inv, o[dvb][qb][4 * i4 + 1] * inv, o[dvb][qb][4 * i4 + 2] * inv, o[dvb][qb][4 * i4 + 3] * inv);
    }
    tl_emit<0>(wl, lane, uptr(Z + zc(ZC_AG + h * 64) + row0 * ZRS), (gcp)nullptr, nullptr, (GAS char*)uptr(F_Y + row0 * DM + h * 64));
}

#define DPPF(old, x, ctrl, rmask) __uint_as_float(__builtin_amdgcn_update_dpp(__float_as_uint(old), __float_as_uint(x), (ctrl), (rmask), 0xf, false))
__device__ __forceinline__ float wave_scan_add(float x, int) {
    x += DPPF(0.f, x, 0x111, 0xf);
    x += DPPF(0.f, x, 0x112, 0xf);
    x += DPPF(0.f, x, 0x114, 0xf);
    x += DPPF(0.f, x, 0x118, 0xf);
    x += DPPF(0.f, x, 0x142, 0xa);
    x += DPPF(0.f, x, 0x143, 0xc);
    return x;
}
__device__ __forceinline__ float wave_scan_max(float x, int) {
    const float ninf = -3.0e38f;
    x = fmaxf(x, DPPF(ninf, x, 0x111, 0xf));
    x = fmaxf(x, DPPF(ninf, x, 0x112, 0xf));
    x = fmaxf(x, DPPF(ninf, x, 0x114, 0xf));
    x = fmaxf(x, DPPF(ninf, x, 0x118, 0xf));
    x = fmaxf(x, DPPF(ninf, x, 0x142, 0xa));
    x = fmaxf(x, DPPF(ninf, x, 0x143, 0xc));
    return x;
}
__device__ __forceinline__ float wave_max(float x) {
#pragma unroll
    for (int o = 1; o < 64; o <<= 1) x = fmaxf(x, __shfl_xor(x, o));
    return x;
}
__device__ __forceinline__ void conv8(const char* zub, unsigned voff, int blk, int s, int tt, int n, LAS const float* w, int c0, float scale, float* out) {
    float acc[8];
#pragma unroll
    for (int e = 0; e < 8; ++e) acc[e] = 0.f;
#pragma unroll
    for (int j = 0; j < 4; ++j) {
        v4u raw = *(const v4u*)(zub + ((long)(32 * blk + j - 3) * ZRS + 16 * s) * 2 + voff);
        if (!(n > 0 || tt + j - 3 >= 0)) raw = (v4u){0u, 0u, 0u, 0u};
        float z[8]; unpack8(raw, z);
        const f32x4 w0 = *(LAS const f32x4*)(w + j * 64 + c0), w1 = *(LAS const f32x4*)(w + j * 64 + c0 + 4);
        acc[0] += z[0] * w0[0]; acc[1] += z[1] * w0[1]; acc[2] += z[2] * w0[2]; acc[3] += z[3] * w0[3];
        acc[4] += z[4] * w1[0]; acc[5] += z[5] * w1[1]; acc[6] += z[6] * w1[2]; acc[7] += z[7] * w1[3];
    }
#pragma unroll
    for (int e = 0; e < 8; ++e) out[e] = fsilu(acc[e]) * scale;
}
__device__ __forceinline__ bf16x8 ld_f32_frag(gcp ub, unsigned voff) {
    const f32x4 a = *(const GAS f32x4*)(ub + voff), b = *(const GAS f32x4*)(ub + voff + 16);
    return pack8(a[0], a[1], a[2], a[3], b[0], b[1], b[2], b[3]);
}

__device__ __forceinline__ void dma_rows67(gcp ub, unsigned voff, LAS unsigned char* img, int lane) {
#pragma unroll
    for (int it = 0; it < 8; ++it) __builtin_amdgcn_global_load_lds((const GAS unsigned*)(ub + (size_t)it * 8 * ZRS * 2 + voff), (LAS unsigned*)(img + it * 1024), 16, 0, 0);
    if (lane < 24) __builtin_amdgcn_global_load_lds((const GAS unsigned*)(ub + (size_t)64 * ZRS * 2 + voff), (LAS unsigned*)(img + 8192), 16, 0, 0);
}
constexpr int IMG1 = 8704;
__device__ __forceinline__ void ml_out_wave(Frame& F, int layer, int cn, int h, LAS unsigned char* wl) {
    const int lane = F_lane, r = lane & 31, hf = lane >> 5;
    const int b = cn / NCHS, n = cn % NCHS;
    const size_t row0 = (size_t)b * SEQ + (size_t)n * CH;
    const bf16* Z = F_Z;
    LAS unsigned char* img0 = wl; LAS unsigned char* img1 = wl + IMG1;
    LAS float* wq = (LAS float*)(wl + 17408); LAS float* wk = wq + 256; LAS float* npl = wq + 512;
    const unsigned dvo = dma_voff(lane);
    dma_rows67(uptr(Z + zc(ZC_MQ + h * 64) + (row0 - 3) * ZRS), dvo, img0, lane);
    dma_rows67(uptr(Z + zc(ZC_MK + h * 64) + (row0 - 3) * ZRS), dvo, img1, lane);
    { const float* cw = F_conv_w + (size_t)layer * 4 * 768 + h * 64 + lane;
#pragma unroll
      for (int j = 0; j < 4; ++j) { wq[j * 64 + lane] = cw[j * 768]; wk[j * 64 + lane] = cw[j * 768 + 384]; } }
    npl[lane] = F_NST[((size_t)cn * 6 + h) * 64 + lane];
    const float* g32 = F_G32 + (row0 + lane) * 32;
    const float ig = g32[h] + F_b_gates[layer * 12 + h];
    const float lf = logsigf(g32[6 + h] + F_b_gates[layer * 12 + 6 + h]);
    const float bc = wave_scan_add(lf, lane);
    const float av = ig - bc;
    const float amax = wave_scan_max(av, lane);
    const float mprev = F_MP[cn * 6 + h];
    float bct[2], mt[2], iw[2];
#pragma unroll
    for (int tb = 0; tb < 2; ++tb) { bct[tb] = __shfl(bc, 32 * tb + r); mt[tb] = fmaxf(mprev, __shfl(amax, 32 * tb + r)); iw[tb] = fexp(mprev - mt[tb]); }
    asm volatile("s_waitcnt vmcnt(0)" ::: "memory");
    bf16x8 qcf[2][4], kcf[2][4];
    float nq[2] = {0.f, 0.f};
#pragma unroll
    for (int s = 0; s < 4; ++s) {
        const int c0 = 16 * s + 8 * hf;
        const f32x4 n0 = *(LAS const f32x4*)(npl + c0), n1 = *(LAS const f32x4*)(npl + c0 + 4);
#pragma unroll
        for (int blk = 0; blk < 2; ++blk) {
            float aq[8], ak[8];
#pragma unroll
            for (int e = 0; e < 8; ++e) { aq[e] = 0.f; ak[e] = 0.f; }
#pragma unroll
            for (int j = 0; j < 4; ++j) {
                const int rho = 32 * blk + r + j, off = tile_off(rho, c0 * 2);
                v4u rq = *(LAS const v4u*)(img0 + off), rk = *(LAS const v4u*)(img1 + off);
                if (n == 0 && rho < 3) { rq = (v4u){0u, 0u, 0u, 0u}; rk = (v4u){0u, 0u, 0u, 0u}; }
                float zq[8], zk[8]; unpack8(rq, zq); unpack8(rk, zk);
                const f32x4 a0 = *(LAS const f32x4*)(wq + j * 64 + c0), a1 = *(LAS const f32x4*)(wq + j * 64 + c0 + 4), b0 = *(LAS const f32x4*)(wk + j * 64 + c0), b1 = *(LAS const f32x4*)(wk + j * 64 + c0 + 4);
                aq[0] += zq[0] * a0[0]; aq[1] += zq[1] * a0[1]; aq[2] += zq[2] * a0[2]; aq[3] += zq[3] * a0[3]; aq[4] += zq[4] * a1[0]; aq[5] += zq[5] * a1[1]; aq[6] += zq[6] * a1[2]; aq[7] += zq[7] * a1[3];
                ak[0] += zk[0] * b0[0]; ak[1] += zk[1] * b0[1]; ak[2] += zk[2] * b0[2]; ak[3] += zk[3] * b0[3]; ak[4] += zk[4] * b1[0]; ak[5] += zk[5] * b1[1]; ak[6] += zk[6] * b1[2]; ak[7] += zk[7] * b1[3];
            }
#pragma unroll
            for (int e = 0; e < 8; ++e) { aq[e] = fsilu(aq[e]); ak[e] = fsilu(ak[e]) * 0.125f; }
            nq[blk] += aq[0] * n0[0] + aq[1] * n0[1] + aq[2] * n0[2] + aq[3] * n0[3] + aq[4] * n1[0] + aq[5] * n1[1] + aq[6] * n1[2] + aq[7] * n1[3];
            qcf[blk][s] = pack8(aq[0], aq[1], aq[2], aq[3], aq[4], aq[5], aq[6], aq[7]);
            kcf[blk][s] = pack8(ak[0], ak[1], ak[2], ak[3], ak[4], ak[5], ak[6], ak[7]);
        }
    }
    dma_tile_u(uptr(Z + zc(ZC_MV + h * 64) + row0 * ZRS), dvo, img0);
    bf16x8 pf0[2], pf1[4];
    float den[2] = {0.f, 0.f};
    {
        f32x16 s00, s01, s11;
#pragma unroll
        for (int i = 0; i < 16; ++i) { s00[i] = 0.f; s01[i] = 0.f; s11[i] = 0.f; }
#pragma unroll
        for (int s = 0; s < 4; ++s) { s00 = MFMA32(kcf[0][s], qcf[0][s], s00); s01 = MFMA32(kcf[0][s], qcf[1][s], s01); s11 = MFMA32(kcf[1][s], qcf[1][s], s11); }
#pragma unroll
        for (int i = 0; i < 16; ++i) {
            const int jr = (i & 3) + 8 * (i >> 2) + 4 * hf;
            const float a0 = __shfl(av, jr), a1 = __shfl(av, 32 + jr);
            const float d00 = (jr <= r) ? fexp(a0 - mt[0]) : 0.f, d01 = fexp(a0 - mt[1]), d11 = (jr <= r) ? fexp(a1 - mt[1]) : 0.f;
            s00[i] *= d00; s01[i] *= d01; s11[i] *= d11;
            den[0] += s00[i]; den[1] += s01[i] + s11[i];
        }
        pf0[0] = pack8(s00[0], s00[1], s00[2], s00[3], s00[4], s00[5], s00[6], s00[7]); pf0[1] = pack8(s00[8], s00[9], s00[10], s00[11], s00[12], s00[13], s00[14], s00[15]);
        pf1[0] = pack8(s01[0], s01[1], s01[2], s01[3], s01[4], s01[5], s01[6], s01[7]); pf1[1] = pack8(s01[8], s01[9], s01[10], s01[11], s01[12], s01[13], s01[14], s01[15]);
        pf1[2] = pack8(s11[0], s11[1], s11[2], s11[3], s11[4], s11[5], s11[6], s11[7]); pf1[3] = pack8(s11[8], s11[9], s11[10], s11[11], s11[12], s11[13], s11[14], s11[15]);
    }
#pragma unroll
    for (int tb = 0; tb < 2; ++tb) {
        den[tb] = xh_sum(den[tb]); nq[tb] = xh_sum(nq[tb]);
        den[tb] = fmaxf(fabsf(den[tb] + iw[tb] * nq[tb]), fexp(-(bct[tb] + mt[tb])));
    }
    unsigned trb0, trb1; tr_bases(lane, trb0, trb1);
    gcp cpb = uptr(F_CPB + ((size_t)cn * 6 + h) * 4096);
    f32x16 num[2][2];
#pragma unroll
    for (int vb = 0; vb < 2; ++vb) {
        bf16x8 cf[4];
#pragma unroll
        for (int s = 0; s < 4; ++s) cf[s] = ldfrag(cpb + ((size_t)32 * vb * 64 + 16 * s) * 2, (unsigned)(r * 64 + 8 * hf) * 2u);
#pragma unroll
        for (int tb = 0; tb < 2; ++tb) {
#pragma unroll
            for (int i = 0; i < 16; ++i) num[vb][tb][i] = 0.f;
#pragma unroll
            for (int s = 0; s < 4; ++s) num[vb][tb] = MFMA32(cf[s], qcf[tb][s], num[vb][tb]);
#pragma unroll
            for (int i = 0; i < 16; ++i) num[vb][tb][i] *= iw[tb];
        }
    }
    asm volatile("s_waitcnt vmcnt(0)" ::: "memory");
#pragma unroll
    for (int vb = 0; vb < 2; ++vb)
#pragma unroll
        for (int ks = 0; ks < 4; ++ks) {
            const bf16x8 vf = tr_frag_b(img0, vb ? trb1 : trb0, ks);
            if (ks < 2) num[vb][0] = MFMA32(vf, pf0[ks], num[vb][0]);
            num[vb][1] = MFMA32(vf, pf1[ks], num[vb][1]);
        }
#pragma unroll
    for (int tb = 0; tb < 2; ++tb) {
        const float rden = 1.0f / den[tb]; float ss = 0.f;
#pragma unroll
        for (int vb = 0; vb < 2; ++vb)
#pragma unroll
            for (int i = 0; i < 16; ++i) { num[vb][tb][i] *= rden; ss += num[vb][tb][i] * num[vb][tb][i]; }
        ss = xh_sum(ss);
        const float rn = 1.0f / sqrtf(ss * (1.0f / 64.0f) + EPS);
#pragma unroll
        for (int vb = 0; vb < 2; ++vb)
#pragma unroll
            for (int i4 = 0; i4 < 4; ++i4) tl_put4(wl, 32 * tb + r, 32 * vb + 8 * i4 + 4 * hf, num[vb][tb][4 * i4] * rn, num[vb][tb][4 * i4 + 1] * rn, num[vb][tb][4 * i4 + 2] * rn, num[vb][tb][4 * i4 + 3] * rn);
    }
    tl_emit<1>(wl, lane, uptr(Z + zc(ZC_MO + h * 64) + row0 * ZRS), uptr(Z + zc(ZC_MG + h * 64) + row0 * ZRS), F_ml_norm_g + layer * 384 + h * 64, (GAS char*)uptr(F_Y + row0 * DM + 384 + h * 64));
}

__device__ __forceinline__ void ml_loc_wave(Frame& F, int layer, int cn, int h, LAS unsigned char* wl) {
    const int lane = F_lane, r = lane & 31, hf = lane >> 5;
    const int b = cn / NCHS, n = cn % NCHS;
    const size_t row0 = (size_t)b * SEQ + (size_t)n * CH;
    const bf16* Z = F_Z;
    LAS unsigned char* img0 = wl; LAS unsigned char* img1 = wl + IMG1;
    const unsigned dvo = dma_voff(lane);
    dma_rows67(uptr(Z + zc(ZC_MK + h * 64) + (row0 - 3) * ZRS), dvo, img0, lane);
    dma_tile_u(uptr(Z + zc(ZC_MV + h * 64) + row0 * ZRS), dvo, img1);
    const int rr = lane >> 3, ch = lane & 7;
    float wk[4][8];
    { const float* cw = F_conv_w + (size_t)layer * 4 * 768 + 384 + h * 64 + ch * 8;
#pragma unroll
      for (int j = 0; j < 4; ++j) { const f32x4 a = *(const f32x4*)(cw + j * 768), c = *(const f32x4*)(cw + j * 768 + 4);
          wk[j][0] = a[0]; wk[j][1] = a[1]; wk[j][2] = a[2]; wk[j][3] = a[3]; wk[j][4] = c[0]; wk[j][5] = c[1]; wk[j][6] = c[2]; wk[j][7] = c[3]; } }
    const float* g32 = F_G32 + (row0 + lane) * 32;
    const float ig = g32[h] + F_b_gates[layer * 12 + h];
    const float lf = logsigf(g32[6 + h] + F_b_gates[layer * 12 + 6 + h]);
    const float bc = wave_scan_add(lf, lane);
    const float g = __shfl(bc, 63);
    const float av = g - bc + ig;
    const float mloc = wave_max(av);
    const float w = fexp(av - mloc);
    asm volatile("s_waitcnt vmcnt(0)" ::: "memory");
#pragma unroll 2
    for (int it = 0; it < 8; ++it) {
        const int row = 8 * it + rr;
        float acc[8];
#pragma unroll
        for (int e = 0; e < 8; ++e) acc[e] = 0.f;
#pragma unroll
        for (int j = 0; j < 4; ++j) {
            v4u raw = *(LAS const v4u*)(img0 + tile_off(row + j, ch * 16));
            if (n == 0 && row + j < 3) raw = (v4u){0u, 0u, 0u, 0u};
            float z[8]; unpack8(raw, z);
#pragma unroll
            for (int e = 0; e < 8; ++e) acc[e] += z[e] * wk[j][e];
        }
        const int lo = tile_off(row, ch * 16);
        float v8[8]; unpack8(*(LAS const v4u*)(img1 + lo), v8);
        const float wr = __shfl(w, row);
        *(LAS v4u*)(img0 + lo) = __builtin_bit_cast(v4u, pack8(fsilu(acc[0]) * 0.125f, fsilu(acc[1]) * 0.125f, fsilu(acc[2]) * 0.125f, fsilu(acc[3]) * 0.125f,
                                                                fsilu(acc[4]) * 0.125f, fsilu(acc[5]) * 0.125f, fsilu(acc[6]) * 0.125f, fsilu(acc[7]) * 0.125f));
        *(LAS v4u*)(img1 + lo) = __builtin_bit_cast(v4u, pack8(v8[0] * wr, v8[1] * wr, v8[2] * wr, v8[3] * wr, v8[4] * wr, v8[5] * wr, v8[6] * wr, v8[7] * wr));
    }
    unsigned trb0, trb1; tr_bases(lane, trb0, trb1);
    f32x16 acc[2][2];
#pragma unroll
    for (int a = 0; a < 2; ++a)
#pragma unroll
        for (int c = 0; c < 2; ++c)
#pragma unroll
            for (int i = 0; i < 16; ++i) acc[a][c][i] = 0.f;
#pragma unroll
    for (int ks = 0; ks < 4; ++ks) {
        const bf16x8 v0 = tr_frag_b(img1, trb0, ks), v1 = tr_frag_b(img1, trb1, ks), k0 = tr_frag_b(img0, trb0, ks), k1 = tr_frag_b(img0, trb1, ks);
        acc[0][0] = MFMA32(k0, v0, acc[0][0]); acc[0][1] = MFMA32(k0, v1, acc[0][1]); acc[1][0] = MFMA32(k1, v0, acc[1][0]); acc[1][1] = MFMA32(k1, v1, acc[1][1]);
    }
    bf16* cst = (bf16*)F_CST + ((size_t)cn * 6 + h) * 4096;
#pragma unroll
    for (int kb = 0; kb < 2; ++kb)
#pragma unroll
        for (int vb = 0; vb < 2; ++vb)
#pragma unroll
            for (int i4 = 0; i4 < 4; ++i4)
                *(unsigned long long*)(cst + (32 * vb + r) * 64 + 32 * kb + 8 * i4 + 4 * hf) =
                    (unsigned long long)cvtpk(acc[kb][vb][4 * i4], acc[kb][vb][4 * i4 + 1]) | ((unsigned long long)cvtpk(acc[kb][vb][4 * i4 + 2], acc[kb][vb][4 * i4 + 3]) << 32);
    float s = 0.f;
#pragma unroll 8
    for (int j = 0; j < 64; ++j) s += __shfl(w, j) * bf2f(*(LAS const unsigned short*)(img0 + tile_off(j, 2 * lane)));
    F_NST[((size_t)cn * 6 + h) * 64 + lane] = s;
    if (lane == 0) { F_GS[cn * 6 + h] = g; F_MS[cn * 6 + h] = mloc; }
}

__device__ __forceinline__ float flogsig(float x) { return fminf(x, 0.f) - 0.6931471805599453f * __builtin_amdgcn_logf(1.0f + fexp(-fabsf(x))); }
__device__ __forceinline__ void gla_loc_wave(Frame& F, int layer, int cn, int hh, LAS unsigned char* wl) {
    const int lane = F_lane, hf = lane >> 5;
    const int b = cn / NCHS, n = cn % NCHS;
    const size_t row0 = (size_t)b * SEQ + (size_t)n * CH, row = row0 + lane;
    const bf16* Z = F_Z;
    dma_tile_u(uptr(Z + zc(ZC_GV + hh * 64) + row0 * ZRS), dma_voff(lane), wl + 8192);
    float ga[16];
    { const f32x4* gp = (const f32x4*)(F_G32 + row * 32 + 12);
#pragma unroll
      for (int q = 0; q < 4; ++q) { const f32x4 v = gp[q]; ga[4 * q] = v[0]; ga[4 * q + 1] = v[1]; ga[4 * q + 2] = v[2]; ga[4 * q + 3] = v[3]; } }
    const float* wa = F_w_alpha + (size_t)layer * 16 * 128 + hh * 32; const float* ba = F_b_alpha + layer * 128 + hh * 32;
    LAS float* wsl = (LAS float*)(wl + 16384);
#pragma unroll
    for (int i = lane; i < 512; i += 64) wsl[i] = wa[(i >> 5) * 128 + (i & 31)];
    float bcv[32];
#pragma unroll
    for (int d4 = 0; d4 < 8; ++d4) {
        f32x4 a = *(const f32x4*)(ba + 4 * d4);
#pragma unroll
        for (int q = 0; q < 16; ++q) a += *(LAS const f32x4*)(wsl + q * 32 + 4 * d4) * ga[q];
#pragma unroll
        for (int e = 0; e < 4; ++e) bcv[4 * d4 + e] = wave_scan_add(flogsig(a[e]) * (1.0f / 16.0f), lane);
    }
    { f32x4* bp = (f32x4*)(F_BC + row * 128 + hh * 32);
#pragma unroll
      for (int q = 0; q < 8; ++q) bp[q] = (f32x4){bcv[4 * q], bcv[4 * q + 1], bcv[4 * q + 2], bcv[4 * q + 3]}; }
#pragma unroll
    for (int c = 0; c < 4; ++c) {
        float k8[8]; unpack8(*(const v4u*)(Z + zc(ZC_GK + hh * 32) + row * ZRS + 8 * c), k8);
#pragma unroll
        for (int e = 0; e < 8; ++e) k8[e] *= fexp(__shfl(bcv[8 * c + e], 63) - bcv[8 * c + e]);
        *(LAS v4u*)(wl + tile_off(lane, c * 16)) = __builtin_bit_cast(v4u, pack8(k8[0], k8[1], k8[2], k8[3], k8[4], k8[5], k8[6], k8[7]));
    }
    if (lane == 63) { f32x4* ap = (f32x4*)(F_ADEC + ((size_t)cn * 4 + hh) * 32);
#pragma unroll
        for (int q = 0; q < 8; ++q) ap[q] = (f32x4){fexp(bcv[4 * q]), fexp(bcv[4 * q + 1]), fexp(bcv[4 * q + 2]), fexp(bcv[4 * q + 3])}; }
    unsigned trb0, trb1; tr_bases(lane, trb0, trb1);
    f32x16 u0, u1;
#pragma unroll
    for (int i = 0; i < 16; ++i) { u0[i] = 0.f; u1[i] = 0.f; }
    asm volatile("s_waitcnt vmcnt(0)" ::: "memory");
#pragma unroll
    for (int ks = 0; ks < 4; ++ks) { const bf16x8 kd = tr_frag_b(wl, trb0, ks);
        u0 = MFMA32(tr_frag_b(wl + 8192, trb0, ks), kd, u0); u1 = MFMA32(tr_frag_b(wl + 8192, trb1, ks), kd, u1); }
    float* sst = F_SST + ((size_t)cn * 4 + hh) * 2048;
#pragma unroll
    for (int i = 0; i < 16; ++i) { const int v = (i & 3) + 8 * (i >> 2) + 4 * hf; sst[v * 32 + (lane & 31)] = u0[i]; sst[(32 + v) * 32 + (lane & 31)] = u1[i]; }
}

__device__ __forceinline__ void gla_out_wave(Frame& F, int layer, int cn, int hh, LAS unsigned char* wl) {
    const int lane = F_lane, r = lane & 31, hf = lane >> 5;
    const int b = cn / NCHS, n = cn % NCHS;
    const size_t row0 = (size_t)b * SEQ + (size_t)n * CH;
    const bf16* Z = F_Z;
    dma_tile_u(uptr(Z + zc(ZC_GV + hh * 64) + row0 * ZRS), dma_voff(lane), wl);
    const unsigned voffK = (unsigned)(r * ZRS + 8 * hf) * 2u, voffB = (unsigned)(r * 128 + 8 * hf) * 4u;
    gcp zq = uptr(Z + zc(ZC_GQ + hh * 32) + row0 * ZRS); gcp zk = uptr(Z + zc(ZC_GK + hh * 32) + row0 * ZRS); gcp bcb = uptr(F_BC + row0 * 128 + hh * 32);
    bf16x8 qf[2][2], kf[2][2];
#pragma unroll
    for (int blk = 0; blk < 2; ++blk)
#pragma unroll
        for (int s = 0; s < 2; ++s) {
            float q8[8], k8[8];
            unpack8(*(const GAS v4u*)(zq + ((size_t)32 * blk * ZRS + 16 * s) * 2 + voffK), q8); unpack8(*(const GAS v4u*)(zk + ((size_t)32 * blk * ZRS + 16 * s) * 2 + voffK), k8);
            const f32x4 c0 = *(const GAS f32x4*)(bcb + ((size_t)32 * blk * 128 + 16 * s) * 4 + voffB), c1 = *(const GAS f32x4*)(bcb + ((size_t)32 * blk * 128 + 16 * s) * 4 + voffB + 16);
            const float bc8[8] = {c0[0], c0[1], c0[2], c0[3], c1[0], c1[1], c1[2], c1[3]};
#pragma unroll
            for (int e = 0; e < 8; ++e) { q8[e] *= 0.17677669529663687f * fexp(bc8[e]); k8[e] *= fexp(-bc8[e]); }
            qf[blk][s] = pack8(q8[0], q8[1], q8[2], q8[3], q8[4], q8[5], q8[6], q8[7]);
            kf[blk][s] = pack8(k8[0], k8[1], k8[2], k8[3], k8[4], k8[5], k8[6], k8[7]);
        }
    bf16x8 pf0[2], pf1[4];
    {
        f32x16 s00, s01, s11;
#pragma unroll
        for (int i = 0; i < 16; ++i) { s00[i] = 0.f; s01[i] = 0.f; s11[i] = 0.f; }
#pragma unroll
        for (int s = 0; s < 2; ++s) { s00 = MFMA32(kf[0][s], qf[0][s], s00); s01 = MFMA32(kf[0][s], qf[1][s], s01); s11 = MFMA32(kf[1][s], qf[1][s], s11); }
#pragma unroll
        for (int i = 0; i < 16; ++i) { const int jr = (i & 3) + 8 * (i >> 2) + 4 * hf; if (jr > r) { s00[i] = 0.f; s11[i] = 0.f; } }
        pf0[0] = pack8(s00[0], s00[1], s00[2], s00[3], s00[4], s00[5], s00[6], s00[7]); pf0[1] = pack8(s00[8], s00[9], s00[10], s00[11], s00[12], s00[13], s00[14], s00[15]);
        pf1[0] = pack8(s01[0], s01[1], s01[2], s01[3], s01[4], s01[5], s01[6], s01[7]); pf1[1] = pack8(s01[8], s01[9], s01[10], s01[11], s01[12], s01[13], s01[14], s01[15]);
        pf1[2] = pack8(s11[0], s11[1], s11[2], s11[3], s11[4], s11[5], s11[6], s11[7]); pf1[3] = pack8(s11[8], s11[9], s11[10], s11[11], s11[12], s11[13], s11[14], s11[15]);
    }
    unsigned trb0, trb1; tr_bases(lane, trb0, trb1);
    gcp spb = uptr(F_SST + ((size_t)cn * 4 + hh) * 2048);
    f32x16 num[2][2];
#pragma unroll
    for (int vb = 0; vb < 2; ++vb) {
        bf16x8 sf[2];
#pragma unroll
        for (int s = 0; s < 2; ++s) sf[s] = ld_f32_frag(spb + ((size_t)32 * vb * 32 + 16 * s) * 4, (unsigned)(r * 32 + 8 * hf) * 4u);
#pragma unroll
        for (int tb = 0; tb < 2; ++tb) {
#pragma unroll
            for (int i = 0; i < 16; ++i) num[vb][tb][i] = 0.f;
#pragma unroll
            for (int s = 0; s < 2; ++s) num[vb][tb] = MFMA32(sf[s], qf[tb][s], num[vb][tb]);
        }
    }
    asm volatile("s_waitcnt vmcnt(0)" ::: "memory");
#pragma unroll
    for (int vb = 0; vb < 2; ++vb)
#pragma unroll
        for (int ks = 0; ks < 4; ++ks) {
            const bf16x8 vf = tr_frag_b(wl, vb ? trb1 : trb0, ks);
            if (ks < 2) num[vb][0] = MFMA32(vf, pf0[ks], num[vb][0]);
            num[vb][1] = MFMA32(vf, pf1[ks], num[vb][1]);
        }
#pragma unroll
    for (int tb = 0; tb < 2; ++tb) {
        float ss = 0.f;
#pragma unroll
        for (int vb = 0; vb < 2; ++vb)
#pragma unroll
            for (int i = 0; i < 16; ++i) ss += num[vb][tb][i] * num[vb][tb][i];
        ss = xh_sum(ss);
        const float rn = 1.0f / sqrtf(ss * (1.0f / 64.0f) + EPS);
#pragma unroll
        for (int vb = 0; vb < 2; ++vb)
#pragma unroll
            for (int i4 = 0; i4 < 4; ++i4) tl_put4(wl, 32 * tb + r, 32 * vb + 8 * i4 + 4 * hf, num[vb][tb][4 * i4] * rn, num[vb][tb][4 * i4 + 1] * rn, num[vb][tb][4 * i4 + 2] * rn, num[vb][tb][4 * i4 + 3] * rn);
    }
    tl_emit<2>(wl, lane, uptr(Z + zc(ZC_GG + hh * 64) + row0 * ZRS), (gcp)nullptr, F_gla_norm_g + layer * 256 + hh * 64, (GAS char*)uptr(F_Y + row0 * DM + 768 + hh * 64));
}

__device__ __forceinline__ void p2_local(Frame& F, int layer) {
    int gw_ = F.vcu * NWAVES + F.wave; asm volatile("" : "+s"(gw_));
    const int gw = gw_, NGW = F.G * NWAVES;
    LAS unsigned char* wl = F.lds + RING_OFF + F.wave * WL_BYTES;
    constexpr int NA = NCHT * 6, NL = NCHT * 10;
    if (NGW == 2048) {
#define LOCAL_TASK(q) do { const int q_ = (q); if (q_ < NA) ml_loc_wave(F, layer, q_ / 6, q_ % 6, wl); else gla_loc_wave(F, layer, (q_ - NA) >> 2, (q_ - NA) & 3, wl); } while (0)
        if (gw < NA) { LOCAL_TASK(gw); attn_wave(F, layer, gw / 6, gw % 6, wl); }
        else { const int q0 = NA + 2 * (gw - NA); for (int q = q0; q < q0 + 2; ++q) LOCAL_TASK(q); }
#undef LOCAL_TASK
    } else {
        for (int a = gw; a < NA; a += NGW) attn_wave(F, layer, a / 6, a % 6, wl);
        for (int q = gw; q < NL; q += NGW) { if (q < NA) ml_loc_wave(F, layer, q / 6, q % 6, wl); else gla_loc_wave(F, layer, (q - NA) >> 2, (q - NA) & 3, wl); }
    }
}
__device__ __forceinline__ void p4_outputs(Frame& F, int layer) {
    int gw_ = F.vcu * NWAVES + F.wave; asm volatile("" : "+s"(gw_));
    const int gw = gw_, NGW = F.G * NWAVES;
    LAS unsigned char* wl = F.lds + RING_OFF + F.wave * WL_BYTES;
    constexpr int NA = NCHT * 6, NG = NCHT * 4;
    if (NGW == 2048) {
        if (gw < NA) { ml_out_wave(F, layer, gw / 6, gw % 6, wl);
#if PROBE_DUP == 8
            ml_out_wave(F, layer, gw / 6, gw % 6, wl);
#endif
        }
        else { for (int q = gw - NA; q < NG; q += 512) gla_out_wave(F, layer, q >> 2, q & 3, wl);
#if PROBE_DUP == 9
            for (int q = gw - NA; q < NG; q += 512) gla_out_wave(F, layer, q >> 2, q & 3, wl);
#endif
        }
    } else {
        for (int a = gw; a < NA; a += NGW) ml_out_wave(F, layer, a / 6, a % 6, wl);
        for (int q = gw; q < NG; q += NGW) gla_out_wave(F, layer, q >> 2, q & 3, wl);
    }
}

__device__ __forceinline__ void p11_final(Frame& F) {
    int gw_ = F.vcu * NWAVES + F.wave; asm volatile("" : "+s"(gw_));
    const int gw = gw_, NGW = F.G * NWAVES;
    const float* ssq = F_SSQ + 2 * T;
    for (int m = gw; m < T; m += NGW) {
        const float rs = 1.0f / sqrtf(ssq[m] * (1.0f / 1024.0f) + EPS);
        const GAS unsigned long long* xr = (const GAS unsigned long long*)(F_XB + (size_t)m * DM) + F_lane;
        GAS f32x4* orow = (GAS f32x4*)(F_out + (size_t)m * DM) + F_lane; const GAS f32x4* gr = (const GAS f32x4*)F_final_g + F_lane;
#pragma unroll
        for (int j = 0; j < 4; ++j) { const unsigned long long w = xr[64 * j]; const f32x4 g = gr[64 * j];
            const f32x4 v = (f32x4){__uint_as_float((unsigned)w << 16), __uint_as_float((unsigned)w & 0xffff0000u), __uint_as_float((unsigned)(w >> 32) << 16), __uint_as_float((unsigned)(w >> 32) & 0xffff0000u)};
            orow[64 * j] = v * rs * g; }
    }
}

__global__ void __launch_bounds__(NTHR, 2) hymba_fwd(Args args) {
    extern __shared__ __attribute__((aligned(16))) unsigned char lds[];
    Frame F;
    F.lds = (LAS unsigned char*)lds;
    F.MISC = (volatile LAS unsigned*)(F.lds + MISC_OFF);
    F.wave = __builtin_amdgcn_readfirstlane(F_tid >> 6);
    F.G = gridDim.x; { const int bx = blockIdx.x; F.vcu = (F.G % 8 == 0) ? (bx % 8) * (F.G / 8) + bx / 8 : bx; }
    F.A = &args;
    for (int u = F_tid; u < (LDS_BYTES - LDSCTL_OFF) / 4; u += NTHR) ((LAS unsigned*)(F.lds + LDSCTL_OFF))[u] = 0u;
    __syncthreads();
    XcdBarrier bar; bar.bar = (unsigned*)(F_ctl + CW_BAR); bar.x = 0; bar.st = nullptr;
    if (N_LAUNCHES == 1) bar = xcd_barrier_post((unsigned*)(F_ctl + CW_BAR), F.MISC + 8);
#define GRID_BAR() do { if (N_LAUNCHES == 1) { XcdBarrier b2_ = bar; unsigned long long v_ = (unsigned long long)bar.bar; asm volatile("" : "+s"(v_)); b2_.bar = (unsigned*)v_; xcd_barrier(b2_); } } while (0)
    const int lo = args.ph_lo, hi = args.ph_hi;
#pragma unroll 1
    for (int ph = lo; ph < hi; ++ph) {
        if (ph == 0) { p0_prologue(F);
#if PROBE_DUP == 4
            GRID_BAR(); p0_prologue(F);
#endif
        } else if (ph == NPHASE - 1) { p11_final(F);
        } else {
            const int layer = (ph - 1) / 5, k = (ph - 1) % 5;
            if (k == 0 || k == 4) {
                const int which = k ? 1 : 0, N = which ? DM : NP;
                pg8::Gemm g{which ? F_Y : F_XB, which ? F_Wout_t + (size_t)layer * DM * DM : F_Win_t + (size_t)layer * NP * DM, T, N, DM};
                pg8::StaticOrder S; S.init(T, N, F.G, (int)blockIdx.x);
                pg8::EpiBoth E{which, pg8::EpiZ{F_Z, LDZ, F_SSQ + layer * T, F_G32, ZC_SM},
                               pg8::EpiRes{(const float*)nullptr, (const bf16*)F_XB, (float*)nullptr, F_XB, F_SSQ + (layer + 1) * T}};
                pg8::gemm_phase<pg8::EpiBoth, pg8::StaticOrder, true, true>(F.lds + RING_OFF, g, S, E);
                if (ph == 1 && F.G == 256 && (int)blockIdx.x >= 64) { int wi_ = ((int)blockIdx.x - 64) * NWAVES + F.wave; asm volatile("" : "+s"(wi_)); p0_weights(F, 1, wi_, 192 * NWAVES); }
            } else if (k == 1) { p2_local(F, layer);
#if PROBE_DUP == 2
                GRID_BAR(); p2_local(F, layer);
#endif
            } else if (k == 2) { p3_scan(F);
            } else { p4_outputs(F, layer);
#if PROBE_DUP == 3
                GRID_BAR(); p4_outputs(F, layer);
#endif
            }
        }
        if (ph + 1 < hi) GRID_BAR();
    }
}

extern "C" void kernel_launch(void* const* d_in, const int* in_sizes, int n_in, void* d_out, int out_size, void* d_ws, size_t ws_size, hipStream_t stream) {
    static int grid = 0;
    if (grid == 0) {
        if (n_in != 12 || in_sizes[0] != T * DM || out_size != T * DM || ws_size < WS_END) {
            fprintf(stderr, "kernel_launch: unexpected shapes (n_in %d, in0 %d, out %d, ws %zu, need %zu); nothing launched\n", n_in, n_in > 0 ? in_sizes[0] : -1, out_size, ws_size, (size_t)WS_END); grid = -1; return; }
        int dev = 0, cus = 0, per_cu = 0;
        if (hipGetDevice(&dev) != hipSuccess || hipDeviceGetAttribute(&cus, hipDeviceAttributeMultiprocessorCount, dev) != hipSuccess) { fprintf(stderr, "kernel_launch: device query failed\n"); grid = -1; return; }
        if (hipFuncSetAttribute((const void*)hymba_fwd, hipFuncAttributeMaxDynamicSharedMemorySize, LDS_BYTES) != hipSuccess) { fprintf(stderr, "kernel_launch: hipFuncSetAttribute failed\n"); grid = -1; return; }
        if (hipOccupancyMaxActiveBlocksPerMultiprocessor(&per_cu, (const void*)hymba_fwd, NTHR, LDS_BYTES) != hipSuccess || per_cu < 1) {
            fprintf(stderr, "kernel_launch: occupancy query reports %d workgroups per CU; nothing launched\n", per_cu); (void)hipGetLastError(); grid = -1; return; }
        grid = cus;
        fprintf(stderr, "kernel_launch: grid %d x %d threads, %d B LDS, occupancy query %d/CU\n", grid, NTHR, LDS_BYTES, per_cu);
    }
    if (grid < 0) return;
    if (hipMemsetAsync((char*)d_ws + WS_CTL, 0, CTL_ZERO_BYTES, stream) != hipSuccess) { fprintf(stderr, "kernel_launch: memset failed\n"); return; }
    Args a{};
    for (int i = 0; i < 12; ++i) a.in[i] = (const float*)d_in[i];
    a.out = (float*)d_out; a.ws = (unsigned char*)d_ws;
    if (N_LAUNCHES == 1) {
        a.ph_lo = 0; a.ph_hi = NPHASE; a.li = 0;
        void* kargs[] = {&a};
        hipError_t e = hipLaunchCooperativeKernel((const void*)hymba_fwd, dim3(grid), dim3(NTHR), kargs, LDS_BYTES, stream);
        if (e != hipSuccess) fprintf(stderr, "kernel_launch: cooperative launch failed: %s\n", hipGetErrorString(e));
    } else {
        for (int p = 0; p < NPHASE; ++p) { a.ph_lo = p; a.ph_hi = p + 1; a.li = p;
            hipLaunchKernelGGL(hymba_fwd, dim3(grid), dim3(NTHR), LDS_BYTES, stream, a);
            if (hipPeekAtLastError() != hipSuccess) { fprintf(stderr, "kernel_launch: launch %d failed\n", p); break; } }
    }
}
```

```cpp
#include <hip/hip_runtime.h>
#include <cstdio>
#include <cstdint>
#include <cmath>

#ifndef PROBE_DUP
#define PROBE_DUP 0
#endif
#ifndef PROBE_T
#define PROBE_T 0
#endif
#ifndef MK_N_LAUNCHES
#define MK_N_LAUNCHES 1
#endif

namespace pg8 {
#define PG8_LAS __attribute__((address_space(3)))
typedef unsigned short bf16_t;
typedef short bf16x8 __attribute__((ext_vector_type(8)));
typedef float f32x4 __attribute__((ext_vector_type(4)));
typedef unsigned u32x4 __attribute__((ext_vector_type(4)));
constexpr int BM = 256, BK = 64, HALF = 128, HTB = HALF * BK * 2  , STAGE_BYTES = 8 * HTB, NXCD = 8, WGM = 8;

__host__ __device__ __forceinline__ int lds_byte(int r, int c) { const int st = (r >> 4) * 2 + (c >> 5), rr = r & 15, cc = c & 31, ob = rr * 64 + cc * 2; return st * 1024 + (ob ^ (((ob >> 9) & 1) << 5)); }
__host__ __device__ __forceinline__ void stage_rc(int b, int& R, int& C) { const int st = b / 1024, sb = b % 1024, swz = sb ^ (((sb >> 9) & 1) << 5); R = (st >> 1) * 16 + swz / 64; C = (st & 1) * 32 + (swz % 64) / 2; }
__host__ __device__ __forceinline__ int perm32(int rho) { const int n = rho >> 4, i = rho & 15; return 8 * (i >> 2) + 4 * n + (i & 3); }

struct Unit { int pm, pn; };
struct Gemm { const bf16_t* A; const bf16_t* Bt; int M, N, K; };

struct StaticOrder {
    int nM, nN, nwg, G, c;
    __host__ __device__ void init(int M, int N, int G_, int c_) { nM = M / BM; nN = N / BM; nwg = nM * nN; G = G_; c = c_; }
    __host__ __device__ bool next(int i, Unit& u) const {
        const long L = (long)i * G + c; if (L >= nwg) return false;
        int wgid = (int)L; { const int q = nwg / NXCD, r = nwg % NXCD, xcd = wgid % NXCD, off = wgid / NXCD; wgid = (xcd < r ? xcd * (q + 1) : r * (q + 1) + (xcd - r) * q) + off; }
        const int nig = WGM * nN, gid = wgid / nig, fm = gid * WGM, gsz = (nM - fm) < WGM ? (nM - fm) : WGM;
        u.pm = fm + ((wgid % nig) % gsz); u.pn = (wgid % nig) / gsz; return true;
    }
    __device__ __forceinline__ void a_ready(const Unit&) const {}
    __device__ __forceinline__ void done(const Unit&) const {}
};

__device__ __forceinline__ unsigned cvt_pk_bf16(float lo, float hi) { unsigned r; asm volatile("v_cvt_pk_bf16_f32 %0, %1, %2" : "=v"(r) : "v"(lo), "v"(hi)); return r; }

typedef unsigned u32x2 __attribute__((ext_vector_type(2)));
struct EpiZ {
    bf16_t* Z; int ldz; const float* ssq; float* G32; int gcol0;
    __device__ __forceinline__ void operator()(const f32x4 (&acc)[2][2][4][2], const Unit& u, int wr, int wc, int fr, int fq) const {
        const int row0 = u.pm * BM + wr * 64 + fr, col0 = u.pn * BM + wc * 32 + 8 * fq;
#pragma unroll
        for (int ai = 0; ai < 2; ++ai)
#pragma unroll
            for (int m = 0; m < 4; ++m) {
                const int row = row0 + ai * HALF + m * 16;
                const float rs = 1.0f / sqrtf(ssq[row] * (1.0f / 1024.0f) + 1e-6f);
#pragma unroll
                for (int bj = 0; bj < 2; ++bj) {
                    const int col = col0 + bj * HALF;
                    const f32x4 v0 = acc[ai][bj][m][0] * rs, v1 = acc[ai][bj][m][1] * rs;
                    if (col < ldz) {
                        u32x4 w; w.x = cvt_pk_bf16(v0[0], v0[1]); w.y = cvt_pk_bf16(v0[2], v0[3]); w.z = cvt_pk_bf16(v1[0], v1[1]); w.w = cvt_pk_bf16(v1[2], v1[3]);
                        *(u32x4*)(Z + (size_t)(col >> 6) * ((size_t)16384 * 64) + (size_t)row * 64 + (col & 63)) = w;
                    } else if (col < gcol0 + 32) {
                        float* gp = G32 + (size_t)row * 32 + (col - gcol0);
                        *(f32x4*)gp = v0; *(f32x4*)(gp + 4) = v1;
                    }
                }
            }
    }
};
struct EpiRes {
    const float* base; const bf16_t* baseb; float* out; bf16_t* xb; float* ssq;
    __device__ __forceinline__ void ldres(int row, int col0, int bj, f32x4& r0, f32x4& r1) const {
        const size_t off = (size_t)row * 1024 + col0 + bj * HALF;
        if (base) { r0 = *(const f32x4*)(base + off); r1 = *(const f32x4*)(base + off + 4); }
        else { const u32x4 w = *(const u32x4*)(baseb + off);
            r0 = (f32x4){__uint_as_float(w.x << 16), __uint_as_float(w.x & 0xffff0000u), __uint_as_float(w.y << 16), __uint_as_float(w.y & 0xffff0000u)};
            r1 = (f32x4){__uint_as_float(w.z << 16), __uint_as_float(w.z & 0xffff0000u), __uint_as_float(w.w << 16), __uint_as_float(w.w & 0xffff0000u)}; }
    }
    __device__ __forceinline__ void operator()(const f32x4 (&acc)[2][2][4][2], const Unit& u, int wr, int wc, int fr, int fq) const {
        const int col0 = u.pn * BM + wc * 32 + 8 * fq;
        f32x4 pre[2][2];
        { const int row = u.pm * BM + wr * 64 + fr;
#pragma unroll
          for (int bj = 0; bj < 2; ++bj) ldres(row, col0, bj, pre[bj][0], pre[bj][1]); }
#pragma unroll
        for (int g = 0; g < 8; ++g) {
            const int ai = g >> 2, m = g & 3;
            const int row = u.pm * BM + ai * HALF + wr * 64 + m * 16 + fr;
            f32x4 nxt[2][2];
            if (g < 7) { const int row2 = u.pm * BM + ((g + 1) >> 2) * HALF + wr * 64 + ((g + 1) & 3) * 16 + fr;
#pragma unroll
                for (int bj = 0; bj < 2; ++bj) ldres(row2, col0, bj, nxt[bj][0], nxt[bj][1]); }
            asm volatile("" ::: "memory");
            float s = 0.f;
#pragma unroll
            for (int bj = 0; bj < 2; ++bj) {
                const size_t off = (size_t)row * 1024 + col0 + bj * HALF;
                const f32x4 o0 = pre[bj][0] + acc[ai][bj][m][0], o1 = pre[bj][1] + acc[ai][bj][m][1];
                if (out) { *(f32x4*)(out + off) = o0; *(f32x4*)(out + off + 4) = o1; }
                s += (o0[0] * o0[0] + o0[1] * o0[1]) + (o0[2] * o0[2] + o0[3] * o0[3]) + (o1[0] * o1[0] + o1[1] * o1[1]) + (o1[2] * o1[2] + o1[3] * o1[3]);
                if (xb) { u32x4 w; w.x = cvt_pk_bf16(o0[0], o0[1]); w.y = cvt_pk_bf16(o0[2], o0[3]); w.z = cvt_pk_bf16(o1[0], o1[1]); w.w = cvt_pk_bf16(o1[2], o1[3]); *(u32x4*)(xb + off) = w; }
            }
            s += __shfl_xor(s, 16); s += __shfl_xor(s, 32);
            if (fq == 0) atomicAdd(ssq + row, s);
            asm volatile("" ::: "memory");
            if (g < 7) {
#pragma unroll
                for (int bj = 0; bj < 2; ++bj) { pre[bj][0] = nxt[bj][0]; pre[bj][1] = nxt[bj][1]; } }
        }
    }
};
struct EpiBoth {
    static constexpr bool PERM = true, AFTER_DRAIN = false;
    int mode; EpiZ z; EpiRes r;
    __device__ __forceinline__ void operator()(const f32x4 (&acc)[2][2][4][2], const Unit& u, int wr, int wc, int fr, int fq) const {
        if (mode == 0) z(acc, u, wr, wc, fr, fq); else r(acc, u, wr, wc, fr, fq);
    }
};

template <class Epi, class Sched, bool ALIGN_EPI = false, bool SP2 = false>
__device__ __forceinline__ void gemm_phase(PG8_LAS unsigned char* lds, const Gemm g, const Sched& S, const Epi& E) {
    int tid_ = threadIdx.x; asm volatile("" : "+v"(tid_));
    const int tid = tid_, wid = __builtin_amdgcn_readfirstlane(tid >> 6), lane = tid & 63, wr = wid >> 2, wc = wid & 3, fr = lane & 15, fq = lane >> 4;
    const int K = g.K, nt = K / BK;
    unsigned voffA[2], voffB[2];
#pragma unroll
    for (int i = 0; i < 2; ++i) { int R, C; stage_rc(tid * 16 + i * 8192, R, C); const int Rb = Epi::PERM ? ((R & ~31) + perm32(R & 31)) : R;
        voffA[i] = (unsigned)(R * K + C) * 2u; voffB[i] = (unsigned)(Rb * K + C) * 2u; }
    const size_t kstep = (size_t)(BK * 2);
    const size_t hstep = (size_t)HALF * K * 2;
    const size_t tstep = 2 * hstep;
    const unsigned ldsw = (unsigned)wid * 1024u;
    const int aoff = lds_byte(wr * 64 + fr, fq * 8), boff = lds_byte(wc * 32 + fr, fq * 8);
#define PG8_SA(b, h) (((b) * 2 + (h)) * HTB)
#define PG8_SB(b, h) ((4 + (b) * 2 + (h)) * HTB)
#define PG8_STAGE(bufoff, gbase, voff) do { _Pragma("unroll") for (int _i = 0; _i < 2; ++_i) \
        __builtin_amdgcn_global_load_lds((const unsigned*)((const char*)(gbase) + (voff)[_i]), (PG8_LAS unsigned*)(lds + (bufoff) + ldsw + _i * 8192), 16, 0, 0); } while (0)
#define PG8_LDA(dst, b, h) do { _Pragma("unroll") for (int m = 0; m < 4; ++m) _Pragma("unroll") for (int k = 0; k < 2; ++k) dst[m][k] = *(const PG8_LAS bf16x8*)(lds + PG8_SA(b, h) + aoff + m * 2048 + k * 1024); } while (0)
#define PG8_LDB(dst, b, h) do { _Pragma("unroll") for (int n = 0; n < 2; ++n) _Pragma("unroll") for (int k = 0; k < 2; ++k) dst[n][k] = *(const PG8_LAS bf16x8*)(lds + PG8_SB(b, h) + boff + n * 2048 + k * 1024); } while (0)
#define PG8_MMA(ai, bj, At, Bt) do { __builtin_amdgcn_s_setprio(1); _Pragma("unroll") for (int m = 0; m < 4; ++m) _Pragma("unroll") for (int n = 0; n < 2; ++n) _Pragma("unroll") for (int k = 0; k < 2; ++k) \
        acc[ai][bj][m][n] = __builtin_amdgcn_mfma_f32_16x16x32_bf16(Bt[n][k], At[m][k], acc[ai][bj][m][n], 0, 0, 0); __builtin_amdgcn_s_setprio(0); } while (0)
#define PG8_WAIT_V(n) asm volatile("s_waitcnt vmcnt(" #n ")" ::: "memory")
#define PG8_WAIT_L(n) asm volatile("s_waitcnt lgkmcnt(" #n ")" ::: "memory")
#define PG8_BAR __builtin_amdgcn_s_barrier()
#define PG8_SCHED __builtin_amdgcn_sched_barrier(0)
    Unit cur, nxt; int ui = 0;
    if (!S.next(0, cur)) return;
    f32x4 acc[2][2][4][2];
#pragma unroll
    for (int a = 0; a < 2; ++a)
#pragma unroll
        for (int b = 0; b < 2; ++b)
#pragma unroll
            for (int m = 0; m < 4; ++m)
#pragma unroll
                for (int n = 0; n < 2; ++n) acc[a][b][m][n] = (f32x4){0.f, 0.f, 0.f, 0.f};
    bf16x8 At[4][2], B0[2][2], B1[2][2];
    const char* cA = (const char*)g.A + (size_t)cur.pm * tstep; const char* cB = (const char*)g.Bt + (size_t)cur.pn * tstep;
    S.a_ready(cur);
    if constexpr (SP2) {
        PG8_STAGE(PG8_SB(0, 0), cB, voffB); PG8_STAGE(PG8_SB(0, 1), cB + hstep, voffB); PG8_STAGE(PG8_SA(0, 0), cA, voffA); PG8_STAGE(PG8_SA(0, 1), cA + hstep, voffA);
        if (wr == 1) PG8_BAR;
        PG8_WAIT_V(2); PG8_BAR;
        PG8_STAGE(PG8_SB(1, 0), cB + kstep, voffB); PG8_STAGE(PG8_SA(1, 0), cA + kstep, voffA); PG8_STAGE(PG8_SB(1, 1), cB + hstep + kstep, voffB);
        PG8_WAIT_V(6); PG8_BAR;
    } else {
        PG8_STAGE(PG8_SB(0, 0), cB, voffB); PG8_STAGE(PG8_SA(0, 0), cA, voffA); PG8_STAGE(PG8_SB(0, 1), cB + hstep, voffB); PG8_STAGE(PG8_SA(0, 1), cA + hstep, voffA);
        if (wr == 1) PG8_BAR;
        PG8_WAIT_V(4); PG8_BAR;
        PG8_STAGE(PG8_SB(1, 0), cB + kstep, voffB); PG8_STAGE(PG8_SA(1, 0), cA + kstep, voffA); PG8_STAGE(PG8_SB(1, 1), cB + hstep + kstep, voffB);
        PG8_WAIT_V(6); PG8_BAR;
    }
    for (;;) {
        const bool has_next = S.next(ui + 1, nxt);
        const char* nA = has_next ? (const char*)g.A + (size_t)nxt.pm * tstep : cA; const char* nB = has_next ? (const char*)g.Bt + (size_t)nxt.pn * tstep : cB;
        for (int t = 0; t < nt; t += 2) {
            const bool last = (t == nt - 2);
            const char* a1 = cA + (size_t)(t + 1) * kstep;
            const char* a2 = last ? nA : cA + (size_t)(t + 2) * kstep; const char* b2 = last ? nB : cB + (size_t)(t + 2) * kstep;
            const char* a3 = a2 + kstep; const char* b3 = b2 + kstep;
            if (last && has_next) S.a_ready(nxt);
            if constexpr (SP2) {
            PG8_LDB(B0, 0, 0); PG8_LDB(B1, 0, 1); PG8_SCHED; PG8_LDA(At, 0, 0); PG8_STAGE(PG8_SA(1, 1), a1 + hstep, voffA);
            PG8_WAIT_V(8); PG8_WAIT_L(0); PG8_BAR; PG8_MMA(0, 0, At, B0); PG8_MMA(0, 1, At, B1); PG8_BAR; PG8_SCHED;
            PG8_LDA(At, 0, 1); PG8_STAGE(PG8_SB(0, 0), b2, voffB); PG8_STAGE(PG8_SB(0, 1), b2 + hstep, voffB); PG8_STAGE(PG8_SA(0, 0), a2, voffA);
            PG8_WAIT_V(8); PG8_WAIT_L(0); PG8_BAR; PG8_MMA(1, 0, At, B0); PG8_MMA(1, 1, At, B1); PG8_BAR; PG8_SCHED;
            PG8_LDB(B0, 1, 0); PG8_LDB(B1, 1, 1); PG8_SCHED; PG8_LDA(At, 1, 0); PG8_STAGE(PG8_SA(0, 1), a2 + hstep, voffA);
            PG8_WAIT_V(8); PG8_WAIT_L(0); PG8_BAR; PG8_MMA(0, 0, At, B0); PG8_MMA(0, 1, At, B1); PG8_BAR; PG8_SCHED;
            PG8_LDA(At, 1, 1); PG8_STAGE(PG8_SB(1, 0), b3, voffB); PG8_STAGE(PG8_SB(1, 1), b3 + hstep, voffB); PG8_STAGE(PG8_SA(1, 0), a3, voffA);
            PG8_WAIT_V(8); PG8_WAIT_L(0); PG8_BAR; PG8_MMA(1, 0, At, B0); PG8_MMA(1, 1, At, B1); PG8_BAR; PG8_SCHED;
            } else {
            PG8_LDB(B0, 0, 0); PG8_SCHED; PG8_LDA(At, 0, 0); PG8_STAGE(PG8_SA(1, 1), a1 + hstep, voffA);
            PG8_WAIT_L(8); PG8_BAR; PG8_WAIT_L(0); PG8_MMA(0, 0, At, B0); PG8_BAR; PG8_SCHED;
            PG8_LDB(B1, 0, 1); PG8_STAGE(PG8_SB(0, 0), b2, voffB);
            PG8_BAR; PG8_WAIT_L(0); PG8_MMA(0, 1, At, B1); PG8_BAR;
            PG8_LDA(At, 0, 1); PG8_STAGE(PG8_SA(0, 0), a2, voffA);
            PG8_BAR; PG8_WAIT_L(0); PG8_MMA(1, 0, At, B0); PG8_BAR; PG8_SCHED;
            PG8_STAGE(PG8_SB(0, 1), b2 + hstep, voffB);
            PG8_WAIT_V(6); PG8_BAR; PG8_MMA(1, 1, At, B1); PG8_BAR;
            PG8_LDB(B0, 1, 0); PG8_SCHED; PG8_LDA(At, 1, 0); PG8_STAGE(PG8_SA(0, 1), a2 + hstep, voffA);
            PG8_WAIT_L(8); PG8_BAR; PG8_WAIT_L(0); PG8_MMA(0, 0, At, B0); PG8_BAR; PG8_SCHED;
            PG8_LDB(B1, 1, 1); PG8_STAGE(PG8_SB(1, 0), b3, voffB);
            PG8_BAR; PG8_WAIT_L(0); PG8_MMA(0, 1, At, B1); PG8_BAR;
            PG8_LDA(At, 1, 1); PG8_STAGE(PG8_SA(1, 0), a3, voffA);
            PG8_BAR; PG8_WAIT_L(0); PG8_MMA(1, 0, At, B0); PG8_BAR; PG8_SCHED;
            PG8_STAGE(PG8_SB(1, 1), b3 + hstep, voffB);
            PG8_WAIT_V(6); PG8_BAR; PG8_MMA(1, 1, At, B1); PG8_BAR;
            }
        }
        if constexpr (ALIGN_EPI) { if (wr == 0) PG8_BAR; }
        if constexpr (!Epi::AFTER_DRAIN) { E(acc, cur, wr, wc, fr, fq); S.done(cur); }
        if (!has_next) break;
#pragma unroll
        for (int a = 0; a < 2; ++a)
#pragma unroll
            for (int b = 0; b < 2; ++b)
#pragma unroll
                for (int m = 0; m < 4; ++m)
#pragma unroll
                    for (int n = 0; n < 2; ++n) acc[a][b][m][n] = (f32x4){0.f, 0.f, 0.f, 0.f};
        cur = nxt; cA = nA; cB = nB; ++ui;
        if constexpr (ALIGN_EPI) { if (wr == 1) PG8_BAR; }
    }
    PG8_WAIT_V(0);
    if constexpr (!ALIGN_EPI) { if (wr == 0) PG8_BAR; }
    PG8_BAR;
    if constexpr (Epi::AFTER_DRAIN) { E.fused(acc, cur, wr, wc, fr, fq, lds, wid, lane); S.done(cur); }
#undef PG8_SA
#undef PG8_SB
#undef PG8_STAGE
#undef PG8_LDA
#undef PG8_LDB
#undef PG8_MMA
#undef PG8_WAIT_V
#undef PG8_WAIT_L
#undef PG8_BAR
#undef PG8_SCHED
}
}

constexpr int NWAVES = 8, NTHR = 512;
constexpr int N_LAUNCHES = MK_N_LAUNCHES;
constexpr int NPHASE = 12;
constexpr int BATCH = 2, SEQ = 8192, DM = 1024, T = BATCH * SEQ, DEPTH = 2, CH = 64, NCHT = T / CH  , NCHS = SEQ / CH  ;
constexpr int DIN = 4252, NP = 4352, LDZ = 4224;
constexpr int ZC_AQ = 0, ZC_AK = 384, ZC_AV = 768, ZC_AG = 1152, ZC_MQ = 1536, ZC_MK = 1920, ZC_MV = 2304, ZC_MO = 2688, ZC_MG = 3072, ZC_GQ = 3456, ZC_GK = 3584, ZC_GV = 3712, ZC_GG = 3968, ZC_SM = 4224;
constexpr float EPS = 1e-6f;
__host__ __device__ __forceinline__ int src_col(int n) {
    if (n < 3072) return n;
    if (n < 3968) return n + 12;
    if (n < 4224) return n + 28;
    if (n < 4236) return n - 1152;
    if (n < 4252) return n - 256;
    return -1;
}

constexpr size_t MiB = 1u << 20;
constexpr size_t WS_CTL = 0, CTL_ZERO_BYTES = 1 * MiB;
constexpr size_t WS_SSQ = 512 * 1024;
constexpr size_t WS_WIN = 1 * MiB;
constexpr size_t WS_WOUT = WS_WIN + (size_t)2 * NP * DM * 2;
constexpr size_t WS_XB = WS_WOUT + (size_t)2 * DM * DM * 2;
constexpr size_t WS_Y = WS_XB + (size_t)T * DM * 2;
constexpr size_t WS_Z = WS_Y + (size_t)T * DM * 2;
constexpr size_t WS_G32 = WS_Z + (size_t)T * LDZ * 2;
constexpr size_t WS_CST = WS_G32 + (size_t)T * 32 * 4;
constexpr size_t WS_NST = WS_CST + (size_t)NCHT * 6 * 4096 * 4;
constexpr size_t WS_SST = WS_NST + (size_t)NCHT * 6 * 64 * 4;
constexpr size_t WS_ADEC = WS_SST + (size_t)NCHT * 4 * 2048 * 4;
constexpr size_t WS_GS = WS_ADEC + (size_t)NCHT * 4 * 32 * 4;
constexpr size_t WS_MS = WS_GS + 8192;
constexpr size_t WS_MP = WS_MS + 8192;
constexpr size_t WS_END = WS_MP + 8192;
static_assert(WS_END <= 268435456, "d_ws map exceeds 256 MiB");
constexpr int CW_BAR = 4096;

constexpr int RING_OFF = 0, RING_BYTES = 162816;
constexpr int WL_BYTES = 20352;
constexpr int LDSCTL_OFF = RING_BYTES, MISC_OFF = LDSCTL_OFF + 320;
constexpr int LDS_BYTES = 163840;
#define GAS __attribute__((address_space(1)))
#define LAS __attribute__((address_space(3)))
typedef unsigned short bf16;
typedef unsigned v4u __attribute__((ext_vector_type(4)));
typedef float f32x4 __attribute__((ext_vector_type(4)));
typedef short bf16x8 __attribute__((ext_vector_type(8)));
typedef GAS unsigned gu32;
typedef GAS unsigned long long gu64;
#define RLX_AGENT __ATOMIC_RELAXED, __HIP_MEMORY_SCOPE_AGENT
#define LDS_WAIT() asm volatile("s_waitcnt lgkmcnt(0)" ::: "memory")
#define VM_WAIT() asm volatile("s_waitcnt vmcnt(0)" ::: "memory")
__device__ __forceinline__ unsigned long long rt() { return __builtin_amdgcn_s_memrealtime(); }
__device__ __forceinline__ unsigned f2bf(float f) { unsigned u = __builtin_bit_cast(unsigned, f); return (u + 0x7fffu + ((u >> 16) & 1u)) >> 16; }
__device__ __forceinline__ unsigned pk2(float lo, float hi) { return f2bf(lo) | (f2bf(hi) << 16); }

#define XB_TMO      128
#define XB_XCNT(j)  (256  + 64 * (j))
#define XB_XSUB(j)  (1280 + 64 * (j))
#define XB_XGEN(j)  (2304 + 64 * (j))
#define XB_TOP      3328
#define XB_TOPGEN   3392
#define XCD_BAR_WORDS 3456
#define XB_SPIN_CAP (1u << 18)

__device__ __forceinline__ unsigned xb_ld(unsigned* p)              { return __hip_atomic_load(p, __ATOMIC_RELAXED, __HIP_MEMORY_SCOPE_AGENT); }
__device__ __forceinline__ unsigned xb_add(unsigned* p, unsigned v) { return __hip_atomic_fetch_add(p, v, __ATOMIC_RELAXED, __HIP_MEMORY_SCOPE_AGENT); }
__device__ __forceinline__ unsigned xb_xcc_id() { return (unsigned)__builtin_amdgcn_s_getreg((3 << 11) | 20) & 0xFu; }
#define XB_SPIN(cond, bar) do { unsigned _sp = 0; while (cond) { __builtin_amdgcn_s_sleep(1); \
    if ((++_sp & 255u) == 0u) { if (xb_ld(&(bar)[XB_TMO])) break; if (_sp > XB_SPIN_CAP) { atomicAdd(&(bar)[XB_TMO], 1u); break; } } } } while (0)

struct XcdBarrier {
    unsigned* bar; unsigned x;
    volatile LAS unsigned* st;
};

__device__ __forceinline__ XcdBarrier xcd_barrier_post(unsigned* bar, volatile LAS unsigned* st) {
    XcdBarrier b; b.bar = bar; b.x = xb_xcc_id(); b.st = st;
    if (threadIdx.x == 0) (void)xb_add(&bar[XB_XCNT(b.x)], 1u);
    return b;
}
__device__ __forceinline__ void xcd_barrier_complete(unsigned* bar, unsigned x, unsigned& nloc, unsigned& nx) {
    const unsigned G = gridDim.x * gridDim.y * gridDim.z;
    unsigned sum, cnt, mine, sp = 0u;
    for (;;) {
        sum = 0u; cnt = 0u; mine = 0u;
#pragma unroll 1
        for (unsigned j = 0; j < 16; ++j) { const unsigned c = xb_ld(&bar[XB_XCNT(j)]); sum += c; cnt += (c > 0u) ? 1u : 0u; mine = (j == x) ? c : mine; }
        if (sum == G) break;
        __builtin_amdgcn_s_sleep(1);
        if ((++sp & 255u) == 0u) { if (xb_ld(&bar[XB_TMO])) break; if (sp > XB_SPIN_CAP) { atomicAdd(&bar[XB_TMO], 1u); break; } }
    }
    nloc = mine > 0u ? mine : 1u; nx = cnt > 0u ? cnt : 1u;
}

__device__ __forceinline__ void xcd_barrier(const XcdBarrier& b) {
    asm volatile("s_waitcnt vmcnt(0)" ::: "memory");
    __syncthreads();
    if (threadIdx.x == 0) {
        unsigned* bar = b.bar;
        __builtin_amdgcn_s_waitcnt(0);
        unsigned nloc = b.st[0], nx = b.st[1];
        if (nloc == 0u) { xcd_barrier_complete(bar, b.x, nloc, nx); b.st[0] = nloc; b.st[1] = nx; }
        const unsigned old = xb_add(&bar[XB_XSUB(b.x)], 1u);
        const unsigned gen = old / nloc;
        if (old + 1u == (gen + 1u) * nloc) {
            __builtin_amdgcn_fence(__ATOMIC_RELEASE, "agent");
            asm volatile("s_waitcnt vmcnt(0)" ::: "memory");
            const unsigned og = xb_add(&bar[XB_TOP], 1u);
            const unsigned tg = og / nx;
            if (og + 1u == (tg + 1u) * nx) xb_add(&bar[XB_TOPGEN], 1u);
            else XB_SPIN(xb_ld(&bar[XB_TOPGEN]) == tg, bar);
            __builtin_amdgcn_fence(__ATOMIC_ACQUIRE, "agent");
            xb_add(&bar[XB_XGEN(b.x)], 1u);
            asm volatile("s_waitcnt vmcnt(0)" ::: "memory");
        } else {
            XB_SPIN(xb_ld(&bar[XB_XGEN(b.x)]) == gen, bar);
            __builtin_amdgcn_fence(__ATOMIC_ACQUIRE, "agent");
            asm volatile("s_waitcnt vmcnt(0)" ::: "memory");
        }
    }
    __syncthreads();
}


struct Args { const float* in[12]; float* out; unsigned char* ws; int ph_lo, ph_hi, li, pad; };
struct Frame {
    LAS unsigned char* lds;
    volatile LAS unsigned* MISC;
    const Args* A;
    int wave, vcu, G;
};
__device__ __forceinline__ int opaque_tid() { int t = threadIdx.x; asm volatile("" : "+v"(t)); return t; }
#define F_tid (opaque_tid())
#define F_lane (opaque_tid() & 63)
__device__ __forceinline__ const Args* opaque_args(const Args* a) { unsigned long long v = (unsigned long long)a; asm volatile("" : "+s"(v)); return (const Args*)v; }
#define F_A (F.A)
#define F_x          (F_A->in[0])
#define F_norm_g     (F_A->in[1])
#define F_w_in       (F_A->in[2])
#define F_b_gates    (F_A->in[3])
#define F_conv_w     (F_A->in[4])
#define F_w_alpha    (F_A->in[5])
#define F_b_alpha    (F_A->in[6])
#define F_rel_bias   (F_A->in[7])
#define F_ml_norm_g  (F_A->in[8])
#define F_gla_norm_g (F_A->in[9])
#define F_w_out      (F_A->in[10])
#define F_final_g    (F_A->in[11])
#define F_out        (F_A->out)
#define F_ws         (F_A->ws)
#define F_ctl        ((gu32*)(F_ws + WS_CTL))
#define F_Win_t      ((bf16*)(F_ws + WS_WIN))
#define F_Wout_t     ((bf16*)(F_ws + WS_WOUT))
#define F_XB         ((bf16*)(F_ws + WS_XB))
#define F_Y          ((bf16*)(F_ws + WS_Y))
#define F_Z          ((bf16*)(F_ws + WS_Z))
#define F_G32        ((float*)(F_ws + WS_G32))
#define F_SSQ        ((float*)(F_ws + WS_SSQ))
#define F_CST        ((float*)(F_ws + WS_CST))
#define F_NST        ((float*)(F_ws + WS_NST))
#define F_SST        ((float*)(F_ws + WS_SST))
#define F_ADEC       ((float*)(F_ws + WS_ADEC))
#define F_GS         ((float*)(F_ws + WS_GS))
#define F_MS         ((float*)(F_ws + WS_MS))
#define F_MP         ((float*)(F_ws + WS_MP))
#define F_BC         (F_out)
#define F_CPB        ((bf16*)(F_out + (size_t)T * 128))
__device__ __forceinline__ float bf2f(unsigned short u) { return __uint_as_float((unsigned)u << 16); }
__device__ __forceinline__ float wave_sum(float v) {
#pragma unroll
    for (int o = 1; o < 64; o <<= 1) v += __shfl_xor(v, o);
    return v;
}
__device__ __forceinline__ float siluf(float x) { return x / (1.0f + expf(-x)); }
__device__ __forceinline__ float sigmf(float x) { return 1.0f / (1.0f + expf(-x)); }
__device__ __forceinline__ float logsigf(float x) { return fminf(x, 0.f) - log1pf(expf(-fabsf(x))); }
__device__ __forceinline__ void ld8(const bf16* p, float* o) {
    const v4u w = *(const v4u*)p;
    o[0] = __uint_as_float(w.x << 16); o[1] = __uint_as_float(w.x & 0xffff0000u); o[2] = __uint_as_float(w.y << 16); o[3] = __uint_as_float(w.y & 0xffff0000u);
    o[4] = __uint_as_float(w.z << 16); o[5] = __uint_as_float(w.z & 0xffff0000u); o[6] = __uint_as_float(w.w << 16); o[7] = __uint_as_float(w.w & 0xffff0000u);
}

template <bool PERMUTE>
__device__ __forceinline__ void p0_transpose_item(const float* W, int Nsrc, int Ndst, const float* gk, bf16* WT, LAS float* scr, int item, int lane) {
    const int nblk = Ndst / 32, kb = item / nblk, nb = item % nblk, k0 = 64 * kb, n0 = 32 * nb;
    const int nd = n0 + (lane & 31), ns = PERMUTE ? src_col(nd) : nd;
#pragma unroll 8
    for (int i = 0; i < 32; ++i) { const int kk = 2 * i + (lane >> 5);
        float v = 0.f; if (ns >= 0) { v = W[(size_t)(k0 + kk) * Nsrc + ns]; if (gk) v *= gk[k0 + kk]; }
        scr[kk * 33 + (lane & 31)] = v; }
    LDS_WAIT(); asm volatile("" ::: "memory");
    const int c = lane & 7;
#pragma unroll
    for (int j = 0; j < 4; ++j) { const int n = (lane >> 3) + 8 * j; const LAS float* s = scr + (8 * c) * 33 + n;
        v4u o; o.x = pk2(s[0 * 33], s[1 * 33]); o.y = pk2(s[2 * 33], s[3 * 33]); o.z = pk2(s[4 * 33], s[5 * 33]); o.w = pk2(s[6 * 33], s[7 * 33]);
        *(GAS v4u*)(WT + (size_t)(n0 + n) * 1024 + k0 + 8 * c) = o; }
    LDS_WAIT(); asm volatile("" ::: "memory");
}
__device__ __forceinline__ void p0_weights(Frame& F, int l, int wi, int nw) {
    LAS float* scr = (LAS float*)(F.lds + RING_OFF + F.wave * 16384);
    constexpr int I_IN = 16 * (NP / 32), I_OUT = 16 * (DM / 32);
    for (int it = wi; it < I_IN + I_OUT; it += nw) {
        if (it < I_IN) p0_transpose_item<true>(F_w_in + (size_t)l * DM * DIN, DIN, NP, F_norm_g + l * DM, F_Win_t + (size_t)l * NP * DM, scr, it, F_lane);
        else p0_transpose_item<false>(F_w_out + (size_t)l * DM * DM, DM, DM, nullptr, F_Wout_t + (size_t)l * DM * DM, scr, it - I_IN, F_lane);
    }
}
__device__ __forceinline__ void p0_prologue(Frame& F) {
    int gw_ = F.vcu * NWAVES + F.wave; asm volatile("" : "+s"(gw_));
    const int gw = gw_, NGW = F.G * NWAVES;
    p0_weights(F, 0, gw, NGW);
    if (F.G != 256) p0_weights(F, 1, gw, NGW);
    for (int m = gw; m < T; m += NGW) {
        const GAS f32x4* xr = (const GAS f32x4*)(F_x + (size_t)m * DM) + F_lane;
        GAS unsigned long long* o8 = (GAS unsigned long long*)(F_XB + (size_t)m * DM) + F_lane;
        float s = 0.f;
#pragma unroll
        for (int j = 0; j < 4; ++j) { const f32x4 v = xr[64 * j]; s += (v.x * v.x + v.y * v.y) + (v.z * v.z + v.w * v.w);
            o8[64 * j] = (unsigned long long)pk2(v.x, v.y) | ((unsigned long long)pk2(v.z, v.w) << 32); }
        s = wave_sum(s);
        if (F_lane == 0) F_SSQ[m] = s;
    }
}

constexpr int LP = 65;
__device__ __forceinline__ void stage_conv(Frame& F, int layer, int b, int n, int zcol, int wch, float scale, LAS float* dst) {
    const float* cw = F_conv_w + (size_t)layer * 4 * 768;
    const int r0 = b * SEQ + n * CH;
    for (int idx = F_tid; idx < 4096; idx += NTHR) {
        const int t = idx >> 6, c = idx & 63;
        float a = 0.f;
#pragma unroll
        for (int j = 0; j < 4; ++j) { const int tt = t + j - 3;
            if (n * CH + tt >= 0) a += bf2f(F_Z[(size_t)(r0 + tt) * LDZ + zcol + c]) * cw[j * 768 + wch + c]; }
        dst[t * LP + c] = siluf(a) * scale;
    }
}
__device__ __forceinline__ void stage_tile(Frame& F, int b, int n, int zcol, int W, float scale, LAS float* dst, int pitch) {
    const int r0 = b * SEQ + n * CH;
    for (int idx = F_tid; idx < 64 * W; idx += NTHR) { const int t = idx / W, c = idx % W; dst[t * pitch + c] = bf2f(F_Z[(size_t)(r0 + t) * LDZ + zcol + c]) * scale; }
}
__device__ __forceinline__ void stage_mgates(Frame& F, int layer, int b, int n, int h, LAS float* ig, LAS float* bc, LAS float* lf) {
    const int r0 = b * SEQ + n * CH;
    if (F_tid < 64) { const float* g = F_G32 + (size_t)(r0 + F_tid) * 32;
        ig[F_tid] = g[h] + F_b_gates[layer * 12 + h]; lf[F_tid] = logsigf(g[6 + h] + F_b_gates[layer * 12 + 6 + h]); }
    __syncthreads();
    if (F_tid < 64) { float s = 0.f; for (int j = 0; j <= F_tid; ++j) s += lf[j]; bc[F_tid] = s; }
}
__device__ __forceinline__ void stage_gla_decay(Frame& F, int layer, int b, int n, int hh, LAS float* bcum) {
    const int r0 = b * SEQ + n * CH;
    const float* wa = F_w_alpha + (size_t)layer * 16 * 128; const float* ba = F_b_alpha + layer * 128;
    for (int idx = F_tid; idx < 2048; idx += NTHR) { const int t = idx >> 5, d = idx & 31;
        const float* g = F_G32 + (size_t)(r0 + t) * 32 + 12; float a = ba[hh * 32 + d];
#pragma unroll
        for (int r = 0; r < 16; ++r) a += g[r] * wa[r * 128 + hh * 32 + d];
        bcum[t * 33 + d] = logsigf(a) * (1.0f / 16.0f); }
    __syncthreads();
    if (F_tid < 32) { float s = 0.f; for (int t = 0; t < 64; ++t) { s += bcum[t * 33 + F_tid]; bcum[t * 33 + F_tid] = s; } }
    __syncthreads();
}

#define DPPF(old, x, ctrl, rmask) __uint_as_float(__builtin_amdgcn_update_dpp(__float_as_uint(old), __float_as_uint(x), (ctrl), (rmask), 0xf, false))
__device__ __forceinline__ void p3_scan(Frame& F) {
    LAS float* L = (LAS float*)(F.lds + RING_OFF);
    LAS float* so = L; LAS float* sn = L + 128; LAS float* gl = L + 256; LAS float* ml = L + 384; LAS float* ex = L + 512;
    const int tid = F_tid, w = tid >> 6, l = tid & 63;
    constexpr int NU_M = 12 * 65, NU = NU_M + 8 * 32;
    const int u0 = (int)(((long)F.vcu * NU) / F.G), u1 = (int)(((long)(F.vcu + 1) * NU) / F.G);
    int cur_bh = -1, par = 0;
    for (int u = u0; u < u1; ++u, par ^= 1) {
        LAS float* exu = ex + par * 1024;
        float c[16], dcy[16];
        float* p; size_t stride;
        if (u < NU_M) {
            const int bh = u / 65, eu = u % 65, b = bh / 6, h = bh % 6;
            if (bh != cur_bh) {
                __syncthreads();
                if (w == 0) {
                    const int ci0 = (b * NCHS + 2 * l) * 6 + h, ci1 = ci0 + 6;
                    const float a0 = F_GS[ci0], b0 = F_MS[ci0], a1 = F_GS[ci1], b1 = F_MS[ci1];
                    float A = a0 + a1, B = fmaxf(b1, a1 + b0);
#define MP_STEP(ctrl, rmask) do { const float as_ = DPPF(0.f, A, ctrl, rmask), bs_ = DPPF(-3.0e38f, B, ctrl, rmask); B = fmaxf(B, A + bs_); A = A + as_; } while (0)
                    MP_STEP(0x111, 0xf); MP_STEP(0x112, 0xf); MP_STEP(0x114, 0xf); MP_STEP(0x118, 0xf); MP_STEP(0x142, 0xa); MP_STEP(0x143, 0xc);
#undef MP_STEP
                    float EA = __shfl_up(A, 1), EB = __shfl_up(B, 1); if (l == 0) { EA = 0.f; EB = -3.0e38f; }
                    const float mp0 = fmaxf(EB, EA), m0 = fmaxf(b0, a0 + mp0), m1 = fmaxf(b1, a1 + m0);
                    so[2 * l] = expf(a0 + mp0 - m0); sn[2 * l] = expf(b0 - m0); so[2 * l + 1] = expf(a1 + m0 - m1); sn[2 * l + 1] = expf(b1 - m1);
                    if (eu == 0) { F_MP[ci0] = mp0; F_MP[ci1] = m0; }
                }
                __syncthreads();
                cur_bh = bh;
            }
            if (eu < 64) { const bf16* p16 = (const bf16*)F_CST + ((size_t)(b * NCHS + 16 * w) * 6 + h) * 4096 + eu * 64 + l; p = nullptr; stride = 0;
#pragma unroll
                for (int i = 0; i < 16; ++i) { c[i] = bf2f(p16[(size_t)i * 6 * 4096]) * sn[16 * w + i]; dcy[i] = so[16 * w + i]; } }
            else { p = F_NST + ((size_t)(b * NCHS + 16 * w) * 6 + h) * 64 + l; stride = (size_t)6 * 64;
#pragma unroll
                for (int i = 0; i < 16; ++i) { c[i] = p[i * stride] * sn[16 * w + i]; dcy[i] = so[16 * w + i]; } }
        } else {
            const int v = u - NU_M, bh = v >> 5, eu = v & 31, b = bh >> 2, hh = bh & 3;
            p = F_SST + ((size_t)(b * NCHS + 16 * w) * 4 + hh) * 2048 + eu * 64 + l; stride = (size_t)4 * 2048;
            const float* ad = F_ADEC + ((size_t)(b * NCHS + 16 * w) * 4 + hh) * 32 + (l & 31);
#pragma unroll
            for (int i = 0; i < 16; ++i) { c[i] = p[i * stride]; dcy[i] = ad[(size_t)i * 4 * 32]; }
        }
        float st = 0.f, P = 1.f;
#pragma unroll
        for (int i = 0; i < 16; ++i) { const float ci = c[i]; c[i] = st; st = dcy[i] * st + ci; P *= dcy[i]; }
        exu[(w * 64 + l) * 2] = P; exu[(w * 64 + l) * 2 + 1] = st;
        __syncthreads();
        float sin = 0.f;
        for (int w2 = 0; w2 < w; ++w2) sin = exu[(w2 * 64 + l) * 2] * sin + exu[(w2 * 64 + l) * 2 + 1];
        float q = sin;
        if (u < NU_M && (u % 65) < 64) {
            const int bh = u / 65, eu = u % 65, b = bh / 6, h = bh % 6;
            bf16* pb = F_CPB + ((size_t)(b * NCHS + 16 * w) * 6 + h) * 4096 + eu * 64 + l;
#pragma unroll
            for (int i = 0; i < 16; ++i) { pb[(size_t)i * 6 * 4096] = (bf16)f2bf(c[i] + q); q *= dcy[i]; }
        } else {
#pragma unroll
            for (int i = 0; i < 16; ++i) { p[i * stride] = c[i] + q; q *= dcy[i]; }
        }
    }
    __syncthreads();
}

#define P4_STORE8(o, kg, yrow, GATE_EXPR) do { _Pragma("unroll") for (int c8 = 0; c8 < 8; ++c8) if ((kg) == c8) { float yv[8]; \
    _Pragma("unroll") for (int i = 0; i < 8; ++i) { const int v = c8 * 8 + i; yv[i] = (o)[v] * (GATE_EXPR); } \
    v4u w; w.x = pk2(yv[0], yv[1]); w.y = pk2(yv[2], yv[3]); w.z = pk2(yv[4], yv[5]); w.w = pk2(yv[6], yv[7]); *(GAS v4u*)((yrow) + c8 * 8) = w; } } while (0)

__device__ __forceinline__ void p4_attn(Frame& F, int layer, int b, int n, int h) {
    const int t = F_tid >> 3, kg = F_tid & 7;
    const int r0 = b * SEQ + n * CH, row = r0 + t;
    LAS float* qL = (LAS float*)(F.lds + RING_OFF);
    stage_tile(F, b, n, ZC_AQ + h * 64, 64, 1.f, qL, LP);
    __syncthreads();
    float o[64];
#pragma unroll
    for (int c = 0; c < 64; ++c) o[c] = 0.f;
    float m = -1e30f, l = 0.f;
    const float* rb = F_rel_bias + (size_t)(layer * 6 + h) * 257;
    for (int i = 0; i < 72; ++i) {
        const int jb = kg + 8 * i, kpos = n * CH - 512 + jb;
        if (kpos < 0) continue;
        const bf16* kr = F_Z + (size_t)(b * SEQ + kpos) * LDZ + ZC_AK + h * 64;
        float s = 0.f;
#pragma unroll
        for (int c = 0; c < 8; ++c) { float kf[8]; ld8(kr + c * 8, kf);
#pragma unroll
            for (int e = 0; e < 8; ++e) s += qL[t * LP + c * 8 + e] * kf[e]; }
        int rel = t + 512 - jb; rel = rel < -128 ? -128 : (rel > 128 ? 128 : rel);
        s = s * 0.125f + rb[rel + 128];
        const float mn = fmaxf(m, s), a = expf(m - mn), p = expf(s - mn);
        l = l * a + p; m = mn;
        const bf16* vr = F_Z + (size_t)(b * SEQ + kpos) * LDZ + ZC_AV + h * 64;
#pragma unroll
        for (int c = 0; c < 8; ++c) { float vf[8]; ld8(vr + c * 8, vf);
#pragma unroll
            for (int e = 0; e < 8; ++e) o[c * 8 + e] = o[c * 8 + e] * a + p * vf[e]; }
    }
#pragma unroll
    for (int off = 1; off < 8; off <<= 1) {
        const float m2 = __shfl_xor(m, off), l2 = __shfl_xor(l, off);
        const float mn = fmaxf(m, m2), a = expf(m - mn), bb = expf(m2 - mn);
        l = l * a + l2 * bb; m = mn;
#pragma unroll
        for (int c = 0; c < 64; ++c) { const float o2 = __shfl_xor(o[c], off); o[c] = o[c] * a + o2 * bb; }
    }
    const float inv = 1.0f / l;
    const bf16* gr = F_Z + (size_t)row * LDZ + ZC_AG + h * 64;
    bf16* yrow = F_Y + (size_t)row * DM + h * 64;
    P4_STORE8(o, kg, yrow, inv * siluf(bf2f(gr[v])));
}

__device__ __forceinline__ void p4_mlstm(Frame& F, int layer, int b, int n, int h) {
    LAS float* L = (LAS float*)(F.lds + RING_OFF);
    LAS float* qc = L; LAS float* kc = qc + 64 * LP; LAS float* vv = kc + 64 * LP; LAS float* Cp = vv + 64 * LP;
    LAS float* np = Cp + 64 * LP; LAS float* ig = np + 64; LAS float* bc = ig + 64; LAS float* lf = bc + 64;
    const int cn = b * NCHS + n, r0 = b * SEQ + n * CH;
    stage_conv(F, layer, b, n, ZC_MQ + h * 64, h * 64, 1.f, qc);
    stage_conv(F, layer, b, n, ZC_MK + h * 64, 384 + h * 64, 0.125f, kc);
    stage_tile(F, b, n, ZC_MV + h * 64, 64, 1.f, vv, LP);
    { const float* cs = F_CST + ((size_t)cn * 6 + h) * 4096; for (int idx = F_tid; idx < 4096; idx += NTHR) Cp[(idx >> 6) * LP + (idx & 63)] = cs[idx]; }
    if (F_tid < 64) np[F_tid] = F_NST[((size_t)cn * 6 + h) * 64 + F_tid];
    stage_mgates(F, layer, b, n, h, ig, bc, lf);
    __syncthreads();
    const float mprev = F_MP[cn * 6 + h];
    const int t = F_tid >> 3, jg = F_tid & 7, row = r0 + t;
    const float bt = bc[t], il = bt + mprev;
    float mx = il;
    for (int i = 0; i < 8; ++i) { const int j = jg + 8 * i; if (j <= t) mx = fmaxf(mx, bt - bc[j] + ig[j]); }
    mx = fmaxf(mx, __shfl_xor(mx, 1)); mx = fmaxf(mx, __shfl_xor(mx, 2)); mx = fmaxf(mx, __shfl_xor(mx, 4));
    float num[64]; float den = 0.f;
#pragma unroll
    for (int c = 0; c < 64; ++c) num[c] = 0.f;
    for (int i = 0; i < 8; ++i) { const int j = jg + 8 * i;
        if (j <= t) { float dot = 0.f;
#pragma unroll 8
            for (int k = 0; k < 64; ++k) dot += qc[t * LP + k] * kc[j * LP + k];
            const float sc = dot * expf(bt - bc[j] + ig[j] - mx); den += sc;
#pragma unroll
            for (int c = 0; c < 64; ++c) num[c] += sc * vv[j * LP + c]; } }
    const float iw = expf(il - mx);
#pragma unroll 2
    for (int kk = 0; kk < 8; ++kk) { const int k = jg * 8 + kk; const float qk = qc[t * LP + k] * iw; den += qk * np[k];
#pragma unroll
        for (int c = 0; c < 64; ++c) num[c] += qk * Cp[c * LP + k]; }
#pragma unroll
    for (int off = 1; off < 8; off <<= 1) { den += __shfl_xor(den, off);
#pragma unroll
        for (int c = 0; c < 64; ++c) num[c] += __shfl_xor(num[c], off); }
    den = fmaxf(fabsf(den), expf(-mx));
    const float rden = 1.0f / den; float ss = 0.f;
#pragma unroll
    for (int c = 0; c < 64; ++c) { num[c] *= rden; ss += num[c] * num[c]; }
    const float rn = 1.0f / sqrtf(ss * (1.0f / 64.0f) + EPS);
    const bf16* mo = F_Z + (size_t)row * LDZ + ZC_MO + h * 64; const bf16* mg = F_Z + (size_t)row * LDZ + ZC_MG + h * 64;
    const float* gn = F_ml_norm_g + layer * 384 + h * 64;
    bf16* yrow = F_Y + (size_t)row * DM + 384 + h * 64;
    P4_STORE8(num, jg, yrow, rn * gn[v] * sigmf(bf2f(mo[v])) * siluf(bf2f(mg[v])));
}

__device__ __forceinline__ void p4_gla(Frame& F, int layer, int b, int n, int hh) {
    LAS float* L = (LAS float*)(F.lds + RING_OFF);
    LAS float* qx = L; LAS float* kk = qx + 64 * 33; LAS float* vv = kk + 64 * 33; LAS float* bcum = vv + 64 * LP; LAS float* Sp = bcum + 64 * 33;
    const int cn = b * NCHS + n, r0 = b * SEQ + n * CH;
    stage_tile(F, b, n, ZC_GQ + hh * 32, 32, 0.17677669529663687f, qx, 33);
    stage_tile(F, b, n, ZC_GK + hh * 32, 32, 1.f, kk, 33);
    stage_tile(F, b, n, ZC_GV + hh * 64, 64, 1.f, vv, LP);
    { const float* ss = F_SST + ((size_t)cn * 4 + hh) * 2048; for (int idx = F_tid; idx < 2048; idx += NTHR) Sp[(idx >> 6) * LP + (idx & 63)] = ss[idx]; }
    stage_gla_decay(F, layer, b, n, hh, bcum);
    const int t = F_tid >> 3, jg = F_tid & 7, row = r0 + t;
    float num[64];
#pragma unroll
    for (int c = 0; c < 64; ++c) num[c] = 0.f;
    for (int i = 0; i < 8; ++i) { const int j = jg + 8 * i;
        if (j <= t) { float att = 0.f;
#pragma unroll 4
            for (int d = 0; d < 32; ++d) att += qx[t * 33 + d] * kk[j * 33 + d] * expf(bcum[t * 33 + d] - bcum[j * 33 + d]);
#pragma unroll
            for (int c = 0; c < 64; ++c) num[c] += att * vv[j * LP + c]; } }
#pragma unroll 2
    for (int dd = 0; dd < 4; ++dd) { const int d = jg * 4 + dd; const float w = qx[t * 33 + d] * expf(bcum[t * 33 + d]);
#pragma unroll
        for (int c = 0; c < 64; ++c) num[c] += w * Sp[d * LP + c]; }
    float ss = 0.f;
#pragma unroll
    for (int off = 1; off < 8; off <<= 1) {
#pragma unroll
        for (int c = 0; c < 64; ++c) num[c] += __shfl_xor(num[c], off); }
#pragma unroll
    for (int c = 0; c < 64; ++c) ss += num[c] * num[c];
    const float rn = 1.0f / sqrtf(ss * (1.0f / 64.0f) + EPS);
    const bf16* gg = F_Z + (size_t)row * LDZ + ZC_GG + hh * 64;
    const float* gn = F_gla_norm_g + layer * 256 + hh * 64;
    bf16* yrow = F_Y + (size_t)row * DM + 768 + hh * 64;
    P4_STORE8(num, jg, yrow, rn * gn[v] * siluf(bf2f(gg[v])));
}

constexpr int ZRS = 64;
__host__ __device__ constexpr size_t zc(int col) { return (size_t)(col >> 6) * ((size_t)T * 64) + (size_t)(col & 63); }
typedef float f32x16 __attribute__((ext_vector_type(16)));
typedef short s16x4 __attribute__((ext_vector_type(4)));
typedef short v4i16_t __attribute__((ext_vector_type(4)));
typedef float f32x2_t __attribute__((ext_vector_type(2))); typedef __bf16 bf16x2_t __attribute__((ext_vector_type(2)));
__device__ __forceinline__ unsigned cvtpk(float lo, float hi) { f32x2_t v = {lo, hi}; bf16x2_t b = __builtin_convertvector(v, bf16x2_t); return __builtin_bit_cast(unsigned, b); }
__device__ __forceinline__ s16x4 lds_tr(LAS const unsigned char* p) { return __builtin_bit_cast(s16x4, __builtin_amdgcn_ds_read_tr16_b64_v4i16((LAS v4i16_t*)p)); }
__device__ __forceinline__ bf16x8 pack8(float a0, float a1, float a2, float a3, float a4, float a5, float a6, float a7) {
    v4u w; w.x = cvtpk(a0, a1); w.y = cvtpk(a2, a3); w.z = cvtpk(a4, a5); w.w = cvtpk(a6, a7); return __builtin_bit_cast(bf16x8, w); }
#define MFMA32(a, b, c) __builtin_amdgcn_mfma_f32_32x32x16_bf16((a), (b), (c), 0, 0, 0)
constexpr float LOG2E = 1.4426950408889634f;
__device__ __forceinline__ float fexp(float x) { return __builtin_amdgcn_exp2f(x * LOG2E); }
__device__ __forceinline__ float fsigm(float x) { return __builtin_amdgcn_rcpf(1.0f + fexp(-x)); }
__device__ __forceinline__ float fsilu(float x) { return x * fsigm(x); }
__device__ __forceinline__ int tile_off(int row, int bytecol) { return row * 128 + ((((bytecol >> 4) ^ (((row >> 1) & 1) << 2)) << 4) | (bytecol & 15)); }
__device__ __forceinline__ void dma_tile(const bf16* g, LAS unsigned char* tile, int lane) {
    const int rr = lane >> 3, cpos = lane & 7;
#pragma unroll
    for (int it = 0; it < 8; ++it) { const int row = 8 * it + rr, ch = cpos ^ (((row >> 1) & 1) << 2);
        __builtin_amdgcn_global_load_lds((const unsigned*)(g + (size_t)row * ZRS + ch * 8), (LAS unsigned*)(tile + it * 1024), 16, 0, 0); }
}
__device__ __forceinline__ bf16x8 tr_frag(LAS const unsigned char* tile, int lane, int c0, int ks) {
    const int g = lane >> 4, i = lane & 15, hf = g >> 1;
    const int row = 16 * ks + 4 * hf + (i >> 2), bc = (c0 + 16 * (g & 1) + 4 * (i & 3)) * 2;
    const s16x4 lo = lds_tr(tile + tile_off(row, bc)), hi = lds_tr(tile + tile_off(row + 8, bc));
    return (bf16x8){lo[0], lo[1], lo[2], lo[3], hi[0], hi[1], hi[2], hi[3]};
}

typedef const GAS char* gcp;
__device__ __forceinline__ gcp uptr(const void* p) { const unsigned long long v = (unsigned long long)p;
    const unsigned lo = __builtin_amdgcn_readfirstlane((unsigned)v), hi = __builtin_amdgcn_readfirstlane((unsigned)(v >> 32)); return (gcp)(((unsigned long long)hi << 32) | lo); }
__device__ __forceinline__ bf16x8 ldfrag(gcp ub, unsigned voff) { return *(const GAS bf16x8*)(ub + voff); }
__device__ __forceinline__ unsigned dma_voff(int lane) { const int rr = lane >> 3; return (unsigned)(rr * ZRS + (((lane & 7) ^ (((rr >> 1) & 1) << 2)) * 8)) * 2u; }
__device__ __forceinline__ void dma_tile_u(gcp ub, unsigned voff, LAS unsigned char* tile) {
#pragma unroll
    for (int it = 0; it < 8; ++it) __builtin_amdgcn_global_load_lds((const GAS unsigned*)(ub + (size_t)it * 8 * ZRS * 2 + voff), (LAS unsigned*)(tile + it * 1024), 16, 0, 0);
}
__device__ __forceinline__ void dma_tile_asm(gcp ub, unsigned voff, LAS unsigned char* tile) {
    const unsigned l0 = __builtin_amdgcn_readfirstlane((unsigned)(unsigned long long)tile);
    gcp ub2 = ub + 4096; unsigned keep;
#define DMA1_(SB, OFF, LD) asm volatile("s_mov_b32 %0, m0\n\ts_mov_b32 m0, %3\n\ts_nop 3\n\tglobal_load_lds_dwordx4 %1, %2 offset:" #OFF "\n\ts_mov_b32 m0, %0" : "=&s"(keep) : "v"(voff), "s"(SB), "s"(LD) : "memory")
    const unsigned l1 = l0 + 4096u;
    DMA1_(ub, 0, l0); DMA1_(ub, 1024, l0); DMA1_(ub, 2048, l0); DMA1_(ub, 3072, l0);
    DMA1_(ub2, 0, l1); DMA1_(ub2, 1024, l1); DMA1_(ub2, 2048, l1); DMA1_(ub2, 3072, l1);
#undef DMA1_
}
__device__ __forceinline__ void tr_bases(int lane, unsigned& b0, unsigned& b1) {
    const int g = lane >> 4, i = lane & 15, hf = g >> 1, row = 4 * hf + (i >> 2), bc = (16 * (g & 1) + 4 * (i & 3)) * 2;
    b0 = (unsigned)tile_off(row, bc); b1 = (unsigned)tile_off(row, bc + 64);
}
__device__ __forceinline__ bf16x8 tr_frag_b(LAS const unsigned char* tile, unsigned base, int ks) {
    const s16x4 lo = lds_tr(tile + base + ks * 2048), hi = lds_tr(tile + base + ks * 2048 + 1024);
    return (bf16x8){lo[0], lo[1], lo[2], lo[3], hi[0], hi[1], hi[2], hi[3]};
}

__device__ __forceinline__ void unpack8(v4u w, float* o) {
    o[0] = __uint_as_float(w.x << 16); o[1] = __uint_as_float(w.x & 0xffff0000u); o[2] = __uint_as_float(w.y << 16); o[3] = __uint_as_float(w.y & 0xffff0000u);
    o[4] = __uint_as_float(w.z << 16); o[5] = __uint_as_float(w.z & 0xffff0000u); o[6] = __uint_as_float(w.w << 16); o[7] = __uint_as_float(w.w & 0xffff0000u);
}
__device__ __forceinline__ float max3f(float a, float b, float c) { float r; asm("v_max3_f32 %0, %1, %2, %3" : "=v"(r) : "v"(a), "v"(b), "v"(c)); return r; }
__device__ __forceinline__ float xh_max(float x) { const auto rr = __builtin_amdgcn_permlane32_swap(__float_as_uint(x), __float_as_uint(x), false, false); return fmaxf(__uint_as_float(rr[0]), __uint_as_float(rr[1])); }
__device__ __forceinline__ float xh_sum(float x) { const auto rr = __builtin_amdgcn_permlane32_swap(__float_as_uint(x), __float_as_uint(x), false, false); return __uint_as_float(rr[0]) + __uint_as_float(rr[1]); }
constexpr int TLP = 68;
__device__ __forceinline__ void tl_put4(LAS unsigned char* wl, int t, int v, float a, float b, float c, float e) { *(LAS f32x4*)(wl + ((t * TLP + v) << 2)) = (f32x4){a, b, c, e}; }
template <int GATE>
__device__ __forceinline__ void tl_emit(LAS const unsigned char* wl, int lane, gcp g0, gcp g1, const float* gn, GAS char* yb) {
    const int rr = lane >> 3, c = lane & 7;
    float gnv[8];
    if (GATE != 0) { const f32x4 a = *(const f32x4*)(gn + 8 * c), b = *(const f32x4*)(gn + 8 * c + 4); gnv[0] = a[0]; gnv[1] = a[1]; gnv[2] = a[2]; gnv[3] = a[3]; gnv[4] = b[0]; gnv[5] = b[1]; gnv[6] = b[2]; gnv[7] = b[3]; }
    const unsigned voff = (unsigned)(rr * ZRS + 8 * c) * 2u, yoff = (unsigned)(rr * DM + 8 * c) * 2u;
    v4u ga[8], gb[8];
#pragma unroll
    for (int it = 0; it < 8; ++it) { ga[it] = *(const GAS v4u*)(g0 + (size_t)it * 8 * ZRS * 2 + voff); if (GATE == 1) gb[it] = *(const GAS v4u*)(g1 + (size_t)it * 8 * ZRS * 2 + voff); }
#pragma unroll
    for (int it = 0; it < 8; ++it) {
        const int row = 8 * it + rr;
        const f32x4 x0 = *(LAS const f32x4*)(wl + ((row * TLP + 8 * c) << 2)), x1 = *(LAS const f32x4*)(wl + ((row * TLP + 8 * c + 4) << 2));
        float x[8] = {x0[0], x0[1], x0[2], x0[3], x1[0], x1[1], x1[2], x1[3]}, p[8], q[8];
        unpack8(ga[it], p); if (GATE == 1) unpack8(gb[it], q);
#pragma unroll
        for (int e = 0; e < 8; ++e) {
            if (GATE == 0) x[e] *= fsilu(p[e]);
            else if (GATE == 1) x[e] *= gnv[e] * fsigm(p[e]) * fsilu(q[e]);
            else x[e] *= gnv[e] * fsilu(p[e]);
        }
        *(GAS v4u*)(yb + (size_t)it * 8 * DM * 2 + yoff) = __builtin_bit_cast(v4u, pack8(x[0], x[1], x[2], x[3], x[4], x[5], x[6], x[7]));
    }
}

__device__ __forceinline__ void attn_wave(Frame& F, int layer, int cn, int h, LAS unsigned char* wl) {
    const int lane = F_lane, r = lane & 31, hf = lane >> 5;
    const int b = cn / NCHS, n = cn % NCHS;
    const size_t row0 = (size_t)b * SEQ + (size_t)n * CH;
    const bf16* Z = F_Z;
    LAS float* rbl = (LAS float*)(wl + 16384);
    const float* rb = F_rel_bias + (size_t)(layer * 6 + h) * 257;
    float tb_[5];
#pragma unroll
    for (int k = 0; k < 5; ++k) { const int i = lane + 64 * k; tb_[k] = rb[i < 257 ? i : 256]; }
    const float bfar = rb[256] * LOG2E;
    constexpr float C1 = 0.125f * LOG2E;
    const unsigned voffK = (unsigned)(r * ZRS + 8 * hf) * 2u, voffV = dma_voff(lane);
    unsigned trb0, trb1; tr_bases(lane, trb0, trb1);
    bf16x8 qf[2][4];
    { gcp qb_ = uptr(Z + zc(ZC_AQ + h * 64) + row0 * ZRS);
#pragma unroll
    for (int qb = 0; qb < 2; ++qb)
#pragma unroll
        for (int s = 0; s < 4; ++s) qf[qb][s] = ldfrag(qb_ + ((size_t)32 * qb * ZRS + 16 * s) * 2, voffK); }
    const int i0 = (n >= 8) ? 0 : 8 - n;
#define KLOAD4(KF, VO, SB) do { \
        asm volatile("s_nop 4\n\tglobal_load_dwordx4 %0, %1, %2" : "+v"(KF[0]) : "v"(VO), "s"(SB) : "memory"); \
        asm volatile("global_load_dwordx4 %0, %1, %2 offset:32" : "+v"(KF[1]) : "v"(VO), "s"(SB) : "memory"); \
        asm volatile("global_load_dwordx4 %0, %1, %2 offset:64" : "+v"(KF[2]) : "v"(VO), "s"(SB) : "memory"); \
        asm volatile("global_load_dwordx4 %0, %1, %2 offset:96" : "+v"(KF[3]) : "v"(VO), "s"(SB) : "memory"); } while (0)
#define KWAIT(KF, N) asm volatile("s_waitcnt vmcnt(" #N ")" : "+v"(KF[0]), "+v"(KF[1]), "+v"(KF[2]), "+v"(KF[3]) :: "memory")
    dma_tile_asm(uptr(Z + zc(ZC_AV + h * 64) + (row0 - 512 + 64 * i0) * ZRS), voffV, wl + (i0 & 1) * 8192);
    bf16x8 kfa[4], kfb[4];
#pragma unroll
    for (int s = 0; s < 4; ++s) { kfa[s] = (bf16x8){0, 0, 0, 0, 0, 0, 0, 0}; kfb[s] = (bf16x8){0, 0, 0, 0, 0, 0, 0, 0}; }
    { gcp kb_ = uptr(Z + zc(ZC_AK + h * 64) + (row0 - 512 + 64 * i0) * ZRS); KLOAD4(kfa, voffK, kb_); }
#pragma unroll
    for (int k = 0; k < 5; ++k) { const int i = lane + 64 * k; if (i < 257) rbl[i] = tb_[k] * LOG2E; }
    f32x16 o[2][2];
#pragma unroll
    for (int a = 0; a < 2; ++a)
#pragma unroll
        for (int c = 0; c < 2; ++c)
#pragma unroll
            for (int i = 0; i < 16; ++i) o[a][c][i] = 0.f;
    float m[2] = {-1e30f, -1e30f}, lsum[2] = {0.f, 0.f};
    asm volatile("" :: "v"(qf[0][0]), "v"(qf[0][1]), "v"(qf[0][2]), "v"(qf[0][3]), "v"(qf[1][0]), "v"(qf[1][1]), "v"(qf[1][2]), "v"(qf[1][3]), "v"(bfar) : "memory");
#define ATTN_STEP(KF, KB) do { \
        f32x16 st[2]; \
        _Pragma("unroll") for (int qb = 0; qb < 2; ++qb) { _Pragma("unroll") for (int i = 0; i < 16; ++i) st[qb][i] = 0.f; \
            _Pragma("unroll") for (int s = 0; s < 4; ++s) st[qb] = MFMA32(KF[s], qf[qb][s], st[qb]); } \
        const bool far_ = (ti <= 5); \
        if (!far_) { _Pragma("unroll") for (int qb = 0; qb < 2; ++qb) _Pragma("unroll") for (int i = 0; i < 16; ++i) { \
            const int kk = 32 * (KB) + (i & 3) + 8 * (i >> 2) + 4 * hf, t = 32 * qb + r; \
            int rel = t + 512 - 64 * ti - kk; rel = rel < -128 ? -128 : (rel > 128 ? 128 : rel); \
            st[qb][i] = st[qb][i] * C1 + rbl[rel + 128]; } } \
        bf16x8 pf[2][2]; \
        _Pragma("unroll") for (int qb = 0; qb < 2; ++qb) { \
            float ma = max3f(st[qb][0], st[qb][1], st[qb][2]), mb = max3f(st[qb][3], st[qb][4], st[qb][5]); \
            ma = max3f(ma, st[qb][6], st[qb][7]); mb = max3f(mb, st[qb][8], st[qb][9]); ma = max3f(ma, st[qb][10], st[qb][11]); mb = max3f(mb, st[qb][12], st[qb][13]); \
            float mx = max3f(ma, mb, fmaxf(st[qb][14], st[qb][15])); \
            if (far_) mx = mx * C1 + bfar;              \
            mx = xh_max(mx); \
            if (__any(mx > m[qb] + 8.0f)) { const float mn = fmaxf(m[qb], mx), alpha = __builtin_amdgcn_exp2f(m[qb] - mn); m[qb] = mn; lsum[qb] *= alpha; \
                _Pragma("unroll") for (int i = 0; i < 16; ++i) { o[0][qb][i] *= alpha; o[1][qb][i] *= alpha; } } \
            const float sc_ = far_ ? C1 : 1.0f, of_ = far_ ? bfar - m[qb] : -m[qb]; \
            float ps0 = 0.f, ps1 = 0.f, ps2 = 0.f, ps3 = 0.f; \
            _Pragma("unroll") for (int i = 0; i < 16; i += 4) { \
                const float p0 = __builtin_amdgcn_exp2f(st[qb][i] * sc_ + of_), p1 = __builtin_amdgcn_exp2f(st[qb][i + 1] * sc_ + of_), p2 = __builtin_amdgcn_exp2f(st[qb][i + 2] * sc_ + of_), p3 = __builtin_amdgcn_exp2f(st[qb][i + 3] * sc_ + of_); \
                st[qb][i] = p0; st[qb][i + 1] = p1; st[qb][i + 2] = p2; st[qb][i + 3] = p3; ps0 += p0; ps1 += p1; ps2 += p2; ps3 += p3; } \
            lsum[qb] += (ps0 + ps1) + (ps2 + ps3); \
            pf[qb][0] = pack8(st[qb][0], st[qb][1], st[qb][2], st[qb][3], st[qb][4], st[qb][5], st[qb][6], st[qb][7]); \
            pf[qb][1] = pack8(st[qb][8], st[qb][9], st[qb][10], st[qb][11], st[qb][12], st[qb][13], st[qb][14], st[qb][15]); } \
        _Pragma("unroll") for (int k2 = 0; k2 < 2; ++k2) _Pragma("unroll") for (int dvb = 0; dvb < 2; ++dvb) { \
            const bf16x8 vf = tr_frag_b(vt, dvb ? trb1 : trb0, 2 * (KB) + k2); \
            o[dvb][0] = MFMA32(vf, pf[0][k2], o[dvb][0]); o[dvb][1] = MFMA32(vf, pf[1][k2], o[dvb][1]); } \
    } while (0)
#pragma unroll 1
    for (int ti = i0; ti < 9; ++ti) {
        const size_t kr0 = row0 - 512 + 64 * ti;
        LAS const unsigned char* vt = wl + (ti & 1) * 8192;
        gcp kb1_ = uptr(Z + zc(ZC_AK + h * 64) + (kr0 + 32) * ZRS);
        gcp kb2_ = uptr(Z + zc(ZC_AK + h * 64) + (kr0 + 64) * ZRS);
        KLOAD4(kfb, voffK, kb1_);
        dma_tile_asm(uptr(Z + zc(ZC_AV + h * 64) + (kr0 + 64) * ZRS), voffV, wl + ((ti + 1) & 1) * 8192);
        KWAIT(kfa, 12);
        ATTN_STEP(kfa, 0);
        KLOAD4(kfa, voffK, kb2_);
        KWAIT(kfb, 12);
        ATTN_STEP(kfb, 1);
    }
    KWAIT(kfa, 0);
#undef KLOAD4
#undef KWAIT
#undef ATTN_STEP
#pragma unroll
    for (int qb = 0; qb < 2; ++qb) {
        const float l = xh_sum(lsum[qb]), inv = 1.0f / l;
#pragma unroll
        for (int dvb = 0; dvb < 2; ++dvb)
#pragma unroll
            for (int i4 = 0; i4 < 4; ++i4) tl_put4(wl, 32 * qb + r, 32 * dvb + 8 * i4 + 4 * hf, o[dvb][qb][4 * i4] * inv, o[dvb][qb][4 * i4 + 1] * inv, o[dvb][qb][4 * i4 + 2] * inv, o[dvb][qb][4 * i4 + 3] * inv);
    }
    tl_emit<0>(wl, lane, uptr(Z + zc(ZC_AG + h * 64) + row0 * ZRS), (gcp)nullptr, nullptr, (GAS char*)uptr(F_Y + row0 * DM + h * 64));
}

__device__ __forceinline__ float wave_scan_add(float x, int) {
    x += DPPF(0.f, x, 0x111, 0xf);
    x += DPPF(0.f, x, 0x112, 0xf);
    x += DPPF(0.f, x, 0x114, 0xf);
    x += DPPF(0.f, x, 0x118, 0xf);
    x += DPPF(0.f, x, 0x142, 0xa);
    x += DPPF(0.f, x, 0x143, 0xc);
    return x;
}
__device__ __forceinline__ float wave_scan_max(float x, int) {
    const float ninf = -3.0e38f;
    x = fmaxf(x, DPPF(ninf, x, 0x111, 0xf));
    x = fmaxf(x, DPPF(ninf, x, 0x112, 0xf));
    x = fmaxf(x, DPPF(ninf, x, 0x114, 0xf));
    x = fmaxf(x, DPPF(ninf, x, 0x118, 0xf));
    x = fmaxf(x, DPPF(ninf, x, 0x142, 0xa));
    x = fmaxf(x, DPPF(ninf, x, 0x143, 0xc));
    return x;
}
__device__ __forceinline__ float wave_max(float x) {
#pragma unroll
    for (int o = 1; o < 64; o <<= 1) x = fmaxf(x, __shfl_xor(x, o));
    return x;
}
__device__ __forceinline__ void conv8(const char* zub, unsigned voff, int blk, int s, int tt, int n, LAS const float* w, int c0, float scale, float* out) {
    float acc[8];
#pragma unroll
    for (int e = 0; e < 8; ++e) acc[e] = 0.f;
#pragma unroll
    for (int j = 0; j < 4; ++j) {
        v4u raw = *(const v4u*)(zub + ((long)(32 * blk + j - 3) * ZRS + 16 * s) * 2 + voff);
        if (!(n > 0 || tt + j - 3 >= 0)) raw = (v4u){0u, 0u, 0u, 0u};
        float z[8]; unpack8(raw, z);
        const f32x4 w0 = *(LAS const f32x4*)(w + j * 64 + c0), w1 = *(LAS const f32x4*)(w + j * 64 + c0 + 4);
        acc[0] += z[0] * w0[0]; acc[1] += z[1] * w0[1]; acc[2] += z[2] * w0[2]; acc[3] += z[3] * w0[3];
        acc[4] += z[4] * w1[0]; acc[5] += z[5] * w1[1]; acc[6] += z[6] * w1[2]; acc[7] += z[7] * w1[3];
    }
#pragma unroll
    for (int e = 0; e < 8; ++e) out[e] = fsilu(acc[e]) * scale;
}
__device__ __forceinline__ bf16x8 ld_f32_frag(gcp ub, unsigned voff) {
    const f32x4 a = *(const GAS f32x4*)(ub + voff), b = *(const GAS f32x4*)(ub + voff + 16);
    return pack8(a[0], a[1], a[2], a[3], b[0], b[1], b[2], b[3]);
}

__device__ __forceinline__ void dma_rows67(gcp ub, unsigned voff, LAS unsigned char* img, int lane) {
#pragma unroll
    for (int it = 0; it < 8; ++it) __builtin_amdgcn_global_load_lds((const GAS unsigned*)(ub + (size_t)it * 8 * ZRS * 2 + voff), (LAS unsigned*)(img + it * 1024), 16, 0, 0);
    if (lane < 24) __builtin_amdgcn_global_load_lds((const GAS unsigned*)(ub + (size_t)64 * ZRS * 2 + voff), (LAS unsigned*)(img + 8192), 16, 0, 0);
}
constexpr int IMG1 = 8704;
__device__ __forceinline__ void ml_out_wave(Frame& F, int layer, int cn, int h, LAS unsigned char* wl) {
    const int lane = F_lane, r = lane & 31, hf = lane >> 5;
    const int b = cn / NCHS, n = cn % NCHS;
    const size_t row0 = (size_t)b * SEQ + (size_t)n * CH;
    const bf16* Z = F_Z;
    LAS unsigned char* img0 = wl; LAS unsigned char* img1 = wl + IMG1;
    LAS float* wq = (LAS float*)(wl + 17408); LAS float* wk = wq + 256; LAS float* npl = wq + 512;
    const unsigned dvo = dma_voff(lane);
    dma_rows67(uptr(Z + zc(ZC_MQ + h * 64) + (row0 - 3) * ZRS), dvo, img0, lane);
    dma_rows67(uptr(Z + zc(ZC_MK + h * 64) + (row0 - 3) * ZRS), dvo, img1, lane);
    { const float* cw = F_conv_w + (size_t)layer * 4 * 768 + h * 64 + lane; float tq_[4], tk_[4];
#pragma unroll
      for (int j = 0; j < 4; ++j) { tq_[j] = cw[j * 768]; tk_[j] = cw[j * 768 + 384]; }
#pragma unroll
      for (int j = 0; j < 4; ++j) { wq[j * 64 + lane] = tq_[j]; wk[j * 64 + lane] = tk_[j]; } }
    npl[lane] = F_NST[((size_t)cn * 6 + h) * 64 + lane];
    const float* g32 = F_G32 + (row0 + lane) * 32;
    const float ig = g32[h] + F_b_gates[layer * 12 + h];
    const float lf = logsigf(g32[6 + h] + F_b_gates[layer * 12 + 6 + h]);
    const float bc = wave_scan_add(lf, lane);
    const float av = ig - bc;
    const float amax = wave_scan_max(av, lane);
    const float mprev = F_MP[cn * 6 + h];
    float bct[2], mt[2], iw[2];
#pragma unroll
    for (int tb = 0; tb < 2; ++tb) { bct[tb] = __shfl(bc, 32 * tb + r); mt[tb] = fmaxf(mprev, __shfl(amax, 32 * tb + r)); iw[tb] = fexp(mprev - mt[tb]); }
    asm volatile("s_waitcnt vmcnt(0)" ::: "memory");
    bf16x8 qcf[2][4], kcf[2][4];
    float nq[2] = {0.f, 0.f};
#pragma unroll
    for (int s = 0; s < 4; ++s) {
        const int c0 = 16 * s + 8 * hf;
        const f32x4 n0 = *(LAS const f32x4*)(npl + c0), n1 = *(LAS const f32x4*)(npl + c0 + 4);
#pragma unroll
        for (int blk = 0; blk < 2; ++blk) {
            float aq[8], ak[8];
#pragma unroll
            for (int e = 0; e < 8; ++e) { aq[e] = 0.f; ak[e] = 0.f; }
#pragma unroll
            for (int j = 0; j < 4; ++j) {
                const int rho = 32 * blk + r + j, off = tile_off(rho, c0 * 2);
                v4u rq = *(LAS const v4u*)(img0 + off), rk = *(LAS const v4u*)(img1 + off);
                if (n == 0 && rho < 3) { rq = (v4u){0u, 0u, 0u, 0u}; rk = (v4u){0u, 0u, 0u, 0u}; }
                float zq[8], zk[8]; unpack8(rq, zq); unpack8(rk, zk);
                const f32x4 a0 = *(LAS const f32x4*)(wq + j * 64 + c0), a1 = *(LAS const f32x4*)(wq + j * 64 + c0 + 4), b0 = *(LAS const f32x4*)(wk + j * 64 + c0), b1 = *(LAS const f32x4*)(wk + j * 64 + c0 + 4);
                aq[0] += zq[0] * a0[0]; aq[1] += zq[1] * a0[1]; aq[2] += zq[2] * a0[2]; aq[3] += zq[3] * a0[3]; aq[4] += zq[4] * a1[0]; aq[5] += zq[5] * a1[1]; aq[6] += zq[6] * a1[2]; aq[7] += zq[7] * a1[3];
                ak[0] += zk[0] * b0[0]; ak[1] += zk[1] * b0[1]; ak[2] += zk[2] * b0[2]; ak[3] += zk[3] * b0[3]; ak[4] += zk[4] * b1[0]; ak[5] += zk[5] * b1[1]; ak[6] += zk[6] * b1[2]; ak[7] += zk[7] * b1[3];
            }
#pragma unroll
            for (int e = 0; e < 8; ++e) { aq[e] = fsilu(aq[e]); ak[e] = fsilu(ak[e]) * 0.125f; }
            nq[blk] += aq[0] * n0[0] + aq[1] * n0[1] + aq[2] * n0[2] + aq[3] * n0[3] + aq[4] * n1[0] + aq[5] * n1[1] + aq[6] * n1[2] + aq[7] * n1[3];
            qcf[blk][s] = pack8(aq[0], aq[1], aq[2], aq[3], aq[4], aq[5], aq[6], aq[7]);
            kcf[blk][s] = pack8(ak[0], ak[1], ak[2], ak[3], ak[4], ak[5], ak[6], ak[7]);
        }
    }
    dma_tile_u(uptr(Z + zc(ZC_MV + h * 64) + row0 * ZRS), dvo, img0);
    bf16x8 pf0[2], pf1[4];
    float den[2] = {0.f, 0.f};
    {
        f32x16 s00, s01, s11;
#pragma unroll
        for (int i = 0; i < 16; ++i) { s00[i] = 0.f; s01[i] = 0.f; s11[i] = 0.f; }
#pragma unroll
        for (int s = 0; s < 4; ++s) { s00 = MFMA32(kcf[0][s], qcf[0][s], s00); s01 = MFMA32(kcf[0][s], qcf[1][s], s01); s11 = MFMA32(kcf[1][s], qcf[1][s], s11); }
#pragma unroll
        for (int i = 0; i < 16; ++i) {
            const int jr = (i & 3) + 8 * (i >> 2) + 4 * hf;
            const float a0 = __shfl(av, jr), a1 = __shfl(av, 32 + jr);
            const float d00 = (jr <= r) ? fexp(a0 - mt[0]) : 0.f, d01 = fexp(a0 - mt[1]), d11 = (jr <= r) ? fexp(a1 - mt[1]) : 0.f;
            s00[i] *= d00; s01[i] *= d01; s11[i] *= d11;
            den[0] += s00[i]; den[1] += s01[i] + s11[i];
        }
        pf0[0] = pack8(s00[0], s00[1], s00[2], s00[3], s00[4], s00[5], s00[6], s00[7]); pf0[1] = pack8(s00[8], s00[9], s00[10], s00[11], s00[12], s00[13], s00[14], s00[15]);
        pf1[0] = pack8(s01[0], s01[1], s01[2], s01[3], s01[4], s01[5], s01[6], s01[7]); pf1[1] = pack8(s01[8], s01[9], s01[10], s01[11], s01[12], s01[13], s01[14], s01[15]);
        pf1[2] = pack8(s11[0], s11[1], s11[2], s11[3], s11[4], s11[5], s11[6], s11[7]); pf1[3] = pack8(s11[8], s11[9], s11[10], s11[11], s11[12], s11[13], s11[14], s11[15]);
    }
#pragma unroll
    for (int tb = 0; tb < 2; ++tb) {
        den[tb] = xh_sum(den[tb]); nq[tb] = xh_sum(nq[tb]);
        den[tb] = fmaxf(fabsf(den[tb] + iw[tb] * nq[tb]), fexp(-(bct[tb] + mt[tb])));
    }
    unsigned trb0, trb1; tr_bases(lane, trb0, trb1);
    gcp cpb = uptr(F_CPB + ((size_t)cn * 6 + h) * 4096);
    f32x16 num[2][2];
#pragma unroll
    for (int vb = 0; vb < 2; ++vb) {
        bf16x8 cf[4];
#pragma unroll
        for (int s = 0; s < 4; ++s) cf[s] = ldfrag(cpb + ((size_t)32 * vb * 64 + 16 * s) * 2, (unsigned)(r * 64 + 8 * hf) * 2u);
#pragma unroll
        for (int tb = 0; tb < 2; ++tb) {
#pragma unroll
            for (int i = 0; i < 16; ++i) num[vb][tb][i] = 0.f;
#pragma unroll
            for (int s = 0; s < 4; ++s) num[vb][tb] = MFMA32(cf[s], qcf[tb][s], num[vb][tb]);
#pragma unroll
            for (int i = 0; i < 16; ++i) num[vb][tb][i] *= iw[tb];
        }
    }
    asm volatile("s_waitcnt vmcnt(0)" ::: "memory");
#pragma unroll
    for (int vb = 0; vb < 2; ++vb)
#pragma unroll
        for (int ks = 0; ks < 4; ++ks) {
            const bf16x8 vf = tr_frag_b(img0, vb ? trb1 : trb0, ks);
            if (ks < 2) num[vb][0] = MFMA32(vf, pf0[ks], num[vb][0]);
            num[vb][1] = MFMA32(vf, pf1[ks], num[vb][1]);
        }
#pragma unroll
    for (int tb = 0; tb < 2; ++tb) {
        const float rden = 1.0f / den[tb]; float ss = 0.f;
#pragma unroll
        for (int vb = 0; vb < 2; ++vb)
#pragma unroll
            for (int i = 0; i < 16; ++i) { num[vb][tb][i] *= rden; ss += num[vb][tb][i] * num[vb][tb][i]; }
        ss = xh_sum(ss);
        const float rn = 1.0f / sqrtf(ss * (1.0f / 64.0f) + EPS);
#pragma unroll
        for (int vb = 0; vb < 2; ++vb)
#pragma unroll
            for (int i4 = 0; i4 < 4; ++i4) tl_put4(wl, 32 * tb + r, 32 * vb + 8 * i4 + 4 * hf, num[vb][tb][4 * i4] * rn, num[vb][tb][4 * i4 + 1] * rn, num[vb][tb][4 * i4 + 2] * rn, num[vb][tb][4 * i4 + 3] * rn);
    }
    tl_emit<1>(wl, lane, uptr(Z + zc(ZC_MO + h * 64) + row0 * ZRS), uptr(Z + zc(ZC_MG + h * 64) + row0 * ZRS), F_ml_norm_g + layer * 384 + h * 64, (GAS char*)uptr(F_Y + row0 * DM + 384 + h * 64));
}

__device__ __forceinline__ void ml_loc_wave(Frame& F, int layer, int cn, int h, LAS unsigned char* wl) {
    const int lane = F_lane, r = lane & 31, hf = lane >> 5;
    const int b = cn / NCHS, n = cn % NCHS;
    const size_t row0 = (size_t)b * SEQ + (size_t)n * CH;
    const bf16* Z = F_Z;
    LAS unsigned char* img0 = wl; LAS unsigned char* img1 = wl + IMG1;
    const unsigned dvo = dma_voff(lane);
    dma_rows67(uptr(Z + zc(ZC_MK + h * 64) + (row0 - 3) * ZRS), dvo, img0, lane);
    dma_tile_u(uptr(Z + zc(ZC_MV + h * 64) + row0 * ZRS), dvo, img1);
    const int rr = lane >> 3, ch = lane & 7;
    float wk[4][8];
    { const float* cw = F_conv_w + (size_t)layer * 4 * 768 + 384 + h * 64 + ch * 8;
#pragma unroll
      for (int j = 0; j < 4; ++j) { const f32x4 a = *(const f32x4*)(cw + j * 768), c = *(const f32x4*)(cw + j * 768 + 4);
          wk[j][0] = a[0]; wk[j][1] = a[1]; wk[j][2] = a[2]; wk[j][3] = a[3]; wk[j][4] = c[0]; wk[j][5] = c[1]; wk[j][6] = c[2]; wk[j][7] = c[3]; } }
    const float* g32 = F_G32 + (row0 + lane) * 32;
    const float ig = g32[h] + F_b_gates[layer * 12 + h];
    const float lf = logsigf(g32[6 + h] + F_b_gates[layer * 12 + 6 + h]);
    const float bc = wave_scan_add(lf, lane);
    const float g = __shfl(bc, 63);
    const float av = g - bc + ig;
    const float mloc = wave_max(av);
    const float w = fexp(av - mloc);
    asm volatile("s_waitcnt vmcnt(0)" ::: "memory");
#pragma unroll 2
    for (int it = 0; it < 8; ++it) {
        const int row = 8 * it + rr;
        float acc[8];
#pragma unroll
        for (int e = 0; e < 8; ++e) acc[e] = 0.f;
#pragma unroll
        for (int j = 0; j < 4; ++j) {
            v4u raw = *(LAS const v4u*)(img0 + tile_off(row + j, ch * 16));
            if (n == 0 && row + j < 3) raw = (v4u){0u, 0u, 0u, 0u};
            float z[8]; unpack8(raw, z);
#pragma unroll
            for (int e = 0; e < 8; ++e) acc[e] += z[e] * wk[j][e];
        }
        const int lo = tile_off(row, ch * 16);
        float v8[8]; unpack8(*(LAS const v4u*)(img1 + lo), v8);
        const float wr = __shfl(w, row);
        *(LAS v4u*)(img0 + lo) = __builtin_bit_cast(v4u, pack8(fsilu(acc[0]) * 0.125f, fsilu(acc[1]) * 0.125f, fsilu(acc[2]) * 0.125f, fsilu(acc[3]) * 0.125f,
                                                                fsilu(acc[4]) * 0.125f, fsilu(acc[5]) * 0.125f, fsilu(acc[6]) * 0.125f, fsilu(acc[7]) * 0.125f));
        *(LAS v4u*)(img1 + lo) = __builtin_bit_cast(v4u, pack8(v8[0] * wr, v8[1] * wr, v8[2] * wr, v8[3] * wr, v8[4] * wr, v8[5] * wr, v8[6] * wr, v8[7] * wr));
    }
    unsigned trb0, trb1; tr_bases(lane, trb0, trb1);
    f32x16 acc[2][2];
#pragma unroll
    for (int a = 0; a < 2; ++a)
#pragma unroll
        for (int c = 0; c < 2; ++c)
#pragma unroll
            for (int i = 0; i < 16; ++i) acc[a][c][i] = 0.f;
#pragma unroll
    for (int ks = 0; ks < 4; ++ks) {
        const bf16x8 v0 = tr_frag_b(img1, trb0, ks), v1 = tr_frag_b(img1, trb1, ks), k0 = tr_frag_b(img0, trb0, ks), k1 = tr_frag_b(img0, trb1, ks);
        acc[0][0] = MFMA32(k0, v0, acc[0][0]); acc[0][1] = MFMA32(k0, v1, acc[0][1]); acc[1][0] = MFMA32(k1, v0, acc[1][0]); acc[1][1] = MFMA32(k1, v1, acc[1][1]);
    }
    bf16* cst = (bf16*)F_CST + ((size_t)cn * 6 + h) * 4096;
#pragma unroll
    for (int kb = 0; kb < 2; ++kb)
#pragma unroll
        for (int vb = 0; vb < 2; ++vb)
#pragma unroll
            for (int i4 = 0; i4 < 4; ++i4)
                *(unsigned long long*)(cst + (32 * vb + r) * 64 + 32 * kb + 8 * i4 + 4 * hf) =
                    (unsigned long long)cvtpk(acc[kb][vb][4 * i4], acc[kb][vb][4 * i4 + 1]) | ((unsigned long long)cvtpk(acc[kb][vb][4 * i4 + 2], acc[kb][vb][4 * i4 + 3]) << 32);
    float s = 0.f;
#pragma unroll 8
    for (int j = 0; j < 64; ++j) s += __shfl(w, j) * bf2f(*(LAS const unsigned short*)(img0 + tile_off(j, 2 * lane)));
    F_NST[((size_t)cn * 6 + h) * 64 + lane] = s;
    if (lane == 0) { F_GS[cn * 6 + h] = g; F_MS[cn * 6 + h] = mloc; }
}

__device__ __forceinline__ float flogsig(float x) { return fminf(x, 0.f) - 0.6931471805599453f * __builtin_amdgcn_logf(1.0f + fexp(-fabsf(x))); }
__device__ __forceinline__ void gla_loc_wave(Frame& F, int layer, int cn, int hh, LAS unsigned char* wl) {
    const int lane = F_lane, hf = lane >> 5;
    const int b = cn / NCHS, n = cn % NCHS;
    const size_t row0 = (size_t)b * SEQ + (size_t)n * CH, row = row0 + lane;
    const bf16* Z = F_Z;
    dma_tile_u(uptr(Z + zc(ZC_GV + hh * 64) + row0 * ZRS), dma_voff(lane), wl + 8192);
    float ga[16];
    { const f32x4* gp = (const f32x4*)(F_G32 + row * 32 + 12);
#pragma unroll
      for (int q = 0; q < 4; ++q) { const f32x4 v = gp[q]; ga[4 * q] = v[0]; ga[4 * q + 1] = v[1]; ga[4 * q + 2] = v[2]; ga[4 * q + 3] = v[3]; } }
    const float* wa = F_w_alpha + (size_t)layer * 16 * 128 + hh * 32; const float* ba = F_b_alpha + layer * 128 + hh * 32;
    LAS float* wsl = (LAS float*)(wl + 16384);
    float tw_[8];
#pragma unroll
    for (int k = 0; k < 8; ++k) { const int i = lane + 64 * k; tw_[k] = wa[(i >> 5) * 128 + (i & 31)]; }
#pragma unroll
    for (int k = 0; k < 8; ++k) wsl[lane + 64 * k] = tw_[k];
    float bcv[32];
#pragma unroll
    for (int d4 = 0; d4 < 8; ++d4) {
        f32x4 a = *(const f32x4*)(ba + 4 * d4);
#pragma unroll
        for (int q = 0; q < 16; ++q) a += *(LAS const f32x4*)(wsl + q * 32 + 4 * d4) * ga[q];
#pragma unroll
        for (int e = 0; e < 4; ++e) bcv[4 * d4 + e] = wave_scan_add(flogsig(a[e]) * (1.0f / 16.0f), lane);
    }
    { f32x4* bp = (f32x4*)(F_BC + row * 128 + hh * 32);
#pragma unroll
      for (int q = 0; q < 8; ++q) bp[q] = (f32x4){bcv[4 * q], bcv[4 * q + 1], bcv[4 * q + 2], bcv[4 * q + 3]}; }
#pragma unroll
    for (int c = 0; c < 4; ++c) {
        float k8[8]; unpack8(*(const v4u*)(Z + zc(ZC_GK + hh * 32) + row * ZRS + 8 * c), k8);
#pragma unroll
        for (int e = 0; e < 8; ++e) k8[e] *= fexp(__shfl(bcv[8 * c + e], 63) - bcv[8 * c + e]);
        *(LAS v4u*)(wl + tile_off(lane, c * 16)) = __builtin_bit_cast(v4u, pack8(k8[0], k8[1], k8[2], k8[3], k8[4], k8[5], k8[6], k8[7]));
    }
    if (lane == 63) { f32x4* ap = (f32x4*)(F_ADEC + ((size_t)cn * 4 + hh) * 32);
#pragma unroll
        for (int q = 0; q < 8; ++q) ap[q] = (f32x4){fexp(bcv[4 * q]), fexp(bcv[4 * q + 1]), fexp(bcv[4 * q + 2]), fexp(bcv[4 * q + 3])}; }
    unsigned trb0, trb1; tr_bases(lane, trb0, trb1);
    f32x16 u0, u1;
#pragma unroll
    for (int i = 0; i < 16; ++i) { u0[i] = 0.f; u1[i] = 0.f; }
    asm volatile("s_waitcnt vmcnt(0)" ::: "memory");
#pragma unroll
    for (int ks = 0; ks < 4; ++ks) { const bf16x8 kd = tr_frag_b(wl, trb0, ks);
        u0 = MFMA32(tr_frag_b(wl + 8192, trb0, ks), kd, u0); u1 = MFMA32(tr_frag_b(wl + 8192, trb1, ks), kd, u1); }
    float* sst = F_SST + ((size_t)cn * 4 + hh) * 2048;
#pragma unroll
    for (int i = 0; i < 16; ++i) { const int v = (i & 3) + 8 * (i >> 2) + 4 * hf; sst[v * 32 + (lane & 31)] = u0[i]; sst[(32 + v) * 32 + (lane & 31)] = u1[i]; }
}

__device__ __forceinline__ void gla_out_wave(Frame& F, int layer, int cn, int hh, LAS unsigned char* wl) {
    const int lane = F_lane, r = lane & 31, hf = lane >> 5;
    const int b = cn / NCHS, n = cn % NCHS;
    const size_t row0 = (size_t)b * SEQ + (size_t)n * CH;
    const bf16* Z = F_Z;
    dma_tile_u(uptr(Z + zc(ZC_GV + hh * 64) + row0 * ZRS), dma_voff(lane), wl);
    const unsigned voffK = (unsigned)(r * ZRS + 8 * hf) * 2u, voffB = (unsigned)(r * 128 + 8 * hf) * 4u;
    gcp zq = uptr(Z + zc(ZC_GQ + hh * 32) + row0 * ZRS); gcp zk = uptr(Z + zc(ZC_GK + hh * 32) + row0 * ZRS); gcp bcb = uptr(F_BC + row0 * 128 + hh * 32);
    bf16x8 qf[2][2], kf[2][2];
    {
        v4u rq[2][2], rk[2][2]; f32x4 rc0[2][2], rc1[2][2];
#pragma unroll
        for (int blk = 0; blk < 2; ++blk)
#pragma unroll
            for (int s = 0; s < 2; ++s) {
                rq[blk][s] = *(const GAS v4u*)(zq + ((size_t)32 * blk * ZRS + 16 * s) * 2 + voffK); rk[blk][s] = *(const GAS v4u*)(zk + ((size_t)32 * blk * ZRS + 16 * s) * 2 + voffK);
                rc0[blk][s] = *(const GAS f32x4*)(bcb + ((size_t)32 * blk * 128 + 16 * s) * 4 + voffB); rc1[blk][s] = *(const GAS f32x4*)(bcb + ((size_t)32 * blk * 128 + 16 * s) * 4 + voffB + 16);
            }
        asm volatile("" : "+v"(rq[0][0]), "+v"(rq[0][1]), "+v"(rq[1][0]), "+v"(rq[1][1]), "+v"(rk[0][0]), "+v"(rk[0][1]), "+v"(rk[1][0]), "+v"(rk[1][1]));
        asm volatile("" : "+v"(rc0[0][0]), "+v"(rc0[0][1]), "+v"(rc0[1][0]), "+v"(rc0[1][1]), "+v"(rc1[0][0]), "+v"(rc1[0][1]), "+v"(rc1[1][0]), "+v"(rc1[1][1]));
#pragma unroll
        for (int blk = 0; blk < 2; ++blk)
#pragma unroll
            for (int s = 0; s < 2; ++s) {
                float q8[8], k8[8];
                unpack8(rq[blk][s], q8); unpack8(rk[blk][s], k8);
                const f32x4 c0 = rc0[blk][s], c1 = rc1[blk][s];
                const float bc8[8] = {c0[0], c0[1], c0[2], c0[3], c1[0], c1[1], c1[2], c1[3]};
#pragma unroll
                for (int e = 0; e < 8; ++e) { q8[e] *= 0.17677669529663687f * fexp(bc8[e]); k8[e] *= fexp(-bc8[e]); }
                qf[blk][s] = pack8(q8[0], q8[1], q8[2], q8[3], q8[4], q8[5], q8[6], q8[7]);
                kf[blk][s] = pack8(k8[0], k8[1], k8[2], k8[3], k8[4], k8[5], k8[6], k8[7]);
            }
    }
    bf16x8 pf0[2], pf1[4];
    {
        f32x16 s00, s01, s11;
#pragma unroll
        for (int i = 0; i < 16; ++i) { s00[i] = 0.f; s01[i] = 0.f; s11[i] = 0.f; }
#pragma unroll
        for (int s = 0; s < 2; ++s) { s00 = MFMA32(kf[0][s], qf[0][s], s00); s01 = MFMA32(kf[0][s], qf[1][s], s01); s11 = MFMA32(kf[1][s], qf[1][s], s11); }
#pragma unroll
        for (int i = 0; i < 16; ++i) { const int jr = (i & 3) + 8 * (i >> 2) + 4 * hf; if (jr > r) { s00[i] = 0.f; s11[i] = 0.f; } }
        pf0[0] = pack8(s00[0], s00[1], s00[2], s00[3], s00[4], s00[5], s00[6], s00[7]); pf0[1] = pack8(s00[8], s00[9], s00[10], s00[11], s00[12], s00[13], s00[14], s00[15]);
        pf1[0] = pack8(s01[0], s01[1], s01[2], s01[3], s01[4], s01[5], s01[6], s01[7]); pf1[1] = pack8(s01[8], s01[9], s01[10], s01[11], s01[12], s01[13], s01[14], s01[15]);
        pf1[2] = pack8(s11[0], s11[1], s11[2], s11[3], s11[4], s11[5], s11[6], s11[7]); pf1[3] = pack8(s11[8], s11[9], s11[10], s11[11], s11[12], s11[13], s11[14], s11[15]);
    }
    unsigned trb0, trb1; tr_bases(lane, trb0, trb1);
    gcp spb = uptr(F_SST + ((size_t)cn * 4 + hh) * 2048);
    f32x16 num[2][2];
#pragma unroll
    for (int vb = 0; vb < 2; ++vb) {
        bf16x8 sf[2];
#pragma unroll
        for (int s = 0; s < 2; ++s) sf[s] = ld_f32_frag(spb + ((size_t)32 * vb * 32 + 16 * s) * 4, (unsigned)(r * 32 + 8 * hf) * 4u);
#pragma unroll
        for (int tb = 0; tb < 2; ++tb) {
#pragma unroll
            for (int i = 0; i < 16; ++i) num[vb][tb][i] = 0.f;
#pragma unroll
            for (int s = 0; s < 2; ++s) num[vb][tb] = MFMA32(sf[s], qf[tb][s], num[vb][tb]);
        }
    }
    asm volatile("s_waitcnt vmcnt(0)" ::: "memory");
#pragma unroll
    for (int vb = 0; vb < 2; ++vb)
#pragma unroll
        for (int ks = 0; ks < 4; ++ks) {
            const bf16x8 vf = tr_frag_b(wl, vb ? trb1 : trb0, ks);
            if (ks < 2) num[vb][0] = MFMA32(vf, pf0[ks], num[vb][0]);
            num[vb][1] = MFMA32(vf, pf1[ks], num[vb][1]);
        }
#pragma unroll
    for (int tb = 0; tb < 2; ++tb) {
        float ss = 0.f;
#pragma unroll
        for (int vb = 0; vb < 2; ++vb)
#pragma unroll
            for (int i = 0; i < 16; ++i) ss += num[vb][tb][i] * num[vb][tb][i];
        ss = xh_sum(ss);
        const float rn = 1.0f / sqrtf(ss * (1.0f / 64.0f) + EPS);
#pragma unroll
        for (int vb = 0; vb < 2; ++vb)
#pragma unroll
            for (int i4 = 0; i4 < 4; ++i4) tl_put4(wl, 32 * tb + r, 32 * vb + 8 * i4 + 4 * hf, num[vb][tb][4 * i4] * rn, num[vb][tb][4 * i4 + 1] * rn, num[vb][tb][4 * i4 + 2] * rn, num[vb][tb][4 * i4 + 3] * rn);
    }
    tl_emit<2>(wl, lane, uptr(Z + zc(ZC_GG + hh * 64) + row0 * ZRS), (gcp)nullptr, F_gla_norm_g + layer * 256 + hh * 64, (GAS char*)uptr(F_Y + row0 * DM + 768 + hh * 64));
}

__device__ __forceinline__ void p2_local(Frame& F, int layer) {
    int gw_ = F.vcu * NWAVES + F.wave; asm volatile("" : "+s"(gw_));
    const int gw = gw_, NGW = F.G * NWAVES;
    LAS unsigned char* wl = F.lds + RING_OFF + F.wave * WL_BYTES;
    constexpr int NA = NCHT * 6, NL = NCHT * 10;
    if (NGW == 2048) {
#define LOCAL_TASK(q) do { const int q_ = (q); if (q_ < NA) ml_loc_wave(F, layer, q_ / 6, q_ % 6, wl); else gla_loc_wave(F, layer, (q_ - NA) >> 2, (q_ - NA) & 3, wl); } while (0)
#if PROBE_T
        if (gw < NA) { LOCAL_TASK(gw);
            const unsigned long long t0_ = __builtin_amdgcn_s_memrealtime();
            attn_wave(F, layer, gw / 6, gw % 6, wl);
            const unsigned dt_ = (unsigned)(__builtin_amdgcn_s_memrealtime() - t0_);
            if (layer == 0 && F_lane == 0) {
                if (PROBE_T == 11 && dt_ > 3500u) atomicAdd((unsigned*)(F_ctl + 2048), 100u);
                if (PROBE_T == 12 && dt_ > 4200u) atomicAdd((unsigned*)(F_ctl + 2048), 100u);
                if (PROBE_T == 13) atomicMax((unsigned*)(F_ctl + 2048), (dt_ << 11) | (unsigned)gw);
                if (PROBE_T == 14 && dt_ < 2600u) atomicAdd((unsigned*)(F_ctl + 2048), 100u);
                if (PROBE_T == 15) atomicAdd((unsigned*)(F_ctl + 2048), dt_ >> 4);
            } }
#else
        if (gw < NA) { LOCAL_TASK(gw); attn_wave(F, layer, gw / 6, gw % 6, wl); }
#endif
        else { const int q0 = NA + 2 * (gw - NA); for (int q = q0; q < q0 + 2; ++q) LOCAL_TASK(q); }
#undef LOCAL_TASK
    } else {
        for (int a = gw; a < NA; a += NGW) attn_wave(F, layer, a / 6, a % 6, wl);
        for (int q = gw; q < NL; q += NGW) { if (q < NA) ml_loc_wave(F, layer, q / 6, q % 6, wl); else gla_loc_wave(F, layer, (q - NA) >> 2, (q - NA) & 3, wl); }
    }
}
__device__ __forceinline__ void p4_outputs(Frame& F, int layer) {
    int gw_ = F.vcu * NWAVES + F.wave; asm volatile("" : "+s"(gw_));
    const int gw = gw_, NGW = F.G * NWAVES;
    LAS unsigned char* wl = F.lds + RING_OFF + F.wave * WL_BYTES;
    constexpr int NA = NCHT * 6, NG = NCHT * 4;
    if (NGW == 2048) {
        if (gw < NA) { ml_out_wave(F, layer, gw / 6, gw % 6, wl);
#if PROBE_DUP == 8
            ml_out_wave(F, layer, gw / 6, gw % 6, wl);
#endif
        }
        else { for (int q = gw - NA; q < NG; q += 512) gla_out_wave(F, layer, q >> 2, q & 3, wl);
#if PROBE_DUP == 9
            for (int q = gw - NA; q < NG; q += 512) gla_out_wave(F, layer, q >> 2, q & 3, wl);
#endif
        }
    } else {
        for (int a = gw; a < NA; a += NGW) ml_out_wave(F, layer, a / 6, a % 6, wl);
        for (int q = gw; q < NG; q += NGW) gla_out_wave(F, layer, q >> 2, q & 3, wl);
    }
}

__device__ __forceinline__ void p11_final(Frame& F) {
    int gw_ = F.vcu * NWAVES + F.wave; asm volatile("" : "+s"(gw_));
    const int gw = gw_, NGW = F.G * NWAVES;
    const float* ssq = F_SSQ + 2 * T;
    for (int m = gw; m < T; m += NGW) {
        const float rs = 1.0f / sqrtf(ssq[m] * (1.0f / 1024.0f) + EPS);
        const GAS unsigned long long* xr = (const GAS unsigned long long*)(F_XB + (size_t)m * DM) + F_lane;
        GAS f32x4* orow = (GAS f32x4*)(F_out + (size_t)m * DM) + F_lane; const GAS f32x4* gr = (const GAS f32x4*)F_final_g + F_lane;
#pragma unroll
        for (int j = 0; j < 4; ++j) { const unsigned long long w = xr[64 * j]; const f32x4 g = gr[64 * j];
            const f32x4 v = (f32x4){__uint_as_float((unsigned)w << 16), __uint_as_float((unsigned)w & 0xffff0000u), __uint_as_float((unsigned)(w >> 32) << 16), __uint_as_float((unsigned)(w >> 32) & 0xffff0000u)};
            orow[64 * j] = v * rs * g; }
    }
}

__global__ void __launch_bounds__(NTHR, 2) hymba_fwd(Args args) {
    extern __shared__ __attribute__((aligned(16))) unsigned char lds[];
    Frame F;
    F.lds = (LAS unsigned char*)lds;
    F.MISC = (volatile LAS unsigned*)(F.lds + MISC_OFF);
    F.wave = __builtin_amdgcn_readfirstlane(F_tid >> 6);
    F.G = gridDim.x; { const int bx = blockIdx.x; F.vcu = (F.G % 8 == 0) ? (bx % 8) * (F.G / 8) + bx / 8 : bx; }
    F.A = &args;
    for (int u = F_tid; u < (LDS_BYTES - LDSCTL_OFF) / 4; u += NTHR) ((LAS unsigned*)(F.lds + LDSCTL_OFF))[u] = 0u;
    __syncthreads();
    XcdBarrier bar; bar.bar = (unsigned*)(F_ctl + CW_BAR); bar.x = 0; bar.st = nullptr;
    if (N_LAUNCHES == 1) bar = xcd_barrier_post((unsigned*)(F_ctl + CW_BAR), F.MISC + 8);
#define GRID_BAR() do { if (N_LAUNCHES == 1) { XcdBarrier b2_ = bar; unsigned long long v_ = (unsigned long long)bar.bar; asm volatile("" : "+s"(v_)); b2_.bar = (unsigned*)v_; xcd_barrier(b2_); } } while (0)
#if PROBE_T == 16 || PROBE_T == 17
    const unsigned long long tk0_ = __builtin_amdgcn_s_memrealtime();
#endif
    const int lo = args.ph_lo, hi = args.ph_hi;
#pragma unroll 1
    for (int ph = lo; ph < hi; ++ph) {
        if (ph == 0) { p0_prologue(F);
#if PROBE_DUP == 4
            GRID_BAR(); p0_prologue(F);
#endif
        } else if (ph == NPHASE - 1) { p11_final(F);
        } else {
            const int layer = (ph - 1) / 5, k = (ph - 1) % 5;
            if (k == 0 || k == 4) {
                const int which = k ? 1 : 0, N = which ? DM : NP;
                pg8::Gemm g{which ? F_Y : F_XB, which ? F_Wout_t + (size_t)layer * DM * DM : F_Win_t + (size_t)layer * NP * DM, T, N, DM};
                pg8::StaticOrder S; S.init(T, N, F.G, (int)blockIdx.x);
                pg8::EpiBoth E{which, pg8::EpiZ{F_Z, LDZ, F_SSQ + layer * T, F_G32, ZC_SM},
                               pg8::EpiRes{(const float*)nullptr, (const bf16*)F_XB, (float*)nullptr, F_XB, F_SSQ + (layer + 1) * T}};
                pg8::gemm_phase<pg8::EpiBoth, pg8::StaticOrder, true, true>(F.lds + RING_OFF, g, S, E);
                if (ph == 1 && F.G == 256 && (int)blockIdx.x >= 64) { int wi_ = ((int)blockIdx.x - 64) * NWAVES + F.wave; asm volatile("" : "+s"(wi_)); p0_weights(F, 1, wi_, 192 * NWAVES); }
            } else if (k == 1) { p2_local(F, layer);
#if PROBE_DUP == 2
                GRID_BAR(); p2_local(F, layer);
#endif
            } else if (k == 2) { p3_scan(F);
            } else { p4_outputs(F, layer);
#if PROBE_DUP == 3
                GRID_BAR(); p4_outputs(F, layer);
#endif
            }
        }
        if (ph + 1 < hi) GRID_BAR();
    }
#if PROBE_T
    if (F.vcu == 100 && F.wave == 0) { unsigned n_ = __hip_atomic_load((unsigned*)(F_ctl + 2048), __ATOMIC_RELAXED, __HIP_MEMORY_SCOPE_AGENT);
#if PROBE_T == 16
        n_ = (unsigned)((__builtin_amdgcn_s_memrealtime() - tk0_) >> 1);
#endif
        if (PROBE_T == 13) n_ = (n_ & 2047u) * 50u;
        const unsigned long long t0_ = __builtin_amdgcn_s_memrealtime(); while (__builtin_amdgcn_s_memrealtime() - t0_ < n_) __builtin_amdgcn_s_sleep(8); }
#endif
}

extern "C" void kernel_launch(void* const* d_in, const int* in_sizes, int n_in, void* d_out, int out_size, void* d_ws, size_t ws_size, hipStream_t stream) {
    static int grid = 0;
    if (grid == 0) {
        if (n_in != 12 || in_sizes[0] != T * DM || out_size != T * DM || ws_size < WS_END) {
            fprintf(stderr, "kernel_launch: unexpected shapes (n_in %d, in0 %d, out %d, ws %zu, need %zu); nothing launched\n", n_in, n_in > 0 ? in_sizes[0] : -1, out_size, ws_size, (size_t)WS_END); grid = -1; return; }
        int dev = 0, cus = 0, per_cu = 0;
        if (hipGetDevice(&dev) != hipSuccess || hipDeviceGetAttribute(&cus, hipDeviceAttributeMultiprocessorCount, dev) != hipSuccess) { fprintf(stderr, "kernel_launch: device query failed\n"); grid = -1; return; }
        if (hipFuncSetAttribute((const void*)hymba_fwd, hipFuncAttributeMaxDynamicSharedMemorySize, LDS_BYTES) != hipSuccess) { fprintf(stderr, "kernel_launch: hipFuncSetAttribute failed\n"); grid = -1; return; }
        if (hipOccupancyMaxActiveBlocksPerMultiprocessor(&per_cu, (const void*)hymba_fwd, NTHR, LDS_BYTES) != hipSuccess || per_cu < 1) {
            fprintf(stderr, "kernel_launch: occupancy query reports %d workgroups per CU; nothing launched\n", per_cu); (void)hipGetLastError(); grid = -1; return; }
        grid = cus;
        fprintf(stderr, "kernel_launch: grid %d x %d threads, %d B LDS, occupancy query %d/CU\n", grid, NTHR, LDS_BYTES, per_cu);
    }
    if (grid < 0) return;
    if (hipMemsetAsync((char*)d_ws + WS_CTL, 0, CTL_ZERO_BYTES, stream) != hipSuccess) { fprintf(stderr, "kernel_launch: memset failed\n"); return; }
    Args a{};
    for (int i = 0; i < 12; ++i) a.in[i] = (const float*)d_in[i];
    a.out = (float*)d_out; a.ws = (unsigned char*)d_ws;
    if (N_LAUNCHES == 1) {
        a.ph_lo = 0; a.ph_hi = NPHASE; a.li = 0;
        void* kargs[] = {&a};
        hipError_t e = hipLaunchCooperativeKernel((const void*)hymba_fwd, dim3(grid), dim3(NTHR), kargs, LDS_BYTES, stream);
        if (e != hipSuccess) fprintf(stderr, "kernel_launch: cooperative launch failed: %s\n", hipGetErrorString(e));
    } else {
        for (int p = 0; p < NPHASE; ++p) { a.ph_lo = p; a.ph_hi = p + 1; a.li = p;
            hipLaunchKernelGGL(hymba_fwd, dim3(grid), dim3(NTHR), LDS_BYTES, stream, a);
            if (hipPeekAtLastError() != hipSuccess) { fprintf(stderr, "kernel_launch: launch %d failed\n", p); break; } }
    }
}
```

```cpp
#include <hip/hip_runtime.h>
#include <cstdio>
#include <cstdint>
#include <cmath>

#ifndef PROBE_DUP
#define PROBE_DUP 0
#endif
#ifndef PROBE_T
#define PROBE_T 0
#endif
#ifndef MK_N_LAUNCHES
#define MK_N_LAUNCHES 1
#endif

namespace pg8 {
#define PG8_LAS __attribute__((address_space(3)))
typedef unsigned short bf16_t;
typedef short bf16x8 __attribute__((ext_vector_type(8)));
typedef float f32x4 __attribute__((ext_vector_type(4)));
typedef unsigned u32x4 __attribute__((ext_vector_type(4)));
constexpr int BM = 256, BK = 64, HALF = 128, HTB = HALF * BK * 2  , STAGE_BYTES = 8 * HTB, NXCD = 8, WGM = 8;

__host__ __device__ __forceinline__ int lds_byte(int r, int c) { const int st = (r >> 4) * 2 + (c >> 5), rr = r & 15, cc = c & 31, ob = rr * 64 + cc * 2; return st * 1024 + (ob ^ (((ob >> 9) & 1) << 5)); }
__host__ __device__ __forceinline__ void stage_rc(int b, int& R, int& C) { const int st = b / 1024, sb = b % 1024, swz = sb ^ (((sb >> 9) & 1) << 5); R = (st >> 1) * 16 + swz / 64; C = (st & 1) * 32 + (swz % 64) / 2; }
__host__ __device__ __forceinline__ int perm32(int rho) { const int n = rho >> 4, i = rho & 15; return 8 * (i >> 2) + 4 * n + (i & 3); }

struct Unit { int pm, pn, roff, half; };
struct Gemm { const bf16_t* A; const bf16_t* Bt; int M, N, K; };

struct StaticOrder {
    int nM, nN, nwg, G, c, mode;
    __host__ __device__ void init(int M, int N, int G_, int c_, int mode_ = 0) { nM = M / BM; nN = N / BM - (mode_ ? 1 : 0); nwg = nM * nN; G = G_; c = c_; mode = mode_; }
    __host__ __device__ bool next(int i, Unit& u) const {
        const long L = (long)i * G + c;
        if (mode == 2) { if (L >= 2 * nM) return false; u = Unit{(int)(L >> 1), nN, (int)(L & 1) * 128, 1}; return true; }
        if (L >= nwg) return false;
        int wgid = (int)L; { const int q = nwg / NXCD, r = nwg % NXCD, xcd = wgid % NXCD, off = wgid / NXCD; wgid = (xcd < r ? xcd * (q + 1) : r * (q + 1) + (xcd - r) * q) + off; }
        const int nig = WGM * nN, gid = wgid / nig, fm = gid * WGM, gsz = (nM - fm) < WGM ? (nM - fm) : WGM;
        u = Unit{fm + ((wgid % nig) % gsz), (wgid % nig) / gsz, 0, 0}; return true;
    }
    __device__ __forceinline__ void a_ready(const Unit&) const {}
    __device__ __forceinline__ void done(const Unit&) const {}
};

__device__ __forceinline__ unsigned cvt_pk_bf16(float lo, float hi) { unsigned r; asm volatile("v_cvt_pk_bf16_f32 %0, %1, %2" : "=v"(r) : "v"(lo), "v"(hi)); return r; }

typedef unsigned u32x2 __attribute__((ext_vector_type(2)));
struct EpiZ {
    bf16_t* Z; int ldz; const float* ssq; float* G32; int gcol0;
    __device__ __forceinline__ void operator()(const f32x4 (&acc)[2][2][4][2], const Unit& u, int wr, int wc, int fr, int fq) const {
        const int row0 = u.pm * BM + u.roff + wr * 64 + fr, col0 = u.pn * BM + wc * 32 + 8 * fq;
#pragma unroll
        for (int ai = 0; ai < 2; ++ai)
#pragma unroll
            for (int m = 0; m < 4; ++m) {
                if (ai == 1 && u.half) continue;
                const int row = row0 + ai * HALF + m * 16;
                const float rs = 1.0f / sqrtf(ssq[row] * (1.0f / 1024.0f) + 1e-6f);
#pragma unroll
                for (int bj = 0; bj < 2; ++bj) {
                    const int col = col0 + bj * HALF;
                    const f32x4 v0 = acc[ai][bj][m][0] * rs, v1 = acc[ai][bj][m][1] * rs;
                    if (col < ldz) {
                        u32x4 w; w.x = cvt_pk_bf16(v0[0], v0[1]); w.y = cvt_pk_bf16(v0[2], v0[3]); w.z = cvt_pk_bf16(v1[0], v1[1]); w.w = cvt_pk_bf16(v1[2], v1[3]);
                        *(u32x4*)(Z + (size_t)(col >> 6) * ((size_t)16384 * 64) + (size_t)row * 64 + (col & 63)) = w;
                    } else if (col < gcol0 + 32) {
                        float* gp = G32 + (size_t)row * 32 + (col - gcol0);
                        *(f32x4*)gp = v0; *(f32x4*)(gp + 4) = v1;
                    }
                }
            }
    }
};
struct EpiRes {
    const float* base; const bf16_t* baseb; float* out; bf16_t* xb; float* ssq;
    __device__ __forceinline__ void ldres(int row, int col0, int bj, f32x4& r0, f32x4& r1) const {
        const size_t off = (size_t)row * 1024 + col0 + bj * HALF;
        if (base) { r0 = *(const f32x4*)(base + off); r1 = *(const f32x4*)(base + off + 4); }
        else { const u32x4 w = *(const u32x4*)(baseb + off);
            r0 = (f32x4){__uint_as_float(w.x << 16), __uint_as_float(w.x & 0xffff0000u), __uint_as_float(w.y << 16), __uint_as_float(w.y & 0xffff0000u)};
            r1 = (f32x4){__uint_as_float(w.z << 16), __uint_as_float(w.z & 0xffff0000u), __uint_as_float(w.w << 16), __uint_as_float(w.w & 0xffff0000u)}; }
    }
    __device__ __forceinline__ void operator()(const f32x4 (&acc)[2][2][4][2], const Unit& u, int wr, int wc, int fr, int fq) const {
        const int col0 = u.pn * BM + wc * 32 + 8 * fq;
        f32x4 pre[2][2];
        { const int row = u.pm * BM + wr * 64 + fr;
#pragma unroll
          for (int bj = 0; bj < 2; ++bj) ldres(row, col0, bj, pre[bj][0], pre[bj][1]); }
#pragma unroll
        for (int g = 0; g < 8; ++g) {
            const int ai = g >> 2, m = g & 3;
            const int row = u.pm * BM + ai * HALF + wr * 64 + m * 16 + fr;
            f32x4 nxt[2][2];
            if (g < 7) { const int row2 = u.pm * BM + ((g + 1) >> 2) * HALF + wr * 64 + ((g + 1) & 3) * 16 + fr;
#pragma unroll
                for (int bj = 0; bj < 2; ++bj) ldres(row2, col0, bj, nxt[bj][0], nxt[bj][1]); }
            asm volatile("" ::: "memory");
            float s = 0.f;
#pragma unroll
            for (int bj = 0; bj < 2; ++bj) {
                const size_t off = (size_t)row * 1024 + col0 + bj * HALF;
                const f32x4 o0 = pre[bj][0] + acc[ai][bj][m][0], o1 = pre[bj][1] + acc[ai][bj][m][1];
                if (out) { *(f32x4*)(out + off) = o0; *(f32x4*)(out + off + 4) = o1; }
                s += (o0[0] * o0[0] + o0[1] * o0[1]) + (o0[2] * o0[2] + o0[3] * o0[3]) + (o1[0] * o1[0] + o1[1] * o1[1]) + (o1[2] * o1[2] + o1[3] * o1[3]);
                if (xb) { u32x4 w; w.x = cvt_pk_bf16(o0[0], o0[1]); w.y = cvt_pk_bf16(o0[2], o0[3]); w.z = cvt_pk_bf16(o1[0], o1[1]); w.w = cvt_pk_bf16(o1[2], o1[3]); *(u32x4*)(xb + off) = w; }
            }
            s += __shfl_xor(s, 16); s += __shfl_xor(s, 32);
            if (fq == 0) atomicAdd(ssq + row, s);
            asm volatile("" ::: "memory");
            if (g < 7) {
#pragma unroll
                for (int bj = 0; bj < 2; ++bj) { pre[bj][0] = nxt[bj][0]; pre[bj][1] = nxt[bj][1]; } }
        }
    }
};
struct EpiBoth {
    static constexpr bool PERM = true, AFTER_DRAIN = false;
    int mode; EpiZ z; EpiRes r;
    __device__ __forceinline__ void operator()(const f32x4 (&acc)[2][2][4][2], const Unit& u, int wr, int wc, int fr, int fq) const {
        if (mode == 0) z(acc, u, wr, wc, fr, fq); else r(acc, u, wr, wc, fr, fq);
    }
};

template <class Epi, class Sched, bool ALIGN_EPI = false, bool SP2 = false, bool HALFM = false>
__device__ __forceinline__ void gemm_phase(PG8_LAS unsigned char* lds, const Gemm g, const Sched& S, const Epi& E) {
    int tid_ = threadIdx.x; asm volatile("" : "+v"(tid_));
    const int tid = tid_, wid = __builtin_amdgcn_readfirstlane(tid >> 6), lane = tid & 63, wr = wid >> 2, wc = wid & 3, fr = lane & 15, fq = lane >> 4;
    const int K = g.K, nt = K / BK;
    unsigned voffA[2], voffB[2];
#pragma unroll
    for (int i = 0; i < 2; ++i) { int R, C; stage_rc(tid * 16 + i * 8192, R, C); const int Rb = Epi::PERM ? ((R & ~31) + perm32(R & 31)) : R;
        voffA[i] = (unsigned)(R * K + C) * 2u; voffB[i] = (unsigned)(Rb * K + C) * 2u; }
    const size_t kstep = (size_t)(BK * 2);
    const size_t hstep = (size_t)HALF * K * 2;
    const size_t tstep = 2 * hstep;
    const unsigned ldsw = (unsigned)wid * 1024u;
    const int aoff = lds_byte(wr * 64 + fr, fq * 8), boff = lds_byte(wc * 32 + fr, fq * 8);
#define PG8_SA(b, h) (((b) * 2 + (h)) * HTB)
#define PG8_SB(b, h) ((4 + (b) * 2 + (h)) * HTB)
#define PG8_STAGE(bufoff, gbase, voff) do { _Pragma("unroll") for (int _i = 0; _i < 2; ++_i) \
        __builtin_amdgcn_global_load_lds((const unsigned*)((const char*)(gbase) + (voff)[_i]), (PG8_LAS unsigned*)(lds + (bufoff) + ldsw + _i * 8192), 16, 0, 0); } while (0)
#define PG8_LDA(dst, b, h) do { _Pragma("unroll") for (int m = 0; m < 4; ++m) _Pragma("unroll") for (int k = 0; k < 2; ++k) dst[m][k] = *(const PG8_LAS bf16x8*)(lds + PG8_SA(b, h) + aoff + m * 2048 + k * 1024); } while (0)
#define PG8_LDB(dst, b, h) do { _Pragma("unroll") for (int n = 0; n < 2; ++n) _Pragma("unroll") for (int k = 0; k < 2; ++k) dst[n][k] = *(const PG8_LAS bf16x8*)(lds + PG8_SB(b, h) + boff + n * 2048 + k * 1024); } while (0)
#define PG8_MMA(ai, bj, At, Bt) do { __builtin_amdgcn_s_setprio(1); _Pragma("unroll") for (int m = 0; m < 4; ++m) _Pragma("unroll") for (int n = 0; n < 2; ++n) _Pragma("unroll") for (int k = 0; k < 2; ++k) \
        acc[ai][bj][m][n] = __builtin_amdgcn_mfma_f32_16x16x32_bf16(Bt[n][k], At[m][k], acc[ai][bj][m][n], 0, 0, 0); __builtin_amdgcn_s_setprio(0); } while (0)
#define PG8_WAIT_V(n) asm volatile("s_waitcnt vmcnt(" #n ")" ::: "memory")
#define PG8_WAIT_L(n) asm volatile("s_waitcnt lgkmcnt(" #n ")" ::: "memory")
#define PG8_BAR __builtin_amdgcn_s_barrier()
#define PG8_SCHED __builtin_amdgcn_sched_barrier(0)
    Unit cur, nxt; int ui = 0;
    if (!S.next(0, cur)) return;
    f32x4 acc[2][2][4][2];
#pragma unroll
    for (int a = 0; a < 2; ++a)
#pragma unroll
        for (int b = 0; b < 2; ++b)
#pragma unroll
            for (int m = 0; m < 4; ++m)
#pragma unroll
                for (int n = 0; n < 2; ++n) acc[a][b][m][n] = (f32x4){0.f, 0.f, 0.f, 0.f};
    bf16x8 At[4][2], B0[2][2], B1[2][2];
    const char* cA = (const char*)g.A + (size_t)cur.pm * tstep + (size_t)cur.roff * K * 2; const char* cB = (const char*)g.Bt + (size_t)cur.pn * tstep;
    S.a_ready(cur);
    if constexpr (SP2) {
        PG8_STAGE(PG8_SB(0, 0), cB, voffB); PG8_STAGE(PG8_SB(0, 1), cB + hstep, voffB); PG8_STAGE(PG8_SA(0, 0), cA, voffA); PG8_STAGE(PG8_SA(0, 1), cA + hstep, voffA);
        if (wr == 1) PG8_BAR;
        PG8_WAIT_V(2); PG8_BAR;
        PG8_STAGE(PG8_SB(1, 0), cB + kstep, voffB); PG8_STAGE(PG8_SA(1, 0), cA + kstep, voffA); PG8_STAGE(PG8_SB(1, 1), cB + hstep + kstep, voffB);
        PG8_WAIT_V(6); PG8_BAR;
    } else {
        PG8_STAGE(PG8_SB(0, 0), cB, voffB); PG8_STAGE(PG8_SA(0, 0), cA, voffA); PG8_STAGE(PG8_SB(0, 1), cB + hstep, voffB); PG8_STAGE(PG8_SA(0, 1), cA + hstep, voffA);
        if (wr == 1) PG8_BAR;
        PG8_WAIT_V(4); PG8_BAR;
        PG8_STAGE(PG8_SB(1, 0), cB + kstep, voffB); PG8_STAGE(PG8_SA(1, 0), cA + kstep, voffA); PG8_STAGE(PG8_SB(1, 1), cB + hstep + kstep, voffB);
        PG8_WAIT_V(6); PG8_BAR;
    }
    for (;;) {
        const bool has_next = S.next(ui + 1, nxt);
        const char* nA = has_next ? (const char*)g.A + (size_t)nxt.pm * tstep + (size_t)nxt.roff * K * 2 : cA; const char* nB = has_next ? (const char*)g.Bt + (size_t)nxt.pn * tstep : cB;
        for (int t = 0; t < nt; t += 2) {
            const bool last = (t == nt - 2);
            const char* a1 = cA + (size_t)(t + 1) * kstep;
            const char* a2 = last ? nA : cA + (size_t)(t + 2) * kstep; const char* b2 = last ? nB : cB + (size_t)(t + 2) * kstep;
            const char* a3 = a2 + kstep; const char* b3 = b2 + kstep;
            if (last && has_next) S.a_ready(nxt);
            if constexpr (SP2) {
            PG8_LDB(B0, 0, 0); PG8_LDB(B1, 0, 1); PG8_SCHED; PG8_LDA(At, 0, 0); PG8_STAGE(PG8_SA(1, 1), a1 + hstep, voffA);
            PG8_WAIT_V(8); PG8_WAIT_L(0); PG8_BAR; PG8_MMA(0, 0, At, B0); PG8_MMA(0, 1, At, B1); PG8_BAR; PG8_SCHED;
            PG8_LDA(At, 0, 1); PG8_STAGE(PG8_SB(0, 0), b2, voffB); PG8_STAGE(PG8_SB(0, 1), b2 + hstep, voffB); PG8_STAGE(PG8_SA(0, 0), a2, voffA);
            PG8_WAIT_V(8); PG8_WAIT_L(0); PG8_BAR; if constexpr (!HALFM) { PG8_MMA(1, 0, At, B0); PG8_MMA(1, 1, At, B1); } PG8_BAR; PG8_SCHED;
            PG8_LDB(B0, 1, 0); PG8_LDB(B1, 1, 1); PG8_SCHED; PG8_LDA(At, 1, 0); PG8_STAGE(PG8_SA(0, 1), a2 + hstep, voffA);
            PG8_WAIT_V(8); PG8_WAIT_L(0); PG8_BAR; PG8_MMA(0, 0, At, B0); PG8_MMA(0, 1, At, B1); PG8_BAR; PG8_SCHED;
            PG8_LDA(At, 1, 1); PG8_STAGE(PG8_SB(1, 0), b3, voffB); PG8_STAGE(PG8_SB(1, 1), b3 + hstep, voffB); PG8_STAGE(PG8_SA(1, 0), a3, voffA);
            PG8_WAIT_V(8); PG8_WAIT_L(0); PG8_BAR; if constexpr (!HALFM) { PG8_MMA(1, 0, At, B0); PG8_MMA(1, 1, At, B1); } PG8_BAR; PG8_SCHED;
            } else {
            PG8_LDB(B0, 0, 0); PG8_SCHED; PG8_LDA(At, 0, 0); PG8_STAGE(PG8_SA(1, 1), a1 + hstep, voffA);
            PG8_WAIT_L(8); PG8_BAR; PG8_WAIT_L(0); PG8_MMA(0, 0, At, B0); PG8_BAR; PG8_SCHED;
            PG8_LDB(B1, 0, 1); PG8_STAGE(PG8_SB(0, 0), b2, voffB);
            PG8_BAR; PG8_WAIT_L(0); PG8_MMA(0, 1, At, B1); PG8_BAR;
            PG8_LDA(At, 0, 1); PG8_STAGE(PG8_SA(0, 0), a2, voffA);
            PG8_BAR; PG8_WAIT_L(0); PG8_MMA(1, 0, At, B0); PG8_BAR; PG8_SCHED;
            PG8_STAGE(PG8_SB(0, 1), b2 + hstep, voffB);
            PG8_WAIT_V(6); PG8_BAR; PG8_MMA(1, 1, At, B1); PG8_BAR;
            PG8_LDB(B0, 1, 0); PG8_SCHED; PG8_LDA(At, 1, 0); PG8_STAGE(PG8_SA(0, 1), a2 + hstep, voffA);
            PG8_WAIT_L(8); PG8_BAR; PG8_WAIT_L(0); PG8_MMA(0, 0, At, B0); PG8_BAR; PG8_SCHED;
            PG8_LDB(B1, 1, 1); PG8_STAGE(PG8_SB(1, 0), b3, voffB);
            PG8_BAR; PG8_WAIT_L(0); PG8_MMA(0, 1, At, B1); PG8_BAR;
            PG8_LDA(At, 1, 1); PG8_STAGE(PG8_SA(1, 0), a3, voffA);
            PG8_BAR; PG8_WAIT_L(0); PG8_MMA(1, 0, At, B0); PG8_BAR; PG8_SCHED;
            PG8_STAGE(PG8_SB(1, 1), b3 + hstep, voffB);
            PG8_WAIT_V(6); PG8_BAR; PG8_MMA(1, 1, At, B1); PG8_BAR;
            }
        }
        if constexpr (ALIGN_EPI) { if (wr == 0) PG8_BAR; }
        if constexpr (!Epi::AFTER_DRAIN) { E(acc, cur, wr, wc, fr, fq); S.done(cur); }
        if (!has_next) break;
#pragma unroll
        for (int a = 0; a < 2; ++a)
#pragma unroll
            for (int b = 0; b < 2; ++b)
#pragma unroll
                for (int m = 0; m < 4; ++m)
#pragma unroll
                    for (int n = 0; n < 2; ++n) acc[a][b][m][n] = (f32x4){0.f, 0.f, 0.f, 0.f};
        cur = nxt; cA = nA; cB = nB; ++ui;
        if constexpr (ALIGN_EPI) { if (wr == 1) PG8_BAR; }
    }
    PG8_WAIT_V(0);
    if constexpr (!ALIGN_EPI) { if (wr == 0) PG8_BAR; }
    PG8_BAR;
    if constexpr (Epi::AFTER_DRAIN) { E.fused(acc, cur, wr, wc, fr, fq, lds, wid, lane); S.done(cur); }
#undef PG8_SA
#undef PG8_SB
#undef PG8_STAGE
#undef PG8_LDA
#undef PG8_LDB
#undef PG8_MMA
#undef PG8_WAIT_V
#undef PG8_WAIT_L
#undef PG8_BAR
#undef PG8_SCHED
}
}

constexpr int NWAVES = 8, NTHR = 512;
constexpr int N_LAUNCHES = MK_N_LAUNCHES;
constexpr int NPHASE = 12;
constexpr int BATCH = 2, SEQ = 8192, DM = 1024, T = BATCH * SEQ, DEPTH = 2, CH = 64, NCHT = T / CH  , NCHS = SEQ / CH  ;
constexpr int DIN = 4252, NP = 4352, LDZ = 4224;
constexpr int ZC_AQ = 0, ZC_AK = 384, ZC_AV = 768, ZC_AG = 1152, ZC_MQ = 1536, ZC_MK = 1920, ZC_MV = 2304, ZC_MO = 2688, ZC_MG = 3072, ZC_GQ = 3456, ZC_GK = 3584, ZC_GV = 3712, ZC_GG = 3968, ZC_SM = 4224;
constexpr float EPS = 1e-6f;
__host__ __device__ __forceinline__ int src_col(int n) {
    if (n < 3072) return n;
    if (n < 3968) return n + 12;
    if (n < 4224) return n + 28;
    if (n < 4236) return n - 1152;
    if (n < 4252) return n - 256;
    return -1;
}

constexpr size_t MiB = 1u << 20;
constexpr size_t WS_CTL = 0, CTL_ZERO_BYTES = 1 * MiB;
constexpr size_t WS_SSQ = 512 * 1024;
constexpr size_t WS_WIN = 1 * MiB;
constexpr size_t WS_WOUT = WS_WIN + (size_t)2 * NP * DM * 2;
constexpr size_t WS_XB = WS_WOUT + (size_t)2 * DM * DM * 2;
constexpr size_t WS_Y = WS_XB + (size_t)T * DM * 2;
constexpr size_t WS_Z = WS_Y + (size_t)T * DM * 2;
constexpr size_t WS_G32 = WS_Z + (size_t)T * LDZ * 2;
constexpr size_t WS_CST = WS_G32 + (size_t)T * 32 * 4;
constexpr size_t WS_NST = WS_CST + (size_t)NCHT * 6 * 4096 * 4;
constexpr size_t WS_SST = WS_NST + (size_t)NCHT * 6 * 64 * 4;
constexpr size_t WS_ADEC = WS_SST + (size_t)NCHT * 4 * 2048 * 4;
constexpr size_t WS_GS = WS_ADEC + (size_t)NCHT * 4 * 32 * 4;
constexpr size_t WS_MS = WS_GS + 8192;
constexpr size_t WS_MP = WS_MS + 8192;
constexpr size_t WS_END = WS_MP + 8192;
static_assert(WS_END <= 268435456, "d_ws map exceeds 256 MiB");
constexpr int CW_BAR = 4096;

constexpr int RING_OFF = 0, RING_BYTES = 162816;
constexpr int WL_BYTES = 20352;
constexpr int LDSCTL_OFF = RING_BYTES, MISC_OFF = LDSCTL_OFF + 320;
constexpr int LDS_BYTES = 163840;
#define GAS __attribute__((address_space(1)))
#define LAS __attribute__((address_space(3)))
typedef unsigned short bf16;
typedef unsigned v4u __attribute__((ext_vector_type(4)));
typedef float f32x4 __attribute__((ext_vector_type(4)));
typedef short bf16x8 __attribute__((ext_vector_type(8)));
typedef GAS unsigned gu32;
typedef GAS unsigned long long gu64;
#define RLX_AGENT __ATOMIC_RELAXED, __HIP_MEMORY_SCOPE_AGENT
#define LDS_WAIT() asm volatile("s_waitcnt lgkmcnt(0)" ::: "memory")
#define VM_WAIT() asm volatile("s_waitcnt vmcnt(0)" ::: "memory")
__device__ __forceinline__ unsigned long long rt() { return __builtin_amdgcn_s_memrealtime(); }
__device__ __forceinline__ unsigned f2bf(float f) { unsigned u = __builtin_bit_cast(unsigned, f); return (u + 0x7fffu + ((u >> 16) & 1u)) >> 16; }
__device__ __forceinline__ unsigned pk2(float lo, float hi) { return f2bf(lo) | (f2bf(hi) << 16); }

#define XB_TMO      128
#define XB_XCNT(j)  (256  + 64 * (j))
#define XB_XSUB(j)  (1280 + 64 * (j))
#define XB_XGEN(j)  (2304 + 64 * (j))
#define XB_TOP      3328
#define XB_TOPGEN   3392
#define XCD_BAR_WORDS 3456
#define XB_SPIN_CAP (1u << 18)

__device__ __forceinline__ unsigned xb_ld(unsigned* p)              { return __hip_atomic_load(p, __ATOMIC_RELAXED, __HIP_MEMORY_SCOPE_AGENT); }
__device__ __forceinline__ unsigned xb_add(unsigned* p, unsigned v) { return __hip_atomic_fetch_add(p, v, __ATOMIC_RELAXED, __HIP_MEMORY_SCOPE_AGENT); }
__device__ __forceinline__ unsigned xb_xcc_id() { return (unsigned)__builtin_amdgcn_s_getreg((3 << 11) | 20) & 0xFu; }
#define XB_SPIN(cond, bar) do { unsigned _sp = 0; while (cond) { __builtin_amdgcn_s_sleep(1); \
    if ((++_sp & 255u) == 0u) { if (xb_ld(&(bar)[XB_TMO])) break; if (_sp > XB_SPIN_CAP) { atomicAdd(&(bar)[XB_TMO], 1u); break; } } } } while (0)

struct XcdBarrier {
    unsigned* bar; unsigned x;
    volatile LAS unsigned* st;
};

__device__ __forceinline__ XcdBarrier xcd_barrier_post(unsigned* bar, volatile LAS unsigned* st) {
    XcdBarrier b; b.bar = bar; b.x = xb_xcc_id(); b.st = st;
    if (threadIdx.x == 0) (void)xb_add(&bar[XB_XCNT(b.x)], 1u);
    return b;
}
__device__ __forceinline__ void xcd_barrier_complete(unsigned* bar, unsigned x, unsigned& nloc, unsigned& nx) {
    const unsigned G = gridDim.x * gridDim.y * gridDim.z;
    unsigned sum, cnt, mine, sp = 0u;
    for (;;) {
        sum = 0u; cnt = 0u; mine = 0u;
#pragma unroll 1
        for (unsigned j = 0; j < 16; ++j) { const unsigned c = xb_ld(&bar[XB_XCNT(j)]); sum += c; cnt += (c > 0u) ? 1u : 0u; mine = (j == x) ? c : mine; }
        if (sum == G) break;
        __builtin_amdgcn_s_sleep(1);
        if ((++sp & 255u) == 0u) { if (xb_ld(&bar[XB_TMO])) break; if (sp > XB_SPIN_CAP) { atomicAdd(&bar[XB_TMO], 1u); break; } }
    }
    nloc = mine > 0u ? mine : 1u; nx = cnt > 0u ? cnt : 1u;
}

__device__ __forceinline__ void xcd_barrier(const XcdBarrier& b) {
    asm volatile("s_waitcnt vmcnt(0)" ::: "memory");
    __syncthreads();
    if (threadIdx.x == 0) {
        unsigned* bar = b.bar;
        __builtin_amdgcn_s_waitcnt(0);
        unsigned nloc = b.st[0], nx = b.st[1];
        if (nloc == 0u) { xcd_barrier_complete(bar, b.x, nloc, nx); b.st[0] = nloc; b.st[1] = nx; }
        const unsigned old = xb_add(&bar[XB_XSUB(b.x)], 1u);
        const unsigned gen = old / nloc;
        if (old + 1u == (gen + 1u) * nloc) {
            __builtin_amdgcn_fence(__ATOMIC_RELEASE, "agent");
            asm volatile("s_waitcnt vmcnt(0)" ::: "memory");
            const unsigned og = xb_add(&bar[XB_TOP], 1u);
            const unsigned tg = og / nx;
            if (og + 1u == (tg + 1u) * nx) xb_add(&bar[XB_TOPGEN], 1u);
            else XB_SPIN(xb_ld(&bar[XB_TOPGEN]) == tg, bar);
            __builtin_amdgcn_fence(__ATOMIC_ACQUIRE, "agent");
            xb_add(&bar[XB_XGEN(b.x)], 1u);
            asm volatile("s_waitcnt vmcnt(0)" ::: "memory");
        } else {
            XB_SPIN(xb_ld(&bar[XB_XGEN(b.x)]) == gen, bar);
            __builtin_amdgcn_fence(__ATOMIC_ACQUIRE, "agent");
            asm volatile("s_waitcnt vmcnt(0)" ::: "memory");
        }
    }
    __syncthreads();
}


struct Args { const float* in[12]; float* out; unsigned char* ws; int ph_lo, ph_hi, li, pad; };
struct Frame {
    LAS unsigned char* lds;
    volatile LAS unsigned* MISC;
    const Args* A;
    int wave, vcu, G;
};
__device__ __forceinline__ int opaque_tid() { int t = threadIdx.x; asm volatile("" : "+v"(t)); return t; }
#define F_tid (opaque_tid())
#define F_lane (opaque_tid() & 63)
__device__ __forceinline__ const Args* opaque_args(const Args* a) { unsigned long long v = (unsigned long long)a; asm volatile("" : "+s"(v)); return (const Args*)v; }
#define F_A (F.A)
#define F_x          (F_A->in[0])
#define F_norm_g     (F_A->in[1])
#define F_w_in       (F_A->in[2])
#define F_b_gates    (F_A->in[3])
#define F_conv_w     (F_A->in[4])
#define F_w_alpha    (F_A->in[5])
#define F_b_alpha    (F_A->in[6])
#define F_rel_bias   (F_A->in[7])
#define F_ml_norm_g  (F_A->in[8])
#define F_gla_norm_g (F_A->in[9])
#define F_w_out      (F_A->in[10])
#define F_final_g    (F_A->in[11])
#define F_out        (F_A->out)
#define F_ws         (F_A->ws)
#define F_ctl        ((gu32*)(F_ws + WS_CTL))
#define F_Win_t      ((bf16*)(F_ws + WS_WIN))
#define F_Wout_t     ((bf16*)(F_ws + WS_WOUT))
#define F_XB         ((bf16*)(F_ws + WS_XB))
#define F_Y          ((bf16*)(F_ws + WS_Y))
#define F_Z          ((bf16*)(F_ws + WS_Z))
#define F_G32        ((float*)(F_ws + WS_G32))
#define F_SSQ        ((float*)(F_ws + WS_SSQ))
#define F_CST        ((float*)(F_ws + WS_CST))
#define F_NST        ((float*)(F_ws + WS_NST))
#define F_SST        ((float*)(F_ws + WS_SST))
#define F_ADEC       ((float*)(F_ws + WS_ADEC))
#define F_GS         ((float*)(F_ws + WS_GS))
#define F_MS         ((float*)(F_ws + WS_MS))
#define F_MP         ((float*)(F_ws + WS_MP))
#define F_BC         (F_out)
#define F_CPB        ((bf16*)(F_out + (size_t)T * 128))
__device__ __forceinline__ float bf2f(unsigned short u) { return __uint_as_float((unsigned)u << 16); }
__device__ __forceinline__ float wave_sum(float v) {
#pragma unroll
    for (int o = 1; o < 64; o <<= 1) v += __shfl_xor(v, o);
    return v;
}
__device__ __forceinline__ float siluf(float x) { return x / (1.0f + expf(-x)); }
__device__ __forceinline__ float sigmf(float x) { return 1.0f / (1.0f + expf(-x)); }
__device__ __forceinline__ float logsigf(float x) { return fminf(x, 0.f) - log1pf(expf(-fabsf(x))); }
__device__ __forceinline__ void ld8(const bf16* p, float* o) {
    const v4u w = *(const v4u*)p;
    o[0] = __uint_as_float(w.x << 16); o[1] = __uint_as_float(w.x & 0xffff0000u); o[2] = __uint_as_float(w.y << 16); o[3] = __uint_as_float(w.y & 0xffff0000u);
    o[4] = __uint_as_float(w.z << 16); o[5] = __uint_as_float(w.z & 0xffff0000u); o[6] = __uint_as_float(w.w << 16); o[7] = __uint_as_float(w.w & 0xffff0000u);
}

template <bool PERMUTE>
__device__ __forceinline__ void p0_transpose_item(const float* W, int Nsrc, int Ndst, const float* gk, bf16* WT, LAS float* scr, int item, int lane) {
    const int nblk = Ndst / 32, kb = item / nblk, nb = item % nblk, k0 = 64 * kb, n0 = 32 * nb;
    const int nd = n0 + (lane & 31), ns = PERMUTE ? src_col(nd) : nd;
    float tv_[32], tg_[32];
#pragma unroll
    for (int i = 0; i < 32; ++i) { const int kk = 2 * i + (lane >> 5);
        tv_[i] = (ns >= 0) ? W[(size_t)(k0 + kk) * Nsrc + ns] : 0.f; tg_[i] = gk ? gk[k0 + kk] : 1.f; }
#pragma unroll
    for (int i = 0; i < 32; ++i) { const int kk = 2 * i + (lane >> 5); scr[kk * 33 + (lane & 31)] = tv_[i] * tg_[i]; }
    LDS_WAIT(); asm volatile("" ::: "memory");
    const int c = lane & 7;
#pragma unroll
    for (int j = 0; j < 4; ++j) { const int n = (lane >> 3) + 8 * j; const LAS float* s = scr + (8 * c) * 33 + n;
        v4u o; o.x = pk2(s[0 * 33], s[1 * 33]); o.y = pk2(s[2 * 33], s[3 * 33]); o.z = pk2(s[4 * 33], s[5 * 33]); o.w = pk2(s[6 * 33], s[7 * 33]);
        *(GAS v4u*)(WT + (size_t)(n0 + n) * 1024 + k0 + 8 * c) = o; }
    LDS_WAIT(); asm volatile("" ::: "memory");
}
__device__ __forceinline__ void p0_weights(Frame& F, int l, int wi, int nw) {
    LAS float* scr = (LAS float*)(F.lds + RING_OFF + F.wave * 16384);
    constexpr int I_IN = 16 * (NP / 32), I_OUT = 16 * (DM / 32);
    for (int it = wi; it < I_IN + I_OUT; it += nw) {
        if (it < I_IN) p0_transpose_item<true>(F_w_in + (size_t)l * DM * DIN, DIN, NP, F_norm_g + l * DM, F_Win_t + (size_t)l * NP * DM, scr, it, F_lane);
        else p0_transpose_item<false>(F_w_out + (size_t)l * DM * DM, DM, DM, nullptr, F_Wout_t + (size_t)l * DM * DM, scr, it - I_IN, F_lane);
    }
}
__device__ __forceinline__ void p0_prologue(Frame& F) {
    int gw_ = F.vcu * NWAVES + F.wave; asm volatile("" : "+s"(gw_));
    const int gw = gw_, NGW = F.G * NWAVES;
    p0_weights(F, 0, gw, NGW);
    if (F.G != 256) p0_weights(F, 1, gw, NGW);
    for (int m = gw; m < T; m += NGW) {
        const GAS f32x4* xr = (const GAS f32x4*)(F_x + (size_t)m * DM) + F_lane;
        GAS unsigned long long* o8 = (GAS unsigned long long*)(F_XB + (size_t)m * DM) + F_lane;
        float s = 0.f;
#pragma unroll
        for (int j = 0; j < 4; ++j) { const f32x4 v = xr[64 * j]; s += (v.x * v.x + v.y * v.y) + (v.z * v.z + v.w * v.w);
            o8[64 * j] = (unsigned long long)pk2(v.x, v.y) | ((unsigned long long)pk2(v.z, v.w) << 32); }
        s = wave_sum(s);
        if (F_lane == 0) F_SSQ[m] = s;
    }
}

constexpr int LP = 65;
__device__ __forceinline__ void stage_conv(Frame& F, int layer, int b, int n, int zcol, int wch, float scale, LAS float* dst) {
    const float* cw = F_conv_w + (size_t)layer * 4 * 768;
    const int r0 = b * SEQ + n * CH;
    for (int idx = F_tid; idx < 4096; idx += NTHR) {
        const int t = idx >> 6, c = idx & 63;
        float a = 0.f;
#pragma unroll
        for (int j = 0; j < 4; ++j) { const int tt = t + j - 3;
            if (n * CH + tt >= 0) a += bf2f(F_Z[(size_t)(r0 + tt) * LDZ + zcol + c]) * cw[j * 768 + wch + c]; }
        dst[t * LP + c] = siluf(a) * scale;
    }
}
__device__ __forceinline__ void stage_tile(Frame& F, int b, int n, int zcol, int W, float scale, LAS float* dst, int pitch) {
    const int r0 = b * SEQ + n * CH;
    for (int idx = F_tid; idx < 64 * W; idx += NTHR) { const int t = idx / W, c = idx % W; dst[t * pitch + c] = bf2f(F_Z[(size_t)(r0 + t) * LDZ + zcol + c]) * scale; }
}
__device__ __forceinline__ void stage_mgates(Frame& F, int layer, int b, int n, int h, LAS float* ig, LAS float* bc, LAS float* lf) {
    const int r0 = b * SEQ + n * CH;
    if (F_tid < 64) { const float* g = F_G32 + (size_t)(r0 + F_tid) * 32;
        ig[F_tid] = g[h] + F_b_gates[layer * 12 + h]; lf[F_tid] = logsigf(g[6 + h] + F_b_gates[layer * 12 + 6 + h]); }
    __syncthreads();
    if (F_tid < 64) { float s = 0.f; for (int j = 0; j <= F_tid; ++j) s += lf[j]; bc[F_tid] = s; }
}
__device__ __forceinline__ void stage_gla_decay(Frame& F, int layer, int b, int n, int hh, LAS float* bcum) {
    const int r0 = b * SEQ + n * CH;
    const float* wa = F_w_alpha + (size_t)layer * 16 * 128; const float* ba = F_b_alpha + layer * 128;
    for (int idx = F_tid; idx < 2048; idx += NTHR) { const int t = idx >> 5, d = idx & 31;
        const float* g = F_G32 + (size_t)(r0 + t) * 32 + 12; float a = ba[hh * 32 + d];
#pragma unroll
        for (int r = 0; r < 16; ++r) a += g[r] * wa[r * 128 + hh * 32 + d];
        bcum[t * 33 + d] = logsigf(a) * (1.0f / 16.0f); }
    __syncthreads();
    if (F_tid < 32) { float s = 0.f; for (int t = 0; t < 64; ++t) { s += bcum[t * 33 + F_tid]; bcum[t * 33 + F_tid] = s; } }
    __syncthreads();
}

#define DPPF(old, x, ctrl, rmask) __uint_as_float(__builtin_amdgcn_update_dpp(__float_as_uint(old), __float_as_uint(x), (ctrl), (rmask), 0xf, false))
__device__ __forceinline__ void p3_scan(Frame& F) {
    LAS float* L = (LAS float*)(F.lds + RING_OFF);
    LAS float* so = L; LAS float* sn = L + 128; LAS float* ex = L + 512;
    const int tid = F_tid, w = tid >> 6, l = tid & 63;
    constexpr int UPB = 33, NU_M = 12 * UPB, NU = NU_M + 8 * 16;
    const int u0 = (int)(((long)F.vcu * NU) / F.G), u1 = (int)(((long)(F.vcu + 1) * NU) / F.G);
    int cur_bh = -1, par = 0;
    for (int u = u0; u < u1; ++u, par ^= 1) {
        LAS float* exu = ex + par * 2048;
        float c0[16], c1[16], dcy0[16], dcy1[16];
        int kind;
        size_t base;
        if (u < NU_M) {
            const int bh = u / UPB, eu = u % UPB, b = bh / 6, h = bh % 6;
            if (bh != cur_bh) {
                __syncthreads();
                if (w == 0) {
                    const int ci0 = (b * NCHS + 2 * l) * 6 + h, ci1 = ci0 + 6;
                    const float a0 = F_GS[ci0], b0 = F_MS[ci0], a1 = F_GS[ci1], b1 = F_MS[ci1];
                    float A = a0 + a1, B = fmaxf(b1, a1 + b0);
#define MP_STEP(ctrl, rmask) do { const float as_ = DPPF(0.f, A, ctrl, rmask), bs_ = DPPF(-3.0e38f, B, ctrl, rmask); B = fmaxf(B, A + bs_); A = A + as_; } while (0)
                    MP_STEP(0x111, 0xf); MP_STEP(0x112, 0xf); MP_STEP(0x114, 0xf); MP_STEP(0x118, 0xf); MP_STEP(0x142, 0xa); MP_STEP(0x143, 0xc);
#undef MP_STEP
                    float EA = __shfl_up(A, 1), EB = __shfl_up(B, 1); if (l == 0) { EA = 0.f; EB = -3.0e38f; }
                    const float mp0 = fmaxf(EB, EA), m0 = fmaxf(b0, a0 + mp0), m1 = fmaxf(b1, a1 + m0);
                    so[2 * l] = expf(a0 + mp0 - m0); sn[2 * l] = expf(b0 - m0); so[2 * l + 1] = expf(a1 + m0 - m1); sn[2 * l + 1] = expf(b1 - m1);
                    if (eu == 0) { F_MP[ci0] = mp0; F_MP[ci1] = m0; }
                }
                __syncthreads();
                cur_bh = bh;
            }
            if (eu < 32) { kind = 0; base = ((size_t)(b * NCHS + 16 * w) * 6 + h) * 4096 + eu * 128 + 2 * l;
                const bf16* p16 = (const bf16*)F_CST + base;
#pragma unroll
                for (int i = 0; i < 16; ++i) { const unsigned x = *(const unsigned*)(p16 + (size_t)i * 6 * 4096); const float s_ = sn[16 * w + i];
                    c0[i] = __uint_as_float(x << 16) * s_; c1[i] = __uint_as_float(x & 0xffff0000u) * s_; dcy0[i] = so[16 * w + i]; dcy1[i] = dcy0[i]; } }
            else { kind = 1; base = ((size_t)(b * NCHS + 16 * w) * 6 + h) * 64 + l;
                const float* p = F_NST + base;
#pragma unroll
                for (int i = 0; i < 16; ++i) { c0[i] = p[(size_t)i * 6 * 64] * sn[16 * w + i]; c1[i] = 0.f; dcy0[i] = so[16 * w + i]; dcy1[i] = dcy0[i]; } }
        } else {
            const int v = u - NU_M, bh = v >> 4, eu = v & 15, b = bh >> 2, hh = bh & 3;
            kind = 2; base = ((size_t)(b * NCHS + 16 * w) * 4 + hh) * 2048 + eu * 128 + 2 * l;
            const float* p = F_SST + base;
            const float* ad = F_ADEC + ((size_t)(b * NCHS + 16 * w) * 4 + hh) * 32 + ((2 * l) & 31);
#pragma unroll
            for (int i = 0; i < 16; ++i) { const unsigned long long x = *(const unsigned long long*)(p + (size_t)i * 4 * 2048); const unsigned long long y = *(const unsigned long long*)(ad + (size_t)i * 4 * 32);
                c0[i] = __uint_as_float((unsigned)x); c1[i] = __uint_as_float((unsigned)(x >> 32)); dcy0[i] = __uint_as_float((unsigned)y); dcy1[i] = __uint_as_float((unsigned)(y >> 32)); }
        }
        float s0 = 0.f, s1 = 0.f, P0 = 1.f, P1 = 1.f;
#pragma unroll
        for (int i = 0; i < 16; ++i) { const float a = c0[i], bb = c1[i]; c0[i] = s0; c1[i] = s1; s0 = dcy0[i] * s0 + a; s1 = dcy1[i] * s1 + bb; P0 *= dcy0[i]; P1 *= dcy1[i]; }
        exu[(w * 64 + l) * 4] = P0; exu[(w * 64 + l) * 4 + 1] = P1; exu[(w * 64 + l) * 4 + 2] = s0; exu[(w * 64 + l) * 4 + 3] = s1;
        __syncthreads();
        float i0 = 0.f, i1 = 0.f;
        for (int w2 = 0; w2 < w; ++w2) { const f32x4 e = *(LAS const f32x4*)(exu + (w2 * 64 + l) * 4); i0 = e[0] * i0 + e[2]; i1 = e[1] * i1 + e[3]; }
        float q0 = i0, q1 = i1;
        if (kind == 0) {
            bf16* pb = F_CPB + base;
#pragma unroll
            for (int i = 0; i < 16; ++i) { *(unsigned*)(pb + (size_t)i * 6 * 4096) = f2bf(c0[i] + q0) | (f2bf(c1[i] + q1) << 16); q0 *= dcy0[i]; q1 *= dcy1[i]; }
        } else if (kind == 1) { float* p = F_NST + base;
#pragma unroll
            for (int i = 0; i < 16; ++i) { p[(size_t)i * 6 * 64] = c0[i] + q0; q0 *= dcy0[i]; }
        } else { float* p = F_SST + base;
#pragma unroll
            for (int i = 0; i < 16; ++i) { *(unsigned long long*)(p + (size_t)i * 4 * 2048) = (unsigned long long)__float_as_uint(c0[i] + q0) | ((unsigned long long)__float_as_uint(c1[i] + q1) << 32); q0 *= dcy0[i]; q1 *= dcy1[i]; }
        }
    }
    __syncthreads();
}

#define P4_STORE8(o, kg, yrow, GATE_EXPR) do { _Pragma("unroll") for (int c8 = 0; c8 < 8; ++c8) if ((kg) == c8) { float yv[8]; \
    _Pragma("unroll") for (int i = 0; i < 8; ++i) { const int v = c8 * 8 + i; yv[i] = (o)[v] * (GATE_EXPR); } \
    v4u w; w.x = pk2(yv[0], yv[1]); w.y = pk2(yv[2], yv[3]); w.z = pk2(yv[4], yv[5]); w.w = pk2(yv[6], yv[7]); *(GAS v4u*)((yrow) + c8 * 8) = w; } } while (0)

__device__ __forceinline__ void p4_attn(Frame& F, int layer, int b, int n, int h) {
    const int t = F_tid >> 3, kg = F_tid & 7;
    const int r0 = b * SEQ + n * CH, row = r0 + t;
    LAS float* qL = (LAS float*)(F.lds + RING_OFF);
    stage_tile(F, b, n, ZC_AQ + h * 64, 64, 1.f, qL, LP);
    __syncthreads();
    float o[64];
#pragma unroll
    for (int c = 0; c < 64; ++c) o[c] = 0.f;
    float m = -1e30f, l = 0.f;
    const float* rb = F_rel_bias + (size_t)(layer * 6 + h) * 257;
    for (int i = 0; i < 72; ++i) {
        const int jb = kg + 8 * i, kpos = n * CH - 512 + jb;
        if (kpos < 0) continue;
        const bf16* kr = F_Z + (size_t)(b * SEQ + kpos) * LDZ + ZC_AK + h * 64;
        float s = 0.f;
#pragma unroll
        for (int c = 0; c < 8; ++c) { float kf[8]; ld8(kr + c * 8, kf);
#pragma unroll
            for (int e = 0; e < 8; ++e) s += qL[t * LP + c * 8 + e] * kf[e]; }
        int rel = t + 512 - jb; rel = rel < -128 ? -128 : (rel > 128 ? 128 : rel);
        s = s * 0.125f + rb[rel + 128];
        const float mn = fmaxf(m, s), a = expf(m - mn), p = expf(s - mn);
        l = l * a + p; m = mn;
        const bf16* vr = F_Z + (size_t)(b * SEQ + kpos) * LDZ + ZC_AV + h * 64;
#pragma unroll
        for (int c = 0; c < 8; ++c) { float vf[8]; ld8(vr + c * 8, vf);
#pragma unroll
            for (int e = 0; e < 8; ++e) o[c * 8 + e] = o[c * 8 + e] * a + p * vf[e]; }
    }
#pragma unroll
    for (int off = 1; off < 8; off <<= 1) {
        const float m2 = __shfl_xor(m, off), l2 = __shfl_xor(l, off);
        const float mn = fmaxf(m, m2), a = expf(m - mn), bb = expf(m2 - mn);
        l = l * a + l2 * bb; m = mn;
#pragma unroll
        for (int c = 0; c < 64; ++c) { const float o2 = __shfl_xor(o[c], off); o[c] = o[c] * a + o2 * bb; }
    }
    const float inv = 1.0f / l;
    const bf16* gr = F_Z + (size_t)row * LDZ + ZC_AG + h * 64;
    bf16* yrow = F_Y + (size_t)row * DM + h * 64;
    P4_STORE8(o, kg, yrow, inv * siluf(bf2f(gr[v])));
}

__device__ __forceinline__ void p4_mlstm(Frame& F, int layer, int b, int n, int h) {
    LAS float* L = (LAS float*)(F.lds + RING_OFF);
    LAS float* qc = L; LAS float* kc = qc + 64 * LP; LAS float* vv = kc + 64 * LP; LAS float* Cp = vv + 64 * LP;
    LAS float* np = Cp + 64 * LP; LAS float* ig = np + 64; LAS float* bc = ig + 64; LAS float* lf = bc + 64;
    const int cn = b * NCHS + n, r0 = b * SEQ + n * CH;
    stage_conv(F, layer, b, n, ZC_MQ + h * 64, h * 64, 1.f, qc);
    stage_conv(F, layer, b, n, ZC_MK + h * 64, 384 + h * 64, 0.125f, kc);
    stage_tile(F, b, n, ZC_MV + h * 64, 64, 1.f, vv, LP);
    { const float* cs = F_CST + ((size_t)cn * 6 + h) * 4096; for (int idx = F_tid; idx < 4096; idx += NTHR) Cp[(idx >> 6) * LP + (idx & 63)] = cs[idx]; }
    if (F_tid < 64) np[F_tid] = F_NST[((size_t)cn * 6 + h) * 64 + F_tid];
    stage_mgates(F, layer, b, n, h, ig, bc, lf);
    __syncthreads();
    const float mprev = F_MP[cn * 6 + h];
    const int t = F_tid >> 3, jg = F_tid & 7, row = r0 + t;
    const float bt = bc[t], il = bt + mprev;
    float mx = il;
    for (int i = 0; i < 8; ++i) { const int j = jg + 8 * i; if (j <= t) mx = fmaxf(mx, bt - bc[j] + ig[j]); }
    mx = fmaxf(mx, __shfl_xor(mx, 1)); mx = fmaxf(mx, __shfl_xor(mx, 2)); mx = fmaxf(mx, __shfl_xor(mx, 4));
    float num[64]; float den = 0.f;
#pragma unroll
    for (int c = 0; c < 64; ++c) num[c] = 0.f;
    for (int i = 0; i < 8; ++i) { const int j = jg + 8 * i;
        if (j <= t) { float dot = 0.f;
#pragma unroll 8
            for (int k = 0; k < 64; ++k) dot += qc[t * LP + k] * kc[j * LP + k];
            const float sc = dot * expf(bt - bc[j] + ig[j] - mx); den += sc;
#pragma unroll
            for (int c = 0; c < 64; ++c) num[c] += sc * vv[j * LP + c]; } }
    const float iw = expf(il - mx);
#pragma unroll 2
    for (int kk = 0; kk < 8; ++kk) { const int k = jg * 8 + kk; const float qk = qc[t * LP + k] * iw; den += qk * np[k];
#pragma unroll
        for (int c = 0; c < 64; ++c) num[c] += qk * Cp[c * LP + k]; }
#pragma unroll
    for (int off = 1; off < 8; off <<= 1) { den += __shfl_xor(den, off);
#pragma unroll
        for (int c = 0; c < 64; ++c) num[c] += __shfl_xor(num[c], off); }
    den = fmaxf(fabsf(den), expf(-mx));
    const float rden = 1.0f / den; float ss = 0.f;
#pragma unroll
    for (int c = 0; c < 64; ++c) { num[c] *= rden; ss += num[c] * num[c]; }
    const float rn = 1.0f / sqrtf(ss * (1.0f / 64.0f) + EPS);
    const bf16* mo = F_Z + (size_t)row * LDZ + ZC_MO + h * 64; const bf16* mg = F_Z + (size_t)row * LDZ + ZC_MG + h * 64;
    const float* gn = F_ml_norm_g + layer * 384 + h * 64;
    bf16* yrow = F_Y + (size_t)row * DM + 384 + h * 64;
    P4_STORE8(num, jg, yrow, rn * gn[v] * sigmf(bf2f(mo[v])) * siluf(bf2f(mg[v])));
}

__device__ __forceinline__ void p4_gla(Frame& F, int layer, int b, int n, int hh) {
    LAS float* L = (LAS float*)(F.lds + RING_OFF);
    LAS float* qx = L; LAS float* kk = qx + 64 * 33; LAS float* vv = kk + 64 * 33; LAS float* bcum = vv + 64 * LP; LAS float* Sp = bcum + 64 * 33;
    const int cn = b * NCHS + n, r0 = b * SEQ + n * CH;
    stage_tile(F, b, n, ZC_GQ + hh * 32, 32, 0.17677669529663687f, qx, 33);
    stage_tile(F, b, n, ZC_GK + hh * 32, 32, 1.f, kk, 33);
    stage_tile(F, b, n, ZC_GV + hh * 64, 64, 1.f, vv, LP);
    { const float* ss = F_SST + ((size_t)cn * 4 + hh) * 2048; for (int idx = F_tid; idx < 2048; idx += NTHR) Sp[(idx >> 6) * LP + (idx & 63)] = ss[idx]; }
    stage_gla_decay(F, layer, b, n, hh, bcum);
    const int t = F_tid >> 3, jg = F_tid & 7, row = r0 + t;
    float num[64];
#pragma unroll
    for (int c = 0; c < 64; ++c) num[c] = 0.f;
    for (int i = 0; i < 8; ++i) { const int j = jg + 8 * i;
        if (j <= t) { float att = 0.f;
#pragma unroll 4
            for (int d = 0; d < 32; ++d) att += qx[t * 33 + d] * kk[j * 33 + d] * expf(bcum[t * 33 + d] - bcum[j * 33 + d]);
#pragma unroll
            for (int c = 0; c < 64; ++c) num[c] += att * vv[j * LP + c]; } }
#pragma unroll 2
    for (int dd = 0; dd < 4; ++dd) { const int d = jg * 4 + dd; const float w = qx[t * 33 + d] * expf(bcum[t * 33 + d]);
#pragma unroll
        for (int c = 0; c < 64; ++c) num[c] += w * Sp[d * LP + c]; }
    float ss = 0.f;
#pragma unroll
    for (int off = 1; off < 8; off <<= 1) {
#pragma unroll
        for (int c = 0; c < 64; ++c) num[c] += __shfl_xor(num[c], off); }
#pragma unroll
    for (int c = 0; c < 64; ++c) ss += num[c] * num[c];
    const float rn = 1.0f / sqrtf(ss * (1.0f / 64.0f) + EPS);
    const bf16* gg = F_Z + (size_t)row * LDZ + ZC_GG + hh * 64;
    const float* gn = F_gla_norm_g + layer * 256 + hh * 64;
    bf16* yrow = F_Y + (size_t)row * DM + 768 + hh * 64;
    P4_STORE8(num, jg, yrow, rn * gn[v] * siluf(bf2f(gg[v])));
}

constexpr int ZRS = 64;
__host__ __device__ constexpr size_t zc(int col) { return (size_t)(col >> 6) * ((size_t)T * 64) + (size_t)(col & 63); }
typedef float f32x16 __attribute__((ext_vector_type(16)));
typedef short s16x4 __attribute__((ext_vector_type(4)));
typedef short v4i16_t __attribute__((ext_vector_type(4)));
typedef float f32x2_t __attribute__((ext_vector_type(2))); typedef __bf16 bf16x2_t __attribute__((ext_vector_type(2)));
__device__ __forceinline__ unsigned cvtpk(float lo, float hi) { f32x2_t v = {lo, hi}; bf16x2_t b = __builtin_convertvector(v, bf16x2_t); return __builtin_bit_cast(unsigned, b); }
__device__ __forceinline__ s16x4 lds_tr(LAS const unsigned char* p) { return __builtin_bit_cast(s16x4, __builtin_amdgcn_ds_read_tr16_b64_v4i16((LAS v4i16_t*)p)); }
__device__ __forceinline__ bf16x8 pack8(float a0, float a1, float a2, float a3, float a4, float a5, float a6, float a7) {
    v4u w; w.x = cvtpk(a0, a1); w.y = cvtpk(a2, a3); w.z = cvtpk(a4, a5); w.w = cvtpk(a6, a7); return __builtin_bit_cast(bf16x8, w); }
#define MFMA32(a, b, c) __builtin_amdgcn_mfma_f32_32x32x16_bf16((a), (b), (c), 0, 0, 0)
constexpr float LOG2E = 1.4426950408889634f;
__device__ __forceinline__ float fexp(float x) { return __builtin_amdgcn_exp2f(x * LOG2E); }
__device__ __forceinline__ float fsigm(float x) { return __builtin_amdgcn_rcpf(1.0f + fexp(-x)); }
__device__ __forceinline__ float fsilu(float x) { return x * fsigm(x); }
__device__ __forceinline__ int tile_off(int row, int bytecol) { return row * 128 + ((((bytecol >> 4) ^ (((row >> 1) & 1) << 2)) << 4) | (bytecol & 15)); }
__device__ __forceinline__ void dma_tile(const bf16* g, LAS unsigned char* tile, int lane) {
    const int rr = lane >> 3, cpos = lane & 7;
#pragma unroll
    for (int it = 0; it < 8; ++it) { const int row = 8 * it + rr, ch = cpos ^ (((row >> 1) & 1) << 2);
        __builtin_amdgcn_global_load_lds((const unsigned*)(g + (size_t)row * ZRS + ch * 8), (LAS unsigned*)(tile + it * 1024), 16, 0, 0); }
}
__device__ __forceinline__ bf16x8 tr_frag(LAS const unsigned char* tile, int lane, int c0, int ks) {
    const int g = lane >> 4, i = lane & 15, hf = g >> 1;
    const int row = 16 * ks + 4 * hf + (i >> 2), bc = (c0 + 16 * (g & 1) + 4 * (i & 3)) * 2;
    const s16x4 lo = lds_tr(tile + tile_off(row, bc)), hi = lds_tr(tile + tile_off(row + 8, bc));
    return (bf16x8){lo[0], lo[1], lo[2], lo[3], hi[0], hi[1], hi[2], hi[3]};
}

typedef const GAS char* gcp;
__device__ __forceinline__ gcp uptr(const void* p) { const unsigned long long v = (unsigned long long)p;
    const unsigned lo = __builtin_amdgcn_readfirstlane((unsigned)v), hi = __builtin_amdgcn_readfirstlane((unsigned)(v >> 32)); return (gcp)(((unsigned long long)hi << 32) | lo); }
__device__ __forceinline__ bf16x8 ldfrag(gcp ub, unsigned voff) { return *(const GAS bf16x8*)(ub + voff); }
__device__ __forceinline__ unsigned dma_voff(int lane) { const int rr = lane >> 3; return (unsigned)(rr * ZRS + (((lane & 7) ^ (((rr >> 1) & 1) << 2)) * 8)) * 2u; }
__device__ __forceinline__ void dma_tile_u(gcp ub, unsigned voff, LAS unsigned char* tile) {
#pragma unroll
    for (int it = 0; it < 8; ++it) __builtin_amdgcn_global_load_lds((const GAS unsigned*)(ub + (size_t)it * 8 * ZRS * 2 + voff), (LAS unsigned*)(tile + it * 1024), 16, 0, 0);
}
__device__ __forceinline__ void dma_tile_asm(gcp ub, unsigned voff, LAS unsigned char* tile) {
    const unsigned l0 = __builtin_amdgcn_readfirstlane((unsigned)(unsigned long long)tile);
    gcp ub2 = ub + 4096; unsigned keep;
#define DMA1_(SB, OFF, LD) asm volatile("s_mov_b32 %0, m0\n\ts_mov_b32 m0, %3\n\ts_nop 3\n\tglobal_load_lds_dwordx4 %1, %2 offset:" #OFF "\n\ts_mov_b32 m0, %0" : "=&s"(keep) : "v"(voff), "s"(SB), "s"(LD) : "memory")
    const unsigned l1 = l0 + 4096u;
    DMA1_(ub, 0, l0); DMA1_(ub, 1024, l0); DMA1_(ub, 2048, l0); DMA1_(ub, 3072, l0);
    DMA1_(ub2, 0, l1); DMA1_(ub2, 1024, l1); DMA1_(ub2, 2048, l1); DMA1_(ub2, 3072, l1);
#undef DMA1_
}
__device__ __forceinline__ void tr_bases(int lane, unsigned& b0, unsigned& b1) {
    const int g = lane >> 4, i = lane & 15, hf = g >> 1, row = 4 * hf + (i >> 2), bc = (16 * (g & 1) + 4 * (i & 3)) * 2;
    b0 = (unsigned)tile_off(row, bc); b1 = (unsigned)tile_off(row, bc + 64);
}
__device__ __forceinline__ bf16x8 tr_frag_b(LAS const unsigned char* tile, unsigned base, int ks) {
    const s16x4 lo = lds_tr(tile + base + ks * 2048), hi = lds_tr(tile + base + ks * 2048 + 1024);
    return (bf16x8){lo[0], lo[1], lo[2], lo[3], hi[0], hi[1], hi[2], hi[3]};
}

__device__ __forceinline__ void unpack8(v4u w, float* o) {
    o[0] = __uint_as_float(w.x << 16); o[1] = __uint_as_float(w.x & 0xffff0000u); o[2] = __uint_as_float(w.y << 16); o[3] = __uint_as_float(w.y & 0xffff0000u);
    o[4] = __uint_as_float(w.z << 16); o[5] = __uint_as_float(w.z & 0xffff0000u); o[6] = __uint_as_float(w.w << 16); o[7] = __uint_as_float(w.w & 0xffff0000u);
}
__device__ __forceinline__ float max3f(float a, float b, float c) { float r; asm("v_max3_f32 %0, %1, %2, %3" : "=v"(r) : "v"(a), "v"(b), "v"(c)); return r; }
__device__ __forceinline__ float xh_max(float x) { const auto rr = __builtin_amdgcn_permlane32_swap(__float_as_uint(x), __float_as_uint(x), false, false); return max3f(__uint_as_float(rr[0]), __uint_as_float(rr[1]), __uint_as_float(rr[1])); }
__device__ __forceinline__ float xh_sum(float x) { const auto rr = __builtin_amdgcn_permlane32_swap(__float_as_uint(x), __float_as_uint(x), false, false); return __uint_as_float(rr[0]) + __uint_as_float(rr[1]); }
constexpr int TLP = 68;
__device__ __forceinline__ void tl_put4(LAS unsigned char* wl, int t, int v, float a, float b, float c, float e) { *(LAS f32x4*)(wl + ((t * TLP + v) << 2)) = (f32x4){a, b, c, e}; }
template <int GATE>
__device__ __forceinline__ void tl_emit(LAS const unsigned char* wl, int lane, gcp g0, gcp g1, const float* gn, GAS char* yb) {
    const int rr = lane >> 3, c = lane & 7;
    float gnv[8];
    if (GATE != 0) { const f32x4 a = *(const f32x4*)(gn + 8 * c), b = *(const f32x4*)(gn + 8 * c + 4); gnv[0] = a[0]; gnv[1] = a[1]; gnv[2] = a[2]; gnv[3] = a[3]; gnv[4] = b[0]; gnv[5] = b[1]; gnv[6] = b[2]; gnv[7] = b[3]; }
    const unsigned voff = (unsigned)(rr * ZRS + 8 * c) * 2u, yoff = (unsigned)(rr * DM + 8 * c) * 2u;
    v4u ga[8], gb[8];
#pragma unroll
    for (int it = 0; it < 8; ++it) { ga[it] = *(const GAS v4u*)(g0 + (size_t)it * 8 * ZRS * 2 + voff); if (GATE == 1) gb[it] = *(const GAS v4u*)(g1 + (size_t)it * 8 * ZRS * 2 + voff); }
#pragma unroll
    for (int it = 0; it < 8; ++it) {
        const int row = 8 * it + rr;
        const f32x4 x0 = *(LAS const f32x4*)(wl + ((row * TLP + 8 * c) << 2)), x1 = *(LAS const f32x4*)(wl + ((row * TLP + 8 * c + 4) << 2));
        float x[8] = {x0[0], x0[1], x0[2], x0[3], x1[0], x1[1], x1[2], x1[3]}, p[8], q[8];
        unpack8(ga[it], p); if (GATE == 1) unpack8(gb[it], q);
#pragma unroll
        for (int e = 0; e < 8; ++e) {
            if (GATE == 0) x[e] *= fsilu(p[e]);
            else if (GATE == 1) x[e] *= gnv[e] * fsigm(p[e]) * fsilu(q[e]);
            else x[e] *= gnv[e] * fsilu(p[e]);
        }
        *(GAS v4u*)(yb + (size_t)it * 8 * DM * 2 + yoff) = __builtin_bit_cast(v4u, pack8(x[0], x[1], x[2], x[3], x[4], x[5], x[6], x[7]));
    }
}

__device__ __forceinline__ void attn_wave(Frame& F, int layer, int cn, int h, LAS unsigned char* wl) {
    const int lane = F_lane, r = lane & 31, hf = lane >> 5;
    const int b = cn / NCHS, n = cn % NCHS;
    const size_t row0 = (size_t)b * SEQ + (size_t)n * CH;
    const bf16* Z = F_Z;
    LAS float* rbl = (LAS float*)(wl + 16384);
    const float* rb = F_rel_bias + (size_t)(layer * 6 + h) * 257;
    float tb_[4];
#pragma unroll
    for (int k = 0; k < 4; ++k) { const int j = lane + 64 * k; tb_[k] = rb[j + 65 < 256 ? j + 65 : 256]; }
    const float bfar = rb[256] * LOG2E;
    constexpr float C1 = 0.125f * LOG2E;
    const unsigned voffK = (unsigned)(r * ZRS + 8 * hf) * 2u, voffV = dma_voff(lane);
    unsigned trb0, trb1; tr_bases(lane, trb0, trb1);
    bf16x8 qf[2][4];
    { gcp qb_ = uptr(Z + zc(ZC_AQ + h * 64) + row0 * ZRS);
#pragma unroll
    for (int qb = 0; qb < 2; ++qb)
#pragma unroll
        for (int s = 0; s < 4; ++s) qf[qb][s] = ldfrag(qb_ + ((size_t)32 * qb * ZRS + 16 * s) * 2, voffK); }
    const int i0 = (n >= 8) ? 0 : 8 - n;
#define KLOAD4(KF, VO, SB) do { \
        asm volatile("s_nop 4\n\tglobal_load_dwordx4 %0, %1, %2" : "+v"(KF[0]) : "v"(VO), "s"(SB) : "memory"); \
        asm volatile("global_load_dwordx4 %0, %1, %2 offset:32" : "+v"(KF[1]) : "v"(VO), "s"(SB) : "memory"); \
        asm volatile("global_load_dwordx4 %0, %1, %2 offset:64" : "+v"(KF[2]) : "v"(VO), "s"(SB) : "memory"); \
        asm volatile("global_load_dwordx4 %0, %1, %2 offset:96" : "+v"(KF[3]) : "v"(VO), "s"(SB) : "memory"); } while (0)
#define KWAIT(KF, N) asm volatile("s_waitcnt vmcnt(" #N ")" : "+v"(KF[0]), "+v"(KF[1]), "+v"(KF[2]), "+v"(KF[3]) :: "memory")
    dma_tile_asm(uptr(Z + zc(ZC_AV + h * 64) + (row0 - 512 + 64 * i0) * ZRS), voffV, wl + (i0 & 1) * 8192);
    bf16x8 kfa[4], kfb[4];
#pragma unroll
    for (int s = 0; s < 4; ++s) { kfa[s] = (bf16x8){0, 0, 0, 0, 0, 0, 0, 0}; kfb[s] = (bf16x8){0, 0, 0, 0, 0, 0, 0, 0}; }
    { gcp kb_ = uptr(Z + zc(ZC_AK + h * 64) + (row0 - 512 + 64 * i0) * ZRS); KLOAD4(kfa, voffK, kb_); }
#pragma unroll
    for (int k = 0; k < 4; ++k) { const int j = lane + 64 * k; if (j < 255) rbl[j] = tb_[k] * LOG2E; }
    const int jl0 = r - 4 * hf + 4;
    f32x16 o[2][2];
#pragma unroll
    for (int a = 0; a < 2; ++a)
#pragma unroll
        for (int c = 0; c < 2; ++c)
#pragma unroll
            for (int i = 0; i < 16; ++i) o[a][c][i] = 0.f;
    float m[2] = {-1e30f, -1e30f}, lsum[2] = {0.f, 0.f};
    asm volatile("" :: "v"(qf[0][0]), "v"(qf[0][1]), "v"(qf[0][2]), "v"(qf[0][3]), "v"(qf[1][0]), "v"(qf[1][1]), "v"(qf[1][2]), "v"(qf[1][3]), "v"(bfar) : "memory");
#if PROBE_T >= 31 && PROBE_T <= 34
#define TS_(k) do { unsigned long long t_; asm volatile("s_memtime %0\n\ts_waitcnt lgkmcnt(0)" : "=s"(t_) :: "memory"); if ((k) > 0 && PROBE_T == 30 + (k)) tacc_ += (unsigned)(t_ - tprev_); tprev_ = t_; } while (0)
#else
#define TS_(k) do { } while (0)
#endif
#define ATTN_STEP(KF, KB) do { \
        TS_(0); \
        f32x16 st[2]; \
        _Pragma("unroll") for (int qb = 0; qb < 2; ++qb) { _Pragma("unroll") for (int i = 0; i < 16; ++i) st[qb][i] = 0.f; \
            _Pragma("unroll") for (int s = 0; s < 4; ++s) st[qb] = MFMA32(KF[s], qf[qb][s], st[qb]); } \
        asm volatile("" : "+v"(st[0]), "+v"(st[1])); TS_(1); \
        const bool far_ = (ti <= 5); \
        if (!far_) { const int jt_ = jl0 + 512 - 64 * ti; \
            _Pragma("unroll") for (int qb = 0; qb < 2; ++qb) _Pragma("unroll") for (int i = 0; i < 16; ++i) \
                st[qb][i] = st[qb][i] * C1 + rbl[jt_ + (32 * qb + 59 - 32 * (KB) - ((i & 3) + 8 * (i >> 2)))]; } \
        bf16x8 pf[2][2]; \
        _Pragma("unroll") for (int qb = 0; qb < 2; ++qb) { \
            float ma = max3f(st[qb][0], st[qb][1], st[qb][2]), mb = max3f(st[qb][3], st[qb][4], st[qb][5]); \
            ma = max3f(ma, st[qb][6], st[qb][7]); mb = max3f(mb, st[qb][8], st[qb][9]); ma = max3f(ma, st[qb][10], st[qb][11]); mb = max3f(mb, st[qb][12], st[qb][13]); \
            float mx = max3f(ma, mb, max3f(st[qb][14], st[qb][15], st[qb][15])); \
            if (far_) mx = mx * C1 + bfar;              \
            mx = xh_max(mx); \
            if (__any(mx > m[qb] + 8.0f)) { const float mn = max3f(m[qb], mx, mx), alpha = __builtin_amdgcn_exp2f(m[qb] - mn); m[qb] = mn; lsum[qb] *= alpha; \
                _Pragma("unroll") for (int i = 0; i < 16; ++i) { o[0][qb][i] *= alpha; o[1][qb][i] *= alpha; } } \
            const float sc_ = far_ ? C1 : 1.0f, of_ = far_ ? bfar - m[qb] : -m[qb]; \
            float ps0 = 0.f, ps1 = 0.f, ps2 = 0.f, ps3 = 0.f; \
            _Pragma("unroll") for (int i = 0; i < 16; i += 4) { \
                const float p0 = __builtin_amdgcn_exp2f(st[qb][i] * sc_ + of_), p1 = __builtin_amdgcn_exp2f(st[qb][i + 1] * sc_ + of_), p2 = __builtin_amdgcn_exp2f(st[qb][i + 2] * sc_ + of_), p3 = __builtin_amdgcn_exp2f(st[qb][i + 3] * sc_ + of_); \
                st[qb][i] = p0; st[qb][i + 1] = p1; st[qb][i + 2] = p2; st[qb][i + 3] = p3; ps0 += p0; ps1 += p1; ps2 += p2; ps3 += p3; } \
            lsum[qb] += (ps0 + ps1) + (ps2 + ps3); \
            pf[qb][0] = pack8(st[qb][0], st[qb][1], st[qb][2], st[qb][3], st[qb][4], st[qb][5], st[qb][6], st[qb][7]); \
            pf[qb][1] = pack8(st[qb][8], st[qb][9], st[qb][10], st[qb][11], st[qb][12], st[qb][13], st[qb][14], st[qb][15]); } \
        asm volatile("" : "+v"(pf[0][0]), "+v"(pf[0][1]), "+v"(pf[1][0]), "+v"(pf[1][1])); TS_(2); \
        _Pragma("unroll") for (int k2 = 0; k2 < 2; ++k2) _Pragma("unroll") for (int dvb = 0; dvb < 2; ++dvb) { \
            const bf16x8 vf = tr_frag_b(vt, dvb ? trb1 : trb0, 2 * (KB) + k2); \
            o[dvb][0] = MFMA32(vf, pf[0][k2], o[dvb][0]); o[dvb][1] = MFMA32(vf, pf[1][k2], o[dvb][1]); } \
        TS_(3); \
    } while (0)
#if PROBE_T >= 31 && PROBE_T <= 34
    unsigned tacc_ = 0; unsigned long long tprev_ = 0; const unsigned long long tl0_ = __builtin_amdgcn_s_memtime();
#endif
#pragma unroll 1
    for (int ti = i0; ti < 9; ++ti) {
        const size_t kr0 = row0 - 512 + 64 * ti;
        LAS const unsigned char* vt = wl + (ti & 1) * 8192;
        gcp kb1_ = uptr(Z + zc(ZC_AK + h * 64) + (kr0 + 32) * ZRS);
        gcp kb2_ = uptr(Z + zc(ZC_AK + h * 64) + (kr0 + 64) * ZRS);
        KLOAD4(kfb, voffK, kb1_);
        dma_tile_asm(uptr(Z + zc(ZC_AV + h * 64) + (kr0 + 64) * ZRS), voffV, wl + ((ti + 1) & 1) * 8192);
        KWAIT(kfa, 12);
        ATTN_STEP(kfa, 0);
        KLOAD4(kfa, voffK, kb2_);
        KWAIT(kfb, 12);
        ATTN_STEP(kfb, 1);
    }
    KWAIT(kfa, 0);
#if PROBE_T >= 31 && PROBE_T <= 34
    if (cn * 6 + h == 900 && layer == 0 && lane == 0) { const unsigned v_ = (PROBE_T == 34) ? (unsigned)(__builtin_amdgcn_s_memtime() - tl0_) : tacc_;
        __hip_atomic_store((unsigned*)(F_ctl + 2049), v_ / 21u, __ATOMIC_RELAXED, __HIP_MEMORY_SCOPE_AGENT); }
#endif
#undef KLOAD4
#undef KWAIT
#undef ATTN_STEP
#pragma unroll
    for (int qb = 0; qb < 2; ++qb) {
        const float l = xh_sum(lsum[qb]), inv = 1.0f / l;
#pragma unroll
        for (int dvb = 0; dvb < 2; ++dvb)
#pragma unroll
            for (int i4 = 0; i4 < 4; ++i4) tl_put4(wl, 32 * qb + r, 32 * dvb + 8 * i4 + 4 * hf, o[dvb][qb][4 * i4] * inv, o[dvb][qb][4 * i4 + 1] * inv, o[dvb][qb][4 * i4 + 2] * inv, o[dvb][qb][4 * i4 + 3] * inv);
    }
    tl_emit<0>(wl, lane, uptr(Z + zc(ZC_AG + h * 64) + row0 * ZRS), (gcp)nullptr, nullptr, (GAS char*)uptr(F_Y + row0 * DM + h * 64));
}

__device__ __forceinline__ float wave_scan_add(float x, int) {
    x += DPPF(0.f, x, 0x111, 0xf);
    x += DPPF(0.f, x, 0x112, 0xf);
    x += DPPF(0.f, x, 0x114, 0xf);
    x += DPPF(0.f, x, 0x118, 0xf);
    x += DPPF(0.f, x, 0x142, 0xa);
    x += DPPF(0.f, x, 0x143, 0xc);
    return x;
}
__device__ __forceinline__ float wave_scan_max(float x, int) {
    const float ninf = -3.0e38f;
    x = fmaxf(x, DPPF(ninf, x, 0x111, 0xf));
    x = fmaxf(x, DPPF(ninf, x, 0x112, 0xf));
    x = fmaxf(x, DPPF(ninf, x, 0x114, 0xf));
    x = fmaxf(x, DPPF(ninf, x, 0x118, 0xf));
    x = fmaxf(x, DPPF(ninf, x, 0x142, 0xa));
    x = fmaxf(x, DPPF(ninf, x, 0x143, 0xc));
    return x;
}
__device__ __forceinline__ float wave_max(float x) {
#pragma unroll
    for (int o = 1; o < 64; o <<= 1) x = fmaxf(x, __shfl_xor(x, o));
    return x;
}
__device__ __forceinline__ void conv8(const char* zub, unsigned voff, int blk, int s, int tt, int n, LAS const float* w, int c0, float scale, float* out) {
    float acc[8];
#pragma unroll
    for (int e = 0; e < 8; ++e) acc[e] = 0.f;
#pragma unroll
    for (int j = 0; j < 4; ++j) {
        v4u raw = *(const v4u*)(zub + ((long)(32 * blk + j - 3) * ZRS + 16 * s) * 2 + voff);
        if (!(n > 0 || tt + j - 3 >= 0)) raw = (v4u){0u, 0u, 0u, 0u};
        float z[8]; unpack8(raw, z);
        const f32x4 w0 = *(LAS const f32x4*)(w + j * 64 + c0), w1 = *(LAS const f32x4*)(w + j * 64 + c0 + 4);
        acc[0] += z[0] * w0[0]; acc[1] += z[1] * w0[1]; acc[2] += z[2] * w0[2]; acc[3] += z[3] * w0[3];
        acc[4] += z[4] * w1[0]; acc[5] += z[5] * w1[1]; acc[6] += z[6] * w1[2]; acc[7] += z[7] * w1[3];
    }
#pragma unroll
    for (int e = 0; e < 8; ++e) out[e] = fsilu(acc[e]) * scale;
}
__device__ __forceinline__ bf16x8 ld_f32_frag(gcp ub, unsigned voff) {
    const f32x4 a = *(const GAS f32x4*)(ub + voff), b = *(const GAS f32x4*)(ub + voff + 16);
    return pack8(a[0], a[1], a[2], a[3], b[0], b[1], b[2], b[3]);
}

__device__ __forceinline__ void dma_rows67(gcp ub, unsigned voff, LAS unsigned char* img, int lane) {
#pragma unroll
    for (int it = 0; it < 8; ++it) __builtin_amdgcn_global_load_lds((const GAS unsigned*)(ub + (size_t)it * 8 * ZRS * 2 + voff), (LAS unsigned*)(img + it * 1024), 16, 0, 0);
    if (lane < 24) __builtin_amdgcn_global_load_lds((const GAS unsigned*)(ub + (size_t)64 * ZRS * 2 + voff), (LAS unsigned*)(img + 8192), 16, 0, 0);
}
constexpr int IMG1 = 8704;
__device__ __forceinline__ void ml_out_wave(Frame& F, int layer, int cn, int h, LAS unsigned char* wl) {
    const int lane = F_lane, r = lane & 31, hf = lane >> 5;
    const int b = cn / NCHS, n = cn % NCHS;
    const size_t row0 = (size_t)b * SEQ + (size_t)n * CH;
    const bf16* Z = F_Z;
    LAS unsigned char* img0 = wl; LAS unsigned char* img1 = wl + IMG1;
    LAS float* wq = (LAS float*)(wl + 17408); LAS float* wk = wq + 256; LAS float* npl = wq + 512;
    const unsigned dvo = dma_voff(lane);
    dma_rows67(uptr(Z + zc(ZC_MQ + h * 64) + (row0 - 3) * ZRS), dvo, img0, lane);
    dma_rows67(uptr(Z + zc(ZC_MK + h * 64) + (row0 - 3) * ZRS), dvo, img1, lane);
    { const float* cw = F_conv_w + (size_t)layer * 4 * 768 + h * 64 + lane; float tq_[4], tk_[4];
#pragma unroll
      for (int j = 0; j < 4; ++j) { tq_[j] = cw[j * 768]; tk_[j] = cw[j * 768 + 384]; }
#pragma unroll
      for (int j = 0; j < 4; ++j) { wq[j * 64 + lane] = tq_[j]; wk[j * 64 + lane] = tk_[j]; } }
    npl[lane] = F_NST[((size_t)cn * 6 + h) * 64 + lane];
    const float* g32 = F_G32 + (row0 + lane) * 32;
    const float ig = g32[h] + F_b_gates[layer * 12 + h];
    const float lf = logsigf(g32[6 + h] + F_b_gates[layer * 12 + 6 + h]);
    const float bc = wave_scan_add(lf, lane);
    const float av = ig - bc;
    const float amax = wave_scan_max(av, lane);
    const float mprev = F_MP[cn * 6 + h];
    float bct[2], mt[2], iw[2];
#pragma unroll
    for (int tb = 0; tb < 2; ++tb) { bct[tb] = __shfl(bc, 32 * tb + r); mt[tb] = fmaxf(mprev, __shfl(amax, 32 * tb + r)); iw[tb] = fexp(mprev - mt[tb]); }
    asm volatile("s_waitcnt vmcnt(0)" ::: "memory");
    bf16x8 qcf[2][4], kcf[2][4];
    float nq[2] = {0.f, 0.f};
#pragma unroll
    for (int s = 0; s < 4; ++s) {
        const int c0 = 16 * s + 8 * hf;
        const f32x4 n0 = *(LAS const f32x4*)(npl + c0), n1 = *(LAS const f32x4*)(npl + c0 + 4);
#pragma unroll
        for (int blk = 0; blk < 2; ++blk) {
            float aq[8], ak[8];
#pragma unroll
            for (int e = 0; e < 8; ++e) { aq[e] = 0.f; ak[e] = 0.f; }
#pragma unroll
            for (int j = 0; j < 4; ++j) {
                const int rho = 32 * blk + r + j, off = tile_off(rho, c0 * 2);
                v4u rq = *(LAS const v4u*)(img0 + off), rk = *(LAS const v4u*)(img1 + off);
                if (n == 0 && rho < 3) { rq = (v4u){0u, 0u, 0u, 0u}; rk = (v4u){0u, 0u, 0u, 0u}; }
                float zq[8], zk[8]; unpack8(rq, zq); unpack8(rk, zk);
                const f32x4 a0 = *(LAS const f32x4*)(wq + j * 64 + c0), a1 = *(LAS const f32x4*)(wq + j * 64 + c0 + 4), b0 = *(LAS const f32x4*)(wk + j * 64 + c0), b1 = *(LAS const f32x4*)(wk + j * 64 + c0 + 4);
                aq[0] += zq[0] * a0[0]; aq[1] += zq[1] * a0[1]; aq[2] += zq[2] * a0[2]; aq[3] += zq[3] * a0[3]; aq[4] += zq[4] * a1[0]; aq[5] += zq[5] * a1[1]; aq[6] += zq[6] * a1[2]; aq[7] += zq[7] * a1[3];
                ak[0] += zk[0] * b0[0]; ak[1] += zk[1] * b0[1]; ak[2] += zk[2] * b0[2]; ak[3] += zk[3] * b0[3]; ak[4] += zk[4] * b1[0]; ak[5] += zk[5] * b1[1]; ak[6] += zk[6] * b1[2]; ak[7] += zk[7] * b1[3];
            }
#pragma unroll
            for (int e = 0; e < 8; ++e) { aq[e] = fsilu(aq[e]); ak[e] = fsilu(ak[e]) * 0.125f; }
            nq[blk] += aq[0] * n0[0] + aq[1] * n0[1] + aq[2] * n0[2] + aq[3] * n0[3] + aq[4] * n1[0] + aq[5] * n1[1] + aq[6] * n1[2] + aq[7] * n1[3];
            qcf[blk][s] = pack8(aq[0], aq[1], aq[2], aq[3], aq[4], aq[5], aq[6], aq[7]);
            kcf[blk][s] = pack8(ak[0], ak[1], ak[2], ak[3], ak[4], ak[5], ak[6], ak[7]);
        }
    }
    dma_tile_u(uptr(Z + zc(ZC_MV + h * 64) + row0 * ZRS), dvo, img0);
    bf16x8 pf0[2], pf1[4];
    float den[2] = {0.f, 0.f};
    {
        f32x16 s00, s01, s11;
#pragma unroll
        for (int i = 0; i < 16; ++i) { s00[i] = 0.f; s01[i] = 0.f; s11[i] = 0.f; }
#pragma unroll
        for (int s = 0; s < 4; ++s) { s00 = MFMA32(kcf[0][s], qcf[0][s], s00); s01 = MFMA32(kcf[0][s], qcf[1][s], s01); s11 = MFMA32(kcf[1][s], qcf[1][s], s11); }
#pragma unroll
        for (int i = 0; i < 16; ++i) {
            const int jr = (i & 3) + 8 * (i >> 2) + 4 * hf;
            const float a0 = __shfl(av, jr), a1 = __shfl(av, 32 + jr);
            const float d00 = (jr <= r) ? fexp(a0 - mt[0]) : 0.f, d01 = fexp(a0 - mt[1]), d11 = (jr <= r) ? fexp(a1 - mt[1]) : 0.f;
            s00[i] *= d00; s01[i] *= d01; s11[i] *= d11;
            den[0] += s00[i]; den[1] += s01[i] + s11[i];
        }
        pf0[0] = pack8(s00[0], s00[1], s00[2], s00[3], s00[4], s00[5], s00[6], s00[7]); pf0[1] = pack8(s00[8], s00[9], s00[10], s00[11], s00[12], s00[13], s00[14], s00[15]);
        pf1[0] = pack8(s01[0], s01[1], s01[2], s01[3], s01[4], s01[5], s01[6], s01[7]); pf1[1] = pack8(s01[8], s01[9], s01[10], s01[11], s01[12], s01[13], s01[14], s01[15]);
        pf1[2] = pack8(s11[0], s11[1], s11[2], s11[3], s11[4], s11[5], s11[6], s11[7]); pf1[3] = pack8(s11[8], s11[9], s11[10], s11[11], s11[12], s11[13], s11[14], s11[15]);
    }
#pragma unroll
    for (int tb = 0; tb < 2; ++tb) {
        den[tb] = xh_sum(den[tb]); nq[tb] = xh_sum(nq[tb]);
        den[tb] = fmaxf(fabsf(den[tb] + iw[tb] * nq[tb]), fexp(-(bct[tb] + mt[tb])));
    }
    unsigned trb0, trb1; tr_bases(lane, trb0, trb1);
    gcp cpb = uptr(F_CPB + ((size_t)cn * 6 + h) * 4096);
    f32x16 num[2][2];
#pragma unroll
    for (int vb = 0; vb < 2; ++vb) {
        bf16x8 cf[4];
#pragma unroll
        for (int s = 0; s < 4; ++s) cf[s] = ldfrag(cpb + ((size_t)32 * vb * 64 + 16 * s) * 2, (unsigned)(r * 64 + 8 * hf) * 2u);
#pragma unroll
        for (int tb = 0; tb < 2; ++tb) {
#pragma unroll
            for (int i = 0; i < 16; ++i) num[vb][tb][i] = 0.f;
#pragma unroll
            for (int s = 0; s < 4; ++s) num[vb][tb] = MFMA32(cf[s], qcf[tb][s], num[vb][tb]);
#pragma unroll
            for (int i = 0; i < 16; ++i) num[vb][tb][i] *= iw[tb];
        }
    }
    asm volatile("s_waitcnt vmcnt(0)" ::: "memory");
#pragma unroll
    for (int vb = 0; vb < 2; ++vb)
#pragma unroll
        for (int ks = 0; ks < 4; ++ks) {
            const bf16x8 vf = tr_frag_b(img0, vb ? trb1 : trb0, ks);
            if (ks < 2) num[vb][0] = MFMA32(vf, pf0[ks], num[vb][0]);
            num[vb][1] = MFMA32(vf, pf1[ks], num[vb][1]);
        }
#pragma unroll
    for (int tb = 0; tb < 2; ++tb) {
        const float rden = 1.0f / den[tb]; float ss = 0.f;
#pragma unroll
        for (int vb = 0; vb < 2; ++vb)
#pragma unroll
            for (int i = 0; i < 16; ++i) { num[vb][tb][i] *= rden; ss += num[vb][tb][i] * num[vb][tb][i]; }
        ss = xh_sum(ss);
        const float rn = 1.0f / sqrtf(ss * (1.0f / 64.0f) + EPS);
#pragma unroll
        for (int vb = 0; vb < 2; ++vb)
#pragma unroll
            for (int i4 = 0; i4 < 4; ++i4) tl_put4(wl, 32 * tb + r, 32 * vb + 8 * i4 + 4 * hf, num[vb][tb][4 * i4] * rn, num[vb][tb][4 * i4 + 1] * rn, num[vb][tb][4 * i4 + 2] * rn, num[vb][tb][4 * i4 + 3] * rn);
    }
    tl_emit<1>(wl, lane, uptr(Z + zc(ZC_MO + h * 64) + row0 * ZRS), uptr(Z + zc(ZC_MG + h * 64) + row0 * ZRS), F_ml_norm_g + layer * 384 + h * 64, (GAS char*)uptr(F_Y + row0 * DM + 384 + h * 64));
}

__device__ __forceinline__ void ml_loc_wave(Frame& F, int layer, int cn, int h, LAS unsigned char* wl) {
    const int lane = F_lane, r = lane & 31, hf = lane >> 5;
    const int b = cn / NCHS, n = cn % NCHS;
    const size_t row0 = (size_t)b * SEQ + (size_t)n * CH;
    const bf16* Z = F_Z;
    LAS unsigned char* img0 = wl; LAS unsigned char* img1 = wl + IMG1;
    const unsigned dvo = dma_voff(lane);
    dma_rows67(uptr(Z + zc(ZC_MK + h * 64) + (row0 - 3) * ZRS), dvo, img0, lane);
    dma_tile_u(uptr(Z + zc(ZC_MV + h * 64) + row0 * ZRS), dvo, img1);
    const int rr = lane >> 3, ch = lane & 7;
    float wk[4][8];
    { const float* cw = F_conv_w + (size_t)layer * 4 * 768 + 384 + h * 64 + ch * 8;
#pragma unroll
      for (int j = 0; j < 4; ++j) { const f32x4 a = *(const f32x4*)(cw + j * 768), c = *(const f32x4*)(cw + j * 768 + 4);
          wk[j][0] = a[0]; wk[j][1] = a[1]; wk[j][2] = a[2]; wk[j][3] = a[3]; wk[j][4] = c[0]; wk[j][5] = c[1]; wk[j][6] = c[2]; wk[j][7] = c[3]; } }
    const float* g32 = F_G32 + (row0 + lane) * 32;
    const float ig = g32[h] + F_b_gates[layer * 12 + h];
    const float lf = logsigf(g32[6 + h] + F_b_gates[layer * 12 + 6 + h]);
    const float bc = wave_scan_add(lf, lane);
    const float g = __shfl(bc, 63);
    const float av = g - bc + ig;
    const float mloc = wave_max(av);
    const float w = fexp(av - mloc);
    asm volatile("s_waitcnt vmcnt(0)" ::: "memory");
#pragma unroll 2
    for (int it = 0; it < 8; ++it) {
        const int row = 8 * it + rr;
        float acc[8];
#pragma unroll
        for (int e = 0; e < 8; ++e) acc[e] = 0.f;
#pragma unroll
        for (int j = 0; j < 4; ++j) {
            v4u raw = *(LAS const v4u*)(img0 + tile_off(row + j, ch * 16));
            if (n == 0 && row + j < 3) raw = (v4u){0u, 0u, 0u, 0u};
            float z[8]; unpack8(raw, z);
#pragma unroll
            for (int e = 0; e < 8; ++e) acc[e] += z[e] * wk[j][e];
        }
        const int lo = tile_off(row, ch * 16);
        float v8[8]; unpack8(*(LAS const v4u*)(img1 + lo), v8);
        const float wr = __shfl(w, row);
        *(LAS v4u*)(img0 + lo) = __builtin_bit_cast(v4u, pack8(fsilu(acc[0]) * 0.125f, fsilu(acc[1]) * 0.125f, fsilu(acc[2]) * 0.125f, fsilu(acc[3]) * 0.125f,
                                                                fsilu(acc[4]) * 0.125f, fsilu(acc[5]) * 0.125f, fsilu(acc[6]) * 0.125f, fsilu(acc[7]) * 0.125f));
        *(LAS v4u*)(img1 + lo) = __builtin_bit_cast(v4u, pack8(v8[0] * wr, v8[1] * wr, v8[2] * wr, v8[3] * wr, v8[4] * wr, v8[5] * wr, v8[6] * wr, v8[7] * wr));
    }
    unsigned trb0, trb1; tr_bases(lane, trb0, trb1);
    f32x16 acc[2][2];
#pragma unroll
    for (int a = 0; a < 2; ++a)
#pragma unroll
        for (int c = 0; c < 2; ++c)
#pragma unroll
            for (int i = 0; i < 16; ++i) acc[a][c][i] = 0.f;
#pragma unroll
    for (int ks = 0; ks < 4; ++ks) {
        const bf16x8 v0 = tr_frag_b(img1, trb0, ks), v1 = tr_frag_b(img1, trb1, ks), k0 = tr_frag_b(img0, trb0, ks), k1 = tr_frag_b(img0, trb1, ks);
        acc[0][0] = MFMA32(k0, v0, acc[0][0]); acc[0][1] = MFMA32(k0, v1, acc[0][1]); acc[1][0] = MFMA32(k1, v0, acc[1][0]); acc[1][1] = MFMA32(k1, v1, acc[1][1]);
    }
    bf16* cst = (bf16*)F_CST + ((size_t)cn * 6 + h) * 4096;
#pragma unroll
    for (int kb = 0; kb < 2; ++kb)
#pragma unroll
        for (int vb = 0; vb < 2; ++vb)
#pragma unroll
            for (int i4 = 0; i4 < 4; ++i4)
                *(unsigned long long*)(cst + (32 * vb + r) * 64 + 32 * kb + 8 * i4 + 4 * hf) =
                    (unsigned long long)cvtpk(acc[kb][vb][4 * i4], acc[kb][vb][4 * i4 + 1]) | ((unsigned long long)cvtpk(acc[kb][vb][4 * i4 + 2], acc[kb][vb][4 * i4 + 3]) << 32);
    float s = 0.f;
#pragma unroll 8
    for (int j = 0; j < 64; ++j) s += __shfl(w, j) * bf2f(*(LAS const unsigned short*)(img0 + tile_off(j, 2 * lane)));
    F_NST[((size_t)cn * 6 + h) * 64 + lane] = s;
    if (lane == 0) { F_GS[cn * 6 + h] = g; F_MS[cn * 6 + h] = mloc; }
}

__device__ __forceinline__ float flogsig(float x) { return fminf(x, 0.f) - 0.6931471805599453f * __builtin_amdgcn_logf(1.0f + fexp(-fabsf(x))); }
__device__ __forceinline__ void gla_loc_wave(Frame& F, int layer, int cn, int hh, LAS unsigned char* wl) {
    const int lane = F_lane, hf = lane >> 5;
    const int b = cn / NCHS, n = cn % NCHS;
    const size_t row0 = (size_t)b * SEQ + (size_t)n * CH, row = row0 + lane;
    const bf16* Z = F_Z;
    dma_tile_u(uptr(Z + zc(ZC_GV + hh * 64) + row0 * ZRS), dma_voff(lane), wl + 8192);
    float ga[16];
    { const f32x4* gp = (const f32x4*)(F_G32 + row * 32 + 12);
#pragma unroll
      for (int q = 0; q < 4; ++q) { const f32x4 v = gp[q]; ga[4 * q] = v[0]; ga[4 * q + 1] = v[1]; ga[4 * q + 2] = v[2]; ga[4 * q + 3] = v[3]; } }
    const float* wa = F_w_alpha + (size_t)layer * 16 * 128 + hh * 32; const float* ba = F_b_alpha + layer * 128 + hh * 32;
    LAS float* wsl = (LAS float*)(wl + 16384);
    float tw_[8];
#pragma unroll
    for (int k = 0; k < 8; ++k) { const int i = lane + 64 * k; tw_[k] = wa[(i >> 5) * 128 + (i & 31)]; }
#pragma unroll
    for (int k = 0; k < 8; ++k) wsl[lane + 64 * k] = tw_[k];
    float bcv[32];
#pragma unroll
    for (int d4 = 0; d4 < 8; ++d4) {
        f32x4 a = *(const f32x4*)(ba + 4 * d4);
#pragma unroll
        for (int q = 0; q < 16; ++q) a += *(LAS const f32x4*)(wsl + q * 32 + 4 * d4) * ga[q];
#pragma unroll
        for (int e = 0; e < 4; ++e) bcv[4 * d4 + e] = wave_scan_add(flogsig(a[e]) * (1.0f / 16.0f), lane);
    }
    { f32x4* bp = (f32x4*)(F_BC + row * 128 + hh * 32);
#pragma unroll
      for (int q = 0; q < 8; ++q) bp[q] = (f32x4){bcv[4 * q], bcv[4 * q + 1], bcv[4 * q + 2], bcv[4 * q + 3]}; }
#pragma unroll
    for (int c = 0; c < 4; ++c) {
        float k8[8]; unpack8(*(const v4u*)(Z + zc(ZC_GK + hh * 32) + row * ZRS + 8 * c), k8);
#pragma unroll
        for (int e = 0; e < 8; ++e) k8[e] *= fexp(__shfl(bcv[8 * c + e], 63) - bcv[8 * c + e]);
        *(LAS v4u*)(wl + tile_off(lane, c * 16)) = __builtin_bit_cast(v4u, pack8(k8[0], k8[1], k8[2], k8[3], k8[4], k8[5], k8[6], k8[7]));
    }
    if (lane == 63) { f32x4* ap = (f32x4*)(F_ADEC + ((size_t)cn * 4 + hh) * 32);
#pragma unroll
        for (int q = 0; q < 8; ++q) ap[q] = (f32x4){fexp(bcv[4 * q]), fexp(bcv[4 * q + 1]), fexp(bcv[4 * q + 2]), fexp(bcv[4 * q + 3])}; }
    unsigned trb0, trb1; tr_bases(lane, trb0, trb1);
    f32x16 u0, u1;
#pragma unroll
    for (int i = 0; i < 16; ++i) { u0[i] = 0.f; u1[i] = 0.f; }
    asm volatile("s_waitcnt vmcnt(0)" ::: "memory");
#pragma unroll
    for (int ks = 0; ks < 4; ++ks) { const bf16x8 kd = tr_frag_b(wl, trb0, ks);
        u0 = MFMA32(tr_frag_b(wl + 8192, trb0, ks), kd, u0); u1 = MFMA32(tr_frag_b(wl + 8192, trb1, ks), kd, u1); }
    float* sst = F_SST + ((size_t)cn * 4 + hh) * 2048;
#pragma unroll
    for (int i = 0; i < 16; ++i) { const int v = (i & 3) + 8 * (i >> 2) + 4 * hf; sst[v * 32 + (lane & 31)] = u0[i]; sst[(32 + v) * 32 + (lane & 31)] = u1[i]; }
}

__device__ __forceinline__ void gla_out_wave(Frame& F, int layer, int cn, int hh, LAS unsigned char* wl) {
    const int lane = F_lane, r = lane & 31, hf = lane >> 5;
    const int b = cn / NCHS, n = cn % NCHS;
    const size_t row0 = (size_t)b * SEQ + (size_t)n * CH;
    const bf16* Z = F_Z;
    dma_tile_u(uptr(Z + zc(ZC_GV + hh * 64) + row0 * ZRS), dma_voff(lane), wl);
    const unsigned voffK = (unsigned)(r * ZRS + 8 * hf) * 2u, voffB = (unsigned)(r * 128 + 8 * hf) * 4u;
    gcp zq = uptr(Z + zc(ZC_GQ + hh * 32) + row0 * ZRS); gcp zk = uptr(Z + zc(ZC_GK + hh * 32) + row0 * ZRS); gcp bcb = uptr(F_BC + row0 * 128 + hh * 32);
    bf16x8 qf[2][2], kf[2][2];
    {
        v4u rq[2][2], rk[2][2]; f32x4 rc0[2][2], rc1[2][2];
#pragma unroll
        for (int blk = 0; blk < 2; ++blk)
#pragma unroll
            for (int s = 0; s < 2; ++s) {
                rq[blk][s] = *(const GAS v4u*)(zq + ((size_t)32 * blk * ZRS + 16 * s) * 2 + voffK); rk[blk][s] = *(const GAS v4u*)(zk + ((size_t)32 * blk * ZRS + 16 * s) * 2 + voffK);
                rc0[blk][s] = *(const GAS f32x4*)(bcb + ((size_t)32 * blk * 128 + 16 * s) * 4 + voffB); rc1[blk][s] = *(const GAS f32x4*)(bcb + ((size_t)32 * blk * 128 + 16 * s) * 4 + voffB + 16);
            }
        asm volatile("" : "+v"(rq[0][0]), "+v"(rq[0][1]), "+v"(rq[1][0]), "+v"(rq[1][1]), "+v"(rk[0][0]), "+v"(rk[0][1]), "+v"(rk[1][0]), "+v"(rk[1][1]));
        asm volatile("" : "+v"(rc0[0][0]), "+v"(rc0[0][1]), "+v"(rc0[1][0]), "+v"(rc0[1][1]), "+v"(rc1[0][0]), "+v"(rc1[0][1]), "+v"(rc1[1][0]), "+v"(rc1[1][1]));
#pragma unroll
        for (int blk = 0; blk < 2; ++blk)
#pragma unroll
            for (int s = 0; s < 2; ++s) {
                float q8[8], k8[8];
                unpack8(rq[blk][s], q8); unpack8(rk[blk][s], k8);
                const f32x4 c0 = rc0[blk][s], c1 = rc1[blk][s];
                const float bc8[8] = {c0[0], c0[1], c0[2], c0[3], c1[0], c1[1], c1[2], c1[3]};
#pragma unroll
                for (int e = 0; e < 8; ++e) { q8[e] *= 0.17677669529663687f * fexp(bc8[e]); k8[e] *= fexp(-bc8[e]); }
                qf[blk][s] = pack8(q8[0], q8[1], q8[2], q8[3], q8[4], q8[5], q8[6], q8[7]);
                kf[blk][s] = pack8(k8[0], k8[1], k8[2], k8[3], k8[4], k8[5], k8[6], k8[7]);
            }
    }
    bf16x8 pf0[2], pf1[4];
    {
        f32x16 s00, s01, s11;
#pragma unroll
        for (int i = 0; i < 16; ++i) { s00[i] = 0.f; s01[i] = 0.f; s11[i] = 0.f; }
#pragma unroll
        for (int s = 0; s < 2; ++s) { s00 = MFMA32(kf[0][s], qf[0][s], s00); s01 = MFMA32(kf[0][s], qf[1][s], s01); s11 = MFMA32(kf[1][s], qf[1][s], s11); }
#pragma unroll
        for (int i = 0; i < 16; ++i) { const int jr = (i & 3) + 8 * (i >> 2) + 4 * hf; if (jr > r) { s00[i] = 0.f; s11[i] = 0.f; } }
        pf0[0] = pack8(s00[0], s00[1], s00[2], s00[3], s00[4], s00[5], s00[6], s00[7]); pf0[1] = pack8(s00[8], s00[9], s00[10], s00[11], s00[12], s00[13], s00[14], s00[15]);
        pf1[0] = pack8(s01[0], s01[1], s01[2], s01[3], s01[4], s01[5], s01[6], s01[7]); pf1[1] = pack8(s01[8], s01[9], s01[10], s01[11], s01[12], s01[13], s01[14], s01[15]);
        pf1[2] = pack8(s11[0], s11[1], s11[2], s11[3], s11[4], s11[5], s11[6], s11[7]); pf1[3] = pack8(s11[8], s11[9], s11[10], s11[11], s11[12], s11[13], s11[14], s11[15]);
    }
    unsigned trb0, trb1; tr_bases(lane, trb0, trb1);
    gcp spb = uptr(F_SST + ((size_t)cn * 4 + hh) * 2048);
    f32x16 num[2][2];
#pragma unroll
    for (int vb = 0; vb < 2; ++vb) {
        bf16x8 sf[2];
#pragma unroll
        for (int s = 0; s < 2; ++s) sf[s] = ld_f32_frag(spb + ((size_t)32 * vb * 32 + 16 * s) * 4, (unsigned)(r * 32 + 8 * hf) * 4u);
#pragma unroll
        for (int tb = 0; tb < 2; ++tb) {
#pragma unroll
            for (int i = 0; i < 16; ++i) num[vb][tb][i] = 0.f;
#pragma unroll
            for (int s = 0; s < 2; ++s) num[vb][tb] = MFMA32(sf[s], qf[tb][s], num[vb][tb]);
        }
    }
    asm volatile("s_waitcnt vmcnt(0)" ::: "memory");
#pragma unroll
    for (int vb = 0; vb < 2; ++vb)
#pragma unroll
        for (int ks = 0; ks < 4; ++ks) {
            const bf16x8 vf = tr_frag_b(wl, vb ? trb1 : trb0, ks);
            if (ks < 2) num[vb][0] = MFMA32(vf, pf0[ks], num[vb][0]);
            num[vb][1] = MFMA32(vf, pf1[ks], num[vb][1]);
        }
#pragma unroll
    for (int tb = 0; tb < 2; ++tb) {
        float ss = 0.f;
#pragma unroll
        for (int vb = 0; vb < 2; ++vb)
#pragma unroll
            for (int i = 0; i < 16; ++i) ss += num[vb][tb][i] * num[vb][tb][i];
        ss = xh_sum(ss);
        const float rn = 1.0f / sqrtf(ss * (1.0f / 64.0f) + EPS);
#pragma unroll
        for (int vb = 0; vb < 2; ++vb)
#pragma unroll
            for (int i4 = 0; i4 < 4; ++i4) tl_put4(wl, 32 * tb + r, 32 * vb + 8 * i4 + 4 * hf, num[vb][tb][4 * i4] * rn, num[vb][tb][4 * i4 + 1] * rn, num[vb][tb][4 * i4 + 2] * rn, num[vb][tb][4 * i4 + 3] * rn);
    }
    tl_emit<2>(wl, lane, uptr(Z + zc(ZC_GG + hh * 64) + row0 * ZRS), (gcp)nullptr, F_gla_norm_g + layer * 256 + hh * 64, (GAS char*)uptr(F_Y + row0 * DM + 768 + hh * 64));
}

__device__ __forceinline__ void p2_local(Frame& F, int layer) {
    int gw_ = F.vcu * NWAVES + F.wave; asm volatile("" : "+s"(gw_));
    const int gw = gw_, NGW = F.G * NWAVES;
    LAS unsigned char* wl = F.lds + RING_OFF + F.wave * WL_BYTES;
    constexpr int NA = NCHT * 6, NL = NCHT * 10;
    if (NGW == 2048) {
#define LOCAL_TASK(q) do { const int q_ = (q); if (q_ < NA) ml_loc_wave(F, layer, q_ / 6, q_ % 6, wl); else gla_loc_wave(F, layer, (q_ - NA) >> 2, (q_ - NA) & 3, wl); } while (0)
#if PROBE_T
        if (gw < NA) { LOCAL_TASK(gw);
            const unsigned long long t0_ = __builtin_amdgcn_s_memrealtime();
            attn_wave(F, layer, gw / 6, gw % 6, wl);
            const unsigned dt_ = (unsigned)(__builtin_amdgcn_s_memrealtime() - t0_);
            if (layer == 0 && F_lane == 0) {
                if (PROBE_T == 11 && dt_ > 3500u) atomicAdd((unsigned*)(F_ctl + 2048), 100u);
                if (PROBE_T == 12 && dt_ > 4200u) atomicAdd((unsigned*)(F_ctl + 2048), 100u);
                if (PROBE_T == 13) atomicMax((unsigned*)(F_ctl + 2048), (dt_ << 11) | (unsigned)gw);
                if (PROBE_T == 14 && dt_ < 2600u) atomicAdd((unsigned*)(F_ctl + 2048), 100u);
                if (PROBE_T == 15) atomicAdd((unsigned*)(F_ctl + 2048), dt_ >> 4);
            } }
#else
        if (gw < NA) { LOCAL_TASK(gw); attn_wave(F, layer, gw / 6, gw % 6, wl); }
#endif
        else { const int q0 = NA + 2 * (gw - NA); for (int q = q0; q < q0 + 2; ++q) LOCAL_TASK(q); }
#undef LOCAL_TASK
    } else {
        for (int a = gw; a < NA; a += NGW) attn_wave(F, layer, a / 6, a % 6, wl);
        for (int q = gw; q < NL; q += NGW) { if (q < NA) ml_loc_wave(F, layer, q / 6, q % 6, wl); else gla_loc_wave(F, layer, (q - NA) >> 2, (q - NA) & 3, wl); }
    }
}
__device__ __forceinline__ void p4_outputs(Frame& F, int layer) {
    int gw_ = F.vcu * NWAVES + F.wave; asm volatile("" : "+s"(gw_));
    const int gw = gw_, NGW = F.G * NWAVES;
    LAS unsigned char* wl = F.lds + RING_OFF + F.wave * WL_BYTES;
    constexpr int NA = NCHT * 6, NG = NCHT * 4;
    if (NGW == 2048) {
        if (gw < NA) { ml_out_wave(F, layer, gw / 6, gw % 6, wl);
#if PROBE_DUP == 8
            ml_out_wave(F, layer, gw / 6, gw % 6, wl);
#endif
        }
        else { for (int q = gw - NA; q < NG; q += 512) gla_out_wave(F, layer, q >> 2, q & 3, wl);
#if PROBE_DUP == 9
            for (int q = gw - NA; q < NG; q += 512) gla_out_wave(F, layer, q >> 2, q & 3, wl);
#endif
        }
    } else {
        for (int a = gw; a < NA; a += NGW) ml_out_wave(F, layer, a / 6, a % 6, wl);
        for (int q = gw; q < NG; q += NGW) gla_out_wave(F, layer, q >> 2, q & 3, wl);
    }
}

__device__ __forceinline__ void p11_final(Frame& F) {
    int gw_ = F.vcu * NWAVES + F.wave; asm volatile("" : "+s"(gw_));
    const int gw = gw_, NGW = F.G * NWAVES;
    const float* ssq = F_SSQ + 2 * T;
    for (int m = gw; m < T; m += NGW) {
        const float rs = 1.0f / sqrtf(ssq[m] * (1.0f / 1024.0f) + EPS);
        const GAS unsigned long long* xr = (const GAS unsigned long long*)(F_XB + (size_t)m * DM) + F_lane;
        GAS f32x4* orow = (GAS f32x4*)(F_out + (size_t)m * DM) + F_lane; const GAS f32x4* gr = (const GAS f32x4*)F_final_g + F_lane;
#pragma unroll
        for (int j = 0; j < 4; ++j) { const unsigned long long w = xr[64 * j]; const f32x4 g = gr[64 * j];
            const f32x4 v = (f32x4){__uint_as_float((unsigned)w << 16), __uint_as_float((unsigned)w & 0xffff0000u), __uint_as_float((unsigned)(w >> 32) << 16), __uint_as_float((unsigned)(w >> 32) & 0xffff0000u)};
            orow[64 * j] = v * rs * g; }
    }
}

__global__ void __launch_bounds__(NTHR, 2) hymba_fwd(Args args) {
    extern __shared__ __attribute__((aligned(16))) unsigned char lds[];
    Frame F;
    F.lds = (LAS unsigned char*)lds;
    F.MISC = (volatile LAS unsigned*)(F.lds + MISC_OFF);
    F.wave = __builtin_amdgcn_readfirstlane(F_tid >> 6);
    F.G = gridDim.x; { const int bx = blockIdx.x; F.vcu = (F.G % 8 == 0) ? (bx % 8) * (F.G / 8) + bx / 8 : bx; }
    F.A = &args;
    for (int u = F_tid; u < (LDS_BYTES - LDSCTL_OFF) / 4; u += NTHR) ((LAS unsigned*)(F.lds + LDSCTL_OFF))[u] = 0u;
    __syncthreads();
    XcdBarrier bar; bar.bar = (unsigned*)(F_ctl + CW_BAR); bar.x = 0; bar.st = nullptr;
    if (N_LAUNCHES == 1) bar = xcd_barrier_post((unsigned*)(F_ctl + CW_BAR), F.MISC + 8);
#define GRID_BAR() do { if (N_LAUNCHES == 1) { XcdBarrier b2_ = bar; unsigned long long v_ = (unsigned long long)bar.bar; asm volatile("" : "+s"(v_)); b2_.bar = (unsigned*)v_; xcd_barrier(b2_); } } while (0)
#if PROBE_T == 16 || PROBE_T == 17
    const unsigned long long tk0_ = __builtin_amdgcn_s_memrealtime();
#endif
    const int lo = args.ph_lo, hi = args.ph_hi;
#pragma unroll 1
    for (int ph = lo; ph < hi; ++ph) {
        if (ph == 0) { p0_prologue(F);
#if PROBE_DUP == 4
            GRID_BAR(); p0_prologue(F);
#endif
        } else if (ph == NPHASE - 1) { p11_final(F);
        } else {
            const int layer = (ph - 1) / 5, k = (ph - 1) % 5;
            if (k == 0 || k == 4) {
                const int which = k ? 1 : 0, N = which ? DM : NP;
                pg8::Gemm g{which ? F_Y : F_XB, which ? F_Wout_t + (size_t)layer * DM * DM : F_Win_t + (size_t)layer * NP * DM, T, N, DM};
                pg8::EpiBoth E{which, pg8::EpiZ{F_Z, LDZ, F_SSQ + layer * T, F_G32, ZC_SM},
                               pg8::EpiRes{(const float*)nullptr, (const bf16*)F_XB, (float*)nullptr, F_XB, F_SSQ + (layer + 1) * T}};
                const bool split = (which == 0 && F.G == 256);
                { pg8::StaticOrder S; S.init(T, N, F.G, (int)blockIdx.x, split ? 1 : 0);
                  pg8::gemm_phase<pg8::EpiBoth, pg8::StaticOrder, true, true, false>(F.lds + RING_OFF, g, S, E); }
                if (split) {
                    pg8::StaticOrder S; S.init(T, N, F.G, (int)blockIdx.x, 2);
                    pg8::gemm_phase<pg8::EpiBoth, pg8::StaticOrder, true, true, true>(F.lds + RING_OFF, g, S, E);
                    if (ph == 1 && (int)blockIdx.x >= 128) { int wi_ = ((int)blockIdx.x - 128) * NWAVES + F.wave; asm volatile("" : "+s"(wi_)); p0_weights(F, 1, wi_, 128 * NWAVES); }
                }
            } else if (k == 1) { p2_local(F, layer);
#if PROBE_DUP == 2
                GRID_BAR(); p2_local(F, layer);
#endif
            } else if (k == 2) { p3_scan(F);
            } else { p4_outputs(F, layer);
#if PROBE_DUP == 3
                GRID_BAR(); p4_outputs(F, layer);
#endif
            }
        }
        if (ph + 1 < hi) GRID_BAR();
    }
#if PROBE_T
    if (F.vcu == 100 && F.wave == 0) { unsigned n_ = __hip_atomic_load((unsigned*)(F_ctl + 2048), __ATOMIC_RELAXED, __HIP_MEMORY_SCOPE_AGENT);
#if PROBE_T == 16
        n_ = (unsigned)((__builtin_amdgcn_s_memrealtime() - tk0_) >> 1);
#endif
        if (PROBE_T == 13) n_ = (n_ & 2047u) * 50u;
        if (PROBE_T >= 21 && PROBE_T <= 45) n_ = __hip_atomic_load((unsigned*)(F_ctl + 2049), __ATOMIC_RELAXED, __HIP_MEMORY_SCOPE_AGENT) * 10u;
        const unsigned long long t0_ = __builtin_amdgcn_s_memrealtime(); while (__builtin_amdgcn_s_memrealtime() - t0_ < n_) __builtin_amdgcn_s_sleep(8); }
#endif
}

extern "C" void kernel_launch(void* const* d_in, const int* in_sizes, int n_in, void* d_out, int out_size, void* d_ws, size_t ws_size, hipStream_t stream) {
    static int grid = 0;
    if (grid == 0) {
        if (n_in != 12 || in_sizes[0] != T * DM || out_size != T * DM || ws_size < WS_END) {
            fprintf(stderr, "kernel_launch: unexpected shapes (n_in %d, in0 %d, out %d, ws %zu, need %zu); nothing launched\n", n_in, n_in > 0 ? in_sizes[0] : -1, out_size, ws_size, (size_t)WS_END); grid = -1; return; }
        int dev = 0, cus = 0, per_cu = 0;
        if (hipGetDevice(&dev) != hipSuccess || hipDeviceGetAttribute(&cus, hipDeviceAttributeMultiprocessorCount, dev) != hipSuccess) { fprintf(stderr, "kernel_launch: device query failed\n"); grid = -1; return; }
        if (hipFuncSetAttribute((const void*)hymba_fwd, hipFuncAttributeMaxDynamicSharedMemorySize, LDS_BYTES) != hipSuccess) { fprintf(stderr, "kernel_launch: hipFuncSetAttribute failed\n"); grid = -1; return; }
        if (hipOccupancyMaxActiveBlocksPerMultiprocessor(&per_cu, (const void*)hymba_fwd, NTHR, LDS_BYTES) != hipSuccess || per_cu < 1) {
            fprintf(stderr, "kernel_launch: occupancy query reports %d workgroups per CU; nothing launched\n", per_cu); (void)hipGetLastError(); grid = -1; return; }
        grid = cus;
        fprintf(stderr, "kernel_launch: grid %d x %d threads, %d B LDS, occupancy query %d/CU\n", grid, NTHR, LDS_BYTES, per_cu);
    }
    if (grid < 0) return;
    if (hipMemsetAsync((char*)d_ws + WS_CTL, 0, CTL_ZERO_BYTES, stream) != hipSuccess) { fprintf(stderr, "kernel_launch: memset failed\n"); return; }
    Args a{};
    for (int i = 0; i < 12; ++i) a.in[i] = (const float*)d_in[i];
    a.out = (float*)d_out; a.ws = (unsigned char*)d_ws;
    if (N_LAUNCHES == 1) {
        a.ph_lo = 0; a.ph_hi = NPHASE; a.li = 0;
        void* kargs[] = {&a};
        hipError_t e = hipLaunchCooperativeKernel((const void*)hymba_fwd, dim3(grid), dim3(NTHR), kargs, LDS_BYTES, stream);
        if (e != hipSuccess) fprintf(stderr, "kernel_launch: cooperative launch failed: %s\n", hipGetErrorString(e));
    } else {
        for (int p = 0; p < NPHASE; ++p) { a.ph_lo = p; a.ph_hi = p + 1; a.li = p;
            hipLaunchKernelGGL(hymba_fwd, dim3(grid), dim3(NTHR), LDS_BYTES, stream, a);
            if (hipPeekAtLastError() != hipSuccess) { fprintf(stderr, "kernel_launch: launch %d failed\n", p); break; } }
    }
}
```

```cpp
#include <hip/hip_runtime.h>
#include <cstdio>
#include <cstdint>
#include <cmath>

#ifndef PROBE_DUP
#define PROBE_DUP 0
#endif
#ifndef PROBE_T
#define PROBE_T 0
#endif
#ifndef MK_N_LAUNCHES
#define MK_N_LAUNCHES 1
#endif

namespace pg8 {
#define PG8_LAS __attribute__((address_space(3)))
typedef unsigned short bf16_t;
typedef short bf16x8 __attribute__((ext_vector_type(8)));
typedef float f32x4 __attribute__((ext_vector_type(4)));
typedef unsigned u32x4 __attribute__((ext_vector_type(4)));
constexpr int BM = 256, BK = 64, HALF = 128, HTB = HALF * BK * 2  , STAGE_BYTES = 8 * HTB, NXCD = 8, WGM = 8;

__host__ __device__ __forceinline__ int lds_byte(int r, int c) { const int st = (r >> 4) * 2 + (c >> 5), rr = r & 15, cc = c & 31, ob = rr * 64 + cc * 2; return st * 1024 + (ob ^ (((ob >> 9) & 1) << 5)); }
__host__ __device__ __forceinline__ void stage_rc(int b, int& R, int& C) { const int st = b / 1024, sb = b % 1024, swz = sb ^ (((sb >> 9) & 1) << 5); R = (st >> 1) * 16 + swz / 64; C = (st & 1) * 32 + (swz % 64) / 2; }
__host__ __device__ __forceinline__ int perm32(int rho) { const int n = rho >> 4, i = rho & 15; return 8 * (i >> 2) + 4 * n + (i & 3); }

struct Unit { int pm, pn, roff, half; };
struct Gemm { const bf16_t* A; const bf16_t* Bt; int M, N, K; };

struct StaticOrder {
    int nM, nN, nwg, G, c, mode;
    __host__ __device__ void init(int M, int N, int G_, int c_, int mode_ = 0) { nM = M / BM; nN = N / BM - (mode_ ? 1 : 0); nwg = nM * nN; G = G_; c = c_; mode = mode_; }
    __host__ __device__ bool next(int i, Unit& u) const {
        const long L = (long)i * G + c;
        if (mode == 2) { if (L >= 2 * nM) return false; u = Unit{(int)(L >> 1), nN, (int)(L & 1) * 128, 1}; return true; }
        if (L >= nwg) return false;
        int wgid = (int)L; { const int q = nwg / NXCD, r = nwg % NXCD, xcd = wgid % NXCD, off = wgid / NXCD; wgid = (xcd < r ? xcd * (q + 1) : r * (q + 1) + (xcd - r) * q) + off; }
        const int nig = WGM * nN, gid = wgid / nig, fm = gid * WGM, gsz = (nM - fm) < WGM ? (nM - fm) : WGM;
        u = Unit{fm + ((wgid % nig) % gsz), (wgid % nig) / gsz, 0, 0}; return true;
    }
    __device__ __forceinline__ void a_ready(const Unit&) const {}
    __device__ __forceinline__ void done(const Unit&) const {}
};

__device__ __forceinline__ unsigned cvt_pk_bf16(float lo, float hi) { unsigned r; asm volatile("v_cvt_pk_bf16_f32 %0, %1, %2" : "=v"(r) : "v"(lo), "v"(hi)); return r; }

typedef unsigned u32x2 __attribute__((ext_vector_type(2)));
struct EpiZ {
    bf16_t* Z; int ldz; const float* ssq; float* G32; int gcol0;
    __device__ __forceinline__ void operator()(const f32x4 (&acc)[2][2][4][2], const Unit& u, int wr, int wc, int fr, int fq) const {
        const int row0 = u.pm * BM + u.roff + wr * 64 + fr, col0 = u.pn * BM + wc * 32 + 8 * fq;
#pragma unroll
        for (int ai = 0; ai < 2; ++ai)
#pragma unroll
            for (int m = 0; m < 4; ++m) {
                if (ai == 1 && u.half) continue;
                const int row = row0 + ai * HALF + m * 16;
                const float rs = 1.0f / sqrtf(ssq[row] * (1.0f / 1024.0f) + 1e-6f);
#pragma unroll
                for (int bj = 0; bj < 2; ++bj) {
                    const int col = col0 + bj * HALF;
                    const f32x4 v0 = acc[ai][bj][m][0] * rs, v1 = acc[ai][bj][m][1] * rs;
                    if (col < ldz) {
                        u32x4 w; w.x = cvt_pk_bf16(v0[0], v0[1]); w.y = cvt_pk_bf16(v0[2], v0[3]); w.z = cvt_pk_bf16(v1[0], v1[1]); w.w = cvt_pk_bf16(v1[2], v1[3]);
                        *(u32x4*)(Z + (size_t)(col >> 6) * ((size_t)16384 * 64) + (size_t)row * 64 + (col & 63)) = w;
                    } else if (col < gcol0 + 32) {
                        float* gp = G32 + (size_t)row * 32 + (col - gcol0);
                        *(f32x4*)gp = v0; *(f32x4*)(gp + 4) = v1;
                    }
                }
            }
    }
};
struct EpiRes {
    const float* base; const bf16_t* baseb; float* out; bf16_t* xb; float* ssq;
    __device__ __forceinline__ void ldres(int row, int col0, int bj, f32x4& r0, f32x4& r1) const {
        const size_t off = (size_t)row * 1024 + col0 + bj * HALF;
        if (base) { r0 = *(const f32x4*)(base + off); r1 = *(const f32x4*)(base + off + 4); }
        else { const u32x4 w = *(const u32x4*)(baseb + off);
            r0 = (f32x4){__uint_as_float(w.x << 16), __uint_as_float(w.x & 0xffff0000u), __uint_as_float(w.y << 16), __uint_as_float(w.y & 0xffff0000u)};
            r1 = (f32x4){__uint_as_float(w.z << 16), __uint_as_float(w.z & 0xffff0000u), __uint_as_float(w.w << 16), __uint_as_float(w.w & 0xffff0000u)}; }
    }
    __device__ __forceinline__ void operator()(const f32x4 (&acc)[2][2][4][2], const Unit& u, int wr, int wc, int fr, int fq) const {
        const int col0 = u.pn * BM + wc * 32 + 8 * fq;
        f32x4 pre[2][2];
        { const int row = u.pm * BM + wr * 64 + fr;
#pragma unroll
          for (int bj = 0; bj < 2; ++bj) ldres(row, col0, bj, pre[bj][0], pre[bj][1]); }
#pragma unroll
        for (int g = 0; g < 8; ++g) {
            const int ai = g >> 2, m = g & 3;
            const int row = u.pm * BM + ai * HALF + wr * 64 + m * 16 + fr;
            f32x4 nxt[2][2];
            if (g < 7) { const int row2 = u.pm * BM + ((g + 1) >> 2) * HALF + wr * 64 + ((g + 1) & 3) * 16 + fr;
#pragma unroll
                for (int bj = 0; bj < 2; ++bj) ldres(row2, col0, bj, nxt[bj][0], nxt[bj][1]); }
            asm volatile("" ::: "memory");
            float s = 0.f;
#pragma unroll
            for (int bj = 0; bj < 2; ++bj) {
                const size_t off = (size_t)row * 1024 + col0 + bj * HALF;
                const f32x4 o0 = pre[bj][0] + acc[ai][bj][m][0], o1 = pre[bj][1] + acc[ai][bj][m][1];
                if (out) { *(f32x4*)(out + off) = o0; *(f32x4*)(out + off + 4) = o1; }
                s += (o0[0] * o0[0] + o0[1] * o0[1]) + (o0[2] * o0[2] + o0[3] * o0[3]) + (o1[0] * o1[0] + o1[1] * o1[1]) + (o1[2] * o1[2] + o1[3] * o1[3]);
                if (xb) { u32x4 w; w.x = cvt_pk_bf16(o0[0], o0[1]); w.y = cvt_pk_bf16(o0[2], o0[3]); w.z = cvt_pk_bf16(o1[0], o1[1]); w.w = cvt_pk_bf16(o1[2], o1[3]); *(u32x4*)(xb + off) = w; }
            }
            s += __shfl_xor(s, 16); s += __shfl_xor(s, 32);
            if (fq == 0) atomicAdd(ssq + row, s);
            asm volatile("" ::: "memory");
            if (g < 7) {
#pragma unroll
                for (int bj = 0; bj < 2; ++bj) { pre[bj][0] = nxt[bj][0]; pre[bj][1] = nxt[bj][1]; } }
        }
    }
};
struct EpiBoth {
    static constexpr bool PERM = true, AFTER_DRAIN = false;
    int mode; EpiZ z; EpiRes r;
    __device__ __forceinline__ void operator()(const f32x4 (&acc)[2][2][4][2], const Unit& u, int wr, int wc, int fr, int fq) const {
        if (mode == 0) z(acc, u, wr, wc, fr, fq); else r(acc, u, wr, wc, fr, fq);
    }
};

template <class Epi, class Sched, bool ALIGN_EPI = false, bool SP2 = false, bool HALFM = false>
__device__ __forceinline__ void gemm_phase(PG8_LAS unsigned char* lds, const Gemm g, const Sched& S, const Epi& E) {
    int tid_ = threadIdx.x; asm volatile("" : "+v"(tid_));
    const int tid = tid_, wid = __builtin_amdgcn_readfirstlane(tid >> 6), lane = tid & 63, wr = wid >> 2, wc = wid & 3, fr = lane & 15, fq = lane >> 4;
    const int K = g.K, nt = K / BK;
    unsigned voffA[2], voffB[2];
#pragma unroll
    for (int i = 0; i < 2; ++i) { int R, C; stage_rc(tid * 16 + i * 8192, R, C); const int Rb = Epi::PERM ? ((R & ~31) + perm32(R & 31)) : R;
        voffA[i] = (unsigned)(R * K + C) * 2u; voffB[i] = (unsigned)(Rb * K + C) * 2u; }
    const size_t kstep = (size_t)(BK * 2);
    const size_t hstep = (size_t)HALF * K * 2;
    const size_t tstep = 2 * hstep;
    const unsigned ldsw = (unsigned)wid * 1024u;
    const int aoff = lds_byte(wr * 64 + fr, fq * 8), boff = lds_byte(wc * 32 + fr, fq * 8);
#define PG8_SA(b, h) (((b) * 2 + (h)) * HTB)
#define PG8_SB(b, h) ((4 + (b) * 2 + (h)) * HTB)
#define PG8_STAGE(bufoff, gbase, voff) do { _Pragma("unroll") for (int _i = 0; _i < 2; ++_i) \
        __builtin_amdgcn_global_load_lds((const unsigned*)((const char*)(gbase) + (voff)[_i]), (PG8_LAS unsigned*)(lds + (bufoff) + ldsw + _i * 8192), 16, 0, 0); } while (0)
#define PG8_LDA(dst, b, h) do { _Pragma("unroll") for (int m = 0; m < 4; ++m) _Pragma("unroll") for (int k = 0; k < 2; ++k) dst[m][k] = *(const PG8_LAS bf16x8*)(lds + PG8_SA(b, h) + aoff + m * 2048 + k * 1024); } while (0)
#define PG8_LDB(dst, b, h) do { _Pragma("unroll") for (int n = 0; n < 2; ++n) _Pragma("unroll") for (int k = 0; k < 2; ++k) dst[n][k] = *(const PG8_LAS bf16x8*)(lds + PG8_SB(b, h) + boff + n * 2048 + k * 1024); } while (0)
#define PG8_MMA(ai, bj, At, Bt) do { __builtin_amdgcn_s_setprio(1); _Pragma("unroll") for (int m = 0; m < 4; ++m) _Pragma("unroll") for (int n = 0; n < 2; ++n) _Pragma("unroll") for (int k = 0; k < 2; ++k) \
        acc[ai][bj][m][n] = __builtin_amdgcn_mfma_f32_16x16x32_bf16(Bt[n][k], At[m][k], acc[ai][bj][m][n], 0, 0, 0); __builtin_amdgcn_s_setprio(0); } while (0)
#define PG8_WAIT_V(n) asm volatile("s_waitcnt vmcnt(" #n ")" ::: "memory")
#define PG8_WAIT_L(n) asm volatile("s_waitcnt lgkmcnt(" #n ")" ::: "memory")
#define PG8_BAR __builtin_amdgcn_s_barrier()
#define PG8_SCHED __builtin_amdgcn_sched_barrier(0)
    Unit cur, nxt; int ui = 0;
    if (!S.next(0, cur)) return;
    f32x4 acc[2][2][4][2];
#pragma unroll
    for (int a = 0; a < 2; ++a)
#pragma unroll
        for (int b = 0; b < 2; ++b)
#pragma unroll
            for (int m = 0; m < 4; ++m)
#pragma unroll
                for (int n = 0; n < 2; ++n) acc[a][b][m][n] = (f32x4){0.f, 0.f, 0.f, 0.f};
    bf16x8 At[4][2], B0[2][2], B1[2][2];
    const char* cA = (const char*)g.A + (size_t)cur.pm * tstep + (size_t)cur.roff * K * 2; const char* cB = (const char*)g.Bt + (size_t)cur.pn * tstep;
    S.a_ready(cur);
    if constexpr (SP2) {
        PG8_STAGE(PG8_SB(0, 0), cB, voffB); PG8_STAGE(PG8_SB(0, 1), cB + hstep, voffB); PG8_STAGE(PG8_SA(0, 0), cA, voffA); PG8_STAGE(PG8_SA(0, 1), cA + hstep, voffA);
        if (wr == 1) PG8_BAR;
        PG8_WAIT_V(2); PG8_BAR;
        PG8_STAGE(PG8_SB(1, 0), cB + kstep, voffB); PG8_STAGE(PG8_SA(1, 0), cA + kstep, voffA); PG8_STAGE(PG8_SB(1, 1), cB + hstep + kstep, voffB);
        PG8_WAIT_V(6); PG8_BAR;
    } else {
        PG8_STAGE(PG8_SB(0, 0), cB, voffB); PG8_STAGE(PG8_SA(0, 0), cA, voffA); PG8_STAGE(PG8_SB(0, 1), cB + hstep, voffB); PG8_STAGE(PG8_SA(0, 1), cA + hstep, voffA);
        if (wr == 1) PG8_BAR;
        PG8_WAIT_V(4); PG8_BAR;
        PG8_STAGE(PG8_SB(1, 0), cB + kstep, voffB); PG8_STAGE(PG8_SA(1, 0), cA + kstep, voffA); PG8_STAGE(PG8_SB(1, 1), cB + hstep + kstep, voffB);
        PG8_WAIT_V(6); PG8_BAR;
    }
    for (;;) {
        const bool has_next = S.next(ui + 1, nxt);
        const char* nA = has_next ? (const char*)g.A + (size_t)nxt.pm * tstep + (size_t)nxt.roff * K * 2 : cA; const char* nB = has_next ? (const char*)g.Bt + (size_t)nxt.pn * tstep : cB;
        for (int t = 0; t < nt; t += 2) {
            const bool last = (t == nt - 2);
            const char* a1 = cA + (size_t)(t + 1) * kstep;
            const char* a2 = last ? nA : cA + (size_t)(t + 2) * kstep; const char* b2 = last ? nB : cB + (size_t)(t + 2) * kstep;
            const char* a3 = a2 + kstep; const char* b3 = b2 + kstep;
            if (last && has_next) S.a_ready(nxt);
            if constexpr (SP2) {
            PG8_LDB(B0, 0, 0); PG8_LDB(B1, 0, 1); PG8_SCHED; PG8_LDA(At, 0, 0); PG8_STAGE(PG8_SA(1, 1), a1 + hstep, voffA);
            PG8_WAIT_V(8); PG8_WAIT_L(0); PG8_BAR; PG8_MMA(0, 0, At, B0); PG8_MMA(0, 1, At, B1); PG8_BAR; PG8_SCHED;
            PG8_LDA(At, 0, 1); PG8_STAGE(PG8_SB(0, 0), b2, voffB); PG8_STAGE(PG8_SB(0, 1), b2 + hstep, voffB); PG8_STAGE(PG8_SA(0, 0), a2, voffA);
            PG8_WAIT_V(8); PG8_WAIT_L(0); PG8_BAR; if constexpr (!HALFM) { PG8_MMA(1, 0, At, B0); PG8_MMA(1, 1, At, B1); } PG8_BAR; PG8_SCHED;
            PG8_LDB(B0, 1, 0); PG8_LDB(B1, 1, 1); PG8_SCHED; PG8_LDA(At, 1, 0); PG8_STAGE(PG8_SA(0, 1), a2 + hstep, voffA);
            PG8_WAIT_V(8); PG8_WAIT_L(0); PG8_BAR; PG8_MMA(0, 0, At, B0); PG8_MMA(0, 1, At, B1); PG8_BAR; PG8_SCHED;
            PG8_LDA(At, 1, 1); PG8_STAGE(PG8_SB(1, 0), b3, voffB); PG8_STAGE(PG8_SB(1, 1), b3 + hstep, voffB); PG8_STAGE(PG8_SA(1, 0), a3, voffA);
            PG8_WAIT_V(8); PG8_WAIT_L(0); PG8_BAR; if constexpr (!HALFM) { PG8_MMA(1, 0, At, B0); PG8_MMA(1, 1, At, B1); } PG8_BAR; PG8_SCHED;
            } else {
            PG8_LDB(B0, 0, 0); PG8_SCHED; PG8_LDA(At, 0, 0); PG8_STAGE(PG8_SA(1, 1), a1 + hstep, voffA);
            PG8_WAIT_L(8); PG8_BAR; PG8_WAIT_L(0); PG8_MMA(0, 0, At, B0); PG8_BAR; PG8_SCHED;
            PG8_LDB(B1, 0, 1); PG8_STAGE(PG8_SB(0, 0), b2, voffB);
            PG8_BAR; PG8_WAIT_L(0); PG8_MMA(0, 1, At, B1); PG8_BAR;
            PG8_LDA(At, 0, 1); PG8_STAGE(PG8_SA(0, 0), a2, voffA);
            PG8_BAR; PG8_WAIT_L(0); PG8_MMA(1, 0, At, B0); PG8_BAR; PG8_SCHED;
            PG8_STAGE(PG8_SB(0, 1), b2 + hstep, voffB);
            PG8_WAIT_V(6); PG8_BAR; PG8_MMA(1, 1, At, B1); PG8_BAR;
            PG8_LDB(B0, 1, 0); PG8_SCHED; PG8_LDA(At, 1, 0); PG8_STAGE(PG8_SA(0, 1), a2 + hstep, voffA);
            PG8_WAIT_L(8); PG8_BAR; PG8_WAIT_L(0); PG8_MMA(0, 0, At, B0); PG8_BAR; PG8_SCHED;
            PG8_LDB(B1, 1, 1); PG8_STAGE(PG8_SB(1, 0), b3, voffB);
            PG8_BAR; PG8_WAIT_L(0); PG8_MMA(0, 1, At, B1); PG8_BAR;
            PG8_LDA(At, 1, 1); PG8_STAGE(PG8_SA(1, 0), a3, voffA);
            PG8_BAR; PG8_WAIT_L(0); PG8_MMA(1, 0, At, B0); PG8_BAR; PG8_SCHED;
            PG8_STAGE(PG8_SB(1, 1), b3 + hstep, voffB);
            PG8_WAIT_V(6); PG8_BAR; PG8_MMA(1, 1, At, B1); PG8_BAR;
            }
        }
        if constexpr (ALIGN_EPI) { if (wr == 0) PG8_BAR; }
        if constexpr (!Epi::AFTER_DRAIN) { E(acc, cur, wr, wc, fr, fq); S.done(cur); }
        if (!has_next) break;
#pragma unroll
        for (int a = 0; a < 2; ++a)
#pragma unroll
            for (int b = 0; b < 2; ++b)
#pragma unroll
                for (int m = 0; m < 4; ++m)
#pragma unroll
                    for (int n = 0; n < 2; ++n) acc[a][b][m][n] = (f32x4){0.f, 0.f, 0.f, 0.f};
        cur = nxt; cA = nA; cB = nB; ++ui;
        if constexpr (ALIGN_EPI) { if (wr == 1) PG8_BAR; }
    }
    PG8_WAIT_V(0);
    if constexpr (!ALIGN_EPI) { if (wr == 0) PG8_BAR; }
    PG8_BAR;
    if constexpr (Epi::AFTER_DRAIN) { E.fused(acc, cur, wr, wc, fr, fq, lds, wid, lane); S.done(cur); }
#undef PG8_SA
#undef PG8_SB
#undef PG8_STAGE
#undef PG8_LDA
#undef PG8_LDB
#undef PG8_MMA
#undef PG8_WAIT_V
#undef PG8_WAIT_L
#undef PG8_BAR
#undef PG8_SCHED
}
}

constexpr int NWAVES = 8, NTHR = 512;
constexpr int N_LAUNCHES = MK_N_LAUNCHES;
constexpr int NPHASE = 12;
constexpr int BATCH = 2, SEQ = 8192, DM = 1024, T = BATCH * SEQ, DEPTH = 2, CH = 64, NCHT = T / CH  , NCHS = SEQ / CH  ;
constexpr int DIN = 4252, NP = 4352, LDZ = 4224;
constexpr int ZC_AQ = 0, ZC_AK = 384, ZC_AV = 768, ZC_AG = 1152, ZC_MQ = 1536, ZC_MK = 1920, ZC_MV = 2304, ZC_MO = 2688, ZC_MG = 3072, ZC_GQ = 3456, ZC_GK = 3584, ZC_GV = 3712, ZC_GG = 3968, ZC_SM = 4224;
constexpr float EPS = 1e-6f;
__host__ __device__ __forceinline__ int src_col(int n) {
    if (n < 3072) return n;
    if (n < 3968) return n + 12;
    if (n < 4224) return n + 28;
    if (n < 4236) return n - 1152;
    if (n < 4252) return n - 256;
    return -1;
}

constexpr size_t MiB = 1u << 20;
constexpr size_t WS_CTL = 0, CTL_ZERO_BYTES = 1 * MiB;
constexpr size_t WS_SSQ = 512 * 1024;
constexpr size_t WS_WIN = 1 * MiB;
constexpr size_t WS_WOUT = WS_WIN + (size_t)2 * NP * DM * 2;
constexpr size_t WS_XB = WS_WOUT + (size_t)2 * DM * DM * 2;
constexpr size_t WS_Y = WS_XB + (size_t)T * DM * 2;
constexpr size_t WS_Z = WS_Y + (size_t)T * DM * 2;
constexpr size_t WS_G32 = WS_Z + (size_t)T * LDZ * 2;
constexpr size_t WS_CST = WS_G32 + (size_t)T * 32 * 4;
constexpr size_t WS_NST = WS_CST + (size_t)NCHT * 6 * 4096 * 4;
constexpr size_t WS_SST = WS_NST + (size_t)NCHT * 6 * 64 * 4;
constexpr size_t WS_ADEC = WS_SST + (size_t)NCHT * 4 * 2048 * 4;
constexpr size_t WS_GS = WS_ADEC + (size_t)NCHT * 4 * 32 * 4;
constexpr size_t WS_MS = WS_GS + 8192;
constexpr size_t WS_MP = WS_MS + 8192;
constexpr size_t WS_END = WS_MP + 8192;
static_assert(WS_END <= 268435456, "d_ws map exceeds 256 MiB");
constexpr int CW_BAR = 4096;

constexpr int RING_OFF = 0, RING_BYTES = 162816;
constexpr int WL_BYTES = 20352;
constexpr int LDSCTL_OFF = RING_BYTES, MISC_OFF = LDSCTL_OFF + 320;
constexpr int LDS_BYTES = 163840;
#define GAS __attribute__((address_space(1)))
#define LAS __attribute__((address_space(3)))
typedef unsigned short bf16;
typedef unsigned v4u __attribute__((ext_vector_type(4)));
typedef float f32x4 __attribute__((ext_vector_type(4)));
typedef short bf16x8 __attribute__((ext_vector_type(8)));
typedef GAS unsigned gu32;
typedef GAS unsigned long long gu64;
#define RLX_AGENT __ATOMIC_RELAXED, __HIP_MEMORY_SCOPE_AGENT
#define LDS_WAIT() asm volatile("s_waitcnt lgkmcnt(0)" ::: "memory")
#define VM_WAIT() asm volatile("s_waitcnt vmcnt(0)" ::: "memory")
__device__ __forceinline__ unsigned long long rt() { return __builtin_amdgcn_s_memrealtime(); }
__device__ __forceinline__ unsigned f2bf(float f) { unsigned u = __builtin_bit_cast(unsigned, f); return (u + 0x7fffu + ((u >> 16) & 1u)) >> 16; }
__device__ __forceinline__ unsigned pk2(float lo, float hi) { return f2bf(lo) | (f2bf(hi) << 16); }

#define XB_TMO      128
#define XB_XCNT(j)  (256  + 64 * (j))
#define XB_XSUB(j)  (1280 + 64 * (j))
#define XB_XGEN(j)  (2304 + 64 * (j))
#define XB_TOP      3328
#define XB_TOPGEN   3392
#define XCD_BAR_WORDS 3456
#define XB_SPIN_CAP (1u << 18)

__device__ __forceinline__ unsigned xb_ld(unsigned* p)              { return __hip_atomic_load(p, __ATOMIC_RELAXED, __HIP_MEMORY_SCOPE_AGENT); }
__device__ __forceinline__ unsigned xb_add(unsigned* p, unsigned v) { return __hip_atomic_fetch_add(p, v, __ATOMIC_RELAXED, __HIP_MEMORY_SCOPE_AGENT); }
__device__ __forceinline__ unsigned xb_xcc_id() { return (unsigned)__builtin_amdgcn_s_getreg((3 << 11) | 20) & 0xFu; }
#define XB_SPIN(cond, bar) do { unsigned _sp = 0; while (cond) { __builtin_amdgcn_s_sleep(1); \
    if ((++_sp & 255u) == 0u) { if (xb_ld(&(bar)[XB_TMO])) break; if (_sp > XB_SPIN_CAP) { atomicAdd(&(bar)[XB_TMO], 1u); break; } } } } while (0)

struct XcdBarrier {
    unsigned* bar; unsigned x;
    volatile LAS unsigned* st;
};

__device__ __forceinline__ XcdBarrier xcd_barrier_post(unsigned* bar, volatile LAS unsigned* st) {
    XcdBarrier b; b.bar = bar; b.x = xb_xcc_id(); b.st = st;
    if (threadIdx.x == 0) (void)xb_add(&bar[XB_XCNT(b.x)], 1u);
    return b;
}
__device__ __forceinline__ void xcd_barrier_complete(unsigned* bar, unsigned x, unsigned& nloc, unsigned& nx) {
    const unsigned G = gridDim.x * gridDim.y * gridDim.z;
    unsigned sum, cnt, mine, sp = 0u;
    for (;;) {
        sum = 0u; cnt = 0u; mine = 0u;
#pragma unroll 1
        for (unsigned j = 0; j < 16; ++j) { const unsigned c = xb_ld(&bar[XB_XCNT(j)]); sum += c; cnt += (c > 0u) ? 1u : 0u; mine = (j == x) ? c : mine; }
        if (sum == G) break;
        __builtin_amdgcn_s_sleep(1);
        if ((++sp & 255u) == 0u) { if (xb_ld(&bar[XB_TMO])) break; if (sp > XB_SPIN_CAP) { atomicAdd(&bar[XB_TMO], 1u); break; } }
    }
    nloc = mine > 0u ? mine : 1u; nx = cnt > 0u ? cnt : 1u;
}

__device__ __forceinline__ void xcd_barrier(const XcdBarrier& b) {
    asm volatile("s_waitcnt vmcnt(0)" ::: "memory");
    __syncthreads();
    if (threadIdx.x == 0) {
        unsigned* bar = b.bar;
        __builtin_amdgcn_s_waitcnt(0);
        unsigned nloc = b.st[0], nx = b.st[1];
        if (nloc == 0u) { xcd_barrier_complete(bar, b.x, nloc, nx); b.st[0] = nloc; b.st[1] = nx; }
        const unsigned old = xb_add(&bar[XB_XSUB(b.x)], 1u);
        const unsigned gen = old / nloc;
        if (old + 1u == (gen + 1u) * nloc) {
            __builtin_amdgcn_fence(__ATOMIC_RELEASE, "agent");
            asm volatile("s_waitcnt vmcnt(0)" ::: "memory");
            const unsigned og = xb_add(&bar[XB_TOP], 1u);
            const unsigned tg = og / nx;
            if (og + 1u == (tg + 1u) * nx) xb_add(&bar[XB_TOPGEN], 1u);
            else XB_SPIN(xb_ld(&bar[XB_TOPGEN]) == tg, bar);
            __builtin_amdgcn_fence(__ATOMIC_ACQUIRE, "agent");
            xb_add(&bar[XB_XGEN(b.x)], 1u);
            asm volatile("s_waitcnt vmcnt(0)" ::: "memory");
        } else {
            XB_SPIN(xb_ld(&bar[XB_XGEN(b.x)]) == gen, bar);
            __builtin_amdgcn_fence(__ATOMIC_ACQUIRE, "agent");
            asm volatile("s_waitcnt vmcnt(0)" ::: "memory");
        }
    }
    __syncthreads();
}


struct Args { const float* in[12]; float* out; unsigned char* ws; int ph_lo, ph_hi, li, pad; };
struct Frame {
    LAS unsigned char* lds;
    volatile LAS unsigned* MISC;
    const Args* A;
    int wave, vcu, G;
};
__device__ __forceinline__ int opaque_tid() { int t = threadIdx.x; asm volatile("" : "+v"(t)); return t; }
#define F_tid (opaque_tid())
#define F_lane (opaque_tid() & 63)
__device__ __forceinline__ const Args* opaque_args(const Args* a) { unsigned long long v = (unsigned long long)a; asm volatile("" : "+s"(v)); return (const Args*)v; }
#define F_A (F.A)
#define F_x          (F_A->in[0])
#define F_norm_g     (F_A->in[1])
#define F_w_in       (F_A->in[2])
#define F_b_gates    (F_A->in[3])
#define F_conv_w     (F_A->in[4])
#define F_w_alpha    (F_A->in[5])
#define F_b_alpha    (F_A->in[6])
#define F_rel_bias   (F_A->in[7])
#define F_ml_norm_g  (F_A->in[8])
#define F_gla_norm_g (F_A->in[9])
#define F_w_out      (F_A->in[10])
#define F_final_g    (F_A->in[11])
#define F_out        (F_A->out)
#define F_ws         (F_A->ws)
#define F_ctl        ((gu32*)(F_ws + WS_CTL))
#define F_Win_t      ((bf16*)(F_ws + WS_WIN))
#define F_Wout_t     ((bf16*)(F_ws + WS_WOUT))
#define F_XB         ((bf16*)(F_ws + WS_XB))
#define F_Y          ((bf16*)(F_ws + WS_Y))
#define F_Z          ((bf16*)(F_ws + WS_Z))
#define F_G32        ((float*)(F_ws + WS_G32))
#define F_SSQ        ((float*)(F_ws + WS_SSQ))
#define F_CST        ((float*)(F_ws + WS_CST))
#define F_NST        ((float*)(F_ws + WS_NST))
#define F_SST        ((float*)(F_ws + WS_SST))
#define F_ADEC       ((float*)(F_ws + WS_ADEC))
#define F_GS         ((float*)(F_ws + WS_GS))
#define F_MS         ((float*)(F_ws + WS_MS))
#define F_MP         ((float*)(F_ws + WS_MP))
#define F_BC         (F_out)
#define F_CPB        ((bf16*)(F_out + (size_t)T * 128))
__device__ __forceinline__ float bf2f(unsigned short u) { return __uint_as_float((unsigned)u << 16); }
__device__ __forceinline__ float wave_sum(float v) {
#pragma unroll
    for (int o = 1; o < 64; o <<= 1) v += __shfl_xor(v, o);
    return v;
}
__device__ __forceinline__ float siluf(float x) { return x / (1.0f + expf(-x)); }
__device__ __forceinline__ float sigmf(float x) { return 1.0f / (1.0f + expf(-x)); }
__device__ __forceinline__ float logsigf(float x) { return fminf(x, 0.f) - log1pf(expf(-fabsf(x))); }
__device__ __forceinline__ void ld8(const bf16* p, float* o) {
    const v4u w = *(const v4u*)p;
    o[0] = __uint_as_float(w.x << 16); o[1] = __uint_as_float(w.x & 0xffff0000u); o[2] = __uint_as_float(w.y << 16); o[3] = __uint_as_float(w.y & 0xffff0000u);
    o[4] = __uint_as_float(w.z << 16); o[5] = __uint_as_float(w.z & 0xffff0000u); o[6] = __uint_as_float(w.w << 16); o[7] = __uint_as_float(w.w & 0xffff0000u);
}

template <bool PERMUTE>
__device__ __forceinline__ void p0_transpose_item(const float* W, int Nsrc, int Ndst, const float* gk, bf16* WT, LAS float* scr, int item, int lane) {
    const int nblk = Ndst / 32, kb = item / nblk, nb = item % nblk, k0 = 64 * kb, n0 = 32 * nb;
    const int nd = n0 + (lane & 31), ns = PERMUTE ? src_col(nd) : nd;
    float tv_[32], tg_[32];
#pragma unroll
    for (int i = 0; i < 32; ++i) { const int kk = 2 * i + (lane >> 5);
        tv_[i] = (ns >= 0) ? W[(size_t)(k0 + kk) * Nsrc + ns] : 0.f; tg_[i] = gk ? gk[k0 + kk] : 1.f; }
#pragma unroll
    for (int i = 0; i < 32; ++i) { const int kk = 2 * i + (lane >> 5); scr[kk * 33 + (lane & 31)] = tv_[i] * tg_[i]; }
    LDS_WAIT(); asm volatile("" ::: "memory");
    const int c = lane & 7;
#pragma unroll
    for (int j = 0; j < 4; ++j) { const int n = (lane >> 3) + 8 * j; const LAS float* s = scr + (8 * c) * 33 + n;
        v4u o; o.x = pk2(s[0 * 33], s[1 * 33]); o.y = pk2(s[2 * 33], s[3 * 33]); o.z = pk2(s[4 * 33], s[5 * 33]); o.w = pk2(s[6 * 33], s[7 * 33]);
        *(GAS v4u*)(WT + (size_t)(n0 + n) * 1024 + k0 + 8 * c) = o; }
    LDS_WAIT(); asm volatile("" ::: "memory");
}
__device__ __forceinline__ void p0_weights(Frame& F, int l, int wi, int nw) {
    LAS float* scr = (LAS float*)(F.lds + RING_OFF + F.wave * 16384);
    constexpr int I_IN = 16 * (NP / 32), I_OUT = 16 * (DM / 32);
    for (int it = wi; it < I_IN + I_OUT; it += nw) {
        if (it < I_IN) p0_transpose_item<true>(F_w_in + (size_t)l * DM * DIN, DIN, NP, F_norm_g + l * DM, F_Win_t + (size_t)l * NP * DM, scr, it, F_lane);
        else p0_transpose_item<false>(F_w_out + (size_t)l * DM * DM, DM, DM, nullptr, F_Wout_t + (size_t)l * DM * DM, scr, it - I_IN, F_lane);
    }
}
__device__ __forceinline__ void p0_prologue(Frame& F) {
    int gw_ = F.vcu * NWAVES + F.wave; asm volatile("" : "+s"(gw_));
    const int gw = gw_, NGW = F.G * NWAVES;
    p0_weights(F, 0, gw, NGW);
    if (F.G != 256) p0_weights(F, 1, gw, NGW);
    for (int m0 = gw; m0 < T; m0 += 4 * NGW) {
        f32x4 v[4][4];
#pragma unroll
        for (int i = 0; i < 4; ++i) { const int m = (m0 + i * NGW < T) ? m0 + i * NGW : m0; const GAS f32x4* xr = (const GAS f32x4*)(F_x + (size_t)m * DM) + F_lane;
#pragma unroll
            for (int j = 0; j < 4; ++j) v[i][j] = xr[64 * j]; }
        asm volatile("" : "+v"(v[0][0]), "+v"(v[0][1]), "+v"(v[0][2]), "+v"(v[0][3]), "+v"(v[1][0]), "+v"(v[1][1]), "+v"(v[1][2]), "+v"(v[1][3]));
        asm volatile("" : "+v"(v[2][0]), "+v"(v[2][1]), "+v"(v[2][2]), "+v"(v[2][3]), "+v"(v[3][0]), "+v"(v[3][1]), "+v"(v[3][2]), "+v"(v[3][3]));
#pragma unroll
        for (int i = 0; i < 4; ++i) { const int m = m0 + i * NGW;
            if (m < T) {
                GAS unsigned long long* o8 = (GAS unsigned long long*)(F_XB + (size_t)m * DM) + F_lane;
                float s = 0.f;
#pragma unroll
                for (int j = 0; j < 4; ++j) { const f32x4 w = v[i][j]; s += (w.x * w.x + w.y * w.y) + (w.z * w.z + w.w * w.w);
                    o8[64 * j] = (unsigned long long)pk2(w.x, w.y) | ((unsigned long long)pk2(w.z, w.w) << 32); }
                s = wave_sum(s);
                if (F_lane == 0) F_SSQ[m] = s;
            } }
    }
}

constexpr int LP = 65;
__device__ __forceinline__ void stage_conv(Frame& F, int layer, int b, int n, int zcol, int wch, float scale, LAS float* dst) {
    const float* cw = F_conv_w + (size_t)layer * 4 * 768;
    const int r0 = b * SEQ + n * CH;
    for (int idx = F_tid; idx < 4096; idx += NTHR) {
        const int t = idx >> 6, c = idx & 63;
        float a = 0.f;
#pragma unroll
        for (int j = 0; j < 4; ++j) { const int tt = t + j - 3;
            if (n * CH + tt >= 0) a += bf2f(F_Z[(size_t)(r0 + tt) * LDZ + zcol + c]) * cw[j * 768 + wch + c]; }
        dst[t * LP + c] = siluf(a) * scale;
    }
}
__device__ __forceinline__ void stage_tile(Frame& F, int b, int n, int zcol, int W, float scale, LAS float* dst, int pitch) {
    const int r0 = b * SEQ + n * CH;
    for (int idx = F_tid; idx < 64 * W; idx += NTHR) { const int t = idx / W, c = idx % W; dst[t * pitch + c] = bf2f(F_Z[(size_t)(r0 + t) * LDZ + zcol + c]) * scale; }
}
__device__ __forceinline__ void stage_mgates(Frame& F, int layer, int b, int n, int h, LAS float* ig, LAS float* bc, LAS float* lf) {
    const int r0 = b * SEQ + n * CH;
    if (F_tid < 64) { const float* g = F_G32 + (size_t)(r0 + F_tid) * 32;
        ig[F_tid] = g[h] + F_b_gates[layer * 12 + h]; lf[F_tid] = logsigf(g[6 + h] + F_b_gates[layer * 12 + 6 + h]); }
    __syncthreads();
    if (F_tid < 64) { float s = 0.f; for (int j = 0; j <= F_tid; ++j) s += lf[j]; bc[F_tid] = s; }
}
__device__ __forceinline__ void stage_gla_decay(Frame& F, int layer, int b, int n, int hh, LAS float* bcum) {
    const int r0 = b * SEQ + n * CH;
    const float* wa = F_w_alpha + (size_t)layer * 16 * 128; const float* ba = F_b_alpha + layer * 128;
    for (int idx = F_tid; idx < 2048; idx += NTHR) { const int t = idx >> 5, d = idx & 31;
        const float* g = F_G32 + (size_t)(r0 + t) * 32 + 12; float a = ba[hh * 32 + d];
#pragma unroll
        for (int r = 0; r < 16; ++r) a += g[r] * wa[r * 128 + hh * 32 + d];
        bcum[t * 33 + d] = logsigf(a) * (1.0f / 16.0f); }
    __syncthreads();
    if (F_tid < 32) { float s = 0.f; for (int t = 0; t < 64; ++t) { s += bcum[t * 33 + F_tid]; bcum[t * 33 + F_tid] = s; } }
    __syncthreads();
}

#define DPPF(old, x, ctrl, rmask) __uint_as_float(__builtin_amdgcn_update_dpp(__float_as_uint(old), __float_as_uint(x), (ctrl), (rmask), 0xf, false))
__device__ __forceinline__ void p3_scan(Frame& F, int ub_, int nb_) {
    LAS float* L = (LAS float*)(F.lds + RING_OFF);
    LAS float* so = L; LAS float* sn = L + 128; LAS float* ex = L + 512;
    LAS float* ex2 = L + 512 + 4096;
    const int tid = F_tid, w = tid >> 6, l = tid & 63;
    constexpr int UPB = 32, NU_M = 12 * UPB, NU = NU_M + 8 * 16;
    const int u0 = (int)(((long)ub_ * NU) / nb_), u1 = (int)(((long)(ub_ + 1) * NU) / nb_);
    int cur_bh = -1, par = 0;
    for (int u = u0; u < u1; ++u, par ^= 1) {
        LAS float* exu = ex + par * 2048; LAS float* ex2u = ex2 + par * 512;
        float c0[16], c1[16], c2[16], dcy0[16], dcy1[16];
        int kind;
        size_t base, base2 = 0;
        if (u < NU_M) {
            const int bh = u / UPB, eu = u % UPB, b = bh / 6, h = bh % 6;
            if (bh != cur_bh) {
                __syncthreads();
                if (w == 0) {
                    const int ci0 = (b * NCHS + 2 * l) * 6 + h, ci1 = ci0 + 6;
                    const float a0 = F_GS[ci0], b0 = F_MS[ci0], a1 = F_GS[ci1], b1 = F_MS[ci1];
                    float A = a0 + a1, B = fmaxf(b1, a1 + b0);
#define MP_STEP(ctrl, rmask) do { const float as_ = DPPF(0.f, A, ctrl, rmask), bs_ = DPPF(-3.0e38f, B, ctrl, rmask); B = fmaxf(B, A + bs_); A = A + as_; } while (0)
                    MP_STEP(0x111, 0xf); MP_STEP(0x112, 0xf); MP_STEP(0x114, 0xf); MP_STEP(0x118, 0xf); MP_STEP(0x142, 0xa); MP_STEP(0x143, 0xc);
#undef MP_STEP
                    float EA = __shfl_up(A, 1), EB = __shfl_up(B, 1); if (l == 0) { EA = 0.f; EB = -3.0e38f; }
                    const float mp0 = fmaxf(EB, EA), m0 = fmaxf(b0, a0 + mp0), m1 = fmaxf(b1, a1 + m0);
                    so[2 * l] = expf(a0 + mp0 - m0); sn[2 * l] = expf(b0 - m0); so[2 * l + 1] = expf(a1 + m0 - m1); sn[2 * l + 1] = expf(b1 - m1);
                    if (eu == 0) { F_MP[ci0] = mp0; F_MP[ci1] = m0; }
                }
                __syncthreads();
                cur_bh = bh;
            }
            kind = (eu == 0) ? 1 : 0; base = ((size_t)(b * NCHS + 16 * w) * 6 + h) * 4096 + eu * 128 + 2 * l; base2 = ((size_t)(b * NCHS + 16 * w) * 6 + h) * 64 + l;
            const bf16* p16 = (const bf16*)F_CST + base; const float* pn = F_NST + base2;
#pragma unroll
            for (int i = 0; i < 16; ++i) { const unsigned x = *(const unsigned*)(p16 + (size_t)i * 6 * 4096); const float s_ = sn[16 * w + i];
                c0[i] = __uint_as_float(x << 16) * s_; c1[i] = __uint_as_float(x & 0xffff0000u) * s_; dcy0[i] = so[16 * w + i]; dcy1[i] = dcy0[i];
                c2[i] = (kind == 1) ? pn[(size_t)i * 6 * 64] * s_ : 0.f; }
        } else {
            const int v = u - NU_M, bh = v >> 4, eu = v & 15, b = bh >> 2, hh = bh & 3;
            kind = 2; base = ((size_t)(b * NCHS + 16 * w) * 4 + hh) * 2048 + eu * 128 + 2 * l;
            const float* p = F_SST + base;
            const float* ad = F_ADEC + ((size_t)(b * NCHS + 16 * w) * 4 + hh) * 32 + ((2 * l) & 31);
#pragma unroll
            for (int i = 0; i < 16; ++i) { const unsigned long long x = *(const unsigned long long*)(p + (size_t)i * 4 * 2048); const unsigned long long y = *(const unsigned long long*)(ad + (size_t)i * 4 * 32);
                c0[i] = __uint_as_float((unsigned)x); c1[i] = __uint_as_float((unsigned)(x >> 32)); dcy0[i] = __uint_as_float((unsigned)y); dcy1[i] = __uint_as_float((unsigned)(y >> 32)); c2[i] = 0.f; }
        }
        float s0 = 0.f, s1 = 0.f, s2 = 0.f, P0 = 1.f, P1 = 1.f;
#pragma unroll
        for (int i = 0; i < 16; ++i) { const float a = c0[i], bb = c1[i], cc = c2[i]; c0[i] = s0; c1[i] = s1; c2[i] = s2; s0 = dcy0[i] * s0 + a; s1 = dcy1[i] * s1 + bb; s2 = dcy0[i] * s2 + cc; P0 *= dcy0[i]; P1 *= dcy1[i]; }
        exu[(w * 64 + l) * 4] = P0; exu[(w * 64 + l) * 4 + 1] = P1; exu[(w * 64 + l) * 4 + 2] = s0; exu[(w * 64 + l) * 4 + 3] = s1; ex2u[w * 64 + l] = s2;
        __syncthreads();
        float i0 = 0.f, i1 = 0.f, i2 = 0.f;
        for (int w2 = 0; w2 < w; ++w2) { const f32x4 e = *(LAS const f32x4*)(exu + (w2 * 64 + l) * 4); i0 = e[0] * i0 + e[2]; i1 = e[1] * i1 + e[3]; i2 = e[0] * i2 + ex2u[w2 * 64 + l]; }
        float q0 = i0, q1 = i1, q2 = i2;
        if (kind <= 1) {
            bf16* pb = F_CPB + base; float* pn = F_NST + base2;
#pragma unroll
            for (int i = 0; i < 16; ++i) { *(unsigned*)(pb + (size_t)i * 6 * 4096) = f2bf(c0[i] + q0) | (f2bf(c1[i] + q1) << 16);
                if (kind == 1) pn[(size_t)i * 6 * 64] = c2[i] + q2;
                q0 *= dcy0[i]; q1 *= dcy1[i]; q2 *= dcy0[i]; }
        } else { float* p = F_SST + base;
#pragma unroll
            for (int i = 0; i < 16; ++i) { *(unsigned long long*)(p + (size_t)i * 4 * 2048) = (unsigned long long)__float_as_uint(c0[i] + q0) | ((unsigned long long)__float_as_uint(c1[i] + q1) << 32); q0 *= dcy0[i]; q1 *= dcy1[i]; }
        }
    }
    __syncthreads();
}

#define P4_STORE8(o, kg, yrow, GATE_EXPR) do { _Pragma("unroll") for (int c8 = 0; c8 < 8; ++c8) if ((kg) == c8) { float yv[8]; \
    _Pragma("unroll") for (int i = 0; i < 8; ++i) { const int v = c8 * 8 + i; yv[i] = (o)[v] * (GATE_EXPR); } \
    v4u w; w.x = pk2(yv[0], yv[1]); w.y = pk2(yv[2], yv[3]); w.z = pk2(yv[4], yv[5]); w.w = pk2(yv[6], yv[7]); *(GAS v4u*)((yrow) + c8 * 8) = w; } } while (0)

__device__ __forceinline__ void p4_attn(Frame& F, int layer, int b, int n, int h) {
    const int t = F_tid >> 3, kg = F_tid & 7;
    const int r0 = b * SEQ + n * CH, row = r0 + t;
    LAS float* qL = (LAS float*)(F.lds + RING_OFF);
    stage_tile(F, b, n, ZC_AQ + h * 64, 64, 1.f, qL, LP);
    __syncthreads();
    float o[64];
#pragma unroll
    for (int c = 0; c < 64; ++c) o[c] = 0.f;
    float m = -1e30f, l = 0.f;
    const float* rb = F_rel_bias + (size_t)(layer * 6 + h) * 257;
    for (int i = 0; i < 72; ++i) {
        const int jb = kg + 8 * i, kpos = n * CH - 512 + jb;
        if (kpos < 0) continue;
        const bf16* kr = F_Z + (size_t)(b * SEQ + kpos) * LDZ + ZC_AK + h * 64;
        float s = 0.f;
#pragma unroll
        for (int c = 0; c < 8; ++c) { float kf[8]; ld8(kr + c * 8, kf);
#pragma unroll
            for (int e = 0; e < 8; ++e) s += qL[t * LP + c * 8 + e] * kf[e]; }
        int rel = t + 512 - jb; rel = rel < -128 ? -128 : (rel > 128 ? 128 : rel);
        s = s * 0.125f + rb[rel + 128];
        const float mn = fmaxf(m, s), a = expf(m - mn), p = expf(s - mn);
        l = l * a + p; m = mn;
        const bf16* vr = F_Z + (size_t)(b * SEQ + kpos) * LDZ + ZC_AV + h * 64;
#pragma unroll
        for (int c = 0; c < 8; ++c) { float vf[8]; ld8(vr + c * 8, vf);
#pragma unroll
            for (int e = 0; e < 8; ++e) o[c * 8 + e] = o[c * 8 + e] * a + p * vf[e]; }
    }
#pragma unroll
    for (int off = 1; off < 8; off <<= 1) {
        const float m2 = __shfl_xor(m, off), l2 = __shfl_xor(l, off);
        const float mn = fmaxf(m, m2), a = expf(m - mn), bb = expf(m2 - mn);
        l = l * a + l2 * bb; m = mn;
#pragma unroll
        for (int c = 0; c < 64; ++c) { const float o2 = __shfl_xor(o[c], off); o[c] = o[c] * a + o2 * bb; }
    }
    const float inv = 1.0f / l;
    const bf16* gr = F_Z + (size_t)row * LDZ + ZC_AG + h * 64;
    bf16* yrow = F_Y + (size_t)row * DM + h * 64;
    P4_STORE8(o, kg, yrow, inv * siluf(bf2f(gr[v])));
}

__device__ __forceinline__ void p4_mlstm(Frame& F, int layer, int b, int n, int h) {
    LAS float* L = (LAS float*)(F.lds + RING_OFF);
    LAS float* qc = L; LAS float* kc = qc + 64 * LP; LAS float* vv = kc + 64 * LP; LAS float* Cp = vv + 64 * LP;
    LAS float* np = Cp + 64 * LP; LAS float* ig = np + 64; LAS float* bc = ig + 64; LAS float* lf = bc + 64;
    const int cn = b * NCHS + n, r0 = b * SEQ + n * CH;
    stage_conv(F, layer, b, n, ZC_MQ + h * 64, h * 64, 1.f, qc);
    stage_conv(F, layer, b, n, ZC_MK + h * 64, 384 + h * 64, 0.125f, kc);
    stage_tile(F, b, n, ZC_MV + h * 64, 64, 1.f, vv, LP);
    { const float* cs = F_CST + ((size_t)cn * 6 + h) * 4096; for (int idx = F_tid; idx < 4096; idx += NTHR) Cp[(idx >> 6) * LP + (idx & 63)] = cs[idx]; }
    if (F_tid < 64) np[F_tid] = F_NST[((size_t)cn * 6 + h) * 64 + F_tid];
    stage_mgates(F, layer, b, n, h, ig, bc, lf);
    __syncthreads();
    const float mprev = F_MP[cn * 6 + h];
    const int t = F_tid >> 3, jg = F_tid & 7, row = r0 + t;
    const float bt = bc[t], il = bt + mprev;
    float mx = il;
    for (int i = 0; i < 8; ++i) { const int j = jg + 8 * i; if (j <= t) mx = fmaxf(mx, bt - bc[j] + ig[j]); }
    mx = fmaxf(mx, __shfl_xor(mx, 1)); mx = fmaxf(mx, __shfl_xor(mx, 2)); mx = fmaxf(mx, __shfl_xor(mx, 4));
    float num[64]; float den = 0.f;
#pragma unroll
    for (int c = 0; c < 64; ++c) num[c] = 0.f;
    for (int i = 0; i < 8; ++i) { const int j = jg + 8 * i;
        if (j <= t) { float dot = 0.f;
#pragma unroll 8
            for (int k = 0; k < 64; ++k) dot += qc[t * LP + k] * kc[j * LP + k];
            const float sc = dot * expf(bt - bc[j] + ig[j] - mx); den += sc;
#pragma unroll
            for (int c = 0; c < 64; ++c) num[c] += sc * vv[j * LP + c]; } }
    const float iw = expf(il - mx);
#pragma unroll 2
    for (int kk = 0; kk < 8; ++kk) { const int k = jg * 8 + kk; const float qk = qc[t * LP + k] * iw; den += qk * np[k];
#pragma unroll
        for (int c = 0; c < 64; ++c) num[c] += qk * Cp[c * LP + k]; }
#pragma unroll
    for (int off = 1; off < 8; off <<= 1) { den += __shfl_xor(den, off);
#pragma unroll
        for (int c = 0; c < 64; ++c) num[c] += __shfl_xor(num[c], off); }
    den = fmaxf(fabsf(den), expf(-mx));
    const float rden = 1.0f / den; float ss = 0.f;
#pragma unroll
    for (int c = 0; c < 64; ++c) { num[c] *= rden; ss += num[c] * num[c]; }
    const float rn = 1.0f / sqrtf(ss * (1.0f / 64.0f) + EPS);
    const bf16* mo = F_Z + (size_t)row * LDZ + ZC_MO + h * 64; const bf16* mg = F_Z + (size_t)row * LDZ + ZC_MG + h * 64;
    const float* gn = F_ml_norm_g + layer * 384 + h * 64;
    bf16* yrow = F_Y + (size_t)row * DM + 384 + h * 64;
    P4_STORE8(num, jg, yrow, rn * gn[v] * sigmf(bf2f(mo[v])) * siluf(bf2f(mg[v])));
}

__device__ __forceinline__ void p4_gla(Frame& F, int layer, int b, int n, int hh) {
    LAS float* L = (LAS float*)(F.lds + RING_OFF);
    LAS float* qx = L; LAS float* kk = qx + 64 * 33; LAS float* vv = kk + 64 * 33; LAS float* bcum = vv + 64 * LP; LAS float* Sp = bcum + 64 * 33;
    const int cn = b * NCHS + n, r0 = b * SEQ + n * CH;
    stage_tile(F, b, n, ZC_GQ + hh * 32, 32, 0.17677669529663687f, qx, 33);
    stage_tile(F, b, n, ZC_GK + hh * 32, 32, 1.f, kk, 33);
    stage_tile(F, b, n, ZC_GV + hh * 64, 64, 1.f, vv, LP);
    { const float* ss = F_SST + ((size_t)cn * 4 + hh) * 2048; for (int idx = F_tid; idx < 2048; idx += NTHR) Sp[(idx >> 6) * LP + (idx & 63)] = ss[idx]; }
    stage_gla_decay(F, layer, b, n, hh, bcum);
    const int t = F_tid >> 3, jg = F_tid & 7, row = r0 + t;
    float num[64];
#pragma unroll
    for (int c = 0; c < 64; ++c) num[c] = 0.f;
    for (int i = 0; i < 8; ++i) { const int j = jg + 8 * i;
        if (j <= t) { float att = 0.f;
#pragma unroll 4
            for (int d = 0; d < 32; ++d) att += qx[t * 33 + d] * kk[j * 33 + d] * expf(bcum[t * 33 + d] - bcum[j * 33 + d]);
#pragma unroll
            for (int c = 0; c < 64; ++c) num[c] += att * vv[j * LP + c]; } }
#pragma unroll 2
    for (int dd = 0; dd < 4; ++dd) { const int d = jg * 4 + dd; const float w = qx[t * 33 + d] * expf(bcum[t * 33 + d]);
#pragma unroll
        for (int c = 0; c < 64; ++c) num[c] += w * Sp[d * LP + c]; }
    float ss = 0.f;
#pragma unroll
    for (int off = 1; off < 8; off <<= 1) {
#pragma unroll
        for (int c = 0; c < 64; ++c) num[c] += __shfl_xor(num[c], off); }
#pragma unroll
    for (int c = 0; c < 64; ++c) ss += num[c] * num[c];
    const float rn = 1.0f / sqrtf(ss * (1.0f / 64.0f) + EPS);
    const bf16* gg = F_Z + (size_t)row * LDZ + ZC_GG + hh * 64;
    const float* gn = F_gla_norm_g + layer * 256 + hh * 64;
    bf16* yrow = F_Y + (size_t)row * DM + 768 + hh * 64;
    P4_STORE8(num, jg, yrow, rn * gn[v] * siluf(bf2f(gg[v])));
}

constexpr int ZRS = 64;
__host__ __device__ constexpr size_t zc(int col) { return (size_t)(col >> 6) * ((size_t)T * 64) + (size_t)(col & 63); }
typedef float f32x16 __attribute__((ext_vector_type(16)));
typedef short s16x4 __attribute__((ext_vector_type(4)));
typedef short v4i16_t __attribute__((ext_vector_type(4)));
typedef float f32x2_t __attribute__((ext_vector_type(2))); typedef __bf16 bf16x2_t __attribute__((ext_vector_type(2)));
__device__ __forceinline__ unsigned cvtpk(float lo, float hi) { f32x2_t v = {lo, hi}; bf16x2_t b = __builtin_convertvector(v, bf16x2_t); return __builtin_bit_cast(unsigned, b); }
__device__ __forceinline__ s16x4 lds_tr(LAS const unsigned char* p) { return __builtin_bit_cast(s16x4, __builtin_amdgcn_ds_read_tr16_b64_v4i16((LAS v4i16_t*)p)); }
__device__ __forceinline__ bf16x8 pack8(float a0, float a1, float a2, float a3, float a4, float a5, float a6, float a7) {
    v4u w; w.x = cvtpk(a0, a1); w.y = cvtpk(a2, a3); w.z = cvtpk(a4, a5); w.w = cvtpk(a6, a7); return __builtin_bit_cast(bf16x8, w); }
#define MFMA32(a, b, c) __builtin_amdgcn_mfma_f32_32x32x16_bf16((a), (b), (c), 0, 0, 0)
constexpr float LOG2E = 1.4426950408889634f;
__device__ __forceinline__ float fexp(float x) { return __builtin_amdgcn_exp2f(x * LOG2E); }
__device__ __forceinline__ float fsigm(float x) { return __builtin_amdgcn_rcpf(1.0f + fexp(-x)); }
__device__ __forceinline__ float fsilu(float x) { return x * fsigm(x); }
__device__ __forceinline__ int tile_off(int row, int bytecol) { return row * 128 + ((((bytecol >> 4) ^ (((row >> 1) & 1) << 2)) << 4) | (bytecol & 15)); }
__device__ __forceinline__ void dma_tile(const bf16* g, LAS unsigned char* tile, int lane) {
    const int rr = lane >> 3, cpos = lane & 7;
#pragma unroll
    for (int it = 0; it < 8; ++it) { const int row = 8 * it + rr, ch = cpos ^ (((row >> 1) & 1) << 2);
        __builtin_amdgcn_global_load_lds((const unsigned*)(g + (size_t)row * ZRS + ch * 8), (LAS unsigned*)(tile + it * 1024), 16, 0, 0); }
}
__device__ __forceinline__ bf16x8 tr_frag(LAS const unsigned char* tile, int lane, int c0, int ks) {
    const int g = lane >> 4, i = lane & 15, hf = g >> 1;
    const int row = 16 * ks + 4 * hf + (i >> 2), bc = (c0 + 16 * (g & 1) + 4 * (i & 3)) * 2;
    const s16x4 lo = lds_tr(tile + tile_off(row, bc)), hi = lds_tr(tile + tile_off(row + 8, bc));
    return (bf16x8){lo[0], lo[1], lo[2], lo[3], hi[0], hi[1], hi[2], hi[3]};
}

typedef const GAS char* gcp;
__device__ __forceinline__ gcp uptr(const void* p) { const unsigned long long v = (unsigned long long)p;
    const unsigned lo = __builtin_amdgcn_readfirstlane((unsigned)v), hi = __builtin_amdgcn_readfirstlane((unsigned)(v >> 32)); return (gcp)(((unsigned long long)hi << 32) | lo); }
__device__ __forceinline__ bf16x8 ldfrag(gcp ub, unsigned voff) { return *(const GAS bf16x8*)(ub + voff); }
__device__ __forceinline__ unsigned dma_voff(int lane) { const int rr = lane >> 3; return (unsigned)(rr * ZRS + (((lane & 7) ^ (((rr >> 1) & 1) << 2)) * 8)) * 2u; }
__device__ __forceinline__ void dma_tile_u(gcp ub, unsigned voff, LAS unsigned char* tile) {
#pragma unroll
    for (int it = 0; it < 8; ++it) __builtin_amdgcn_global_load_lds((const GAS unsigned*)(ub + (size_t)it * 8 * ZRS * 2 + voff), (LAS unsigned*)(tile + it * 1024), 16, 0, 0);
}
__device__ __forceinline__ void dma_tile_asm(gcp ub, unsigned voff, LAS unsigned char* tile) {
    const unsigned l0 = __builtin_amdgcn_readfirstlane((unsigned)(unsigned long long)tile);
    gcp ub2 = ub + 4096; unsigned keep;
#define DMA1_(SB, OFF, LD) asm volatile("s_mov_b32 %0, m0\n\ts_mov_b32 m0, %3\n\ts_nop 3\n\tglobal_load_lds_dwordx4 %1, %2 offset:" #OFF "\n\ts_mov_b32 m0, %0" : "=&s"(keep) : "v"(voff), "s"(SB), "s"(LD) : "memory")
    const unsigned l1 = l0 + 4096u;
    DMA1_(ub, 0, l0); DMA1_(ub, 1024, l0); DMA1_(ub, 2048, l0); DMA1_(ub, 3072, l0);
    DMA1_(ub2, 0, l1); DMA1_(ub2, 1024, l1); DMA1_(ub2, 2048, l1); DMA1_(ub2, 3072, l1);
#undef DMA1_
}
__device__ __forceinline__ void tr_bases(int lane, unsigned& b0, unsigned& b1) {
    const int g = lane >> 4, i = lane & 15, hf = g >> 1, row = 4 * hf + (i >> 2), bc = (16 * (g & 1) + 4 * (i & 3)) * 2;
    b0 = (unsigned)tile_off(row, bc); b1 = (unsigned)tile_off(row, bc + 64);
}
__device__ __forceinline__ bf16x8 tr_frag_b(LAS const unsigned char* tile, unsigned base, int ks) {
    const s16x4 lo = lds_tr(tile + base + ks * 2048), hi = lds_tr(tile + base + ks * 2048 + 1024);
    return (bf16x8){lo[0], lo[1], lo[2], lo[3], hi[0], hi[1], hi[2], hi[3]};
}

__device__ __forceinline__ void unpack8(v4u w, float* o) {
    o[0] = __uint_as_float(w.x << 16); o[1] = __uint_as_float(w.x & 0xffff0000u); o[2] = __uint_as_float(w.y << 16); o[3] = __uint_as_float(w.y & 0xffff0000u);
    o[4] = __uint_as_float(w.z << 16); o[5] = __uint_as_float(w.z & 0xffff0000u); o[6] = __uint_as_float(w.w << 16); o[7] = __uint_as_float(w.w & 0xffff0000u);
}
__device__ __forceinline__ float max3f(float a, float b, float c) { float r; asm("v_max3_f32 %0, %1, %2, %3" : "=v"(r) : "v"(a), "v"(b), "v"(c)); return r; }
__device__ __forceinline__ float xh_max(float x) { const auto rr = __builtin_amdgcn_permlane32_swap(__float_as_uint(x), __float_as_uint(x), false, false); return max3f(__uint_as_float(rr[0]), __uint_as_float(rr[1]), __uint_as_float(rr[1])); }
__device__ __forceinline__ float xh_sum(float x) { const auto rr = __builtin_amdgcn_permlane32_swap(__float_as_uint(x), __float_as_uint(x), false, false); return __uint_as_float(rr[0]) + __uint_as_float(rr[1]); }
constexpr int TLP = 68;
__device__ __forceinline__ void tl_put4(LAS unsigned char* wl, int t, int v, float a, float b, float c, float e) { *(LAS f32x4*)(wl + ((t * TLP + v) << 2)) = (f32x4){a, b, c, e}; }
template <int GATE>
__device__ __forceinline__ void tl_emit(LAS const unsigned char* wl, int lane, gcp g0, gcp g1, const float* gn, GAS char* yb) {
    const int rr = lane >> 3, c = lane & 7;
    float gnv[8];
    if (GATE != 0) { const f32x4 a = *(const f32x4*)(gn + 8 * c), b = *(const f32x4*)(gn + 8 * c + 4); gnv[0] = a[0]; gnv[1] = a[1]; gnv[2] = a[2]; gnv[3] = a[3]; gnv[4] = b[0]; gnv[5] = b[1]; gnv[6] = b[2]; gnv[7] = b[3]; }
    const unsigned voff = (unsigned)(rr * ZRS + 8 * c) * 2u, yoff = (unsigned)(rr * DM + 8 * c) * 2u;
    v4u ga[8], gb[8];
#pragma unroll
    for (int it = 0; it < 8; ++it) { ga[it] = *(const GAS v4u*)(g0 + (size_t)it * 8 * ZRS * 2 + voff); if (GATE == 1) gb[it] = *(const GAS v4u*)(g1 + (size_t)it * 8 * ZRS * 2 + voff); }
#pragma unroll
    for (int it = 0; it < 8; ++it) {
        const int row = 8 * it + rr;
        const f32x4 x0 = *(LAS const f32x4*)(wl + ((row * TLP + 8 * c) << 2)), x1 = *(LAS const f32x4*)(wl + ((row * TLP + 8 * c + 4) << 2));
        float x[8] = {x0[0], x0[1], x0[2], x0[3], x1[0], x1[1], x1[2], x1[3]}, p[8], q[8];
        unpack8(ga[it], p); if (GATE == 1) unpack8(gb[it], q);
#pragma unroll
        for (int e = 0; e < 8; ++e) {
            if (GATE == 0) x[e] *= fsilu(p[e]);
            else if (GATE == 1) x[e] *= gnv[e] * fsigm(p[e]) * fsilu(q[e]);
            else x[e] *= gnv[e] * fsilu(p[e]);
        }
        *(GAS v4u*)(yb + (size_t)it * 8 * DM * 2 + yoff) = __builtin_bit_cast(v4u, pack8(x[0], x[1], x[2], x[3], x[4], x[5], x[6], x[7]));
    }
}

__device__ __forceinline__ void attn_wave(Frame& F, int layer, int cn, int h, LAS unsigned char* wl) {
    const int lane = F_lane, r = lane & 31, hf = lane >> 5;
    const int b = cn / NCHS, n = cn % NCHS;
    const size_t row0 = (size_t)b * SEQ + (size_t)n * CH;
    const bf16* Z = F_Z;
    LAS float* rbl = (LAS float*)(wl + 16384);
    const float* rb = F_rel_bias + (size_t)(layer * 6 + h) * 257;
    float tb_[4];
#pragma unroll
    for (int k = 0; k < 4; ++k) { const int j = lane + 64 * k; tb_[k] = rb[j + 65 < 256 ? j + 65 : 256]; }
    const float bfar = rb[256] * LOG2E;
    constexpr float C1 = 0.125f * LOG2E;
    const unsigned voffK = (unsigned)(r * ZRS + 8 * hf) * 2u, voffV = dma_voff(lane);
    unsigned trb0, trb1; tr_bases(lane, trb0, trb1);
    bf16x8 qf[2][4];
    { gcp qb_ = uptr(Z + zc(ZC_AQ + h * 64) + row0 * ZRS);
#pragma unroll
    for (int qb = 0; qb < 2; ++qb)
#pragma unroll
        for (int s = 0; s < 4; ++s) qf[qb][s] = ldfrag(qb_ + ((size_t)32 * qb * ZRS + 16 * s) * 2, voffK); }
    const int i0 = (n >= 8) ? 0 : 8 - n;
#define KLOAD4(KF, VO, SB) do { \
        asm volatile("s_nop 4\n\tglobal_load_dwordx4 %0, %1, %2" : "+v"(KF[0]) : "v"(VO), "s"(SB) : "memory"); \
        asm volatile("global_load_dwordx4 %0, %1, %2 offset:32" : "+v"(KF[1]) : "v"(VO), "s"(SB) : "memory"); \
        asm volatile("global_load_dwordx4 %0, %1, %2 offset:64" : "+v"(KF[2]) : "v"(VO), "s"(SB) : "memory"); \
        asm volatile("global_load_dwordx4 %0, %1, %2 offset:96" : "+v"(KF[3]) : "v"(VO), "s"(SB) : "memory"); } while (0)
#define KWAIT(KF, N) asm volatile("s_waitcnt vmcnt(" #N ")" : "+v"(KF[0]), "+v"(KF[1]), "+v"(KF[2]), "+v"(KF[3]) :: "memory")
    dma_tile_asm(uptr(Z + zc(ZC_AV + h * 64) + (row0 - 512 + 64 * i0) * ZRS), voffV, wl + (i0 & 1) * 8192);
    bf16x8 kfa[4], kfb[4];
#pragma unroll
    for (int s = 0; s < 4; ++s) { kfa[s] = (bf16x8){0, 0, 0, 0, 0, 0, 0, 0}; kfb[s] = (bf16x8){0, 0, 0, 0, 0, 0, 0, 0}; }
    { gcp kb_ = uptr(Z + zc(ZC_AK + h * 64) + (row0 - 512 + 64 * i0) * ZRS); KLOAD4(kfa, voffK, kb_); }
#pragma unroll
    for (int k = 0; k < 4; ++k) { const int j = lane + 64 * k; if (j < 255) rbl[254 - j] = tb_[k] * 8.0f; }
    const int jl0 = r - 4 * hf + 4;
    f32x16 o[2][2];
#pragma unroll
    for (int a = 0; a < 2; ++a)
#pragma unroll
        for (int c = 0; c < 2; ++c)
#pragma unroll
            for (int i = 0; i < 16; ++i) o[a][c][i] = 0.f;
    float m[2] = {-1e30f, -1e30f}, lsum[2] = {0.f, 0.f};
    asm volatile("" :: "v"(qf[0][0]), "v"(qf[0][1]), "v"(qf[0][2]), "v"(qf[0][3]), "v"(qf[1][0]), "v"(qf[1][1]), "v"(qf[1][2]), "v"(qf[1][3]), "v"(bfar) : "memory");
#if PROBE_T >= 31 && PROBE_T <= 34
#define TS_(k) do { unsigned long long t_; asm volatile("s_memtime %0\n\ts_waitcnt lgkmcnt(0)" : "=s"(t_) :: "memory"); if ((k) > 0 && PROBE_T == 30 + (k)) tacc_ += (unsigned)(t_ - tprev_); tprev_ = t_; } while (0)
#else
#define TS_(k) do { } while (0)
#endif
#define ATTN_STEP(KF, KB) do { \
        TS_(0); \
        f32x16 st[2]; \
        const bool far_ = (ti <= 5); \
        if (far_) { _Pragma("unroll") for (int qb = 0; qb < 2; ++qb) { _Pragma("unroll") for (int i = 0; i < 16; ++i) st[qb][i] = 0.f; \
            _Pragma("unroll") for (int s = 0; s < 4; ++s) st[qb] = MFMA32(KF[s], qf[qb][s], st[qb]); } } \
        else { const int jr_ = 195 - (jl0 + 512 - 64 * ti) + 32 * (KB);            \
            _Pragma("unroll") for (int qb = 0; qb < 2; ++qb) { _Pragma("unroll") for (int i = 0; i < 16; ++i) st[qb][i] = rbl[jr_ - 32 * qb + ((i & 3) + 8 * (i >> 2))]; \
            _Pragma("unroll") for (int s = 0; s < 4; ++s) st[qb] = MFMA32(KF[s], qf[qb][s], st[qb]); } } \
        asm volatile("" : "+v"(st[0]), "+v"(st[1])); TS_(1); \
        const float boff_ = far_ ? bfar : 0.f; \
        bf16x8 pf[2][2]; \
        _Pragma("unroll") for (int qb = 0; qb < 2; ++qb) { \
            float ma = max3f(st[qb][0], st[qb][1], st[qb][2]), mb = max3f(st[qb][3], st[qb][4], st[qb][5]); \
            ma = max3f(ma, st[qb][6], st[qb][7]); mb = max3f(mb, st[qb][8], st[qb][9]); ma = max3f(ma, st[qb][10], st[qb][11]); mb = max3f(mb, st[qb][12], st[qb][13]); \
            float mx = max3f(ma, mb, max3f(st[qb][14], st[qb][15], st[qb][15])); \
            mx = mx * C1 + boff_;                       \
            mx = xh_max(mx); \
            if (__any(mx > m[qb] + 8.0f)) { const float mn = max3f(m[qb], mx, mx), alpha = __builtin_amdgcn_exp2f(m[qb] - mn); m[qb] = mn; lsum[qb] *= alpha; \
                _Pragma("unroll") for (int i = 0; i < 16; ++i) { o[0][qb][i] *= alpha; o[1][qb][i] *= alpha; } } \
            const float sc_ = C1, of_ = boff_ - m[qb]; \
            float ps0 = 0.f, ps1 = 0.f, ps2 = 0.f, ps3 = 0.f; \
            _Pragma("unroll") for (int i = 0; i < 16; i += 4) { \
                const float p0 = __builtin_amdgcn_exp2f(st[qb][i] * sc_ + of_), p1 = __builtin_amdgcn_exp2f(st[qb][i + 1] * sc_ + of_), p2 = __builtin_amdgcn_exp2f(st[qb][i + 2] * sc_ + of_), p3 = __builtin_amdgcn_exp2f(st[qb][i + 3] * sc_ + of_); \
                st[qb][i] = p0; st[qb][i + 1] = p1; st[qb][i + 2] = p2; st[qb][i + 3] = p3; ps0 += p0; ps1 += p1; ps2 += p2; ps3 += p3; } \
            lsum[qb] += (ps0 + ps1) + (ps2 + ps3); \
            pf[qb][0] = pack8(st[qb][0], st[qb][1], st[qb][2], st[qb][3], st[qb][4], st[qb][5], st[qb][6], st[qb][7]); \
            pf[qb][1] = pack8(st[qb][8], st[qb][9], st[qb][10], st[qb][11], st[qb][12], st[qb][13], st[qb][14], st[qb][15]); } \
        asm volatile("" : "+v"(pf[0][0]), "+v"(pf[0][1]), "+v"(pf[1][0]), "+v"(pf[1][1])); TS_(2); \
        bf16x8 vf_[2][2];            \
        _Pragma("unroll") for (int k2 = 0; k2 < 2; ++k2) _Pragma("unroll") for (int dvb = 0; dvb < 2; ++dvb) vf_[k2][dvb] = tr_frag_b(vt, dvb ? trb1 : trb0, 2 * (KB) + k2); \
        asm volatile("" : "+v"(vf_[0][0]), "+v"(vf_[0][1]), "+v"(vf_[1][0]), "+v"(vf_[1][1])); \
        _Pragma("unroll") for (int k2 = 0; k2 < 2; ++k2) _Pragma("unroll") for (int dvb = 0; dvb < 2; ++dvb) { \
            o[dvb][0] = MFMA32(vf_[k2][dvb], pf[0][k2], o[dvb][0]); o[dvb][1] = MFMA32(vf_[k2][dvb], pf[1][k2], o[dvb][1]); } \
        TS_(3); \
    } while (0)
#if PROBE_T >= 31 && PROBE_T <= 34
    unsigned tacc_ = 0; unsigned long long tprev_ = 0; const unsigned long long tl0_ = __builtin_amdgcn_s_memtime();
#endif
#pragma unroll 1
    for (int ti = i0; ti < 9; ++ti) {
        const size_t kr0 = row0 - 512 + 64 * ti;
        LAS const unsigned char* vt = wl + (ti & 1) * 8192;
        gcp kb1_ = uptr(Z + zc(ZC_AK + h * 64) + (kr0 + 32) * ZRS);
        gcp kb2_ = uptr(Z + zc(ZC_AK + h * 64) + (kr0 + 64) * ZRS);
        KLOAD4(kfb, voffK, kb1_);
        dma_tile_asm(uptr(Z + zc(ZC_AV + h * 64) + (kr0 + 64) * ZRS), voffV, wl + ((ti + 1) & 1) * 8192);
        KWAIT(kfa, 12);
        ATTN_STEP(kfa, 0);
        KLOAD4(kfa, voffK, kb2_);
        KWAIT(kfb, 12);
        ATTN_STEP(kfb, 1);
    }
    KWAIT(kfa, 0);
#if PROBE_T >= 31 && PROBE_T <= 34
    if (cn * 6 + h == 900 && layer == 0 && lane == 0) { const unsigned v_ = (PROBE_T == 34) ? (unsigned)(__builtin_amdgcn_s_memtime() - tl0_) : tacc_;
        __hip_atomic_store((unsigned*)(F_ctl + 2049), v_ / 21u, __ATOMIC_RELAXED, __HIP_MEMORY_SCOPE_AGENT); }
#endif
#undef KLOAD4
#undef KWAIT
#undef ATTN_STEP
#pragma unroll
    for (int qb = 0; qb < 2; ++qb) {
        const float l = xh_sum(lsum[qb]), inv = 1.0f / l;
#pragma unroll
        for (int dvb = 0; dvb < 2; ++dvb)
#pragma unroll
            for (int i4 = 0; i4 < 4; ++i4) tl_put4(wl, 32 * qb + r, 32 * dvb + 8 * i4 + 4 * hf, o[dvb][qb][4 * i4] * inv, o[dvb][qb][4 * i4 + 1] * inv, o[dvb][qb][4 * i4 + 2] * inv, o[dvb][qb][4 * i4 + 3] * inv);
    }
    tl_emit<0>(wl, lane, uptr(Z + zc(ZC_AG + h * 64) + row0 * ZRS), (gcp)nullptr, nullptr, (GAS char*)uptr(F_Y + row0 * DM + h * 64));
}

__device__ __forceinline__ float wave_scan_add(float x, int) {
    x += DPPF(0.f, x, 0x111, 0xf);
    x += DPPF(0.f, x, 0x112, 0xf);
    x += DPPF(0.f, x, 0x114, 0xf);
    x += DPPF(0.f, x, 0x118, 0xf);
    x += DPPF(0.f, x, 0x142, 0xa);
    x += DPPF(0.f, x, 0x143, 0xc);
    return x;
}
__device__ __forceinline__ float wave_scan_max(float x, int) {
    const float ninf = -3.0e38f;
    x = fmaxf(x, DPPF(ninf, x, 0x111, 0xf));
    x = fmaxf(x, DPPF(ninf, x, 0x112, 0xf));
    x = fmaxf(x, DPPF(ninf, x, 0x114, 0xf));
    x = fmaxf(x, DPPF(ninf, x, 0x118, 0xf));
    x = fmaxf(x, DPPF(ninf, x, 0x142, 0xa));
    x = fmaxf(x, DPPF(ninf, x, 0x143, 0xc));
    return x;
}
__device__ __forceinline__ float wave_max(float x) {
#pragma unroll
    for (int o = 1; o < 64; o <<= 1) x = fmaxf(x, __shfl_xor(x, o));
    return x;
}
__device__ __forceinline__ void conv8(const char* zub, unsigned voff, int blk, int s, int tt, int n, LAS const float* w, int c0, float scale, float* out) {
    float acc[8];
#pragma unroll
    for (int e = 0; e < 8; ++e) acc[e] = 0.f;
#pragma unroll
    for (int j = 0; j < 4; ++j) {
        v4u raw = *(const v4u*)(zub + ((long)(32 * blk + j - 3) * ZRS + 16 * s) * 2 + voff);
        if (!(n > 0 || tt + j - 3 >= 0)) raw = (v4u){0u, 0u, 0u, 0u};
        float z[8]; unpack8(raw, z);
        const f32x4 w0 = *(LAS const f32x4*)(w + j * 64 + c0), w1 = *(LAS const f32x4*)(w + j * 64 + c0 + 4);
        acc[0] += z[0] * w0[0]; acc[1] += z[1] * w0[1]; acc[2] += z[2] * w0[2]; acc[3] += z[3] * w0[3];
        acc[4] += z[4] * w1[0]; acc[5] += z[5] * w1[1]; acc[6] += z[6] * w1[2]; acc[7] += z[7] * w1[3];
    }
#pragma unroll
    for (int e = 0; e < 8; ++e) out[e] = fsilu(acc[e]) * scale;
}
__device__ __forceinline__ bf16x8 ld_f32_frag(gcp ub, unsigned voff) {
    const f32x4 a = *(const GAS f32x4*)(ub + voff), b = *(const GAS f32x4*)(ub + voff + 16);
    return pack8(a[0], a[1], a[2], a[3], b[0], b[1], b[2], b[3]);
}

__device__ __forceinline__ void dma_rows67(gcp ub, unsigned voff, LAS unsigned char* img, int lane) {
#pragma unroll
    for (int it = 0; it < 8; ++it) __builtin_amdgcn_global_load_lds((const GAS unsigned*)(ub + (size_t)it * 8 * ZRS * 2 + voff), (LAS unsigned*)(img + it * 1024), 16, 0, 0);
    if (lane < 24) __builtin_amdgcn_global_load_lds((const GAS unsigned*)(ub + (size_t)64 * ZRS * 2 + voff), (LAS unsigned*)(img + 8192), 16, 0, 0);
}
constexpr int IMG1 = 8704;
__device__ __forceinline__ void ml_out_wave(Frame& F, int layer, int cn, int h, LAS unsigned char* wl) {
    const int lane = F_lane, r = lane & 31, hf = lane >> 5;
    const int b = cn / NCHS, n = cn % NCHS;
    const size_t row0 = (size_t)b * SEQ + (size_t)n * CH;
    const bf16* Z = F_Z;
    LAS unsigned char* img0 = wl; LAS unsigned char* img1 = wl + IMG1;
    LAS float* wq = (LAS float*)(wl + 17408); LAS float* wk = wq + 256; LAS float* npl = wq + 512;
    const unsigned dvo = dma_voff(lane);
    dma_rows67(uptr(Z + zc(ZC_MQ + h * 64) + (row0 - 3) * ZRS), dvo, img0, lane);
    dma_rows67(uptr(Z + zc(ZC_MK + h * 64) + (row0 - 3) * ZRS), dvo, img1, lane);
    { const float* cw = F_conv_w + (size_t)layer * 4 * 768 + h * 64 + lane; float tq_[4], tk_[4];
#pragma unroll
      for (int j = 0; j < 4; ++j) { tq_[j] = cw[j * 768]; tk_[j] = cw[j * 768 + 384]; }
#pragma unroll
      for (int j = 0; j < 4; ++j) { wq[j * 64 + lane] = tq_[j]; wk[j * 64 + lane] = tk_[j]; } }
    npl[lane] = F_NST[((size_t)cn * 6 + h) * 64 + lane];
    bf16x8 cf[2][4];
    { gcp cpb = uptr(F_CPB + ((size_t)cn * 6 + h) * 4096);
#pragma unroll
      for (int vb = 0; vb < 2; ++vb)
#pragma unroll
          for (int s = 0; s < 4; ++s) cf[vb][s] = ldfrag(cpb + ((size_t)32 * vb * 64 + 16 * s) * 2, (unsigned)(r * 64 + 8 * hf) * 2u); }
    const float* g32 = F_G32 + (row0 + lane) * 32;
    const float ig = g32[h] + F_b_gates[layer * 12 + h];
    const float lf = logsigf(g32[6 + h] + F_b_gates[layer * 12 + 6 + h]);
    const float bc = wave_scan_add(lf, lane);
    const float av = ig - bc;
    const float amax = wave_scan_max(av, lane);
    const float mprev = F_MP[cn * 6 + h];
    float bct[2], mt[2], iw[2];
#pragma unroll
    for (int tb = 0; tb < 2; ++tb) { bct[tb] = __shfl(bc, 32 * tb + r); mt[tb] = fmaxf(mprev, __shfl(amax, 32 * tb + r)); iw[tb] = fexp(mprev - mt[tb]); }
    asm volatile("s_waitcnt vmcnt(0)" ::: "memory");
    bf16x8 qcf[2][4], kcf[2][4];
    float nq[2] = {0.f, 0.f};
#pragma unroll
    for (int s = 0; s < 4; ++s) {
        const int c0 = 16 * s + 8 * hf;
        const f32x4 n0 = *(LAS const f32x4*)(npl + c0), n1 = *(LAS const f32x4*)(npl + c0 + 4);
#pragma unroll
        for (int blk = 0; blk < 2; ++blk) {
            float aq[8], ak[8];
#pragma unroll
            for (int e = 0; e < 8; ++e) { aq[e] = 0.f; ak[e] = 0.f; }
#pragma unroll
            for (int j = 0; j < 4; ++j) {
                const int rho = 32 * blk + r + j, off = tile_off(rho, c0 * 2);
                v4u rq = *(LAS const v4u*)(img0 + off), rk = *(LAS const v4u*)(img1 + off);
                if (n == 0 && rho < 3) { rq = (v4u){0u, 0u, 0u, 0u}; rk = (v4u){0u, 0u, 0u, 0u}; }
                float zq[8], zk[8]; unpack8(rq, zq); unpack8(rk, zk);
                const f32x4 a0 = *(LAS const f32x4*)(wq + j * 64 + c0), a1 = *(LAS const f32x4*)(wq + j * 64 + c0 + 4), b0 = *(LAS const f32x4*)(wk + j * 64 + c0), b1 = *(LAS const f32x4*)(wk + j * 64 + c0 + 4);
                aq[0] += zq[0] * a0[0]; aq[1] += zq[1] * a0[1]; aq[2] += zq[2] * a0[2]; aq[3] += zq[3] * a0[3]; aq[4] += zq[4] * a1[0]; aq[5] += zq[5] * a1[1]; aq[6] += zq[6] * a1[2]; aq[7] += zq[7] * a1[3];
                ak[0] += zk[0] * b0[0]; ak[1] += zk[1] * b0[1]; ak[2] += zk[2] * b0[2]; ak[3] += zk[3] * b0[3]; ak[4] += zk[4] * b1[0]; ak[5] += zk[5] * b1[1]; ak[6] += zk[6] * b1[2]; ak[7] += zk[7] * b1[3];
            }
#pragma unroll
            for (int e = 0; e < 8; ++e) { aq[e] = fsilu(aq[e]); ak[e] = fsilu(ak[e]) * 0.125f; }
            nq[blk] += aq[0] * n0[0] + aq[1] * n0[1] + aq[2] * n0[2] + aq[3] * n0[3] + aq[4] * n1[0] + aq[5] * n1[1] + aq[6] * n1[2] + aq[7] * n1[3];
            qcf[blk][s] = pack8(aq[0], aq[1], aq[2], aq[3], aq[4], aq[5], aq[6], aq[7]);
            kcf[blk][s] = pack8(ak[0], ak[1], ak[2], ak[3], ak[4], ak[5], ak[6], ak[7]);
        }
    }
    dma_tile_u(uptr(Z + zc(ZC_MV + h * 64) + row0 * ZRS), dvo, img0);
    bf16x8 pf0[2], pf1[4];
    float den[2] = {0.f, 0.f};
    {
        f32x16 s00, s01, s11;
#pragma unroll
        for (int i = 0; i < 16; ++i) { s00[i] = 0.f; s01[i] = 0.f; s11[i] = 0.f; }
#pragma unroll
        for (int s = 0; s < 4; ++s) { s00 = MFMA32(kcf[0][s], qcf[0][s], s00); s01 = MFMA32(kcf[0][s], qcf[1][s], s01); s11 = MFMA32(kcf[1][s], qcf[1][s], s11); }
#pragma unroll
        for (int i = 0; i < 16; ++i) {
            const int jr = (i & 3) + 8 * (i >> 2) + 4 * hf;
            const float a0 = __shfl(av, jr), a1 = __shfl(av, 32 + jr);
            const float d00 = (jr <= r) ? fexp(a0 - mt[0]) : 0.f, d01 = fexp(a0 - mt[1]), d11 = (jr <= r) ? fexp(a1 - mt[1]) : 0.f;
            s00[i] *= d00; s01[i] *= d01; s11[i] *= d11;
            den[0] += s00[i]; den[1] += s01[i] + s11[i];
        }
        pf0[0] = pack8(s00[0], s00[1], s00[2], s00[3], s00[4], s00[5], s00[6], s00[7]); pf0[1] = pack8(s00[8], s00[9], s00[10], s00[11], s00[12], s00[13], s00[14], s00[15]);
        pf1[0] = pack8(s01[0], s01[1], s01[2], s01[3], s01[4], s01[5], s01[6], s01[7]); pf1[1] = pack8(s01[8], s01[9], s01[10], s01[11], s01[12], s01[13], s01[14], s01[15]);
        pf1[2] = pack8(s11[0], s11[1], s11[2], s11[3], s11[4], s11[5], s11[6], s11[7]); pf1[3] = pack8(s11[8], s11[9], s11[10], s11[11], s11[12], s11[13], s11[14], s11[15]);
    }
#pragma unroll
    for (int tb = 0; tb < 2; ++tb) {
        den[tb] = xh_sum(den[tb]); nq[tb] = xh_sum(nq[tb]);
        den[tb] = fmaxf(fabsf(den[tb] + iw[tb] * nq[tb]), fexp(-(bct[tb] + mt[tb])));
    }
    unsigned trb0, trb1; tr_bases(lane, trb0, trb1);
    f32x16 num[2][2];
#pragma unroll
    for (int vb = 0; vb < 2; ++vb) {
#pragma unroll
        for (int tb = 0; tb < 2; ++tb) {
#pragma unroll
            for (int i = 0; i < 16; ++i) num[vb][tb][i] = 0.f;
#pragma unroll
            for (int s = 0; s < 4; ++s) num[vb][tb] = MFMA32(cf[vb][s], qcf[tb][s], num[vb][tb]);
#pragma unroll
            for (int i = 0; i < 16; ++i) num[vb][tb][i] *= iw[tb];
        }
    }
    asm volatile("s_waitcnt vmcnt(0)" ::: "memory");
#pragma unroll
    for (int vb = 0; vb < 2; ++vb)
#pragma unroll
        for (int ks = 0; ks < 4; ++ks) {
            const bf16x8 vf = tr_frag_b(img0, vb ? trb1 : trb0, ks);
            if (ks < 2) num[vb][0] = MFMA32(vf, pf0[ks], num[vb][0]);
            num[vb][1] = MFMA32(vf, pf1[ks], num[vb][1]);
        }
#pragma unroll
    for (int tb = 0; tb < 2; ++tb) {
        const float rden = 1.0f / den[tb]; float ss = 0.f;
#pragma unroll
        for (int vb = 0; vb < 2; ++vb)
#pragma unroll
            for (int i = 0; i < 16; ++i) { num[vb][tb][i] *= rden; ss += num[vb][tb][i] * num[vb][tb][i]; }
        ss = xh_sum(ss);
        const float rn = 1.0f / sqrtf(ss * (1.0f / 64.0f) + EPS);
#pragma unroll
        for (int vb = 0; vb < 2; ++vb)
#pragma unroll
            for (int i4 = 0; i4 < 4; ++i4) tl_put4(wl, 32 * tb + r, 32 * vb + 8 * i4 + 4 * hf, num[vb][tb][4 * i4] * rn, num[vb][tb][4 * i4 + 1] * rn, num[vb][tb][4 * i4 + 2] * rn, num[vb][tb][4 * i4 + 3] * rn);
    }
    tl_emit<1>(wl, lane, uptr(Z + zc(ZC_MO + h * 64) + row0 * ZRS), uptr(Z + zc(ZC_MG + h * 64) + row0 * ZRS), F_ml_norm_g + layer * 384 + h * 64, (GAS char*)uptr(F_Y + row0 * DM + 384 + h * 64));
}

__device__ __forceinline__ void ml_loc_wave(Frame& F, int layer, int cn, int h, LAS unsigned char* wl) {
    const int lane = F_lane, r = lane & 31, hf = lane >> 5;
    const int b = cn / NCHS, n = cn % NCHS;
    const size_t row0 = (size_t)b * SEQ + (size_t)n * CH;
    const bf16* Z = F_Z;
    LAS unsigned char* img0 = wl; LAS unsigned char* img1 = wl + IMG1;
    const unsigned dvo = dma_voff(lane);
    dma_rows67(uptr(Z + zc(ZC_MK + h * 64) + (row0 - 3) * ZRS), dvo, img0, lane);
    dma_tile_u(uptr(Z + zc(ZC_MV + h * 64) + row0 * ZRS), dvo, img1);
    const int rr = lane >> 3, ch = lane & 7;
    float wk[4][8];
    { const float* cw = F_conv_w + (size_t)layer * 4 * 768 + 384 + h * 64 + ch * 8;
#pragma unroll
      for (int j = 0; j < 4; ++j) { const f32x4 a = *(const f32x4*)(cw + j * 768), c = *(const f32x4*)(cw + j * 768 + 4);
          wk[j][0] = a[0]; wk[j][1] = a[1]; wk[j][2] = a[2]; wk[j][3] = a[3]; wk[j][4] = c[0]; wk[j][5] = c[1]; wk[j][6] = c[2]; wk[j][7] = c[3]; } }
    const float* g32 = F_G32 + (row0 + lane) * 32;
    const float ig = g32[h] + F_b_gates[layer * 12 + h];
    const float lf = logsigf(g32[6 + h] + F_b_gates[layer * 12 + 6 + h]);
    const float bc = wave_scan_add(lf, lane);
    const float g = __shfl(bc, 63);
    const float av = g - bc + ig;
    const float mloc = wave_max(av);
    const float w = fexp(av - mloc);
    asm volatile("s_waitcnt vmcnt(0)" ::: "memory");
#pragma unroll 2
    for (int it = 0; it < 8; ++it) {
        const int row = 8 * it + rr;
        float acc[8];
#pragma unroll
        for (int e = 0; e < 8; ++e) acc[e] = 0.f;
#pragma unroll
        for (int j = 0; j < 4; ++j) {
            v4u raw = *(LAS const v4u*)(img0 + tile_off(row + j, ch * 16));
            if (n == 0 && row + j < 3) raw = (v4u){0u, 0u, 0u, 0u};
            float z[8]; unpack8(raw, z);
#pragma unroll
            for (int e = 0; e < 8; ++e) acc[e] += z[e] * wk[j][e];
        }
        const int lo = tile_off(row, ch * 16);
        float v8[8]; unpack8(*(LAS const v4u*)(img1 + lo), v8);
        const float wr = __shfl(w, row);
        *(LAS v4u*)(img0 + lo) = __builtin_bit_cast(v4u, pack8(fsilu(acc[0]) * 0.125f, fsilu(acc[1]) * 0.125f, fsilu(acc[2]) * 0.125f, fsilu(acc[3]) * 0.125f,
                                                                fsilu(acc[4]) * 0.125f, fsilu(acc[5]) * 0.125f, fsilu(acc[6]) * 0.125f, fsilu(acc[7]) * 0.125f));
        *(LAS v4u*)(img1 + lo) = __builtin_bit_cast(v4u, pack8(v8[0] * wr, v8[1] * wr, v8[2] * wr, v8[3] * wr, v8[4] * wr, v8[5] * wr, v8[6] * wr, v8[7] * wr));
    }
    unsigned trb0, trb1; tr_bases(lane, trb0, trb1);
    f32x16 acc[2][2];
#pragma unroll
    for (int a = 0; a < 2; ++a)
#pragma unroll
        for (int c = 0; c < 2; ++c)
#pragma unroll
            for (int i = 0; i < 16; ++i) acc[a][c][i] = 0.f;
#pragma unroll
    for (int ks = 0; ks < 4; ++ks) {
        const bf16x8 v0 = tr_frag_b(img1, trb0, ks), v1 = tr_frag_b(img1, trb1, ks), k0 = tr_frag_b(img0, trb0, ks), k1 = tr_frag_b(img0, trb1, ks);
        acc[0][0] = MFMA32(k0, v0, acc[0][0]); acc[0][1] = MFMA32(k0, v1, acc[0][1]); acc[1][0] = MFMA32(k1, v0, acc[1][0]); acc[1][1] = MFMA32(k1, v1, acc[1][1]);
    }
    bf16* cst = (bf16*)F_CST + ((size_t)cn * 6 + h) * 4096;
#pragma unroll
    for (int kb = 0; kb < 2; ++kb)
#pragma unroll
        for (int vb = 0; vb < 2; ++vb)
#pragma unroll
            for (int i4 = 0; i4 < 4; ++i4)
                *(unsigned long long*)(cst + (32 * vb + r) * 64 + 32 * kb + 8 * i4 + 4 * hf) =
                    (unsigned long long)cvtpk(acc[kb][vb][4 * i4], acc[kb][vb][4 * i4 + 1]) | ((unsigned long long)cvtpk(acc[kb][vb][4 * i4 + 2], acc[kb][vb][4 * i4 + 3]) << 32);
    float s = 0.f;
#pragma unroll 8
    for (int j = 0; j < 64; ++j) s += __shfl(w, j) * bf2f(*(LAS const unsigned short*)(img0 + tile_off(j, 2 * lane)));
    F_NST[((size_t)cn * 6 + h) * 64 + lane] = s;
    if (lane == 0) { F_GS[cn * 6 + h] = g; F_MS[cn * 6 + h] = mloc; }
}

__device__ __forceinline__ float flogsig(float x) { return fminf(x, 0.f) - 0.6931471805599453f * __builtin_amdgcn_logf(1.0f + fexp(-fabsf(x))); }
__device__ __forceinline__ void gla_loc_wave(Frame& F, int layer, int cn, int hh, LAS unsigned char* wl) {
    const int lane = F_lane, hf = lane >> 5;
    const int b = cn / NCHS, n = cn % NCHS;
    const size_t row0 = (size_t)b * SEQ + (size_t)n * CH, row = row0 + lane;
    const bf16* Z = F_Z;
    dma_tile_u(uptr(Z + zc(ZC_GV + hh * 64) + row0 * ZRS), dma_voff(lane), wl + 8192);
    float ga[16];
    { const f32x4* gp = (const f32x4*)(F_G32 + row * 32 + 12);
#pragma unroll
      for (int q = 0; q < 4; ++q) { const f32x4 v = gp[q]; ga[4 * q] = v[0]; ga[4 * q + 1] = v[1]; ga[4 * q + 2] = v[2]; ga[4 * q + 3] = v[3]; } }
    const float* wa = F_w_alpha + (size_t)layer * 16 * 128 + hh * 32; const float* ba = F_b_alpha + layer * 128 + hh * 32;
    LAS float* wsl = (LAS float*)(wl + 16384);
    float tw_[8];
#pragma unroll
    for (int k = 0; k < 8; ++k) { const int i = lane + 64 * k; tw_[k] = wa[(i >> 5) * 128 + (i & 31)]; }
#pragma unroll
    for (int k = 0; k < 8; ++k) wsl[lane + 64 * k] = tw_[k];
    float bcv[32];
    {
        f32x4 a[8];
#pragma unroll
        for (int d4 = 0; d4 < 8; ++d4) a[d4] = *(const f32x4*)(ba + 4 * d4);
#pragma unroll
        for (int q = 0; q < 16; ++q) {
            f32x4 w_[8];
#pragma unroll
            for (int d4 = 0; d4 < 8; ++d4) w_[d4] = *(LAS const f32x4*)(wsl + q * 32 + 4 * d4);
            asm volatile("" : "+v"(w_[0]), "+v"(w_[1]), "+v"(w_[2]), "+v"(w_[3]), "+v"(w_[4]), "+v"(w_[5]), "+v"(w_[6]), "+v"(w_[7]));
#pragma unroll
            for (int d4 = 0; d4 < 8; ++d4) a[d4] += w_[d4] * ga[q];
        }
#pragma unroll
        for (int d4 = 0; d4 < 8; ++d4)
#pragma unroll
            for (int e = 0; e < 4; ++e) bcv[4 * d4 + e] = wave_scan_add(flogsig(a[d4][e]) * (1.0f / 16.0f), lane);
    }
    { f32x4* bp = (f32x4*)(F_BC + row * 128 + hh * 32);
#pragma unroll
      for (int q = 0; q < 8; ++q) bp[q] = (f32x4){bcv[4 * q], bcv[4 * q + 1], bcv[4 * q + 2], bcv[4 * q + 3]}; }
#pragma unroll
    for (int c = 0; c < 4; ++c) {
        float k8[8]; unpack8(*(const v4u*)(Z + zc(ZC_GK + hh * 32) + row * ZRS + 8 * c), k8);
#pragma unroll
        for (int e = 0; e < 8; ++e) k8[e] *= fexp(__shfl(bcv[8 * c + e], 63) - bcv[8 * c + e]);
        *(LAS v4u*)(wl + tile_off(lane, c * 16)) = __builtin_bit_cast(v4u, pack8(k8[0], k8[1], k8[2], k8[3], k8[4], k8[5], k8[6], k8[7]));
    }
    if (lane == 63) { f32x4* ap = (f32x4*)(F_ADEC + ((size_t)cn * 4 + hh) * 32);
#pragma unroll
        for (int q = 0; q < 8; ++q) ap[q] = (f32x4){fexp(bcv[4 * q]), fexp(bcv[4 * q + 1]), fexp(bcv[4 * q + 2]), fexp(bcv[4 * q + 3])}; }
    unsigned trb0, trb1; tr_bases(lane, trb0, trb1);
    f32x16 u0, u1;
#pragma unroll
    for (int i = 0; i < 16; ++i) { u0[i] = 0.f; u1[i] = 0.f; }
    asm volatile("s_waitcnt vmcnt(0)" ::: "memory");
#pragma unroll
    for (int ks = 0; ks < 4; ++ks) { const bf16x8 kd = tr_frag_b(wl, trb0, ks);
        u0 = MFMA32(tr_frag_b(wl + 8192, trb0, ks), kd, u0); u1 = MFMA32(tr_frag_b(wl + 8192, trb1, ks), kd, u1); }
    float* sst = F_SST + ((size_t)cn * 4 + hh) * 2048;
#pragma unroll
    for (int i = 0; i < 16; ++i) { const int v = (i & 3) + 8 * (i >> 2) + 4 * hf; sst[v * 32 + (lane & 31)] = u0[i]; sst[(32 + v) * 32 + (lane & 31)] = u1[i]; }
}

__device__ __forceinline__ void gla_out_wave(Frame& F, int layer, int cn, int hh, LAS unsigned char* wl) {
    const int lane = F_lane, r = lane & 31, hf = lane >> 5;
    const int b = cn / NCHS, n = cn % NCHS;
    const size_t row0 = (size_t)b * SEQ + (size_t)n * CH;
    const bf16* Z = F_Z;
    dma_tile_u(uptr(Z + zc(ZC_GV + hh * 64) + row0 * ZRS), dma_voff(lane), wl);
    const unsigned voffK = (unsigned)(r * ZRS + 8 * hf) * 2u, voffB = (unsigned)(r * 128 + 8 * hf) * 4u;
    gcp zq = uptr(Z + zc(ZC_GQ + hh * 32) + row0 * ZRS); gcp zk = uptr(Z + zc(ZC_GK + hh * 32) + row0 * ZRS); gcp bcb = uptr(F_BC + row0 * 128 + hh * 32);
    bf16x8 qf[2][2], kf[2][2];
    {
        v4u rq[2][2], rk[2][2]; f32x4 rc0[2][2], rc1[2][2];
#pragma unroll
        for (int blk = 0; blk < 2; ++blk)
#pragma unroll
            for (int s = 0; s < 2; ++s) {
                rq[blk][s] = *(const GAS v4u*)(zq + ((size_t)32 * blk * ZRS + 16 * s) * 2 + voffK); rk[blk][s] = *(const GAS v4u*)(zk + ((size_t)32 * blk * ZRS + 16 * s) * 2 + voffK);
                rc0[blk][s] = *(const GAS f32x4*)(bcb + ((size_t)32 * blk * 128 + 16 * s) * 4 + voffB); rc1[blk][s] = *(const GAS f32x4*)(bcb + ((size_t)32 * blk * 128 + 16 * s) * 4 + voffB + 16);
            }
        asm volatile("" : "+v"(rq[0][0]), "+v"(rq[0][1]), "+v"(rq[1][0]), "+v"(rq[1][1]), "+v"(rk[0][0]), "+v"(rk[0][1]), "+v"(rk[1][0]), "+v"(rk[1][1]));
        asm volatile("" : "+v"(rc0[0][0]), "+v"(rc0[0][1]), "+v"(rc0[1][0]), "+v"(rc0[1][1]), "+v"(rc1[0][0]), "+v"(rc1[0][1]), "+v"(rc1[1][0]), "+v"(rc1[1][1]));
#pragma unroll
        for (int blk = 0; blk < 2; ++blk)
#pragma unroll
            for (int s = 0; s < 2; ++s) {
                float q8[8], k8[8];
                unpack8(rq[blk][s], q8); unpack8(rk[blk][s], k8);
                const f32x4 c0 = rc0[blk][s], c1 = rc1[blk][s];
                const float bc8[8] = {c0[0], c0[1], c0[2], c0[3], c1[0], c1[1], c1[2], c1[3]};
#pragma unroll
                for (int e = 0; e < 8; ++e) { q8[e] *= 0.17677669529663687f * fexp(bc8[e]); k8[e] *= fexp(-bc8[e]); }
                qf[blk][s] = pack8(q8[0], q8[1], q8[2], q8[3], q8[4], q8[5], q8[6], q8[7]);
                kf[blk][s] = pack8(k8[0], k8[1], k8[2], k8[3], k8[4], k8[5], k8[6], k8[7]);
            }
    }
    bf16x8 pf0[2], pf1[4];
    {
        f32x16 s00, s01, s11;
#pragma unroll
        for (int i = 0; i < 16; ++i) { s00[i] = 0.f; s01[i] = 0.f; s11[i] = 0.f; }
#pragma unroll
        for (int s = 0; s < 2; ++s) { s00 = MFMA32(kf[0][s], qf[0][s], s00); s01 = MFMA32(kf[0][s], qf[1][s], s01); s11 = MFMA32(kf[1][s], qf[1][s], s11); }
#pragma unroll
        for (int i = 0; i < 16; ++i) { const int jr = (i & 3) + 8 * (i >> 2) + 4 * hf; if (jr > r) { s00[i] = 0.f; s11[i] = 0.f; } }
        pf0[0] = pack8(s00[0], s00[1], s00[2], s00[3], s00[4], s00[5], s00[6], s00[7]); pf0[1] = pack8(s00[8], s00[9], s00[10], s00[11], s00[12], s00[13], s00[14], s00[15]);
        pf1[0] = pack8(s01[0], s01[1], s01[2], s01[3], s01[4], s01[5], s01[6], s01[7]); pf1[1] = pack8(s01[8], s01[9], s01[10], s01[11], s01[12], s01[13], s01[14], s01[15]);
        pf1[2] = pack8(s11[0], s11[1], s11[2], s11[3], s11[4], s11[5], s11[6], s11[7]); pf1[3] = pack8(s11[8], s11[9], s11[10], s11[11], s11[12], s11[13], s11[14], s11[15]);
    }
    unsigned trb0, trb1; tr_bases(lane, trb0, trb1);
    gcp spb = uptr(F_SST + ((size_t)cn * 4 + hh) * 2048);
    f32x16 num[2][2];
#pragma unroll
    for (int vb = 0; vb < 2; ++vb) {
        bf16x8 sf[2];
#pragma unroll
        for (int s = 0; s < 2; ++s) sf[s] = ld_f32_frag(spb + ((size_t)32 * vb * 32 + 16 * s) * 4, (unsigned)(r * 32 + 8 * hf) * 4u);
#pragma unroll
        for (int tb = 0; tb < 2; ++tb) {
#pragma unroll
            for (int i = 0; i < 16; ++i) num[vb][tb][i] = 0.f;
#pragma unroll
            for (int s = 0; s < 2; ++s) num[vb][tb] = MFMA32(sf[s], qf[tb][s], num[vb][tb]);
        }
    }
    asm volatile("s_waitcnt vmcnt(0)" ::: "memory");
#pragma unroll
    for (int vb = 0; vb < 2; ++vb)
#pragma unroll
        for (int ks = 0; ks < 4; ++ks) {
            const bf16x8 vf = tr_frag_b(wl, vb ? trb1 : trb0, ks);
            if (ks < 2) num[vb][0] = MFMA32(vf, pf0[ks], num[vb][0]);
            num[vb][1] = MFMA32(vf, pf1[ks], num[vb][1]);
        }
#pragma unroll
    for (int tb = 0; tb < 2; ++tb) {
        float ss = 0.f;
#pragma unroll
        for (int vb = 0; vb < 2; ++vb)
#pragma unroll
            for (int i = 0; i < 16; ++i) ss += num[vb][tb][i] * num[vb][tb][i];
        ss = xh_sum(ss);
        const float rn = 1.0f / sqrtf(ss * (1.0f / 64.0f) + EPS);
#pragma unroll
        for (int vb = 0; vb < 2; ++vb)
#pragma unroll
            for (int i4 = 0; i4 < 4; ++i4) tl_put4(wl, 32 * tb + r, 32 * vb + 8 * i4 + 4 * hf, num[vb][tb][4 * i4] * rn, num[vb][tb][4 * i4 + 1] * rn, num[vb][tb][4 * i4 + 2] * rn, num[vb][tb][4 * i4 + 3] * rn);
    }
    tl_emit<2>(wl, lane, uptr(Z + zc(ZC_GG + hh * 64) + row0 * ZRS), (gcp)nullptr, F_gla_norm_g + layer * 256 + hh * 64, (GAS char*)uptr(F_Y + row0 * DM + 768 + hh * 64));
}

__device__ __forceinline__ void p2_local(Frame& F, int layer, int part) {
    int gw_ = F.vcu * NWAVES + F.wave; asm volatile("" : "+s"(gw_));
    const int gw = gw_, NGW = F.G * NWAVES;
    LAS unsigned char* wl = F.lds + RING_OFF + F.wave * WL_BYTES;
    constexpr int NA = NCHT * 6, NL = NCHT * 10;
    if (NGW == 2048) {
#define LOCAL_TASK(q) do { const int q_ = (q); if (q_ < NA) ml_loc_wave(F, layer, q_ / 6, q_ % 6, wl); else gla_loc_wave(F, layer, (q_ - NA) >> 2, (q_ - NA) & 3, wl); } while (0)
#if PROBE_T >= 61 && PROBE_T <= 79
        const unsigned long long tq0_ = __builtin_amdgcn_s_memrealtime();
#endif
        if (part == 0) {
            if (gw < NA) {
                const bool swap_ = (F.wave & 1) != 0;
#pragma unroll 1
                for (int st_ = 0; st_ < 2; ++st_) { if ((st_ == 0) != swap_) LOCAL_TASK(gw); else attn_wave(F, layer, gw / 6, gw % 6, wl); }
            } else { const int q0 = NA + 2 * (gw - NA); for (int q = q0; q < q0 + 2; ++q) LOCAL_TASK(q); }
        } else p3_scan(F, F.vcu, F.G);
#if PROBE_T >= 61 && PROBE_T <= 79
        { const unsigned dt_ = (unsigned)(__builtin_amdgcn_s_memrealtime() - tq0_);
          if (layer == 0 && F_lane == 0) {
              if (PROBE_T == 61 && part == 0 && gw < NA) atomicAdd((unsigned*)(F_ctl + 2048), dt_ >> 4);
              if (PROBE_T == 62 && part == 0 && gw >= NA) atomicAdd((unsigned*)(F_ctl + 2048), dt_ >> 4);
              if (PROBE_T == 63 && part == 0 && gw < NA) atomicMax((unsigned*)(F_ctl + 2048), dt_ * 10u);
              if (PROBE_T == 64 && part == 0 && gw >= NA) atomicMax((unsigned*)(F_ctl + 2048), dt_ * 10u);
              if (PROBE_T == 65 && part == 1 && gw < NA) atomicMax((unsigned*)(F_ctl + 2048), dt_ * 10u);
              if (PROBE_T == 67 && part == 0 && gw < NA) atomicMax((unsigned*)(F_ctl + 2048), (dt_ << 11) | (unsigned)gw);
              if (PROBE_T == 68 && part == 0 && gw < NA && gw >= 8) atomicMax((unsigned*)(F_ctl + 2048), (dt_ << 11) | (unsigned)gw);
              if (PROBE_T == 69 && part == 0 && gw < NA && gw >= 8) atomicMax((unsigned*)(F_ctl + 2048), dt_ * 10u);
              if (PROBE_T == 70 && part == 1 && gw < NA) atomicMax((unsigned*)(F_ctl + 2048), (dt_ << 11) | (unsigned)gw);
              if (PROBE_T == 71 && part == 1 && gw < NA) atomicMin((unsigned*)(F_ctl + 2050), (dt_ << 11) | (unsigned)gw);
              if (PROBE_T == 72 && part == 1 && gw < NA && dt_ > 4000u) atomicAdd((unsigned*)(F_ctl + 2048), 100u);
              if (PROBE_T == 73 && part == 1 && gw < NA && dt_ > 3600u) atomicAdd((unsigned*)(F_ctl + 2048), 100u);
              if (PROBE_T == 74 && part == 1 && gw < NA && gw >= 1280 && dt_ > 4000u) atomicAdd((unsigned*)(F_ctl + 2048), 100u);
              if (PROBE_T == 75 && part == 1 && gw < NA && (gw & 7) == 7 && dt_ > 4000u) atomicAdd((unsigned*)(F_ctl + 2048), 100u);
              if (PROBE_T == 66 && part == 1 && gw >= NA) atomicMax((unsigned*)(F_ctl + 2048), dt_ * 10u);
          } }
#endif
#undef LOCAL_TASK
    } else {
        if (part == 0) { for (int a = gw; a < NA; a += NGW) attn_wave(F, layer, a / 6, a % 6, wl);
            for (int q = gw; q < NL; q += NGW) { if (q < NA) ml_loc_wave(F, layer, q / 6, q % 6, wl); else gla_loc_wave(F, layer, (q - NA) >> 2, (q - NA) & 3, wl); } }
        else p3_scan(F, F.vcu, F.G);
    }
}
__device__ __forceinline__ void p4_outputs(Frame& F, int layer) {
    int gw_ = F.vcu * NWAVES + F.wave; asm volatile("" : "+s"(gw_));
    const int gw = gw_, NGW = F.G * NWAVES;
    LAS unsigned char* wl = F.lds + RING_OFF + F.wave * WL_BYTES;
    constexpr int NA = NCHT * 6, NG = NCHT * 4;
    if (NGW == 2048) {
        if (gw < NA) { ml_out_wave(F, layer, gw / 6, gw % 6, wl);
#if PROBE_DUP == 8
            ml_out_wave(F, layer, gw / 6, gw % 6, wl);
#endif
        }
        else { for (int q = gw - NA; q < NG; q += 512) gla_out_wave(F, layer, q >> 2, q & 3, wl);
#if PROBE_DUP == 9
            for (int q = gw - NA; q < NG; q += 512) gla_out_wave(F, layer, q >> 2, q & 3, wl);
#endif
        }
    } else {
        for (int a = gw; a < NA; a += NGW) ml_out_wave(F, layer, a / 6, a % 6, wl);
        for (int q = gw; q < NG; q += NGW) gla_out_wave(F, layer, q >> 2, q & 3, wl);
    }
}

__device__ __forceinline__ void p11_final(Frame& F) {
    int gw_ = F.vcu * NWAVES + F.wave; asm volatile("" : "+s"(gw_));
    const int gw = gw_, NGW = F.G * NWAVES;
    const float* ssq = F_SSQ + 2 * T;
    for (int m = gw; m < T; m += NGW) {
        const float rs = 1.0f / sqrtf(ssq[m] * (1.0f / 1024.0f) + EPS);
        const GAS unsigned long long* xr = (const GAS unsigned long long*)(F_XB + (size_t)m * DM) + F_lane;
        GAS f32x4* orow = (GAS f32x4*)(F_out + (size_t)m * DM) + F_lane; const GAS f32x4* gr = (const GAS f32x4*)F_final_g + F_lane;
#pragma unroll
        for (int j = 0; j < 4; ++j) { const unsigned long long w = xr[64 * j]; const f32x4 g = gr[64 * j];
            const f32x4 v = (f32x4){__uint_as_float((unsigned)w << 16), __uint_as_float((unsigned)w & 0xffff0000u), __uint_as_float((unsigned)(w >> 32) << 16), __uint_as_float((unsigned)(w >> 32) & 0xffff0000u)};
            orow[64 * j] = v * rs * g; }
    }
}

__global__ void __launch_bounds__(NTHR, 2) hymba_fwd(Args args) {
    extern __shared__ __attribute__((aligned(16))) unsigned char lds[];
    Frame F;
    F.lds = (LAS unsigned char*)lds;
    F.MISC = (volatile LAS unsigned*)(F.lds + MISC_OFF);
    F.wave = __builtin_amdgcn_readfirstlane(F_tid >> 6);
    F.G = gridDim.x; { const int bx = blockIdx.x; F.vcu = (F.G % 8 == 0) ? (bx % 8) * (F.G / 8) + bx / 8 : bx; }
    F.A = &args;
    for (int u = F_tid; u < (LDS_BYTES - LDSCTL_OFF) / 4; u += NTHR) ((LAS unsigned*)(F.lds + LDSCTL_OFF))[u] = 0u;
    __syncthreads();
    XcdBarrier bar; bar.bar = (unsigned*)(F_ctl + CW_BAR); bar.x = 0; bar.st = nullptr;
    if (N_LAUNCHES == 1) bar = xcd_barrier_post((unsigned*)(F_ctl + CW_BAR), F.MISC + 8);
#define GRID_BAR() do { if (N_LAUNCHES == 1) { XcdBarrier b2_ = bar; unsigned long long v_ = (unsigned long long)bar.bar; asm volatile("" : "+s"(v_)); b2_.bar = (unsigned*)v_; xcd_barrier(b2_); } } while (0)
#if PROBE_T == 16 || PROBE_T == 17
    const unsigned long long tk0_ = __builtin_amdgcn_s_memrealtime();
#endif
    const int lo = args.ph_lo, hi = args.ph_hi;
#if PROBE_T >= 40 && PROBE_T < 60
    unsigned tph_ = 0;
#endif
#pragma unroll 1
    for (int ph = lo; ph < hi; ++ph) {
#if PROBE_T >= 40 && PROBE_T < 60
        const unsigned long long tp0_ = __builtin_amdgcn_s_memrealtime();
#endif
        if (ph == 0) { p0_prologue(F);
#if PROBE_DUP == 4
            GRID_BAR(); p0_prologue(F);
#endif
        } else if (ph == NPHASE - 1) { p11_final(F);
        } else {
            const int layer = (ph - 1) / 5, k = (ph - 1) % 5;
            if (k == 0 || k == 4) {
                const int which = k ? 1 : 0, N = which ? DM : NP;
                pg8::Gemm g{which ? F_Y : F_XB, which ? F_Wout_t + (size_t)layer * DM * DM : F_Win_t + (size_t)layer * NP * DM, T, N, DM};
                pg8::EpiBoth E{which, pg8::EpiZ{F_Z, LDZ, F_SSQ + layer * T, F_G32, ZC_SM},
                               pg8::EpiRes{(const float*)nullptr, (const bf16*)F_XB, (float*)nullptr, F_XB, F_SSQ + (layer + 1) * T}};
                const bool split = (which == 0 && F.G == 256);
                { pg8::StaticOrder S; S.init(T, N, F.G, (int)blockIdx.x, split ? 1 : 0);
                  pg8::gemm_phase<pg8::EpiBoth, pg8::StaticOrder, true, true, false>(F.lds + RING_OFF, g, S, E); }
                if (split) {
                    pg8::StaticOrder S; S.init(T, N, F.G, (int)blockIdx.x, 2);
                    pg8::gemm_phase<pg8::EpiBoth, pg8::StaticOrder, true, true, true>(F.lds + RING_OFF, g, S, E);
                    if (ph == 1 && (int)blockIdx.x >= 128) { int wi_ = ((int)blockIdx.x - 128) * NWAVES + F.wave; asm volatile("" : "+s"(wi_)); p0_weights(F, 1, wi_, 128 * NWAVES); }
                }
            } else if (k == 1 || k == 2) { int part_ = k - 1; asm volatile("" : "+s"(part_)); p2_local(F, layer, part_);
            } else { p4_outputs(F, layer);
#if PROBE_DUP == 3
                GRID_BAR(); p4_outputs(F, layer);
#endif
            }
        }
        if (ph + 1 < hi) GRID_BAR();
#if PROBE_T >= 40 && PROBE_T < 60
        if (ph == PROBE_T - 40) tph_ = (unsigned)(__builtin_amdgcn_s_memrealtime() - tp0_);
#endif
    }
#if PROBE_T
    if (F.vcu == 100 && F.wave == 0) { unsigned n_ = __hip_atomic_load((unsigned*)(F_ctl + 2048), __ATOMIC_RELAXED, __HIP_MEMORY_SCOPE_AGENT);
#if PROBE_T == 16
        n_ = (unsigned)((__builtin_amdgcn_s_memrealtime() - tk0_) >> 1);
#endif
        if (PROBE_T == 13 || PROBE_T == 67 || PROBE_T == 68 || PROBE_T == 70) n_ = (n_ & 2047u) * 50u;
        if (PROBE_T >= 21 && PROBE_T <= 39) n_ = __hip_atomic_load((unsigned*)(F_ctl + 2049), __ATOMIC_RELAXED, __HIP_MEMORY_SCOPE_AGENT) * 10u;
#if PROBE_T >= 40 && PROBE_T < 60
        n_ = tph_ * 10u;
#endif
        const unsigned long long t0_ = __builtin_amdgcn_s_memrealtime(); while (__builtin_amdgcn_s_memrealtime() - t0_ < n_) __builtin_amdgcn_s_sleep(8); }
#endif
}

extern "C" void kernel_launch(void* const* d_in, const int* in_sizes, int n_in, void* d_out, int out_size, void* d_ws, size_t ws_size, hipStream_t stream) {
    static int grid = 0;
    if (grid == 0) {
        if (n_in != 12 || in_sizes[0] != T * DM || out_size != T * DM || ws_size < WS_END) {
            fprintf(stderr, "kernel_launch: unexpected shapes (n_in %d, in0 %d, out %d, ws %zu, need %zu); nothing launched\n", n_in, n_in > 0 ? in_sizes[0] : -1, out_size, ws_size, (size_t)WS_END); grid = -1; return; }
        int dev = 0, cus = 0, per_cu = 0;
        if (hipGetDevice(&dev) != hipSuccess || hipDeviceGetAttribute(&cus, hipDeviceAttributeMultiprocessorCount, dev) != hipSuccess) { fprintf(stderr, "kernel_launch: device query failed\n"); grid = -1; return; }
        if (hipFuncSetAttribute((const void*)hymba_fwd, hipFuncAttributeMaxDynamicSharedMemorySize, LDS_BYTES) != hipSuccess) { fprintf(stderr, "kernel_launch: hipFuncSetAttribute failed\n"); grid = -1; return; }
        if (hipOccupancyMaxActiveBlocksPerMultiprocessor(&per_cu, (const void*)hymba_fwd, NTHR, LDS_BYTES) != hipSuccess || per_cu < 1) {
            fprintf(stderr, "kernel_launch: occupancy query reports %d workgroups per CU; nothing launched\n", per_cu); (void)hipGetLastError(); grid = -1; return; }
        grid = cus;
        fprintf(stderr, "kernel_launch: grid %d x %d threads, %d B LDS, occupancy query %d/CU\n", grid, NTHR, LDS_BYTES, per_cu);
    }
    if (grid < 0) return;
    if (hipMemsetAsync((char*)d_ws + WS_CTL, 0, CTL_ZERO_BYTES, stream) != hipSuccess) { fprintf(stderr, "kernel_launch: memset failed\n"); return; }
    Args a{};
    for (int i = 0; i < 12; ++i) a.in[i] = (const float*)d_in[i];
    a.out = (float*)d_out; a.ws = (unsigned char*)d_ws;
    if (N_LAUNCHES == 1) {
        a.ph_lo = 0; a.ph_hi = NPHASE; a.li = 0;
        void* kargs[] = {&a};
        hipError_t e = hipLaunchCooperativeKernel((const void*)hymba_fwd, dim3(grid), dim3(NTHR), kargs, LDS_BYTES, stream);
        if (e != hipSuccess) fprintf(stderr, "kernel_launch: cooperative launch failed: %s\n", hipGetErrorString(e));
    } else {
        for (int p = 0; p < NPHASE; ++p) { a.ph_lo = p; a.ph_hi = p + 1; a.li = p;
            hipLaunchKernelGGL(hymba_fwd, dim3(grid), dim3(NTHR), LDS_BYTES, stream, a);
            if (hipPeekAtLastError() != hipSuccess) { fprintf(stderr, "kernel_launch: launch %d failed\n", p); break; } }
    }
}
```

```cpp
#include <hip/hip_runtime.h>
#include <cstdio>
#include <cstdint>
#include <cmath>

#ifndef PROBE_DUP
#define PROBE_DUP 0
#endif
#ifndef PROBE_T
#define PROBE_T 0
#endif
#ifndef MK_N_LAUNCHES
#define MK_N_LAUNCHES 1
#endif

namespace pg8 {
#define PG8_LAS __attribute__((address_space(3)))
typedef unsigned short bf16_t;
typedef short bf16x8 __attribute__((ext_vector_type(8)));
typedef float f32x4 __attribute__((ext_vector_type(4)));
typedef unsigned u32x4 __attribute__((ext_vector_type(4)));
constexpr int BM = 256, BK = 64, HALF = 128, HTB = HALF * BK * 2  , STAGE_BYTES = 8 * HTB, NXCD = 8, WGM = 8;

__host__ __device__ __forceinline__ int lds_byte(int r, int c) { const int st = (r >> 4) * 2 + (c >> 5), rr = r & 15, cc = c & 31, ob = rr * 64 + cc * 2; return st * 1024 + (ob ^ (((ob >> 9) & 1) << 5)); }
__host__ __device__ __forceinline__ void stage_rc(int b, int& R, int& C) { const int st = b / 1024, sb = b % 1024, swz = sb ^ (((sb >> 9) & 1) << 5); R = (st >> 1) * 16 + swz / 64; C = (st & 1) * 32 + (swz % 64) / 2; }
__host__ __device__ __forceinline__ int perm32(int rho) { const int n = rho >> 4, i = rho & 15; return 8 * (i >> 2) + 4 * n + (i & 3); }

struct Unit { int pm, pn, roff, half; };
struct Gemm { const bf16_t* A; const bf16_t* Bt; int M, N, K; };

struct StaticOrder {
    int nM, nN, nwg, G, c, mode;
    __host__ __device__ void init(int M, int N, int G_, int c_, int mode_ = 0) { nM = M / BM; nN = N / BM - (mode_ ? 1 : 0); nwg = nM * nN; G = G_; c = c_; mode = mode_; }
    __host__ __device__ bool next(int i, Unit& u) const {
        const long L = (long)i * G + c;
        if (mode == 2) { if (L >= 2 * nM) return false; u = Unit{(int)(L >> 1), nN, (int)(L & 1) * 128, 1}; return true; }
        if (L >= nwg) return false;
        int wgid = (int)L; { const int q = nwg / NXCD, r = nwg % NXCD, xcd = wgid % NXCD, off = wgid / NXCD; wgid = (xcd < r ? xcd * (q + 1) : r * (q + 1) + (xcd - r) * q) + off; }
        const int nig = WGM * nN, gid = wgid / nig, fm = gid * WGM, gsz = (nM - fm) < WGM ? (nM - fm) : WGM;
        u = Unit{fm + ((wgid % nig) % gsz), (wgid % nig) / gsz, 0, 0}; return true;
    }
    __device__ __forceinline__ void a_ready(const Unit&) const {}
    __device__ __forceinline__ void done(const Unit&) const {}
};

__device__ __forceinline__ unsigned cvt_pk_bf16(float lo, float hi) { unsigned r; asm volatile("v_cvt_pk_bf16_f32 %0, %1, %2" : "=v"(r) : "v"(lo), "v"(hi)); return r; }

typedef unsigned u32x2 __attribute__((ext_vector_type(2)));
struct EpiZ {
    bf16_t* Z; int ldz; const float* ssq; float* G32; int gcol0;
    __device__ __forceinline__ void operator()(f32x4 (&acc)[2][2][4][2], const Unit& u, int wr, int wc, int fr, int fq) const {
        const int row0 = u.pm * BM + u.roff + wr * 64 + fr, col0 = u.pn * BM + wc * 32 + 8 * fq;
        float rsv[2][4];
#pragma unroll
        for (int ai = 0; ai < 2; ++ai)
#pragma unroll
            for (int m = 0; m < 4; ++m) rsv[ai][m] = ssq[row0 + (u.half ? 0 : ai * HALF) + m * 16];
        asm volatile("" : "+v"(rsv[0][0]), "+v"(rsv[0][1]), "+v"(rsv[0][2]), "+v"(rsv[0][3]), "+v"(rsv[1][0]), "+v"(rsv[1][1]), "+v"(rsv[1][2]), "+v"(rsv[1][3]));
#pragma unroll
        for (int ai = 0; ai < 2; ++ai)
#pragma unroll
            for (int m = 0; m < 4; ++m) {
                if (ai == 1 && u.half) continue;
                const int row = row0 + ai * HALF + m * 16;
                const float rs = 1.0f / sqrtf(rsv[ai][m] * (1.0f / 1024.0f) + 1e-6f);
#pragma unroll
                for (int bj = 0; bj < 2; ++bj) {
                    const int col = col0 + bj * HALF;
                    const f32x4 v0 = acc[ai][bj][m][0] * rs, v1 = acc[ai][bj][m][1] * rs;
                    if (col < ldz) {
                        u32x4 w; w.x = cvt_pk_bf16(v0[0], v0[1]); w.y = cvt_pk_bf16(v0[2], v0[3]); w.z = cvt_pk_bf16(v1[0], v1[1]); w.w = cvt_pk_bf16(v1[2], v1[3]);
                        *(u32x4*)(Z + (size_t)(col >> 6) * ((size_t)16384 * 64) + (size_t)row * 64 + (col & 63)) = w;
                    } else if (col < gcol0 + 32) {
                        float* gp = G32 + (size_t)row * 32 + (col - gcol0);
                        *(f32x4*)gp = v0; *(f32x4*)(gp + 4) = v1;
                    }
                }
            }
    }
};
template <bool FIN>
struct EpiResT {
    const float* base; const bf16_t* baseb; float* out; bf16_t* xb; float* ssq;
    const float* fin_g; float* fin_out; unsigned* fin_cnt;
    __device__ __forceinline__ void ldres(int row, int col0, int bj, f32x4& r0, f32x4& r1) const {
        const size_t off = (size_t)row * 1024 + col0 + bj * HALF;
        if (base) { r0 = *(const f32x4*)(base + off); r1 = *(const f32x4*)(base + off + 4); }
        else { const u32x4 w = *(const u32x4*)(baseb + off);
            r0 = (f32x4){__uint_as_float(w.x << 16), __uint_as_float(w.x & 0xffff0000u), __uint_as_float(w.y << 16), __uint_as_float(w.y & 0xffff0000u)};
            r1 = (f32x4){__uint_as_float(w.z << 16), __uint_as_float(w.z & 0xffff0000u), __uint_as_float(w.w << 16), __uint_as_float(w.w & 0xffff0000u)}; }
    }
    __device__ __forceinline__ void operator()(f32x4 (&acc)[2][2][4][2], const Unit& u, int wr, int wc, int fr, int fq) const {
        const int col0 = u.pn * BM + wc * 32 + 8 * fq;
#pragma unroll
        for (int gh = 0; gh < 2; ++gh) {
        u32x4 rw[4][2];
#pragma unroll
        for (int g4 = 0; g4 < 4; ++g4) { const int row = u.pm * BM + gh * HALF + wr * 64 + g4 * 16 + fr;
#pragma unroll
            for (int bj = 0; bj < 2; ++bj) rw[g4][bj] = *(const u32x4*)(baseb + (size_t)row * 1024 + col0 + bj * HALF); }
        asm volatile("" : "+v"(rw[0][0]), "+v"(rw[0][1]), "+v"(rw[1][0]), "+v"(rw[1][1]), "+v"(rw[2][0]), "+v"(rw[2][1]), "+v"(rw[3][0]), "+v"(rw[3][1]));
#pragma unroll
        for (int g4 = 0; g4 < 4; ++g4) {
            const int ai = gh, m = g4;
            const int row = u.pm * BM + ai * HALF + wr * 64 + m * 16 + fr;
            float s = 0.f;
#pragma unroll
            for (int bj = 0; bj < 2; ++bj) {
                const size_t off = (size_t)row * 1024 + col0 + bj * HALF;
                const u32x4 w0 = rw[g4][bj];
                const f32x4 r0 = (f32x4){__uint_as_float(w0.x << 16), __uint_as_float(w0.x & 0xffff0000u), __uint_as_float(w0.y << 16), __uint_as_float(w0.y & 0xffff0000u)};
                const f32x4 r1 = (f32x4){__uint_as_float(w0.z << 16), __uint_as_float(w0.z & 0xffff0000u), __uint_as_float(w0.w << 16), __uint_as_float(w0.w & 0xffff0000u)};
                const f32x4 o0 = r0 + acc[ai][bj][m][0], o1 = r1 + acc[ai][bj][m][1];
                if (out) { *(f32x4*)(out + off) = o0; *(f32x4*)(out + off + 4) = o1; }
                s += (o0[0] * o0[0] + o0[1] * o0[1]) + (o0[2] * o0[2] + o0[3] * o0[3]) + (o1[0] * o1[0] + o1[1] * o1[1]) + (o1[2] * o1[2] + o1[3] * o1[3]);
                if (FIN) { acc[ai][bj][m][0] = o0; acc[ai][bj][m][1] = o1; }
                else if (xb) { u32x4 w; w.x = cvt_pk_bf16(o0[0], o0[1]); w.y = cvt_pk_bf16(o0[2], o0[3]); w.z = cvt_pk_bf16(o1[0], o1[1]); w.w = cvt_pk_bf16(o1[2], o1[3]); *(u32x4*)(xb + off) = w; }
            }
            s += __shfl_xor(s, 16); s += __shfl_xor(s, 32);
            if (fq == 0) atomicAdd(ssq + row, s);
        }
        }
        if (FIN) {
            f32x4 gv[2][2];
#pragma unroll
            for (int bj = 0; bj < 2; ++bj) { gv[bj][0] = *(const f32x4*)(fin_g + col0 + bj * HALF); gv[bj][1] = *(const f32x4*)(fin_g + col0 + bj * HALF + 4); }
            asm volatile("s_waitcnt vmcnt(0)" ::: "memory");
            __builtin_amdgcn_s_barrier();
            if (wr == 0 && wc == 0 && fr == 0 && fq == 0) {
                unsigned* c_ = fin_cnt + u.pm;
                const unsigned nt_ = 4u;
                __hip_atomic_fetch_add(c_, 1u, __ATOMIC_RELAXED, __HIP_MEMORY_SCOPE_AGENT);
                unsigned sp_ = 0;
                while (__hip_atomic_load(c_, __ATOMIC_RELAXED, __HIP_MEMORY_SCOPE_AGENT) < nt_) { __builtin_amdgcn_s_sleep(1); if (++sp_ > (1u << 22)) break; }
            }
            __builtin_amdgcn_s_barrier();
#pragma unroll
            for (int g = 0; g < 8; ++g) {
                const int ai = g >> 2, m = g & 3;
                const int row = u.pm * BM + ai * HALF + wr * 64 + m * 16 + fr;
                const float rs = 1.0f / sqrtf(__hip_atomic_load(ssq + row, __ATOMIC_RELAXED, __HIP_MEMORY_SCOPE_AGENT) * (1.0f / 1024.0f) + 1e-6f);
#pragma unroll
                for (int bj = 0; bj < 2; ++bj) {
                    const size_t off = (size_t)row * 1024 + col0 + bj * HALF;
                    *(f32x4*)(fin_out + off) = acc[ai][bj][m][0] * rs * gv[bj][0]; *(f32x4*)(fin_out + off + 4) = acc[ai][bj][m][1] * rs * gv[bj][1];
                }
            }
        }
    }
};
typedef EpiResT<false> EpiRes;
template <bool FIN>
struct EpiBothT {
    static constexpr bool PERM = true, AFTER_DRAIN = false;
    int mode; EpiZ z; EpiResT<FIN> r;
    __device__ __forceinline__ void operator()(f32x4 (&acc)[2][2][4][2], const Unit& u, int wr, int wc, int fr, int fq) const {
        if (mode == 0) z(acc, u, wr, wc, fr, fq); else r(acc, u, wr, wc, fr, fq);
    }
};
typedef EpiBothT<false> EpiBoth;

template <class Epi, class Sched, bool ALIGN_EPI = false, bool SP2 = false, bool HALFM = false>
__device__ __forceinline__ void gemm_phase(PG8_LAS unsigned char* lds, const Gemm g, const Sched& S, const Epi& E) {
    int tid_ = threadIdx.x; asm volatile("" : "+v"(tid_));
    const int tid = tid_, wid = __builtin_amdgcn_readfirstlane(tid >> 6), lane = tid & 63, wr = wid >> 2, wc = wid & 3, fr = lane & 15, fq = lane >> 4;
    const int K = g.K, nt = K / BK;
    unsigned voffA[2], voffB[2];
#pragma unroll
    for (int i = 0; i < 2; ++i) { int R, C; stage_rc(tid * 16 + i * 8192, R, C); const int Rb = Epi::PERM ? ((R & ~31) + perm32(R & 31)) : R;
        voffA[i] = (unsigned)(R * K + C) * 2u; voffB[i] = (unsigned)(Rb * K + C) * 2u; }
    const size_t kstep = (size_t)(BK * 2);
    const size_t hstep = (size_t)HALF * K * 2;
    const size_t tstep = 2 * hstep;
    const unsigned ldsw = (unsigned)wid * 1024u;
    const int aoff = lds_byte(wr * 64 + fr, fq * 8), boff = lds_byte(wc * 32 + fr, fq * 8);
#define PG8_SA(b, h) (((b) * 2 + (h)) * HTB)
#define PG8_SB(b, h) ((4 + (b) * 2 + (h)) * HTB)
#define PG8_STAGE(bufoff, gbase, voff) do { _Pragma("unroll") for (int _i = 0; _i < 2; ++_i) \
        __builtin_amdgcn_global_load_lds((const unsigned*)((const char*)(gbase) + (voff)[_i]), (PG8_LAS unsigned*)(lds + (bufoff) + ldsw + _i * 8192), 16, 0, 0); } while (0)
#define PG8_LDA(dst, b, h) do { _Pragma("unroll") for (int m = 0; m < 4; ++m) _Pragma("unroll") for (int k = 0; k < 2; ++k) dst[m][k] = *(const PG8_LAS bf16x8*)(lds + PG8_SA(b, h) + aoff + m * 2048 + k * 1024); } while (0)
#define PG8_LDB(dst, b, h) do { _Pragma("unroll") for (int n = 0; n < 2; ++n) _Pragma("unroll") for (int k = 0; k < 2; ++k) dst[n][k] = *(const PG8_LAS bf16x8*)(lds + PG8_SB(b, h) + boff + n * 2048 + k * 1024); } while (0)
#define PG8_MMA(ai, bj, At, Bt) do { __builtin_amdgcn_s_setprio(1); _Pragma("unroll") for (int m = 0; m < 4; ++m) _Pragma("unroll") for (int n = 0; n < 2; ++n) _Pragma("unroll") for (int k = 0; k < 2; ++k) \
        acc[ai][bj][m][n] = __builtin_amdgcn_mfma_f32_16x16x32_bf16(Bt[n][k], At[m][k], acc[ai][bj][m][n], 0, 0, 0); __builtin_amdgcn_s_setprio(0); } while (0)
#define PG8_WAIT_V(n) asm volatile("s_waitcnt vmcnt(" #n ")" ::: "memory")
#define PG8_WAIT_L(n) asm volatile("s_waitcnt lgkmcnt(" #n ")" ::: "memory")
#define PG8_BAR __builtin_amdgcn_s_barrier()
#define PG8_SCHED __builtin_amdgcn_sched_barrier(0)
    Unit cur, nxt; int ui = 0;
    if (!S.next(0, cur)) return;
    f32x4 acc[2][2][4][2];
#pragma unroll
    for (int a = 0; a < 2; ++a)
#pragma unroll
        for (int b = 0; b < 2; ++b)
#pragma unroll
            for (int m = 0; m < 4; ++m)
#pragma unroll
                for (int n = 0; n < 2; ++n) acc[a][b][m][n] = (f32x4){0.f, 0.f, 0.f, 0.f};
    bf16x8 At[4][2], B0[2][2], B1[2][2];
    const char* cA = (const char*)g.A + (size_t)cur.pm * tstep + (size_t)cur.roff * K * 2; const char* cB = (const char*)g.Bt + (size_t)cur.pn * tstep;
    S.a_ready(cur);
    if constexpr (SP2) {
        PG8_STAGE(PG8_SB(0, 0), cB, voffB); PG8_STAGE(PG8_SB(0, 1), cB + hstep, voffB); PG8_STAGE(PG8_SA(0, 0), cA, voffA); PG8_STAGE(PG8_SA(0, 1), cA + hstep, voffA);
        if (wr == 1) PG8_BAR;
        PG8_WAIT_V(2); PG8_BAR;
        PG8_STAGE(PG8_SB(1, 0), cB + kstep, voffB); PG8_STAGE(PG8_SA(1, 0), cA + kstep, voffA); PG8_STAGE(PG8_SB(1, 1), cB + hstep + kstep, voffB);
        PG8_WAIT_V(6); PG8_BAR;
    } else {
        PG8_STAGE(PG8_SB(0, 0), cB, voffB); PG8_STAGE(PG8_SA(0, 0), cA, voffA); PG8_STAGE(PG8_SB(0, 1), cB + hstep, voffB); PG8_STAGE(PG8_SA(0, 1), cA + hstep, voffA);
        if (wr == 1) PG8_BAR;
        PG8_WAIT_V(4); PG8_BAR;
        PG8_STAGE(PG8_SB(1, 0), cB + kstep, voffB); PG8_STAGE(PG8_SA(1, 0), cA + kstep, voffA); PG8_STAGE(PG8_SB(1, 1), cB + hstep + kstep, voffB);
        PG8_WAIT_V(6); PG8_BAR;
    }
    for (;;) {
        const bool has_next = S.next(ui + 1, nxt);
        const char* nA = has_next ? (const char*)g.A + (size_t)nxt.pm * tstep + (size_t)nxt.roff * K * 2 : cA; const char* nB = has_next ? (const char*)g.Bt + (size_t)nxt.pn * tstep : cB;
        for (int t = 0; t < nt; t += 2) {
            const bool last = (t == nt - 2);
            const char* a1 = cA + (size_t)(t + 1) * kstep;
            const char* a2 = last ? nA : cA + (size_t)(t + 2) * kstep; const char* b2 = last ? nB : cB + (size_t)(t + 2) * kstep;
            const char* a3 = a2 + kstep; const char* b3 = b2 + kstep;
            if (last && has_next) S.a_ready(nxt);
            if constexpr (SP2) {
            PG8_LDB(B0, 0, 0); PG8_LDB(B1, 0, 1); PG8_SCHED; PG8_LDA(At, 0, 0); if constexpr (!HALFM) PG8_STAGE(PG8_SA(1, 1), a1 + hstep, voffA);
            PG8_WAIT_V(8); PG8_WAIT_L(0); PG8_BAR; PG8_MMA(0, 0, At, B0); PG8_MMA(0, 1, At, B1); PG8_BAR; PG8_SCHED;
            if constexpr (!HALFM) PG8_LDA(At, 0, 1); PG8_STAGE(PG8_SB(0, 0), b2, voffB); PG8_STAGE(PG8_SB(0, 1), b2 + hstep, voffB); PG8_STAGE(PG8_SA(0, 0), a2, voffA);
            if constexpr (HALFM) PG8_WAIT_V(6); else PG8_WAIT_V(8); PG8_WAIT_L(0); PG8_BAR; if constexpr (!HALFM) { PG8_MMA(1, 0, At, B0); PG8_MMA(1, 1, At, B1); } PG8_BAR; PG8_SCHED;
            PG8_LDB(B0, 1, 0); PG8_LDB(B1, 1, 1); PG8_SCHED; PG8_LDA(At, 1, 0); if constexpr (!HALFM) PG8_STAGE(PG8_SA(0, 1), a2 + hstep, voffA);
            PG8_WAIT_V(8); PG8_WAIT_L(0); PG8_BAR; PG8_MMA(0, 0, At, B0); PG8_MMA(0, 1, At, B1); PG8_BAR; PG8_SCHED;
            if constexpr (!HALFM) PG8_LDA(At, 1, 1); PG8_STAGE(PG8_SB(1, 0), b3, voffB); PG8_STAGE(PG8_SB(1, 1), b3 + hstep, voffB); PG8_STAGE(PG8_SA(1, 0), a3, voffA);
            if constexpr (HALFM) PG8_WAIT_V(6); else PG8_WAIT_V(8); PG8_WAIT_L(0); PG8_BAR; if constexpr (!HALFM) { PG8_MMA(1, 0, At, B0); PG8_MMA(1, 1, At, B1); } PG8_BAR; PG8_SCHED;
            } else {
            PG8_LDB(B0, 0, 0); PG8_SCHED; PG8_LDA(At, 0, 0); PG8_STAGE(PG8_SA(1, 1), a1 + hstep, voffA);
            PG8_WAIT_L(8); PG8_BAR; PG8_WAIT_L(0); PG8_MMA(0, 0, At, B0); PG8_BAR; PG8_SCHED;
            PG8_LDB(B1, 0, 1); PG8_STAGE(PG8_SB(0, 0), b2, voffB);
            PG8_BAR; PG8_WAIT_L(0); PG8_MMA(0, 1, At, B1); PG8_BAR;
            PG8_LDA(At, 0, 1); PG8_STAGE(PG8_SA(0, 0), a2, voffA);
            PG8_BAR; PG8_WAIT_L(0); PG8_MMA(1, 0, At, B0); PG8_BAR; PG8_SCHED;
            PG8_STAGE(PG8_SB(0, 1), b2 + hstep, voffB);
            PG8_WAIT_V(6); PG8_BAR; PG8_MMA(1, 1, At, B1); PG8_BAR;
            PG8_LDB(B0, 1, 0); PG8_SCHED; PG8_LDA(At, 1, 0); PG8_STAGE(PG8_SA(0, 1), a2 + hstep, voffA);
            PG8_WAIT_L(8); PG8_BAR; PG8_WAIT_L(0); PG8_MMA(0, 0, At, B0); PG8_BAR; PG8_SCHED;
            PG8_LDB(B1, 1, 1); PG8_STAGE(PG8_SB(1, 0), b3, voffB);
            PG8_BAR; PG8_WAIT_L(0); PG8_MMA(0, 1, At, B1); PG8_BAR;
            PG8_LDA(At, 1, 1); PG8_STAGE(PG8_SA(1, 0), a3, voffA);
            PG8_BAR; PG8_WAIT_L(0); PG8_MMA(1, 0, At, B0); PG8_BAR; PG8_SCHED;
            PG8_STAGE(PG8_SB(1, 1), b3 + hstep, voffB);
            PG8_WAIT_V(6); PG8_BAR; PG8_MMA(1, 1, At, B1); PG8_BAR;
            }
        }
        if constexpr (ALIGN_EPI) { if (wr == 0) PG8_BAR; }
        if constexpr (!Epi::AFTER_DRAIN) { E(acc, cur, wr, wc, fr, fq); S.done(cur); }
        if (!has_next) break;
#pragma unroll
        for (int a = 0; a < 2; ++a)
#pragma unroll
            for (int b = 0; b < 2; ++b)
#pragma unroll
                for (int m = 0; m < 4; ++m)
#pragma unroll
                    for (int n = 0; n < 2; ++n) acc[a][b][m][n] = (f32x4){0.f, 0.f, 0.f, 0.f};
        cur = nxt; cA = nA; cB = nB; ++ui;
        if constexpr (ALIGN_EPI) { if (wr == 1) PG8_BAR; }
    }
    PG8_WAIT_V(0);
    if constexpr (!ALIGN_EPI) { if (wr == 0) PG8_BAR; }
    PG8_BAR;
    if constexpr (Epi::AFTER_DRAIN) { E.fused(acc, cur, wr, wc, fr, fq, lds, wid, lane); S.done(cur); }
#undef PG8_SA
#undef PG8_SB
#undef PG8_STAGE
#undef PG8_LDA
#undef PG8_LDB
#undef PG8_MMA
#undef PG8_WAIT_V
#undef PG8_WAIT_L
#undef PG8_BAR
#undef PG8_SCHED
}
}

constexpr int NWAVES = 8, NTHR = 512;
constexpr int N_LAUNCHES = MK_N_LAUNCHES;
constexpr int NPHASE = 12;
constexpr int BATCH = 2, SEQ = 8192, DM = 1024, T = BATCH * SEQ, DEPTH = 2, CH = 64, NCHT = T / CH  , NCHS = SEQ / CH  ;
constexpr int DIN = 4252, NP = 4352, LDZ = 4224;
constexpr int ZC_AQ = 0, ZC_AK = 384, ZC_AV = 768, ZC_AG = 1152, ZC_MQ = 1536, ZC_MK = 1920, ZC_MV = 2304, ZC_MO = 2688, ZC_MG = 3072, ZC_GQ = 3456, ZC_GK = 3584, ZC_GV = 3712, ZC_GG = 3968, ZC_SM = 4224;
constexpr float EPS = 1e-6f;
__host__ __device__ __forceinline__ int src_col(int n) {
    if (n < 3072) return n;
    if (n < 3968) return n + 12;
    if (n < 4224) return n + 28;
    if (n < 4236) return n - 1152;
    if (n < 4252) return n - 256;
    return -1;
}

constexpr size_t MiB = 1u << 20;
constexpr size_t WS_CTL = 0, CTL_ZERO_BYTES = 1 * MiB;
constexpr size_t WS_SSQ = 512 * 1024;
constexpr size_t WS_WIN = 1 * MiB;
constexpr size_t WS_WOUT = WS_WIN + (size_t)2 * NP * DM * 2;
constexpr size_t WS_XB = WS_WOUT + (size_t)2 * DM * DM * 2;
constexpr size_t WS_Y = WS_XB + (size_t)T * DM * 2;
constexpr size_t WS_Z = WS_Y + (size_t)T * DM * 2;
constexpr size_t WS_G32 = WS_Z + (size_t)T * LDZ * 2;
constexpr size_t WS_CST = WS_G32 + (size_t)T * 32 * 4;
constexpr size_t WS_NST = WS_CST + (size_t)NCHT * 6 * 4096 * 4;
constexpr size_t WS_SST = WS_NST + (size_t)NCHT * 6 * 64 * 4;
constexpr size_t WS_ADEC = WS_SST + (size_t)NCHT * 4 * 2048 * 4;
constexpr size_t WS_GS = WS_ADEC + (size_t)NCHT * 4 * 32 * 4;
constexpr size_t WS_MS = WS_GS + 8192;
constexpr size_t WS_MP = WS_MS + 8192;
constexpr size_t WS_END = WS_MP + 8192;
static_assert(WS_END <= 268435456, "d_ws map exceeds 256 MiB");
constexpr int CW_FIN = 16384;
constexpr int CW_BAR = 4096;

constexpr int RING_OFF = 0, RING_BYTES = 162816;
constexpr int WL_BYTES = 20352;
constexpr int LDSCTL_OFF = RING_BYTES, MISC_OFF = LDSCTL_OFF + 320;
constexpr int LDS_BYTES = 163840;
#define GAS __attribute__((address_space(1)))
#define LAS __attribute__((address_space(3)))
typedef unsigned short bf16;
typedef unsigned v4u __attribute__((ext_vector_type(4)));
typedef float f32x4 __attribute__((ext_vector_type(4)));
typedef short bf16x8 __attribute__((ext_vector_type(8)));
typedef GAS unsigned gu32;
typedef GAS unsigned long long gu64;
#define RLX_AGENT __ATOMIC_RELAXED, __HIP_MEMORY_SCOPE_AGENT
#define LDS_WAIT() asm volatile("s_waitcnt lgkmcnt(0)" ::: "memory")
#define VM_WAIT() asm volatile("s_waitcnt vmcnt(0)" ::: "memory")
__device__ __forceinline__ unsigned long long rt() { return __builtin_amdgcn_s_memrealtime(); }
__device__ __forceinline__ unsigned f2bf(float f) { unsigned u = __builtin_bit_cast(unsigned, f); return (u + 0x7fffu + ((u >> 16) & 1u)) >> 16; }
__device__ __forceinline__ unsigned pk2(float lo, float hi) { return f2bf(lo) | (f2bf(hi) << 16); }

#define XB_TMO      128
#define XB_XCNT(j)  (256  + 64 * (j))
#define XB_XSUB(j)  (1280 + 64 * (j))
#define XB_XGEN(j)  (2304 + 64 * (j))
#define XB_TOP      3328
#define XB_TOPGEN   3392
#define XCD_BAR_WORDS 3456
#define XB_SPIN_CAP (1u << 18)

__device__ __forceinline__ unsigned xb_ld(unsigned* p)              { return __hip_atomic_load(p, __ATOMIC_RELAXED, __HIP_MEMORY_SCOPE_AGENT); }
__device__ __forceinline__ unsigned xb_add(unsigned* p, unsigned v) { return __hip_atomic_fetch_add(p, v, __ATOMIC_RELAXED, __HIP_MEMORY_SCOPE_AGENT); }
__device__ __forceinline__ unsigned xb_xcc_id() { return (unsigned)__builtin_amdgcn_s_getreg((3 << 11) | 20) & 0xFu; }
#define XB_SPIN(cond, bar) do { unsigned _sp = 0; while (cond) { __builtin_amdgcn_s_sleep(1); \
    if ((++_sp & 255u) == 0u) { if (xb_ld(&(bar)[XB_TMO])) break; if (_sp > XB_SPIN_CAP) { atomicAdd(&(bar)[XB_TMO], 1u); break; } } } } while (0)

struct XcdBarrier {
    unsigned* bar; unsigned x;
    volatile LAS unsigned* st;
};

__device__ __forceinline__ XcdBarrier xcd_barrier_post(unsigned* bar, volatile LAS unsigned* st) {
    XcdBarrier b; b.bar = bar; b.x = xb_xcc_id(); b.st = st;
    if (threadIdx.x == 0) (void)xb_add(&bar[XB_XCNT(b.x)], 1u);
    return b;
}
__device__ __forceinline__ void xcd_barrier_complete(unsigned* bar, unsigned x, unsigned& nloc, unsigned& nx) {
    const unsigned G = gridDim.x * gridDim.y * gridDim.z;
    unsigned sum, cnt, mine, sp = 0u;
    for (;;) {
        sum = 0u; cnt = 0u; mine = 0u;
#pragma unroll 1
        for (unsigned j = 0; j < 16; ++j) { const unsigned c = xb_ld(&bar[XB_XCNT(j)]); sum += c; cnt += (c > 0u) ? 1u : 0u; mine = (j == x) ? c : mine; }
        if (sum == G) break;
        __builtin_amdgcn_s_sleep(1);
        if ((++sp & 255u) == 0u) { if (xb_ld(&bar[XB_TMO])) break; if (sp > XB_SPIN_CAP) { atomicAdd(&bar[XB_TMO], 1u); break; } }
    }
    nloc = mine > 0u ? mine : 1u; nx = cnt > 0u ? cnt : 1u;
}

__device__ __forceinline__ void xcd_barrier(const XcdBarrier& b) {
    asm volatile("s_waitcnt vmcnt(0)" ::: "memory");
    __syncthreads();
    if (threadIdx.x == 0) {
        unsigned* bar = b.bar;
        __builtin_amdgcn_s_waitcnt(0);
        unsigned nloc = b.st[0], nx = b.st[1];
        if (nloc == 0u) { xcd_barrier_complete(bar, b.x, nloc, nx); b.st[0] = nloc; b.st[1] = nx; }
        const unsigned old = xb_add(&bar[XB_XSUB(b.x)], 1u);
        const unsigned gen = old / nloc;
        if (old + 1u == (gen + 1u) * nloc) {
            __builtin_amdgcn_fence(__ATOMIC_RELEASE, "agent");
            asm volatile("s_waitcnt vmcnt(0)" ::: "memory");
            const unsigned og = xb_add(&bar[XB_TOP], 1u);
            const unsigned tg = og / nx;
            if (og + 1u == (tg + 1u) * nx) xb_add(&bar[XB_TOPGEN], 1u);
            else XB_SPIN(xb_ld(&bar[XB_TOPGEN]) == tg, bar);
            __builtin_amdgcn_fence(__ATOMIC_ACQUIRE, "agent");
            xb_add(&bar[XB_XGEN(b.x)], 1u);
            asm volatile("s_waitcnt vmcnt(0)" ::: "memory");
        } else {
            XB_SPIN(xb_ld(&bar[XB_XGEN(b.x)]) == gen, bar);
            __builtin_amdgcn_fence(__ATOMIC_ACQUIRE, "agent");
            asm volatile("s_waitcnt vmcnt(0)" ::: "memory");
        }
    }
    __syncthreads();
}


struct Args { const float* in[12]; float* out; unsigned char* ws; int ph_lo, ph_hi, li, pad; };
struct Frame {
    LAS unsigned char* lds;
    volatile LAS unsigned* MISC;
    const Args* A;
    int wave, vcu, G;
};
__device__ __forceinline__ int opaque_tid() { int t = threadIdx.x; asm volatile("" : "+v"(t)); return t; }
#define F_tid (opaque_tid())
#define F_lane (opaque_tid() & 63)
__device__ __forceinline__ const Args* opaque_args(const Args* a) { unsigned long long v = (unsigned long long)a; asm volatile("" : "+s"(v)); return (const Args*)v; }
#define F_A (F.A)
#define F_x          (F_A->in[0])
#define F_norm_g     (F_A->in[1])
#define F_w_in       (F_A->in[2])
#define F_b_gates    (F_A->in[3])
#define F_conv_w     (F_A->in[4])
#define F_w_alpha    (F_A->in[5])
#define F_b_alpha    (F_A->in[6])
#define F_rel_bias   (F_A->in[7])
#define F_ml_norm_g  (F_A->in[8])
#define F_gla_norm_g (F_A->in[9])
#define F_w_out      (F_A->in[10])
#define F_final_g    (F_A->in[11])
#define F_out        (F_A->out)
#define F_ws         (F_A->ws)
#define F_ctl        ((gu32*)(F_ws + WS_CTL))
#define F_Win_t      ((bf16*)(F_ws + WS_WIN))
#define F_Wout_t     ((bf16*)(F_ws + WS_WOUT))
#define F_XB         ((bf16*)(F_ws + WS_XB))
#define F_Y          ((bf16*)(F_ws + WS_Y))
#define F_Z          ((bf16*)(F_ws + WS_Z))
#define F_G32        ((float*)(F_ws + WS_G32))
#define F_SSQ        ((float*)(F_ws + WS_SSQ))
#define F_CST        ((float*)(F_ws + WS_CST))
#define F_NST        ((float*)(F_ws + WS_NST))
#define F_SST        ((float*)(F_ws + WS_SST))
#define F_ADEC       ((float*)(F_ws + WS_ADEC))
#define F_GS         ((float*)(F_ws + WS_GS))
#define F_MS         ((float*)(F_ws + WS_MS))
#define F_MP         ((float*)(F_ws + WS_MP))
#define F_BC         (F_out)
#define F_SPB        ((bf16*)(F_ws + WS_CST) + (size_t)NCHT * 6 * 4096)
#define F_CPB        ((bf16*)(F_out + (size_t)T * 128))
__device__ __forceinline__ float bf2f(unsigned short u) { return __uint_as_float((unsigned)u << 16); }
__device__ __forceinline__ float wave_sum(float v) {
#pragma unroll
    for (int o = 1; o < 64; o <<= 1) v += __shfl_xor(v, o);
    return v;
}
__device__ __forceinline__ float siluf(float x) { return x / (1.0f + expf(-x)); }
__device__ __forceinline__ float sigmf(float x) { return 1.0f / (1.0f + expf(-x)); }
__device__ __forceinline__ float logsigf(float x) { return fminf(x, 0.f) - log1pf(expf(-fabsf(x))); }
__device__ __forceinline__ void ld8(const bf16* p, float* o) {
    const v4u w = *(const v4u*)p;
    o[0] = __uint_as_float(w.x << 16); o[1] = __uint_as_float(w.x & 0xffff0000u); o[2] = __uint_as_float(w.y << 16); o[3] = __uint_as_float(w.y & 0xffff0000u);
    o[4] = __uint_as_float(w.z << 16); o[5] = __uint_as_float(w.z & 0xffff0000u); o[6] = __uint_as_float(w.w << 16); o[7] = __uint_as_float(w.w & 0xffff0000u);
}

template <bool PERMUTE>
__device__ __forceinline__ void p0_item_load(const float* W, int Nsrc, int Ndst, const float* gk, int item, int lane, float (&tv_)[32], float (&tg_)[32]) {
    const int nblk = Ndst / 32, kb = item / nblk, nb = item % nblk, k0 = 64 * kb, n0 = 32 * nb;
    const int nd = n0 + (lane & 31), ns = PERMUTE ? src_col(nd) : nd;
#pragma unroll
    for (int i = 0; i < 32; ++i) { const int kk = 2 * i + (lane >> 5);
        tv_[i] = (ns >= 0) ? __builtin_nontemporal_load(W + (size_t)(k0 + kk) * Nsrc + ns) : 0.f; tg_[i] = gk ? gk[k0 + kk] : 1.f; }
}
__device__ __forceinline__ void p0_item_store(int Ndst, bf16* WT, LAS float* scr, int item, int lane, const float (&tv_)[32], const float (&tg_)[32]) {
    const int nblk = Ndst / 32, kb = item / nblk, nb = item % nblk, k0 = 64 * kb, n0 = 32 * nb;
#pragma unroll
    for (int i = 0; i < 32; ++i) { const int kk = 2 * i + (lane >> 5); scr[kk * 33 + (lane & 31)] = tv_[i] * tg_[i]; }
    LDS_WAIT(); asm volatile("" ::: "memory");
    const int c = lane & 7;
#pragma unroll
    for (int j = 0; j < 4; ++j) { const int n = (lane >> 3) + 8 * j; const LAS float* s = scr + (8 * c) * 33 + n;
        v4u o; o.x = pk2(s[0 * 33], s[1 * 33]); o.y = pk2(s[2 * 33], s[3 * 33]); o.z = pk2(s[4 * 33], s[5 * 33]); o.w = pk2(s[6 * 33], s[7 * 33]);
        *(GAS v4u*)(WT + (size_t)(n0 + n) * 1024 + k0 + 8 * c) = o; }
    LDS_WAIT(); asm volatile("" ::: "memory");
}
__device__ __forceinline__ void p0_weights(Frame& F, int l, int wi, int nw) {
    LAS float* scr = (LAS float*)(F.lds + RING_OFF + F.wave * 16384);
    constexpr int I_IN = 16 * (NP / 32), I_OUT = 16 * (DM / 32), NI = I_IN + I_OUT;
#define P0_LOAD(it_, tv, tg) do { if ((it_) < I_IN) p0_item_load<true>(F_w_in + (size_t)l * DM * DIN, DIN, NP, F_norm_g + l * DM, (it_), F_lane, tv, tg); \
        else p0_item_load<false>(F_w_out + (size_t)l * DM * DM, DM, DM, nullptr, (it_) - I_IN, F_lane, tv, tg); } while (0)
#define P0_STORE(it_, tv, tg) do { if ((it_) < I_IN) p0_item_store(NP, F_Win_t + (size_t)l * NP * DM, scr, (it_), F_lane, tv, tg); \
        else p0_item_store(DM, F_Wout_t + (size_t)l * DM * DM, scr, (it_) - I_IN, F_lane, tv, tg); } while (0)
    for (int it = wi; it < NI; it += 2 * nw) {
        float ta[32], ga[32], tb[32], gb[32];
        const int it2 = it + nw; const bool two = it2 < NI;
        P0_LOAD(it, ta, ga);
        if (two) P0_LOAD(it2, tb, gb);
        P0_STORE(it, ta, ga);
        if (two) P0_STORE(it2, tb, gb);
    }
#undef P0_LOAD
#undef P0_STORE
}
__device__ __forceinline__ void p0_prologue(Frame& F) {
    int gw_ = F.vcu * NWAVES + F.wave; asm volatile("" : "+s"(gw_));
    const int gw = gw_, NGW = F.G * NWAVES;
    p0_weights(F, 0, gw, NGW);
    if (F.G != 256) p0_weights(F, 1, gw, NGW);
    for (int m0 = gw; m0 < T; m0 += 4 * NGW) {
        f32x4 v[4][4];
#pragma unroll
        for (int i = 0; i < 4; ++i) { const int m = (m0 + i * NGW < T) ? m0 + i * NGW : m0; const GAS f32x4* xr = (const GAS f32x4*)(F_x + (size_t)m * DM) + F_lane;
#pragma unroll
            for (int j = 0; j < 4; ++j) v[i][j] = __builtin_nontemporal_load(xr + 64 * j); }
        asm volatile("" : "+v"(v[0][0]), "+v"(v[0][1]), "+v"(v[0][2]), "+v"(v[0][3]), "+v"(v[1][0]), "+v"(v[1][1]), "+v"(v[1][2]), "+v"(v[1][3]));
        asm volatile("" : "+v"(v[2][0]), "+v"(v[2][1]), "+v"(v[2][2]), "+v"(v[2][3]), "+v"(v[3][0]), "+v"(v[3][1]), "+v"(v[3][2]), "+v"(v[3][3]));
#pragma unroll
        for (int i = 0; i < 4; ++i) { const int m = m0 + i * NGW;
            if (m < T) {
                GAS unsigned long long* o8 = (GAS unsigned long long*)(F_XB + (size_t)m * DM) + F_lane;
                float s = 0.f;
#pragma unroll
                for (int j = 0; j < 4; ++j) { const f32x4 w = v[i][j]; s += (w.x * w.x + w.y * w.y) + (w.z * w.z + w.w * w.w);
                    o8[64 * j] = (unsigned long long)pk2(w.x, w.y) | ((unsigned long long)pk2(w.z, w.w) << 32); }
                s = wave_sum(s);
                if (F_lane == 0) F_SSQ[m] = s;
            } }
    }
}

constexpr int LP = 65;
__device__ __forceinline__ void stage_conv(Frame& F, int layer, int b, int n, int zcol, int wch, float scale, LAS float* dst) {
    const float* cw = F_conv_w + (size_t)layer * 4 * 768;
    const int r0 = b * SEQ + n * CH;
    for (int idx = F_tid; idx < 4096; idx += NTHR) {
        const int t = idx >> 6, c = idx & 63;
        float a = 0.f;
#pragma unroll
        for (int j = 0; j < 4; ++j) { const int tt = t + j - 3;
            if (n * CH + tt >= 0) a += bf2f(F_Z[(size_t)(r0 + tt) * LDZ + zcol + c]) * cw[j * 768 + wch + c]; }
        dst[t * LP + c] = siluf(a) * scale;
    }
}
__device__ __forceinline__ void stage_tile(Frame& F, int b, int n, int zcol, int W, float scale, LAS float* dst, int pitch) {
    const int r0 = b * SEQ + n * CH;
    for (int idx = F_tid; idx < 64 * W; idx += NTHR) { const int t = idx / W, c = idx % W; dst[t * pitch + c] = bf2f(F_Z[(size_t)(r0 + t) * LDZ + zcol + c]) * scale; }
}
__device__ __forceinline__ void stage_mgates(Frame& F, int layer, int b, int n, int h, LAS float* ig, LAS float* bc, LAS float* lf) {
    const int r0 = b * SEQ + n * CH;
    if (F_tid < 64) { const float* g = F_G32 + (size_t)(r0 + F_tid) * 32;
        ig[F_tid] = g[h] + F_b_gates[layer * 12 + h]; lf[F_tid] = logsigf(g[6 + h] + F_b_gates[layer * 12 + 6 + h]); }
    __syncthreads();
    if (F_tid < 64) { float s = 0.f; for (int j = 0; j <= F_tid; ++j) s += lf[j]; bc[F_tid] = s; }
}
__device__ __forceinline__ void stage_gla_decay(Frame& F, int layer, int b, int n, int hh, LAS float* bcum) {
    const int r0 = b * SEQ + n * CH;
    const float* wa = F_w_alpha + (size_t)layer * 16 * 128; const float* ba = F_b_alpha + layer * 128;
    for (int idx = F_tid; idx < 2048; idx += NTHR) { const int t = idx >> 5, d = idx & 31;
        const float* g = F_G32 + (size_t)(r0 + t) * 32 + 12; float a = ba[hh * 32 + d];
#pragma unroll
        for (int r = 0; r < 16; ++r) a += g[r] * wa[r * 128 + hh * 32 + d];
        bcum[t * 33 + d] = logsigf(a) * (1.0f / 16.0f); }
    __syncthreads();
    if (F_tid < 32) { float s = 0.f; for (int t = 0; t < 64; ++t) { s += bcum[t * 33 + F_tid]; bcum[t * 33 + F_tid] = s; } }
    __syncthreads();
}

#define DPPF(old, x, ctrl, rmask) __uint_as_float(__builtin_amdgcn_update_dpp(__float_as_uint(old), __float_as_uint(x), (ctrl), (rmask), 0xf, false))
__device__ __forceinline__ void p3_scan(Frame& F, int ub_, int nb_) {
    LAS float* L = (LAS float*)(F.lds + RING_OFF);
    LAS float* so = L; LAS float* sn = L + 128; LAS float* ex = L + 512;
    LAS float* ex2 = L + 512 + 4096;
    const int tid = F_tid, w = tid >> 6, l = tid & 63;
    constexpr int UPB = 32, NU_M = 12 * UPB, NU = NU_M + 8 * 16;
    const int u0 = (int)(((long)ub_ * NU) / nb_), u1 = (int)(((long)(ub_ + 1) * NU) / nb_);
    int kindN = 0, bhN = 0, euN = 0, bN = 0, hN = 0; size_t baseN = 0, base2N = 0, adN = 0;
    unsigned long long rx[16], ry[16]; float rn[16];
#define P3_DESC(u_) do { const int uu_ = (u_); \
        if (uu_ < NU_M) { bhN = uu_ / UPB; euN = uu_ % UPB; bN = bhN / 6; hN = bhN % 6; kindN = (euN == 0) ? 1 : 0; \
            baseN = ((size_t)(bN * NCHS + 16 * w) * 6 + hN) * 4096 + euN * 128 + 2 * l; base2N = ((size_t)(bN * NCHS + 16 * w) * 6 + hN) * 64 + l; adN = 0; } \
        else { const int v_ = uu_ - NU_M; bhN = 100 + (v_ >> 4); euN = v_ & 15; bN = (v_ >> 4) >> 2; hN = (v_ >> 4) & 3; kindN = 2; \
            baseN = ((size_t)(bN * NCHS + 16 * w) * 4 + hN) * 2048 + euN * 128 + 2 * l; base2N = 0; adN = ((size_t)(bN * NCHS + 16 * w) * 4 + hN) * 32 + ((2 * l) & 31); } } while (0)
#define P3_LOAD() do { \
        if (kindN <= 1) { const bf16* p16_ = (const bf16*)F_CST + baseN; const float* pn_ = F_NST + base2N; \
            _Pragma("unroll") for (int i = 0; i < 16; ++i) { rx[i] = *(const unsigned*)(p16_ + (size_t)i * 6 * 4096); ry[i] = 0ull; rn[i] = (kindN == 1) ? pn_[(size_t)i * 6 * 64] : 0.f; } } \
        else { const float* p_ = F_SST + baseN; const float* ad_ = F_ADEC + adN;            \
            _Pragma("unroll") for (int i = 0; i < 16; ++i) { rx[i] = *(const unsigned long long*)(p_ + (size_t)i * 4 * 2048); ry[i] = *(const unsigned long long*)(ad_ + (size_t)i * 4 * 32); rn[i] = 0.f; } } } while (0)
    if (u0 < u1) { P3_DESC(u0); P3_LOAD(); }
    int cur_bh = -1, par = 0;
    for (int u = u0; u < u1; ++u, par ^= 1) {
        LAS float* exu = ex + par * 2048; LAS float* ex2u = ex2 + par * 512;
        const int kind = kindN, bh = bhN, eu = euN, b = bN, h = hN;
        const size_t base = baseN, base2 = base2N;
        if (kind <= 1 && bh != cur_bh) {
            __syncthreads();
            if (w == 0) {
                const int ci0 = (b * NCHS + 2 * l) * 6 + h, ci1 = ci0 + 6;
                const float a0 = F_GS[ci0], b0 = F_MS[ci0], a1 = F_GS[ci1], b1 = F_MS[ci1];
                float A = a0 + a1, B = fmaxf(b1, a1 + b0);
#define MP_STEP(ctrl, rmask) do { const float as_ = DPPF(0.f, A, ctrl, rmask), bs_ = DPPF(-3.0e38f, B, ctrl, rmask); B = fmaxf(B, A + bs_); A = A + as_; } while (0)
                MP_STEP(0x111, 0xf); MP_STEP(0x112, 0xf); MP_STEP(0x114, 0xf); MP_STEP(0x118, 0xf); MP_STEP(0x142, 0xa); MP_STEP(0x143, 0xc);
#undef MP_STEP
                float EA = __shfl_up(A, 1), EB = __shfl_up(B, 1); if (l == 0) { EA = 0.f; EB = -3.0e38f; }
                const float mp0 = fmaxf(EB, EA), m0 = fmaxf(b0, a0 + mp0), m1 = fmaxf(b1, a1 + m0);
                so[2 * l] = expf(a0 + mp0 - m0); sn[2 * l] = expf(b0 - m0); so[2 * l + 1] = expf(a1 + m0 - m1); sn[2 * l + 1] = expf(b1 - m1);
                if (eu == 0) { F_MP[ci0] = mp0; F_MP[ci1] = m0; }
            }
            __syncthreads();
            cur_bh = bh;
        }
        float c0[16], c1[16], c2[16], dcy0[16], dcy1[16];
        if (kind <= 1) {
#pragma unroll
            for (int i = 0; i < 16; ++i) { const unsigned x = (unsigned)rx[i]; const float s_ = sn[16 * w + i];
                c0[i] = __uint_as_float(x << 16) * s_; c1[i] = __uint_as_float(x & 0xffff0000u) * s_; dcy0[i] = so[16 * w + i]; dcy1[i] = dcy0[i]; c2[i] = rn[i] * s_; }
        } else {
#pragma unroll
            for (int i = 0; i < 16; ++i) { c0[i] = __uint_as_float((unsigned)rx[i]); c1[i] = __uint_as_float((unsigned)(rx[i] >> 32)); dcy0[i] = __uint_as_float((unsigned)ry[i]); dcy1[i] = __uint_as_float((unsigned)(ry[i] >> 32)); c2[i] = 0.f; }
        }
        if (u + 1 < u1) { P3_DESC(u + 1); P3_LOAD(); }
        float s0 = 0.f, s1 = 0.f, s2 = 0.f, P0 = 1.f, P1 = 1.f;
#pragma unroll
        for (int i = 0; i < 16; ++i) { const float a = c0[i], bb = c1[i], cc = c2[i]; c0[i] = s0; c1[i] = s1; c2[i] = s2; s0 = dcy0[i] * s0 + a; s1 = dcy1[i] * s1 + bb; s2 = dcy0[i] * s2 + cc; P0 *= dcy0[i]; P1 *= dcy1[i]; }
        exu[(w * 64 + l) * 4] = P0; exu[(w * 64 + l) * 4 + 1] = P1; exu[(w * 64 + l) * 4 + 2] = s0; exu[(w * 64 + l) * 4 + 3] = s1; ex2u[w * 64 + l] = s2;
        __syncthreads();
        float i0 = 0.f, i1 = 0.f, i2 = 0.f;
        for (int w2 = 0; w2 < w; ++w2) { const f32x4 e = *(LAS const f32x4*)(exu + (w2 * 64 + l) * 4); i0 = e[0] * i0 + e[2]; i1 = e[1] * i1 + e[3]; i2 = e[0] * i2 + ex2u[w2 * 64 + l]; }
        float q0 = i0, q1 = i1, q2 = i2;
        if (kind <= 1) {
            bf16* pb = F_CPB + base; float* pn = F_NST + base2;
#pragma unroll
            for (int i = 0; i < 16; ++i) { *(unsigned*)(pb + (size_t)i * 6 * 4096) = f2bf(c0[i] + q0) | (f2bf(c1[i] + q1) << 16);
                if (kind == 1) pn[(size_t)i * 6 * 64] = c2[i] + q2;
                q0 *= dcy0[i]; q1 *= dcy1[i]; q2 *= dcy0[i]; }
        } else { bf16* p = F_SPB + base;
#pragma unroll
            for (int i = 0; i < 16; ++i) { *(unsigned*)(p + (size_t)i * 4 * 2048) = f2bf(c0[i] + q0) | (f2bf(c1[i] + q1) << 16); q0 *= dcy0[i]; q1 *= dcy1[i]; }
        }
    }
#undef P3_DESC
#undef P3_LOAD
    __syncthreads();
}

#define P4_STORE8(o, kg, yrow, GATE_EXPR) do { _Pragma("unroll") for (int c8 = 0; c8 < 8; ++c8) if ((kg) == c8) { float yv[8]; \
    _Pragma("unroll") for (int i = 0; i < 8; ++i) { const int v = c8 * 8 + i; yv[i] = (o)[v] * (GATE_EXPR); } \
    v4u w; w.x = pk2(yv[0], yv[1]); w.y = pk2(yv[2], yv[3]); w.z = pk2(yv[4], yv[5]); w.w = pk2(yv[6], yv[7]); *(GAS v4u*)((yrow) + c8 * 8) = w; } } while (0)

__device__ __forceinline__ void p4_attn(Frame& F, int layer, int b, int n, int h) {
    const int t = F_tid >> 3, kg = F_tid & 7;
    const int r0 = b * SEQ + n * CH, row = r0 + t;
    LAS float* qL = (LAS float*)(F.lds + RING_OFF);
    stage_tile(F, b, n, ZC_AQ + h * 64, 64, 1.f, qL, LP);
    __syncthreads();
    float o[64];
#pragma unroll
    for (int c = 0; c < 64; ++c) o[c] = 0.f;
    float m = -1e30f, l = 0.f;
    const float* rb = F_rel_bias + (size_t)(layer * 6 + h) * 257;
    for (int i = 0; i < 72; ++i) {
        const int jb = kg + 8 * i, kpos = n * CH - 512 + jb;
        if (kpos < 0) continue;
        const bf16* kr = F_Z + (size_t)(b * SEQ + kpos) * LDZ + ZC_AK + h * 64;
        float s = 0.f;
#pragma unroll
        for (int c = 0; c < 8; ++c) { float kf[8]; ld8(kr + c * 8, kf);
#pragma unroll
            for (int e = 0; e < 8; ++e) s += qL[t * LP + c * 8 + e] * kf[e]; }
        int rel = t + 512 - jb; rel = rel < -128 ? -128 : (rel > 128 ? 128 : rel);
        s = s * 0.125f + rb[rel + 128];
        const float mn = fmaxf(m, s), a = expf(m - mn), p = expf(s - mn);
        l = l * a + p; m = mn;
        const bf16* vr = F_Z + (size_t)(b * SEQ + kpos) * LDZ + ZC_AV + h * 64;
#pragma unroll
        for (int c = 0; c < 8; ++c) { float vf[8]; ld8(vr + c * 8, vf);
#pragma unroll
            for (int e = 0; e < 8; ++e) o[c * 8 + e] = o[c * 8 + e] * a + p * vf[e]; }
    }
#pragma unroll
    for (int off = 1; off < 8; off <<= 1) {
        const float m2 = __shfl_xor(m, off), l2 = __shfl_xor(l, off);
        const float mn = fmaxf(m, m2), a = expf(m - mn), bb = expf(m2 - mn);
        l = l * a + l2 * bb; m = mn;
#pragma unroll
        for (int c = 0; c < 64; ++c) { const float o2 = __shfl_xor(o[c], off); o[c] = o[c] * a + o2 * bb; }
    }
    const float inv = 1.0f / l;
    const bf16* gr = F_Z + (size_t)row * LDZ + ZC_AG + h * 64;
    bf16* yrow = F_Y + (size_t)row * DM + h * 64;
    P4_STORE8(o, kg, yrow, inv * siluf(bf2f(gr[v])));
}

__device__ __forceinline__ void p4_mlstm(Frame& F, int layer, int b, int n, int h) {
    LAS float* L = (LAS float*)(F.lds + RING_OFF);
    LAS float* qc = L; LAS float* kc = qc + 64 * LP; LAS float* vv = kc + 64 * LP; LAS float* Cp = vv + 64 * LP;
    LAS float* np = Cp + 64 * LP; LAS float* ig = np + 64; LAS float* bc = ig + 64; LAS float* lf = bc + 64;
    const int cn = b * NCHS + n, r0 = b * SEQ + n * CH;
    stage_conv(F, layer, b, n, ZC_MQ + h * 64, h * 64, 1.f, qc);
    stage_conv(F, layer, b, n, ZC_MK + h * 64, 384 + h * 64, 0.125f, kc);
    stage_tile(F, b, n, ZC_MV + h * 64, 64, 1.f, vv, LP);
    { const float* cs = F_CST + ((size_t)cn * 6 + h) * 4096; for (int idx = F_tid; idx < 4096; idx += NTHR) Cp[(idx >> 6) * LP + (idx & 63)] = cs[idx]; }
    if (F_tid < 64) np[F_tid] = F_NST[((size_t)cn * 6 + h) * 64 + F_tid];
    stage_mgates(F, layer, b, n, h, ig, bc, lf);
    __syncthreads();
    const float mprev = F_MP[cn * 6 + h];
    const int t = F_tid >> 3, jg = F_tid & 7, row = r0 + t;
    const float bt = bc[t], il = bt + mprev;
    float mx = il;
    for (int i = 0; i < 8; ++i) { const int j = jg + 8 * i; if (j <= t) mx = fmaxf(mx, bt - bc[j] + ig[j]); }
    mx = fmaxf(mx, __shfl_xor(mx, 1)); mx = fmaxf(mx, __shfl_xor(mx, 2)); mx = fmaxf(mx, __shfl_xor(mx, 4));
    float num[64]; float den = 0.f;
#pragma unroll
    for (int c = 0; c < 64; ++c) num[c] = 0.f;
    for (int i = 0; i < 8; ++i) { const int j = jg + 8 * i;
        if (j <= t) { float dot = 0.f;
#pragma unroll 8
            for (int k = 0; k < 64; ++k) dot += qc[t * LP + k] * kc[j * LP + k];
            const float sc = dot * expf(bt - bc[j] + ig[j] - mx); den += sc;
#pragma unroll
            for (int c = 0; c < 64; ++c) num[c] += sc * vv[j * LP + c]; } }
    const float iw = expf(il - mx);
#pragma unroll 2
    for (int kk = 0; kk < 8; ++kk) { const int k = jg * 8 + kk; const float qk = qc[t * LP + k] * iw; den += qk * np[k];
#pragma unroll
        for (int c = 0; c < 64; ++c) num[c] += qk * Cp[c * LP + k]; }
#pragma unroll
    for (int off = 1; off < 8; off <<= 1) { den += __shfl_xor(den, off);
#pragma unroll
        for (int c = 0; c < 64; ++c) num[c] += __shfl_xor(num[c], off); }
    den = fmaxf(fabsf(den), expf(-mx));
    const float rden = 1.0f / den; float ss = 0.f;
#pragma unroll
    for (int c = 0; c < 64; ++c) { num[c] *= rden; ss += num[c] * num[c]; }
    const float rn = 1.0f / sqrtf(ss * (1.0f / 64.0f) + EPS);
    const bf16* mo = F_Z + (size_t)row * LDZ + ZC_MO + h * 64; const bf16* mg = F_Z + (size_t)row * LDZ + ZC_MG + h * 64;
    const float* gn = F_ml_norm_g + layer * 384 + h * 64;
    bf16* yrow = F_Y + (size_t)row * DM + 384 + h * 64;
    P4_STORE8(num, jg, yrow, rn * gn[v] * sigmf(bf2f(mo[v])) * siluf(bf2f(mg[v])));
}

__device__ __forceinline__ void p4_gla(Frame& F, int layer, int b, int n, int hh) {
    LAS float* L = (LAS float*)(F.lds + RING_OFF);
    LAS float* qx = L; LAS float* kk = qx + 64 * 33; LAS float* vv = kk + 64 * 33; LAS float* bcum = vv + 64 * LP; LAS float* Sp = bcum + 64 * 33;
    const int cn = b * NCHS + n, r0 = b * SEQ + n * CH;
    stage_tile(F, b, n, ZC_GQ + hh * 32, 32, 0.17677669529663687f, qx, 33);
    stage_tile(F, b, n, ZC_GK + hh * 32, 32, 1.f, kk, 33);
    stage_tile(F, b, n, ZC_GV + hh * 64, 64, 1.f, vv, LP);
    { const float* ss = F_SST + ((size_t)cn * 4 + hh) * 2048; for (int idx = F_tid; idx < 2048; idx += NTHR) Sp[(idx >> 6) * LP + (idx & 63)] = ss[idx]; }
    stage_gla_decay(F, layer, b, n, hh, bcum);
    const int t = F_tid >> 3, jg = F_tid & 7, row = r0 + t;
    float num[64];
#pragma unroll
    for (int c = 0; c < 64; ++c) num[c] = 0.f;
    for (int i = 0; i < 8; ++i) { const int j = jg + 8 * i;
        if (j <= t) { float att = 0.f;
#pragma unroll 4
            for (int d = 0; d < 32; ++d) att += qx[t * 33 + d] * kk[j * 33 + d] * expf(bcum[t * 33 + d] - bcum[j * 33 + d]);
#pragma unroll
            for (int c = 0; c < 64; ++c) num[c] += att * vv[j * LP + c]; } }
#pragma unroll 2
    for (int dd = 0; dd < 4; ++dd) { const int d = jg * 4 + dd; const float w = qx[t * 33 + d] * expf(bcum[t * 33 + d]);
#pragma unroll
        for (int c = 0; c < 64; ++c) num[c] += w * Sp[d * LP + c]; }
    float ss = 0.f;
#pragma unroll
    for (int off = 1; off < 8; off <<= 1) {
#pragma unroll
        for (int c = 0; c < 64; ++c) num[c] += __shfl_xor(num[c], off); }
#pragma unroll
    for (int c = 0; c < 64; ++c) ss += num[c] * num[c];
    const float rn = 1.0f / sqrtf(ss * (1.0f / 64.0f) + EPS);
    const bf16* gg = F_Z + (size_t)row * LDZ + ZC_GG + hh * 64;
    const float* gn = F_gla_norm_g + layer * 256 + hh * 64;
    bf16* yrow = F_Y + (size_t)row * DM + 768 + hh * 64;
    P4_STORE8(num, jg, yrow, rn * gn[v] * siluf(bf2f(gg[v])));
}

constexpr int ZRS = 64;
__host__ __device__ constexpr size_t zc(int col) { return (size_t)(col >> 6) * ((size_t)T * 64) + (size_t)(col & 63); }
typedef float f32x16 __attribute__((ext_vector_type(16)));
typedef short s16x4 __attribute__((ext_vector_type(4)));
typedef short v4i16_t __attribute__((ext_vector_type(4)));
typedef float f32x2_t __attribute__((ext_vector_type(2))); typedef __bf16 bf16x2_t __attribute__((ext_vector_type(2)));
__device__ __forceinline__ unsigned cvtpk(float lo, float hi) { f32x2_t v = {lo, hi}; bf16x2_t b = __builtin_convertvector(v, bf16x2_t); return __builtin_bit_cast(unsigned, b); }
__device__ __forceinline__ s16x4 lds_tr(LAS const unsigned char* p) { return __builtin_bit_cast(s16x4, __builtin_amdgcn_ds_read_tr16_b64_v4i16((LAS v4i16_t*)p)); }
__device__ __forceinline__ bf16x8 pack8(float a0, float a1, float a2, float a3, float a4, float a5, float a6, float a7) {
    v4u w; w.x = cvtpk(a0, a1); w.y = cvtpk(a2, a3); w.z = cvtpk(a4, a5); w.w = cvtpk(a6, a7); return __builtin_bit_cast(bf16x8, w); }
#define MFMA32(a, b, c) __builtin_amdgcn_mfma_f32_32x32x16_bf16((a), (b), (c), 0, 0, 0)
constexpr float LOG2E = 1.4426950408889634f;
__device__ __forceinline__ float fexp(float x) { return __builtin_amdgcn_exp2f(x * LOG2E); }
__device__ __forceinline__ float fsigm(float x) { return __builtin_amdgcn_rcpf(1.0f + fexp(-x)); }
__device__ __forceinline__ float fsilu(float x) { return x * fsigm(x); }
__device__ __forceinline__ int tile_off(int row, int bytecol) { return row * 128 + ((((bytecol >> 4) ^ (((row >> 1) & 1) << 2)) << 4) | (bytecol & 15)); }
__device__ __forceinline__ void dma_tile(const bf16* g, LAS unsigned char* tile, int lane) {
    const int rr = lane >> 3, cpos = lane & 7;
#pragma unroll
    for (int it = 0; it < 8; ++it) { const int row = 8 * it + rr, ch = cpos ^ (((row >> 1) & 1) << 2);
        __builtin_amdgcn_global_load_lds((const unsigned*)(g + (size_t)row * ZRS + ch * 8), (LAS unsigned*)(tile + it * 1024), 16, 0, 0); }
}
__device__ __forceinline__ bf16x8 tr_frag(LAS const unsigned char* tile, int lane, int c0, int ks) {
    const int g = lane >> 4, i = lane & 15, hf = g >> 1;
    const int row = 16 * ks + 4 * hf + (i >> 2), bc = (c0 + 16 * (g & 1) + 4 * (i & 3)) * 2;
    const s16x4 lo = lds_tr(tile + tile_off(row, bc)), hi = lds_tr(tile + tile_off(row + 8, bc));
    return (bf16x8){lo[0], lo[1], lo[2], lo[3], hi[0], hi[1], hi[2], hi[3]};
}

typedef const GAS char* gcp;
__device__ __forceinline__ gcp uptr(const void* p) { const unsigned long long v = (unsigned long long)p;
    const unsigned lo = __builtin_amdgcn_readfirstlane((unsigned)v), hi = __builtin_amdgcn_readfirstlane((unsigned)(v >> 32)); return (gcp)(((unsigned long long)hi << 32) | lo); }
__device__ __forceinline__ bf16x8 ldfrag(gcp ub, unsigned voff) { return *(const GAS bf16x8*)(ub + voff); }
__device__ __forceinline__ unsigned dma_voff(int lane) { const int rr = lane >> 3; return (unsigned)(rr * ZRS + (((lane & 7) ^ (((rr >> 1) & 1) << 2)) * 8)) * 2u; }
__device__ __forceinline__ void dma_tile_u(gcp ub, unsigned voff, LAS unsigned char* tile) {
#pragma unroll
    for (int it = 0; it < 8; ++it) __builtin_amdgcn_global_load_lds((const GAS unsigned*)(ub + (size_t)it * 8 * ZRS * 2 + voff), (LAS unsigned*)(tile + it * 1024), 16, 0, 0);
}
__device__ __forceinline__ void dma_tile_asm(gcp ub, unsigned voff, LAS unsigned char* tile) {
    const unsigned l0 = __builtin_amdgcn_readfirstlane((unsigned)(unsigned long long)tile);
    gcp ub2 = ub + 4096; unsigned keep;
#define DMA1_(SB, OFF, LD) asm volatile("s_mov_b32 %0, m0\n\ts_mov_b32 m0, %3\n\ts_nop 3\n\tglobal_load_lds_dwordx4 %1, %2 offset:" #OFF "\n\ts_mov_b32 m0, %0" : "=&s"(keep) : "v"(voff), "s"(SB), "s"(LD) : "memory")
    const unsigned l1 = l0 + 4096u;
    DMA1_(ub, 0, l0); DMA1_(ub, 1024, l0); DMA1_(ub, 2048, l0); DMA1_(ub, 3072, l0);
    DMA1_(ub2, 0, l1); DMA1_(ub2, 1024, l1); DMA1_(ub2, 2048, l1); DMA1_(ub2, 3072, l1);
#undef DMA1_
}
__device__ __forceinline__ void tr_bases(int lane, unsigned& b0, unsigned& b1) {
    const int g = lane >> 4, i = lane & 15, hf = g >> 1, row = 4 * hf + (i >> 2), bc = (16 * (g & 1) + 4 * (i & 3)) * 2;
    b0 = (unsigned)tile_off(row, bc); b1 = (unsigned)tile_off(row, bc + 64);
}
__device__ __forceinline__ bf16x8 tr_frag_b(LAS const unsigned char* tile, unsigned base, int ks) {
    const s16x4 lo = lds_tr(tile + base + ks * 2048), hi = lds_tr(tile + base + ks * 2048 + 1024);
    return (bf16x8){lo[0], lo[1], lo[2], lo[3], hi[0], hi[1], hi[2], hi[3]};
}

__device__ __forceinline__ void unpack8(v4u w, float* o) {
    o[0] = __uint_as_float(w.x << 16); o[1] = __uint_as_float(w.x & 0xffff0000u); o[2] = __uint_as_float(w.y << 16); o[3] = __uint_as_float(w.y & 0xffff0000u);
    o[4] = __uint_as_float(w.z << 16); o[5] = __uint_as_float(w.z & 0xffff0000u); o[6] = __uint_as_float(w.w << 16); o[7] = __uint_as_float(w.w & 0xffff0000u);
}
__device__ __forceinline__ float max3f(float a, float b, float c) { float r; asm("v_max3_f32 %0, %1, %2, %3" : "=v"(r) : "v"(a), "v"(b), "v"(c)); return r; }
__device__ __forceinline__ float xh_max(float x) { const auto rr = __builtin_amdgcn_permlane32_swap(__float_as_uint(x), __float_as_uint(x), false, false); return max3f(__uint_as_float(rr[0]), __uint_as_float(rr[1]), __uint_as_float(rr[1])); }
__device__ __forceinline__ float xh_sum(float x) { const auto rr = __builtin_amdgcn_permlane32_swap(__float_as_uint(x), __float_as_uint(x), false, false); return __uint_as_float(rr[0]) + __uint_as_float(rr[1]); }
constexpr int TLP = 68;
__device__ __forceinline__ void tl_put4(LAS unsigned char* wl, int t, int v, float a, float b, float c, float e) { *(LAS f32x4*)(wl + ((t * TLP + v) << 2)) = (f32x4){a, b, c, e}; }
template <int GATE>
__device__ __forceinline__ void tl_emit(LAS const unsigned char* wl, int lane, gcp g0, gcp g1, const float* gn, GAS char* yb) {
    const int rr = lane >> 3, c = lane & 7;
    float gnv[8];
    if (GATE != 0) { const f32x4 a = *(const f32x4*)(gn + 8 * c), b = *(const f32x4*)(gn + 8 * c + 4); gnv[0] = a[0]; gnv[1] = a[1]; gnv[2] = a[2]; gnv[3] = a[3]; gnv[4] = b[0]; gnv[5] = b[1]; gnv[6] = b[2]; gnv[7] = b[3]; }
    const unsigned voff = (unsigned)(rr * ZRS + 8 * c) * 2u, yoff = (unsigned)(rr * DM + 8 * c) * 2u;
    v4u ga[8], gb[8];
#pragma unroll
    for (int it = 0; it < 8; ++it) { ga[it] = *(const GAS v4u*)(g0 + (size_t)it * 8 * ZRS * 2 + voff); if (GATE == 1) gb[it] = *(const GAS v4u*)(g1 + (size_t)it * 8 * ZRS * 2 + voff); }
#pragma unroll
    for (int it = 0; it < 8; ++it) {
        const int row = 8 * it + rr;
        const f32x4 x0 = *(LAS const f32x4*)(wl + ((row * TLP + 8 * c) << 2)), x1 = *(LAS const f32x4*)(wl + ((row * TLP + 8 * c + 4) << 2));
        float x[8] = {x0[0], x0[1], x0[2], x0[3], x1[0], x1[1], x1[2], x1[3]}, p[8], q[8];
        unpack8(ga[it], p); if (GATE == 1) unpack8(gb[it], q);
#pragma unroll
        for (int e = 0; e < 8; ++e) {
            if (GATE == 0) x[e] *= fsilu(p[e]);
            else if (GATE == 1) x[e] *= gnv[e] * fsigm(p[e]) * fsilu(q[e]);
            else x[e] *= gnv[e] * fsilu(p[e]);
        }
        *(GAS v4u*)(yb + (size_t)it * 8 * DM * 2 + yoff) = __builtin_bit_cast(v4u, pack8(x[0], x[1], x[2], x[3], x[4], x[5], x[6], x[7]));
    }
}

__device__ __forceinline__ void attn_wave(Frame& F, int layer, int cn, int h, LAS unsigned char* wl) {
    const int lane = F_lane, r = lane & 31, hf = lane >> 5;
    const int b = cn / NCHS, n = cn % NCHS;
    const size_t row0 = (size_t)b * SEQ + (size_t)n * CH;
    const bf16* Z = F_Z;
    LAS float* rbl = (LAS float*)(wl + 16384);
    const float* rb = F_rel_bias + (size_t)(layer * 6 + h) * 257;
    float tb_[4];
#pragma unroll
    for (int k = 0; k < 4; ++k) { const int j = lane + 64 * k; tb_[k] = rb[j + 65 < 256 ? j + 65 : 256]; }
    const float bfar = rb[256] * LOG2E;
    constexpr float C1 = 0.125f * LOG2E;
    const unsigned voffK = (unsigned)(r * ZRS + 8 * hf) * 2u, voffV = dma_voff(lane);
    unsigned trb0, trb1; tr_bases(lane, trb0, trb1);
    bf16x8 qf[2][4];
    { gcp qb_ = uptr(Z + zc(ZC_AQ + h * 64) + row0 * ZRS);
#pragma unroll
    for (int qb = 0; qb < 2; ++qb)
#pragma unroll
        for (int s = 0; s < 4; ++s) qf[qb][s] = ldfrag(qb_ + ((size_t)32 * qb * ZRS + 16 * s) * 2, voffK); }
    const int i0 = (n >= 8) ? 0 : 8 - n;
#define KLOAD4(KF, VO, SB) do { \
        asm volatile("s_nop 4\n\tglobal_load_dwordx4 %0, %1, %2" : "+v"(KF[0]) : "v"(VO), "s"(SB) : "memory"); \
        asm volatile("global_load_dwordx4 %0, %1, %2 offset:32" : "+v"(KF[1]) : "v"(VO), "s"(SB) : "memory"); \
        asm volatile("global_load_dwordx4 %0, %1, %2 offset:64" : "+v"(KF[2]) : "v"(VO), "s"(SB) : "memory"); \
        asm volatile("global_load_dwordx4 %0, %1, %2 offset:96" : "+v"(KF[3]) : "v"(VO), "s"(SB) : "memory"); } while (0)
#define KWAIT(KF, N) asm volatile("s_waitcnt vmcnt(" #N ")" : "+v"(KF[0]), "+v"(KF[1]), "+v"(KF[2]), "+v"(KF[3]) :: "memory")
    dma_tile_asm(uptr(Z + zc(ZC_AV + h * 64) + (row0 - 512 + 64 * i0) * ZRS), voffV, wl + (i0 & 1) * 8192);
    bf16x8 kfa[4], kfb[4];
#pragma unroll
    for (int s = 0; s < 4; ++s) { kfa[s] = (bf16x8){0, 0, 0, 0, 0, 0, 0, 0}; kfb[s] = (bf16x8){0, 0, 0, 0, 0, 0, 0, 0}; }
    { gcp kb_ = uptr(Z + zc(ZC_AK + h * 64) + (row0 - 512 + 64 * i0) * ZRS); KLOAD4(kfa, voffK, kb_); }
#pragma unroll
    for (int k = 0; k < 4; ++k) { const int j = lane + 64 * k; if (j < 255) rbl[254 - j] = tb_[k] * 8.0f; }
    const int jl0 = r - 4 * hf + 4;
    f32x16 o[2][2];
#pragma unroll
    for (int a = 0; a < 2; ++a)
#pragma unroll
        for (int c = 0; c < 2; ++c)
#pragma unroll
            for (int i = 0; i < 16; ++i) o[a][c][i] = 0.f;
    float m[2] = {-1e30f, -1e30f}, lsum[2] = {0.f, 0.f};
    asm volatile("" :: "v"(qf[0][0]), "v"(qf[0][1]), "v"(qf[0][2]), "v"(qf[0][3]), "v"(qf[1][0]), "v"(qf[1][1]), "v"(qf[1][2]), "v"(qf[1][3]), "v"(bfar) : "memory");
#if PROBE_T >= 31 && PROBE_T <= 34
#define TS_(k) do { unsigned long long t_; asm volatile("s_memtime %0\n\ts_waitcnt lgkmcnt(0)" : "=s"(t_) :: "memory"); if ((k) > 0 && PROBE_T == 30 + (k)) tacc_ += (unsigned)(t_ - tprev_); tprev_ = t_; } while (0)
#else
#define TS_(k) do { } while (0)
#endif
#define ATTN_STEP(KF, KB) do { \
        TS_(0); \
        f32x16 st[2]; \
        const bool far_ = (ti <= 5); \
        if (far_) { _Pragma("unroll") for (int qb = 0; qb < 2; ++qb) { _Pragma("unroll") for (int i = 0; i < 16; ++i) st[qb][i] = 0.f; \
            _Pragma("unroll") for (int s = 0; s < 4; ++s) st[qb] = MFMA32(KF[s], qf[qb][s], st[qb]); } } \
        else { const int jr_ = 195 - (jl0 + 512 - 64 * ti) + 32 * (KB);            \
            _Pragma("unroll") for (int qb = 0; qb < 2; ++qb) { _Pragma("unroll") for (int i = 0; i < 16; ++i) st[qb][i] = rbl[jr_ - 32 * qb + ((i & 3) + 8 * (i >> 2))]; \
            _Pragma("unroll") for (int s = 0; s < 4; ++s) st[qb] = MFMA32(KF[s], qf[qb][s], st[qb]); } } \
        asm volatile("" : "+v"(st[0]), "+v"(st[1])); TS_(1); \
        const float boff_ = far_ ? bfar : 0.f; \
        bf16x8 pf[2][2]; \
        _Pragma("unroll") for (int qb = 0; qb < 2; ++qb) { \
            float ma = max3f(st[qb][0], st[qb][1], st[qb][2]), mb = max3f(st[qb][3], st[qb][4], st[qb][5]); \
            ma = max3f(ma, st[qb][6], st[qb][7]); mb = max3f(mb, st[qb][8], st[qb][9]); ma = max3f(ma, st[qb][10], st[qb][11]); mb = max3f(mb, st[qb][12], st[qb][13]); \
            float mx = max3f(ma, mb, max3f(st[qb][14], st[qb][15], st[qb][15])); \
            mx = mx * C1 + boff_;                       \
            mx = xh_max(mx); \
            if (__any(mx > m[qb] + 8.0f)) { const float mn = max3f(m[qb], mx, mx), alpha = __builtin_amdgcn_exp2f(m[qb] - mn); m[qb] = mn; lsum[qb] *= alpha; \
                _Pragma("unroll") for (int i = 0; i < 16; ++i) { o[0][qb][i] *= alpha; o[1][qb][i] *= alpha; } } \
            const float sc_ = C1, of_ = boff_ - m[qb]; \
            float ps0 = 0.f, ps1 = 0.f, ps2 = 0.f, ps3 = 0.f; \
            _Pragma("unroll") for (int i = 0; i < 16; i += 4) { \
                const float p0 = __builtin_amdgcn_exp2f(st[qb][i] * sc_ + of_), p1 = __builtin_amdgcn_exp2f(st[qb][i + 1] * sc_ + of_), p2 = __builtin_amdgcn_exp2f(st[qb][i + 2] * sc_ + of_), p3 = __builtin_amdgcn_exp2f(st[qb][i + 3] * sc_ + of_); \
                st[qb][i] = p0; st[qb][i + 1] = p1; st[qb][i + 2] = p2; st[qb][i + 3] = p3; ps0 += p0; ps1 += p1; ps2 += p2; ps3 += p3; } \
            lsum[qb] += (ps0 + ps1) + (ps2 + ps3); \
            pf[qb][0] = pack8(st[qb][0], st[qb][1], st[qb][2], st[qb][3], st[qb][4], st[qb][5], st[qb][6], st[qb][7]); \
            pf[qb][1] = pack8(st[qb][8], st[qb][9], st[qb][10], st[qb][11], st[qb][12], st[qb][13], st[qb][14], st[qb][15]); } \
        asm volatile("" : "+v"(pf[0][0]), "+v"(pf[0][1]), "+v"(pf[1][0]), "+v"(pf[1][1])); TS_(2); \
        bf16x8 vf_[2][2];            \
        _Pragma("unroll") for (int k2 = 0; k2 < 2; ++k2) _Pragma("unroll") for (int dvb = 0; dvb < 2; ++dvb) vf_[k2][dvb] = tr_frag_b(vt, dvb ? trb1 : trb0, 2 * (KB) + k2); \
        asm volatile("" : "+v"(vf_[0][0]), "+v"(vf_[0][1]), "+v"(vf_[1][0]), "+v"(vf_[1][1])); \
        _Pragma("unroll") for (int k2 = 0; k2 < 2; ++k2) _Pragma("unroll") for (int dvb = 0; dvb < 2; ++dvb) { \
            o[dvb][0] = MFMA32(vf_[k2][dvb], pf[0][k2], o[dvb][0]); o[dvb][1] = MFMA32(vf_[k2][dvb], pf[1][k2], o[dvb][1]); } \
        TS_(3); \
    } while (0)
#if PROBE_T >= 31 && PROBE_T <= 34
    unsigned tacc_ = 0; unsigned long long tprev_ = 0; const unsigned long long tl0_ = __builtin_amdgcn_s_memtime();
#endif
#pragma unroll 1
    for (int ti = i0; ti < 9; ++ti) {
        const size_t kr0 = row0 - 512 + 64 * ti;
        LAS const unsigned char* vt = wl + (ti & 1) * 8192;
        gcp kb1_ = uptr(Z + zc(ZC_AK + h * 64) + (kr0 + 32) * ZRS);
        gcp kb2_ = uptr(Z + zc(ZC_AK + h * 64) + (kr0 + 64) * ZRS);
        KLOAD4(kfb, voffK, kb1_);
        dma_tile_asm(uptr(Z + zc(ZC_AV + h * 64) + (kr0 + 64) * ZRS), voffV, wl + ((ti + 1) & 1) * 8192);
        KWAIT(kfa, 12);
        ATTN_STEP(kfa, 0);
        KLOAD4(kfa, voffK, kb2_);
        KWAIT(kfb, 12);
        ATTN_STEP(kfb, 1);
    }
    KWAIT(kfa, 0);
#if PROBE_T >= 31 && PROBE_T <= 34
    if (cn * 6 + h == 900 && layer == 0 && lane == 0) { const unsigned v_ = (PROBE_T == 34) ? (unsigned)(__builtin_amdgcn_s_memtime() - tl0_) : tacc_;
        __hip_atomic_store((unsigned*)(F_ctl + 2049), v_ / 21u, __ATOMIC_RELAXED, __HIP_MEMORY_SCOPE_AGENT); }
#endif
#undef KLOAD4
#undef KWAIT
#undef ATTN_STEP
#pragma unroll
    for (int qb = 0; qb < 2; ++qb) {
        const float l = xh_sum(lsum[qb]), inv = 1.0f / l;
#pragma unroll
        for (int dvb = 0; dvb < 2; ++dvb)
#pragma unroll
            for (int i4 = 0; i4 < 4; ++i4) tl_put4(wl, 32 * qb + r, 32 * dvb + 8 * i4 + 4 * hf, o[dvb][qb][4 * i4] * inv, o[dvb][qb][4 * i4 + 1] * inv, o[dvb][qb][4 * i4 + 2] * inv, o[dvb][qb][4 * i4 + 3] * inv);
    }
    tl_emit<0>(wl, lane, uptr(Z + zc(ZC_AG + h * 64) + row0 * ZRS), (gcp)nullptr, nullptr, (GAS char*)uptr(F_Y + row0 * DM + h * 64));
}

__device__ __forceinline__ float wave_scan_add(float x, int) {
    x += DPPF(0.f, x, 0x111, 0xf);
    x += DPPF(0.f, x, 0x112, 0xf);
    x += DPPF(0.f, x, 0x114, 0xf);
    x += DPPF(0.f, x, 0x118, 0xf);
    x += DPPF(0.f, x, 0x142, 0xa);
    x += DPPF(0.f, x, 0x143, 0xc);
    return x;
}
__device__ __forceinline__ float wave_scan_max(float x, int) {
    const float ninf = -3.0e38f;
    x = fmaxf(x, DPPF(ninf, x, 0x111, 0xf));
    x = fmaxf(x, DPPF(ninf, x, 0x112, 0xf));
    x = fmaxf(x, DPPF(ninf, x, 0x114, 0xf));
    x = fmaxf(x, DPPF(ninf, x, 0x118, 0xf));
    x = fmaxf(x, DPPF(ninf, x, 0x142, 0xa));
    x = fmaxf(x, DPPF(ninf, x, 0x143, 0xc));
    return x;
}
__device__ __forceinline__ float wave_max(float x) {
#pragma unroll
    for (int o = 1; o < 64; o <<= 1) x = fmaxf(x, __shfl_xor(x, o));
    return x;
}
__device__ __forceinline__ void conv8(const char* zub, unsigned voff, int blk, int s, int tt, int n, LAS const float* w, int c0, float scale, float* out) {
    float acc[8];
#pragma unroll
    for (int e = 0; e < 8; ++e) acc[e] = 0.f;
#pragma unroll
    for (int j = 0; j < 4; ++j) {
        v4u raw = *(const v4u*)(zub + ((long)(32 * blk + j - 3) * ZRS + 16 * s) * 2 + voff);
        if (!(n > 0 || tt + j - 3 >= 0)) raw = (v4u){0u, 0u, 0u, 0u};
        float z[8]; unpack8(raw, z);
        const f32x4 w0 = *(LAS const f32x4*)(w + j * 64 + c0), w1 = *(LAS const f32x4*)(w + j * 64 + c0 + 4);
        acc[0] += z[0] * w0[0]; acc[1] += z[1] * w0[1]; acc[2] += z[2] * w0[2]; acc[3] += z[3] * w0[3];
        acc[4] += z[4] * w1[0]; acc[5] += z[5] * w1[1]; acc[6] += z[6] * w1[2]; acc[7] += z[7] * w1[3];
    }
#pragma unroll
    for (int e = 0; e < 8; ++e) out[e] = fsilu(acc[e]) * scale;
}
__device__ __forceinline__ bf16x8 ld_f32_frag(gcp ub, unsigned voff) {
    const f32x4 a = *(const GAS f32x4*)(ub + voff), b = *(const GAS f32x4*)(ub + voff + 16);
    return pack8(a[0], a[1], a[2], a[3], b[0], b[1], b[2], b[3]);
}

__device__ __forceinline__ void dma_rows67(gcp ub, unsigned voff, LAS unsigned char* img, int lane) {
#pragma unroll
    for (int it = 0; it < 8; ++it) __builtin_amdgcn_global_load_lds((const GAS unsigned*)(ub + (size_t)it * 8 * ZRS * 2 + voff), (LAS unsigned*)(img + it * 1024), 16, 0, 0);
    if (lane < 24) __builtin_amdgcn_global_load_lds((const GAS unsigned*)(ub + (size_t)64 * ZRS * 2 + voff), (LAS unsigned*)(img + 8192), 16, 0, 0);
}
constexpr int IMG1 = 8704;
__device__ __forceinline__ void ml_out_wave(Frame& F, int layer, int cn, int h, LAS unsigned char* wl) {
    const int lane = F_lane, r = lane & 31, hf = lane >> 5;
    const int b = cn / NCHS, n = cn % NCHS;
    const size_t row0 = (size_t)b * SEQ + (size_t)n * CH;
    const bf16* Z = F_Z;
    LAS unsigned char* img0 = wl; LAS unsigned char* img1 = wl + IMG1;
    LAS float* wq = (LAS float*)(wl + 17408); LAS float* wk = wq + 256; LAS float* npl = wq + 512;
    const unsigned dvo = dma_voff(lane);
    dma_rows67(uptr(Z + zc(ZC_MQ + h * 64) + (row0 - 3) * ZRS), dvo, img0, lane);
    dma_rows67(uptr(Z + zc(ZC_MK + h * 64) + (row0 - 3) * ZRS), dvo, img1, lane);
    { const float* cw = F_conv_w + (size_t)layer * 4 * 768 + h * 64 + lane; float tq_[4], tk_[4];
#pragma unroll
      for (int j = 0; j < 4; ++j) { tq_[j] = cw[j * 768]; tk_[j] = cw[j * 768 + 384]; }
#pragma unroll
      for (int j = 0; j < 4; ++j) { wq[j * 64 + lane] = tq_[j]; wk[j * 64 + lane] = tk_[j]; } }
    npl[lane] = F_NST[((size_t)cn * 6 + h) * 64 + lane];
    const float* g32 = F_G32 + (row0 + lane) * 32;
    const float ig = g32[h] + F_b_gates[layer * 12 + h];
    const float lf = logsigf(g32[6 + h] + F_b_gates[layer * 12 + 6 + h]);
    const float bc = wave_scan_add(lf, lane);
    const float av = ig - bc;
    const float amax = wave_scan_max(av, lane);
    const float mprev = F_MP[cn * 6 + h];
    float bct[2], mt[2], iw[2];
#pragma unroll
    for (int tb = 0; tb < 2; ++tb) { bct[tb] = __shfl(bc, 32 * tb + r); mt[tb] = fmaxf(mprev, __shfl(amax, 32 * tb + r)); iw[tb] = fexp(mprev - mt[tb]); }
    asm volatile("s_waitcnt vmcnt(0)" ::: "memory");
    bf16x8 qcf[2][4], kcf[2][4];
    float nq[2] = {0.f, 0.f};
#pragma unroll
    for (int s = 0; s < 4; ++s) {
        const int c0 = 16 * s + 8 * hf;
        const f32x4 n0 = *(LAS const f32x4*)(npl + c0), n1 = *(LAS const f32x4*)(npl + c0 + 4);
#pragma unroll
        for (int blk = 0; blk < 2; ++blk) {
            float aq[8], ak[8];
#pragma unroll
            for (int e = 0; e < 8; ++e) { aq[e] = 0.f; ak[e] = 0.f; }
#pragma unroll
            for (int j = 0; j < 4; ++j) {
                const int rho = 32 * blk + r + j, off = tile_off(rho, c0 * 2);
                v4u rq = *(LAS const v4u*)(img0 + off), rk = *(LAS const v4u*)(img1 + off);
                if (n == 0 && rho < 3) { rq = (v4u){0u, 0u, 0u, 0u}; rk = (v4u){0u, 0u, 0u, 0u}; }
                float zq[8], zk[8]; unpack8(rq, zq); unpack8(rk, zk);
                const f32x4 a0 = *(LAS const f32x4*)(wq + j * 64 + c0), a1 = *(LAS const f32x4*)(wq + j * 64 + c0 + 4), b0 = *(LAS const f32x4*)(wk + j * 64 + c0), b1 = *(LAS const f32x4*)(wk + j * 64 + c0 + 4);
                aq[0] += zq[0] * a0[0]; aq[1] += zq[1] * a0[1]; aq[2] += zq[2] * a0[2]; aq[3] += zq[3] * a0[3]; aq[4] += zq[4] * a1[0]; aq[5] += zq[5] * a1[1]; aq[6] += zq[6] * a1[2]; aq[7] += zq[7] * a1[3];
                ak[0] += zk[0] * b0[0]; ak[1] += zk[1] * b0[1]; ak[2] += zk[2] * b0[2]; ak[3] += zk[3] * b0[3]; ak[4] += zk[4] * b1[0]; ak[5] += zk[5] * b1[1]; ak[6] += zk[6] * b1[2]; ak[7] += zk[7] * b1[3];
            }
#pragma unroll
            for (int e = 0; e < 8; ++e) { aq[e] = fsilu(aq[e]); ak[e] = fsilu(ak[e]) * 0.125f; }
            nq[blk] += aq[0] * n0[0] + aq[1] * n0[1] + aq[2] * n0[2] + aq[3] * n0[3] + aq[4] * n1[0] + aq[5] * n1[1] + aq[6] * n1[2] + aq[7] * n1[3];
            qcf[blk][s] = pack8(aq[0], aq[1], aq[2], aq[3], aq[4], aq[5], aq[6], aq[7]);
            kcf[blk][s] = pack8(ak[0], ak[1], ak[2], ak[3], ak[4], ak[5], ak[6], ak[7]);
        }
    }
    dma_tile_u(uptr(Z + zc(ZC_MV + h * 64) + row0 * ZRS), dvo, img0);
    bf16x8 cf[2][4];
    { gcp cpb = uptr(F_CPB + ((size_t)cn * 6 + h) * 4096);
#pragma unroll
      for (int vb = 0; vb < 2; ++vb)
#pragma unroll
          for (int s = 0; s < 4; ++s) cf[vb][s] = ldfrag(cpb + ((size_t)32 * vb * 64 + 16 * s) * 2, (unsigned)(r * 64 + 8 * hf) * 2u); }
    bf16x8 pf0[2], pf1[4];
    float den[2] = {0.f, 0.f};
    {
        f32x16 s00, s01, s11;
#pragma unroll
        for (int i = 0; i < 16; ++i) { s00[i] = 0.f; s01[i] = 0.f; s11[i] = 0.f; }
#pragma unroll
        for (int s = 0; s < 4; ++s) { s00 = MFMA32(kcf[0][s], qcf[0][s], s00); s01 = MFMA32(kcf[0][s], qcf[1][s], s01); s11 = MFMA32(kcf[1][s], qcf[1][s], s11); }
#pragma unroll
        for (int i = 0; i < 16; ++i) {
            const int jr = (i & 3) + 8 * (i >> 2) + 4 * hf;
            const float a0 = __shfl(av, jr), a1 = __shfl(av, 32 + jr);
            const float d00 = (jr <= r) ? fexp(a0 - mt[0]) : 0.f, d01 = fexp(a0 - mt[1]), d11 = (jr <= r) ? fexp(a1 - mt[1]) : 0.f;
            s00[i] *= d00; s01[i] *= d01; s11[i] *= d11;
            den[0] += s00[i]; den[1] += s01[i] + s11[i];
        }
        pf0[0] = pack8(s00[0], s00[1], s00[2], s00[3], s00[4], s00[5], s00[6], s00[7]); pf0[1] = pack8(s00[8], s00[9], s00[10], s00[11], s00[12], s00[13], s00[14], s00[15]);
        pf1[0] = pack8(s01[0], s01[1], s01[2], s01[3], s01[4], s01[5], s01[6], s01[7]); pf1[1] = pack8(s01[8], s01[9], s01[10], s01[11], s01[12], s01[13], s01[14], s01[15]);
        pf1[2] = pack8(s11[0], s11[1], s11[2], s11[3], s11[4], s11[5], s11[6], s11[7]); pf1[3] = pack8(s11[8], s11[9], s11[10], s11[11], s11[12], s11[13], s11[14], s11[15]);
    }
#pragma unroll
    for (int tb = 0; tb < 2; ++tb) {
        den[tb] = xh_sum(den[tb]); nq[tb] = xh_sum(nq[tb]);
        den[tb] = fmaxf(fabsf(den[tb] + iw[tb] * nq[tb]), fexp(-(bct[tb] + mt[tb])));
    }
    unsigned trb0, trb1; tr_bases(lane, trb0, trb1);
    f32x16 num[2][2];
#pragma unroll
    for (int vb = 0; vb < 2; ++vb) {
#pragma unroll
        for (int tb = 0; tb < 2; ++tb) {
#pragma unroll
            for (int i = 0; i < 16; ++i) num[vb][tb][i] = 0.f;
#pragma unroll
            for (int s = 0; s < 4; ++s) num[vb][tb] = MFMA32(cf[vb][s], qcf[tb][s], num[vb][tb]);
#pragma unroll
            for (int i = 0; i < 16; ++i) num[vb][tb][i] *= iw[tb];
        }
    }
    asm volatile("s_waitcnt vmcnt(0)" ::: "memory");
#pragma unroll
    for (int vb = 0; vb < 2; ++vb)
#pragma unroll
        for (int ks = 0; ks < 4; ++ks) {
            const bf16x8 vf = tr_frag_b(img0, vb ? trb1 : trb0, ks);
            if (ks < 2) num[vb][0] = MFMA32(vf, pf0[ks], num[vb][0]);
            num[vb][1] = MFMA32(vf, pf1[ks], num[vb][1]);
        }
#pragma unroll
    for (int tb = 0; tb < 2; ++tb) {
        const float rden = 1.0f / den[tb]; float ss = 0.f;
#pragma unroll
        for (int vb = 0; vb < 2; ++vb)
#pragma unroll
            for (int i = 0; i < 16; ++i) { num[vb][tb][i] *= rden; ss += num[vb][tb][i] * num[vb][tb][i]; }
        ss = xh_sum(ss);
        const float rn = 1.0f / sqrtf(ss * (1.0f / 64.0f) + EPS);
#pragma unroll
        for (int vb = 0; vb < 2; ++vb)
#pragma unroll
            for (int i4 = 0; i4 < 4; ++i4) tl_put4(wl, 32 * tb + r, 32 * vb + 8 * i4 + 4 * hf, num[vb][tb][4 * i4] * rn, num[vb][tb][4 * i4 + 1] * rn, num[vb][tb][4 * i4 + 2] * rn, num[vb][tb][4 * i4 + 3] * rn);
    }
    tl_emit<1>(wl, lane, uptr(Z + zc(ZC_MO + h * 64) + row0 * ZRS), uptr(Z + zc(ZC_MG + h * 64) + row0 * ZRS), F_ml_norm_g + layer * 384 + h * 64, (GAS char*)uptr(F_Y + row0 * DM + 384 + h * 64));
}

__device__ __forceinline__ void ml_loc_wave(Frame& F, int layer, int cn, int h, LAS unsigned char* wl) {
    const int lane = F_lane, r = lane & 31, hf = lane >> 5;
    const int b = cn / NCHS, n = cn % NCHS;
    const size_t row0 = (size_t)b * SEQ + (size_t)n * CH;
    const bf16* Z = F_Z;
    LAS unsigned char* img0 = wl; LAS unsigned char* img1 = wl + IMG1;
    const unsigned dvo = dma_voff(lane);
    dma_rows67(uptr(Z + zc(ZC_MK + h * 64) + (row0 - 3) * ZRS), dvo, img0, lane);
    dma_tile_u(uptr(Z + zc(ZC_MV + h * 64) + row0 * ZRS), dvo, img1);
    const int rr = lane >> 3, ch = lane & 7;
    float wk[4][8];
    { const float* cw = F_conv_w + (size_t)layer * 4 * 768 + 384 + h * 64 + ch * 8;
#pragma unroll
      for (int j = 0; j < 4; ++j) { const f32x4 a = *(const f32x4*)(cw + j * 768), c = *(const f32x4*)(cw + j * 768 + 4);
          wk[j][0] = a[0]; wk[j][1] = a[1]; wk[j][2] = a[2]; wk[j][3] = a[3]; wk[j][4] = c[0]; wk[j][5] = c[1]; wk[j][6] = c[2]; wk[j][7] = c[3]; } }
    const float* g32 = F_G32 + (row0 + lane) * 32;
    const float ig = g32[h] + F_b_gates[layer * 12 + h];
    const float lf = logsigf(g32[6 + h] + F_b_gates[layer * 12 + 6 + h]);
    const float bc = wave_scan_add(lf, lane);
    const float g = __shfl(bc, 63);
    const float av = g - bc + ig;
    const float mloc = wave_max(av);
    const float w = fexp(av - mloc);
    asm volatile("s_waitcnt vmcnt(0)" ::: "memory");
    float nacc[8];
#pragma unroll
    for (int e = 0; e < 8; ++e) nacc[e] = 0.f;
#pragma unroll
    for (int hb = 0; hb < 2; ++hb) {
        v4u raw[4][4], rv[4]; float wr[4];
#pragma unroll
        for (int i = 0; i < 4; ++i) { const int row = 8 * (4 * hb + i) + rr;
#pragma unroll
            for (int j = 0; j < 4; ++j) raw[i][j] = *(LAS const v4u*)(img0 + tile_off(row + j, ch * 16));
            rv[i] = *(LAS const v4u*)(img1 + tile_off(row, ch * 16)); wr[i] = __shfl(w, row); }
        asm volatile("" : "+v"(raw[0][0]), "+v"(raw[0][1]), "+v"(raw[0][2]), "+v"(raw[0][3]), "+v"(raw[1][0]), "+v"(raw[1][1]), "+v"(raw[1][2]), "+v"(raw[1][3]), "+v"(rv[0]), "+v"(rv[1]), "+v"(wr[0]), "+v"(wr[1]));
        asm volatile("" : "+v"(raw[2][0]), "+v"(raw[2][1]), "+v"(raw[2][2]), "+v"(raw[2][3]), "+v"(raw[3][0]), "+v"(raw[3][1]), "+v"(raw[3][2]), "+v"(raw[3][3]), "+v"(rv[2]), "+v"(rv[3]), "+v"(wr[2]), "+v"(wr[3]));
#pragma unroll
        for (int i = 0; i < 4; ++i) { const int row = 8 * (4 * hb + i) + rr;
            float acc[8];
#pragma unroll
            for (int e = 0; e < 8; ++e) acc[e] = 0.f;
#pragma unroll
            for (int j = 0; j < 4; ++j) {
                v4u rw_ = raw[i][j];
                if (n == 0 && row + j < 3) rw_ = (v4u){0u, 0u, 0u, 0u};
                float z[8]; unpack8(rw_, z);
#pragma unroll
                for (int e = 0; e < 8; ++e) acc[e] += z[e] * wk[j][e];
            }
            float kc[8], v8[8]; unpack8(rv[i], v8);
#pragma unroll
            for (int e = 0; e < 8; ++e) { kc[e] = fsilu(acc[e]) * 0.125f; nacc[e] += wr[i] * kc[e]; }
            const int lo = tile_off(row, ch * 16);
            *(LAS v4u*)(img0 + lo) = __builtin_bit_cast(v4u, pack8(kc[0], kc[1], kc[2], kc[3], kc[4], kc[5], kc[6], kc[7]));
            *(LAS v4u*)(img1 + lo) = __builtin_bit_cast(v4u, pack8(v8[0] * wr[i], v8[1] * wr[i], v8[2] * wr[i], v8[3] * wr[i], v8[4] * wr[i], v8[5] * wr[i], v8[6] * wr[i], v8[7] * wr[i]));
        }
    }
#pragma unroll
    for (int e = 0; e < 8; ++e) { nacc[e] += __shfl_xor(nacc[e], 8); nacc[e] += __shfl_xor(nacc[e], 16); nacc[e] += __shfl_xor(nacc[e], 32); }
    if (rr == 0) { f32x4* np_ = (f32x4*)(F_NST + ((size_t)cn * 6 + h) * 64 + ch * 8); np_[0] = (f32x4){nacc[0], nacc[1], nacc[2], nacc[3]}; np_[1] = (f32x4){nacc[4], nacc[5], nacc[6], nacc[7]}; }
    unsigned trb0, trb1; tr_bases(lane, trb0, trb1);
    f32x16 acc[2][2];
#pragma unroll
    for (int a = 0; a < 2; ++a)
#pragma unroll
        for (int c = 0; c < 2; ++c)
#pragma unroll
            for (int i = 0; i < 16; ++i) acc[a][c][i] = 0.f;
#pragma unroll
    for (int ks = 0; ks < 4; ++ks) {
        const bf16x8 v0 = tr_frag_b(img1, trb0, ks), v1 = tr_frag_b(img1, trb1, ks), k0 = tr_frag_b(img0, trb0, ks), k1 = tr_frag_b(img0, trb1, ks);
        acc[0][0] = MFMA32(k0, v0, acc[0][0]); acc[0][1] = MFMA32(k0, v1, acc[0][1]); acc[1][0] = MFMA32(k1, v0, acc[1][0]); acc[1][1] = MFMA32(k1, v1, acc[1][1]);
    }
    bf16* cst = (bf16*)F_CST + ((size_t)cn * 6 + h) * 4096;
#pragma unroll
    for (int kb = 0; kb < 2; ++kb)
#pragma unroll
        for (int vb = 0; vb < 2; ++vb)
#pragma unroll
            for (int i4 = 0; i4 < 4; ++i4)
                *(unsigned long long*)(cst + (32 * vb + r) * 64 + 32 * kb + 8 * i4 + 4 * hf) =
                    (unsigned long long)cvtpk(acc[kb][vb][4 * i4], acc[kb][vb][4 * i4 + 1]) | ((unsigned long long)cvtpk(acc[kb][vb][4 * i4 + 2], acc[kb][vb][4 * i4 + 3]) << 32);
    if (lane == 0) { F_GS[cn * 6 + h] = g; F_MS[cn * 6 + h] = mloc; }
}

__device__ __forceinline__ float flogsig(float x) { return fminf(x, 0.f) - 0.6931471805599453f * __builtin_amdgcn_logf(1.0f + fexp(-fabsf(x))); }
__device__ __forceinline__ void gla_loc_wave(Frame& F, int layer, int cn, int hh, LAS unsigned char* wl) {
    const int lane = F_lane, hf = lane >> 5;
    const int b = cn / NCHS, n = cn % NCHS;
    const size_t row0 = (size_t)b * SEQ + (size_t)n * CH, row = row0 + lane;
    const bf16* Z = F_Z;
    dma_tile_u(uptr(Z + zc(ZC_GV + hh * 64) + row0 * ZRS), dma_voff(lane), wl + 8192);
    float ga[16];
    { const f32x4* gp = (const f32x4*)(F_G32 + row * 32 + 12);
#pragma unroll
      for (int q = 0; q < 4; ++q) { const f32x4 v = gp[q]; ga[4 * q] = v[0]; ga[4 * q + 1] = v[1]; ga[4 * q + 2] = v[2]; ga[4 * q + 3] = v[3]; } }
    const float* wa = F_w_alpha + (size_t)layer * 16 * 128 + hh * 32; const float* ba = F_b_alpha + layer * 128 + hh * 32;
    LAS float* wsl = (LAS float*)(wl + 16384);
    float tw_[8];
#pragma unroll
    for (int k = 0; k < 8; ++k) { const int i = lane + 64 * k; tw_[k] = wa[(i >> 5) * 128 + (i & 31)]; }
#pragma unroll
    for (int k = 0; k < 8; ++k) wsl[lane + 64 * k] = tw_[k];
    float bcv[32];
    {
        f32x4 a[8];
#pragma unroll
        for (int d4 = 0; d4 < 8; ++d4) a[d4] = *(const f32x4*)(ba + 4 * d4);
#pragma unroll
        for (int q = 0; q < 16; ++q) {
            f32x4 w_[8];
#pragma unroll
            for (int d4 = 0; d4 < 8; ++d4) w_[d4] = *(LAS const f32x4*)(wsl + q * 32 + 4 * d4);
            asm volatile("" : "+v"(w_[0]), "+v"(w_[1]), "+v"(w_[2]), "+v"(w_[3]), "+v"(w_[4]), "+v"(w_[5]), "+v"(w_[6]), "+v"(w_[7]));
#pragma unroll
            for (int d4 = 0; d4 < 8; ++d4) a[d4] += w_[d4] * ga[q];
        }
#pragma unroll
        for (int d4 = 0; d4 < 8; ++d4)
#pragma unroll
            for (int e = 0; e < 4; ++e) bcv[4 * d4 + e] = wave_scan_add(flogsig(a[d4][e]) * (1.0f / 16.0f), lane);
    }
    { f32x4* bp = (f32x4*)(F_BC + row * 128 + hh * 32);
#pragma unroll
      for (int q = 0; q < 8; ++q) bp[q] = (f32x4){bcv[4 * q], bcv[4 * q + 1], bcv[4 * q + 2], bcv[4 * q + 3]}; }
#pragma unroll
    for (int c = 0; c < 4; ++c) {
        float k8[8]; unpack8(*(const v4u*)(Z + zc(ZC_GK + hh * 32) + row * ZRS + 8 * c), k8);
#pragma unroll
        for (int e = 0; e < 8; ++e) k8[e] *= fexp(__shfl(bcv[8 * c + e], 63) - bcv[8 * c + e]);
        *(LAS v4u*)(wl + tile_off(lane, c * 16)) = __builtin_bit_cast(v4u, pack8(k8[0], k8[1], k8[2], k8[3], k8[4], k8[5], k8[6], k8[7]));
    }
    if (lane == 63) { f32x4* ap = (f32x4*)(F_ADEC + ((size_t)cn * 4 + hh) * 32);
#pragma unroll
        for (int q = 0; q < 8; ++q) ap[q] = (f32x4){fexp(bcv[4 * q]), fexp(bcv[4 * q + 1]), fexp(bcv[4 * q + 2]), fexp(bcv[4 * q + 3])}; }
    unsigned trb0, trb1; tr_bases(lane, trb0, trb1);
    f32x16 u0, u1;
#pragma unroll
    for (int i = 0; i < 16; ++i) { u0[i] = 0.f; u1[i] = 0.f; }
    asm volatile("s_waitcnt vmcnt(0)" ::: "memory");
#pragma unroll
    for (int ks = 0; ks < 4; ++ks) { const bf16x8 kd = tr_frag_b(wl, trb0, ks);
        u0 = MFMA32(tr_frag_b(wl + 8192, trb0, ks), kd, u0); u1 = MFMA32(tr_frag_b(wl + 8192, trb1, ks), kd, u1); }
    float* sst = F_SST + ((size_t)cn * 4 + hh) * 2048;
#pragma unroll
    for (int i = 0; i < 16; ++i) { const int v = (i & 3) + 8 * (i >> 2) + 4 * hf; sst[v * 32 + (lane & 31)] = u0[i]; sst[(32 + v) * 32 + (lane & 31)] = u1[i]; }
}

__device__ __forceinline__ void gla_out_wave(Frame& F, int layer, int cn, int hh, LAS unsigned char* wl) {
    const int lane = F_lane, r = lane & 31, hf = lane >> 5;
    const int b = cn / NCHS, n = cn % NCHS;
    const size_t row0 = (size_t)b * SEQ + (size_t)n * CH;
    const bf16* Z = F_Z;
    dma_tile_u(uptr(Z + zc(ZC_GV + hh * 64) + row0 * ZRS), dma_voff(lane), wl);
    const unsigned voffK = (unsigned)(r * ZRS + 8 * hf) * 2u, voffB = (unsigned)(r * 128 + 8 * hf) * 4u;
    gcp zq = uptr(Z + zc(ZC_GQ + hh * 32) + row0 * ZRS); gcp zk = uptr(Z + zc(ZC_GK + hh * 32) + row0 * ZRS); gcp bcb = uptr(F_BC + row0 * 128 + hh * 32);
    bf16x8 qf[2][2], kf[2][2];
    {
        v4u rq[2][2], rk[2][2]; f32x4 rc0[2][2], rc1[2][2];
#pragma unroll
        for (int blk = 0; blk < 2; ++blk)
#pragma unroll
            for (int s = 0; s < 2; ++s) {
                rq[blk][s] = *(const GAS v4u*)(zq + ((size_t)32 * blk * ZRS + 16 * s) * 2 + voffK); rk[blk][s] = *(const GAS v4u*)(zk + ((size_t)32 * blk * ZRS + 16 * s) * 2 + voffK);
                rc0[blk][s] = *(const GAS f32x4*)(bcb + ((size_t)32 * blk * 128 + 16 * s) * 4 + voffB); rc1[blk][s] = *(const GAS f32x4*)(bcb + ((size_t)32 * blk * 128 + 16 * s) * 4 + voffB + 16);
            }
        asm volatile("" : "+v"(rq[0][0]), "+v"(rq[0][1]), "+v"(rq[1][0]), "+v"(rq[1][1]), "+v"(rk[0][0]), "+v"(rk[0][1]), "+v"(rk[1][0]), "+v"(rk[1][1]));
        asm volatile("" : "+v"(rc0[0][0]), "+v"(rc0[0][1]), "+v"(rc0[1][0]), "+v"(rc0[1][1]), "+v"(rc1[0][0]), "+v"(rc1[0][1]), "+v"(rc1[1][0]), "+v"(rc1[1][1]));
#pragma unroll
        for (int blk = 0; blk < 2; ++blk)
#pragma unroll
            for (int s = 0; s < 2; ++s) {
                float q8[8], k8[8];
                unpack8(rq[blk][s], q8); unpack8(rk[blk][s], k8);
                const f32x4 c0 = rc0[blk][s], c1 = rc1[blk][s];
                const float bc8[8] = {c0[0], c0[1], c0[2], c0[3], c1[0], c1[1], c1[2], c1[3]};
#pragma unroll
                for (int e = 0; e < 8; ++e) { q8[e] *= 0.17677669529663687f * fexp(bc8[e]); k8[e] *= fexp(-bc8[e]); }
                qf[blk][s] = pack8(q8[0], q8[1], q8[2], q8[3], q8[4], q8[5], q8[6], q8[7]);
                kf[blk][s] = pack8(k8[0], k8[1], k8[2], k8[3], k8[4], k8[5], k8[6], k8[7]);
            }
    }
    bf16x8 pf0[2], pf1[4];
    {
        f32x16 s00, s01, s11;
#pragma unroll
        for (int i = 0; i < 16; ++i) { s00[i] = 0.f; s01[i] = 0.f; s11[i] = 0.f; }
#pragma unroll
        for (int s = 0; s < 2; ++s) { s00 = MFMA32(kf[0][s], qf[0][s], s00); s01 = MFMA32(kf[0][s], qf[1][s], s01); s11 = MFMA32(kf[1][s], qf[1][s], s11); }
#pragma unroll
        for (int i = 0; i < 16; ++i) { const int jr = (i & 3) + 8 * (i >> 2) + 4 * hf; if (jr > r) { s00[i] = 0.f; s11[i] = 0.f; } }
        pf0[0] = pack8(s00[0], s00[1], s00[2], s00[3], s00[4], s00[5], s00[6], s00[7]); pf0[1] = pack8(s00[8], s00[9], s00[10], s00[11], s00[12], s00[13], s00[14], s00[15]);
        pf1[0] = pack8(s01[0], s01[1], s01[2], s01[3], s01[4], s01[5], s01[6], s01[7]); pf1[1] = pack8(s01[8], s01[9], s01[10], s01[11], s01[12], s01[13], s01[14], s01[15]);
        pf1[2] = pack8(s11[0], s11[1], s11[2], s11[3], s11[4], s11[5], s11[6], s11[7]); pf1[3] = pack8(s11[8], s11[9], s11[10], s11[11], s11[12], s11[13], s11[14], s11[15]);
    }
    unsigned trb0, trb1; tr_bases(lane, trb0, trb1);
    gcp spb = uptr(F_SPB + ((size_t)cn * 4 + hh) * 2048);
    f32x16 num[2][2];
#pragma unroll
    for (int vb = 0; vb < 2; ++vb) {
        bf16x8 sf[2];
#pragma unroll
        for (int s = 0; s < 2; ++s) sf[s] = ldfrag(spb + ((size_t)32 * vb * 32 + 16 * s) * 2, (unsigned)(r * 32 + 8 * hf) * 2u);
#pragma unroll
        for (int tb = 0; tb < 2; ++tb) {
#pragma unroll
            for (int i = 0; i < 16; ++i) num[vb][tb][i] = 0.f;
#pragma unroll
            for (int s = 0; s < 2; ++s) num[vb][tb] = MFMA32(sf[s], qf[tb][s], num[vb][tb]);
        }
    }
    asm volatile("s_waitcnt vmcnt(0)" ::: "memory");
#pragma unroll
    for (int vb = 0; vb < 2; ++vb)
#pragma unroll
        for (int ks = 0; ks < 4; ++ks) {
            const bf16x8 vf = tr_frag_b(wl, vb ? trb1 : trb0, ks);
            if (ks < 2) num[vb][0] = MFMA32(vf, pf0[ks], num[vb][0]);
            num[vb][1] = MFMA32(vf, pf1[ks], num[vb][1]);
        }
#pragma unroll
    for (int tb = 0; tb < 2; ++tb) {
        float ss = 0.f;
#pragma unroll
        for (int vb = 0; vb < 2; ++vb)
#pragma unroll
            for (int i = 0; i < 16; ++i) ss += num[vb][tb][i] * num[vb][tb][i];
        ss = xh_sum(ss);
        const float rn = 1.0f / sqrtf(ss * (1.0f / 64.0f) + EPS);
#pragma unroll
        for (int vb = 0; vb < 2; ++vb)
#pragma unroll
            for (int i4 = 0; i4 < 4; ++i4) tl_put4(wl, 32 * tb + r, 32 * vb + 8 * i4 + 4 * hf, num[vb][tb][4 * i4] * rn, num[vb][tb][4 * i4 + 1] * rn, num[vb][tb][4 * i4 + 2] * rn, num[vb][tb][4 * i4 + 3] * rn);
    }
    tl_emit<2>(wl, lane, uptr(Z + zc(ZC_GG + hh * 64) + row0 * ZRS), (gcp)nullptr, F_gla_norm_g + layer * 256 + hh * 64, (GAS char*)uptr(F_Y + row0 * DM + 768 + hh * 64));
}

__device__ __forceinline__ void p2_local(Frame& F, int layer, int part) {
    int gw_ = F.vcu * NWAVES + F.wave; if (F.G * NWAVES == 2048) gw_ = F.wave < 6 ? F.vcu * 6 + F.wave : NCHT * 6 + F.vcu * 2 + (F.wave - 6);
    asm volatile("" : "+s"(gw_));
    const int gw = gw_, NGW = F.G * NWAVES;
    LAS unsigned char* wl = F.lds + RING_OFF + F.wave * WL_BYTES;
    constexpr int NA = NCHT * 6, NL = NCHT * 10;
    if (NGW == 2048) {
#define LOCAL_TASK(q) do { const int q_ = (q); __builtin_amdgcn_s_setprio(2); if (q_ < NA) ml_loc_wave(F, layer, q_ / 6, q_ % 6, wl); else gla_loc_wave(F, layer, (q_ - NA) >> 2, (q_ - NA) & 3, wl); __builtin_amdgcn_s_setprio(0); } while (0)
#if PROBE_T >= 61 && PROBE_T <= 79
        const unsigned long long tq0_ = __builtin_amdgcn_s_memrealtime();
#endif
        if (part == 0) {
            if (gw < NA) {
                const bool swap_ = true;
                const bool has_loc_ = F.wave >= 4;
#pragma unroll 1
                for (int st_ = 0; st_ < 2; ++st_) { if ((st_ == 0) != swap_) { if (has_loc_) LOCAL_TASK(gw); } else { if (has_loc_) __builtin_amdgcn_s_setprio(1); attn_wave(F, layer, gw / 6, gw % 6, wl); __builtin_amdgcn_s_setprio(0); } }
            } else { const int q0 = NA + 2 * (gw - NA), m0 = F.vcu * 6 + 2 * (F.wave - 6);
#pragma unroll 1
                     for (int i = 0; i < 4; ++i) LOCAL_TASK(i < 2 ? q0 + i : m0 + i - 2); }
        } else p3_scan(F, F.vcu, F.G);
#if PROBE_T >= 61 && PROBE_T <= 79
        { const unsigned dt_ = (unsigned)(__builtin_amdgcn_s_memrealtime() - tq0_);
          if (layer == 0 && F_lane == 0) {
              if (PROBE_T == 61 && part == 0 && gw < NA) atomicAdd((unsigned*)(F_ctl + 2048), dt_ >> 4);
              if (PROBE_T == 62 && part == 0 && gw >= NA) atomicAdd((unsigned*)(F_ctl + 2048), dt_ >> 4);
              if (PROBE_T == 63 && part == 0 && gw < NA) atomicMax((unsigned*)(F_ctl + 2048), dt_ * 10u);
              if (PROBE_T == 64 && part == 0 && gw >= NA) atomicMax((unsigned*)(F_ctl + 2048), dt_ * 10u);
              if (PROBE_T == 65 && part == 1 && gw < NA) atomicMax((unsigned*)(F_ctl + 2048), dt_ * 10u);
              if (PROBE_T == 67 && part == 0 && gw < NA) atomicMax((unsigned*)(F_ctl + 2048), (dt_ << 11) | (unsigned)gw);
              if (PROBE_T == 68 && part == 0 && gw < NA && gw >= 8) atomicMax((unsigned*)(F_ctl + 2048), (dt_ << 11) | (unsigned)gw);
              if (PROBE_T == 69 && part == 0 && gw < NA && gw >= 8) atomicMax((unsigned*)(F_ctl + 2048), dt_ * 10u);
              if (PROBE_T == 70 && part == 1 && gw < NA) atomicMax((unsigned*)(F_ctl + 2048), (dt_ << 11) | (unsigned)gw);
              if (PROBE_T == 71 && part == 1 && gw < NA) atomicMin((unsigned*)(F_ctl + 2050), (dt_ << 11) | (unsigned)gw);
              if (PROBE_T == 72 && part == 1 && gw < NA && dt_ > 4000u) atomicAdd((unsigned*)(F_ctl + 2048), 100u);
              if (PROBE_T == 73 && part == 1 && gw < NA && dt_ > 3600u) atomicAdd((unsigned*)(F_ctl + 2048), 100u);
              if (PROBE_T == 74 && part == 1 && gw < NA && gw >= 1280 && dt_ > 4000u) atomicAdd((unsigned*)(F_ctl + 2048), 100u);
              if (PROBE_T == 75 && part == 1 && gw < NA && (gw & 7) == 7 && dt_ > 4000u) atomicAdd((unsigned*)(F_ctl + 2048), 100u);
              if (PROBE_T == 66 && part == 1 && gw >= NA) atomicMax((unsigned*)(F_ctl + 2048), dt_ * 10u);
          } }
#endif
#undef LOCAL_TASK
    } else {
        if (part == 0) { for (int a = gw; a < NA; a += NGW) attn_wave(F, layer, a / 6, a % 6, wl);
            for (int q = gw; q < NL; q += NGW) { if (q < NA) ml_loc_wave(F, layer, q / 6, q % 6, wl); else gla_loc_wave(F, layer, (q - NA) >> 2, (q - NA) & 3, wl); } }
        else p3_scan(F, F.vcu, F.G);
    }
}
__device__ __forceinline__ void p4_outputs(Frame& F, int layer) {
    int gw_ = F.vcu * NWAVES + F.wave; if (F.G * NWAVES == 2048) gw_ = F.wave < 6 ? F.vcu * 6 + F.wave : NCHT * 6 + F.vcu * 2 + (F.wave - 6);
    asm volatile("" : "+s"(gw_));
    const int gw = gw_, NGW = F.G * NWAVES;
    LAS unsigned char* wl = F.lds + RING_OFF + F.wave * WL_BYTES;
    constexpr int NA = NCHT * 6, NG = NCHT * 4;
    if (NGW == 2048) {
        if (gw < NA) { ml_out_wave(F, layer, gw / 6, gw % 6, wl);
#if PROBE_DUP == 8
            ml_out_wave(F, layer, gw / 6, gw % 6, wl);
#endif
        }
        else { __builtin_amdgcn_s_setprio(2); for (int q = gw - NA; q < NG; q += 512) gla_out_wave(F, layer, q >> 2, q & 3, wl); __builtin_amdgcn_s_setprio(0);
#if PROBE_DUP == 9
            for (int q = gw - NA; q < NG; q += 512) gla_out_wave(F, layer, q >> 2, q & 3, wl);
#endif
        }
    } else {
        for (int a = gw; a < NA; a += NGW) ml_out_wave(F, layer, a / 6, a % 6, wl);
        for (int q = gw; q < NG; q += NGW) gla_out_wave(F, layer, q >> 2, q & 3, wl);
    }
}

__device__ __forceinline__ void p11_final(Frame& F) {
    int gw_ = F.vcu * NWAVES + F.wave; asm volatile("" : "+s"(gw_));
    const int gw = gw_, NGW = F.G * NWAVES;
    const float* ssq = F_SSQ + 2 * T;
    f32x4 g[4];
    { const GAS f32x4* gr = (const GAS f32x4*)F_final_g + F_lane;
#pragma unroll
      for (int j = 0; j < 4; ++j) g[j] = gr[64 * j]; }
    for (int m0 = gw; m0 < T; m0 += 4 * NGW) {
        unsigned long long w[4][4]; float sq[4];
#pragma unroll
        for (int i = 0; i < 4; ++i) { const int m = (m0 + i * NGW < T) ? m0 + i * NGW : m0;
            const GAS unsigned long long* xr = (const GAS unsigned long long*)(F_XB + (size_t)m * DM) + F_lane;
            sq[i] = ssq[m];
#pragma unroll
            for (int j = 0; j < 4; ++j) w[i][j] = xr[64 * j]; }
        asm volatile("" : "+v"(w[0][0]), "+v"(w[0][1]), "+v"(w[0][2]), "+v"(w[0][3]), "+v"(w[1][0]), "+v"(w[1][1]), "+v"(w[1][2]), "+v"(w[1][3]), "+v"(sq[0]), "+v"(sq[1]));
        asm volatile("" : "+v"(w[2][0]), "+v"(w[2][1]), "+v"(w[2][2]), "+v"(w[2][3]), "+v"(w[3][0]), "+v"(w[3][1]), "+v"(w[3][2]), "+v"(w[3][3]), "+v"(sq[2]), "+v"(sq[3]));
#pragma unroll
        for (int i = 0; i < 4; ++i) { const int m = m0 + i * NGW;
            if (m < T) {
                const float rs = 1.0f / sqrtf(sq[i] * (1.0f / 1024.0f) + EPS);
                GAS f32x4* orow = (GAS f32x4*)(F_out + (size_t)m * DM) + F_lane;
#pragma unroll
                for (int j = 0; j < 4; ++j) { const unsigned long long ww = w[i][j];
                    const f32x4 v = (f32x4){__uint_as_float((unsigned)ww << 16), __uint_as_float((unsigned)ww & 0xffff0000u), __uint_as_float((unsigned)(ww >> 32) << 16), __uint_as_float((unsigned)(ww >> 32) & 0xffff0000u)};
                    orow[64 * j] = v * rs * g[j]; }
            } }
    }
}

__global__ void __launch_bounds__(NTHR, 2) hymba_fwd(Args args) {
    extern __shared__ __attribute__((aligned(16))) unsigned char lds[];
    Frame F;
    F.lds = (LAS unsigned char*)lds;
    F.MISC = (volatile LAS unsigned*)(F.lds + MISC_OFF);
    F.wave = __builtin_amdgcn_readfirstlane(F_tid >> 6);
    F.G = gridDim.x; { const int bx = blockIdx.x; F.vcu = (F.G % 8 == 0) ? (bx % 8) * (F.G / 8) + bx / 8 : bx; }
    F.A = &args;
    for (int u = F_tid; u < (LDS_BYTES - LDSCTL_OFF) / 4; u += NTHR) ((LAS unsigned*)(F.lds + LDSCTL_OFF))[u] = 0u;
    __syncthreads();
    XcdBarrier bar; bar.bar = (unsigned*)(F_ctl + CW_BAR); bar.x = 0; bar.st = nullptr;
    if (N_LAUNCHES == 1) bar = xcd_barrier_post((unsigned*)(F_ctl + CW_BAR), F.MISC + 8);
#define GRID_BAR() do { if (N_LAUNCHES == 1) { XcdBarrier b2_ = bar; unsigned long long v_ = (unsigned long long)bar.bar; asm volatile("" : "+s"(v_)); b2_.bar = (unsigned*)v_; xcd_barrier(b2_); } } while (0)
#if PROBE_T == 16 || PROBE_T == 17
    const unsigned long long tk0_ = __builtin_amdgcn_s_memrealtime();
#endif
    const int lo = args.ph_lo, hi = args.ph_hi;
    const bool fuse_fin = (N_LAUNCHES == 1 && F.G == 256);
#if PROBE_T >= 40 && PROBE_T < 60
    unsigned tph_ = 0;
#endif
#pragma unroll 1
    for (int ph = lo; ph < hi; ++ph) {
#if PROBE_T >= 40 && PROBE_T < 60
        const unsigned long long tp0_ = __builtin_amdgcn_s_memrealtime();
#endif
        if (ph == 0) { p0_prologue(F);
#if PROBE_DUP == 4
            GRID_BAR(); p0_prologue(F);
#endif
        } else if (ph == NPHASE - 1) { if (!fuse_fin) p11_final(F);
        } else {
            const int layer = (ph - 1) / 5, k = (ph - 1) % 5;
            if (k == 0 || k == 4) {
                const int which = k ? 1 : 0, N = which ? DM : NP;
                pg8::Gemm g{which ? F_Y : F_XB, which ? F_Wout_t + (size_t)layer * DM * DM : F_Win_t + (size_t)layer * NP * DM, T, N, DM};
                const pg8::EpiZ EZ{F_Z, LDZ, F_SSQ + layer * T, F_G32, ZC_SM};
                if (fuse_fin && which == 1 && layer == DEPTH - 1) {
                    pg8::EpiBothT<true> EF{1, EZ, pg8::EpiResT<true>{(const float*)nullptr, (const bf16*)F_XB, (float*)nullptr, (bf16*)nullptr, F_SSQ + (layer + 1) * T, F_final_g, F_out, (unsigned*)(F_ctl + CW_FIN)}};
                    pg8::StaticOrder S; S.init(T, N, F.G, (int)blockIdx.x, 0);
                    pg8::gemm_phase<pg8::EpiBothT<true>, pg8::StaticOrder, true, true, false>(F.lds + RING_OFF, g, S, EF);
                } else {
                pg8::EpiBoth E{which, EZ,
                               pg8::EpiRes{(const float*)nullptr, (const bf16*)F_XB, (float*)nullptr, F_XB, F_SSQ + (layer + 1) * T, (const float*)nullptr, (float*)nullptr, (unsigned*)nullptr}};
                const bool split = (which == 0 && F.G == 256);
                { pg8::StaticOrder S; S.init(T, N, F.G, (int)blockIdx.x, split ? 1 : 0);
                  pg8::gemm_phase<pg8::EpiBoth, pg8::StaticOrder, true, true, false>(F.lds + RING_OFF, g, S, E); }
                if (split) {
                    pg8::StaticOrder S; S.init(T, N, F.G, (int)blockIdx.x, 2);
                    pg8::gemm_phase<pg8::EpiBoth, pg8::StaticOrder, true, true, true>(F.lds + RING_OFF, g, S, E);
                    if (ph == 1 && (int)blockIdx.x >= 128) { int wi_ = ((int)blockIdx.x - 128) * NWAVES + F.wave; asm volatile("" : "+s"(wi_)); p0_weights(F, 1, wi_, 128 * NWAVES); }
                }
                }
            } else if (k == 1 || k == 2) { int part_ = k - 1; asm volatile("" : "+s"(part_)); p2_local(F, layer, part_);
            } else { p4_outputs(F, layer);
#if PROBE_DUP == 3
                GRID_BAR(); p4_outputs(F, layer);
#endif
            }
        }
        if (ph + 1 < hi && !(fuse_fin && ph == NPHASE - 2)) GRID_BAR();
#if PROBE_T >= 40 && PROBE_T < 60
        if (ph == PROBE_T - 40) tph_ = (unsigned)(__builtin_amdgcn_s_memrealtime() - tp0_);
#endif
    }
#if PROBE_T
    if (F.vcu == 100 && F.wave == 0) { unsigned n_ = __hip_atomic_load((unsigned*)(F_ctl + 2048), __ATOMIC_RELAXED, __HIP_MEMORY_SCOPE_AGENT);
#if PROBE_T == 16
        n_ = (unsigned)((__builtin_amdgcn_s_memrealtime() - tk0_) >> 1);
#endif
        if (PROBE_T == 13 || PROBE_T == 67 || PROBE_T == 68 || PROBE_T == 70) n_ = (n_ & 2047u) * 50u;
        if (PROBE_T >= 21 && PROBE_T <= 39) n_ = __hip_atomic_load((unsigned*)(F_ctl + 2049), __ATOMIC_RELAXED, __HIP_MEMORY_SCOPE_AGENT) * 10u;
#if PROBE_T >= 40 && PROBE_T < 60
        n_ = tph_ * 10u;
#endif
        const unsigned long long t0_ = __builtin_amdgcn_s_memrealtime(); while (__builtin_amdgcn_s_memrealtime() - t0_ < n_) __builtin_amdgcn_s_sleep(8); }
#endif
}

extern "C" void kernel_launch(void* const* d_in, const int* in_sizes, int n_in, void* d_out, int out_size, void* d_ws, size_t ws_size, hipStream_t stream) {
    static int grid = 0;
    if (grid == 0) {
        if (n_in != 12 || in_sizes[0] != T * DM || out_size != T * DM || ws_size < WS_END) {
            fprintf(stderr, "kernel_launch: unexpected shapes (n_in %d, in0 %d, out %d, ws %zu, need %zu); nothing launched\n", n_in, n_in > 0 ? in_sizes[0] : -1, out_size, ws_size, (size_t)WS_END); grid = -1; return; }
        int dev = 0, cus = 0, per_cu = 0;
        if (hipGetDevice(&dev) != hipSuccess || hipDeviceGetAttribute(&cus, hipDeviceAttributeMultiprocessorCount, dev) != hipSuccess) { fprintf(stderr, "kernel_launch: device query failed\n"); grid = -1; return; }
        if (hipFuncSetAttribute((const void*)hymba_fwd, hipFuncAttributeMaxDynamicSharedMemorySize, LDS_BYTES) != hipSuccess) { fprintf(stderr, "kernel_launch: hipFuncSetAttribute failed\n"); grid = -1; return; }
        if (hipOccupancyMaxActiveBlocksPerMultiprocessor(&per_cu, (const void*)hymba_fwd, NTHR, LDS_BYTES) != hipSuccess || per_cu < 1) {
            fprintf(stderr, "kernel_launch: occupancy query reports %d workgroups per CU; nothing launched\n", per_cu); (void)hipGetLastError(); grid = -1; return; }
        grid = cus;
        fprintf(stderr, "kernel_launch: grid %d x %d threads, %d B LDS, occupancy query %d/CU\n", grid, NTHR, LDS_BYTES, per_cu);
    }
    if (grid < 0) return;
    if (hipMemsetAsync((char*)d_ws + WS_CTL, 0, CTL_ZERO_BYTES, stream) != hipSuccess) { fprintf(stderr, "kernel_launch: memset failed\n"); return; }
    Args a{};
    for (int i = 0; i < 12; ++i) a.in[i] = (const float*)d_in[i];
    a.out = (float*)d_out; a.ws = (unsigned char*)d_ws;
    if (N_LAUNCHES == 1) {
        a.ph_lo = 0; a.ph_hi = NPHASE; a.li = 0;
        void* kargs[] = {&a};
        hipError_t e = hipLaunchCooperativeKernel((const void*)hymba_fwd, dim3(grid), dim3(NTHR), kargs, LDS_BYTES, stream);
        if (e != hipSuccess) fprintf(stderr, "kernel_launch: cooperative launch failed: %s\n", hipGetErrorString(e));
    } else {
        for (int p = 0; p < NPHASE; ++p) { a.ph_lo = p; a.ph_hi = p + 1; a.li = p;
            hipLaunchKernelGGL(hymba_fwd, dim3(grid), dim3(NTHR), LDS_BYTES, stream, a);
            if (hipPeekAtLastError() != hipSuccess) { fprintf(stderr, "kernel_launch: launch %d failed\n", p); break; } }
    }
}
```
